# Optimizing an MI355X kernel written in HIP

```python
import jax, jax.numpy as jnp
from jax import lax
import numpy as np

D_MODEL = 1024
BATCH = 32
SEQ = 256
DEPTH = 2
DEC_BATCH = 2
DEC_SEQ = 4096
PAST_LEN = 512

GRID_W = 64
N_EVEN = (DEPTH + 1) // 2
N_ODD = DEPTH // 2
FN_GROUPS = 4
FN_CH = D_MODEL // 2 // FN_GROUPS
FN_WIDTH = FN_GROUPS * FN_CH
NA_HEADS = 8
NA_HEAD_DIM = D_MODEL // 2 // NA_HEADS
NA_WIDTH = NA_HEADS * NA_HEAD_DIM
WIN_R = 8
WIN_C = 16
Q_BLOCK = 128
EVEN_IN = 2 * FN_WIDTH + 4 * NA_WIDTH
RW_HEAD_DIM = 64
RW_HEADS = D_MODEL // RW_HEAD_DIM
DECAY_LORA = 64
AAA_LORA = 64
GATE_LORA = 128
N_LERP = 6
DECAY_SCALE = 0.606531
ALPHA = (2 * DEPTH) ** 0.25
BETA = (8 * DEPTH) ** -0.25
LN_EPS = 1e-6
GN_EPS = 64e-5
NEG_INF = -1e30

kernel_name = 'hybrid_fnet_natten_rwkv7_diffusion_step'


def layer_norm(x, g=None, b=None, eps=LN_EPS):
    xf = x.astype(jnp.float32)
    mu = xf.mean(-1, keepdims=True)
    var = jnp.square(xf - mu).mean(-1, keepdims=True)
    y = (xf - mu) * lax.rsqrt(var + eps)
    if g is not None:
        y = y * g.astype(jnp.float32) + b.astype(jnp.float32)
    return y.astype(x.dtype)


def modulation(cvec, w, b):
    m = jax.nn.silu(cvec) @ w + b
    shift, scale, gate = jnp.split(m[:, None, :], 3, axis=-1)
    return shift, scale, gate


def fourier_mix(a):
    B, L, _ = a.shape
    af = a.reshape(B, L, FN_GROUPS, FN_CH).astype(jnp.float32)
    f = jnp.fft.fft2(af, axes=(1, 3), norm='ortho').real
    return f.astype(a.dtype)


def ctx_attention(q, k, v):
    B, S, H, d = q.shape
    nb = S // Q_BLOCK
    qb = jnp.moveaxis(q.reshape(B, nb, Q_BLOCK, H, d), 1, 0)
    scale = d ** -0.5

    def block(qi):
        s = jnp.einsum('bqhd,bkhd->bhqk', qi, k).astype(jnp.float32) * scale
        p = jax.nn.softmax(s, axis=-1).astype(v.dtype)
        return jnp.einsum('bhqk,bkhd->bqhd', p, v)

    o = lax.map(block, qb)
    return jnp.moveaxis(o, 0, 1).reshape(B, S, H, d)


def neighbourhood_attention(q, k, v, k_ctx, v_ctx, rpb):
    B, L, H, d = q.shape
    rows = L // GRID_W
    wr = min(WIN_R, rows)
    r_q = jnp.arange(rows)
    row_idx = jnp.clip(r_q - wr // 2, 0, rows - wr)[:, None] + jnp.arange(wr)[None, :]
    c_q = jnp.arange(GRID_W)
    c_start = jnp.clip(c_q - WIN_C // 2, 0, GRID_W - WIN_C)
    col_in = (c_q[None, :] >= c_start[:, None]) & (c_q[None, :] < c_start[:, None] + WIN_C)
    dr = row_idx - r_q[:, None] + (WIN_R - 1)
    dc = jnp.clip(c_q[None, :] - c_q[:, None] + (WIN_C - 1), 0, 2 * WIN_C - 2)
    bias = rpb.astype(jnp.float32)[:, dr[:, None, :, None], dc[None, :, None, :]]
    bias = jnp.where(col_in[None, None, :, None, :], bias, NEG_INF)
    qg = q.reshape(B, rows, GRID_W, H, d)
    kg = k.reshape(B, rows, GRID_W, H, d)[:, row_idx]
    vg = v.reshape(B, rows, GRID_W, H, d)[:, row_idx]
    scale = d ** -0.5
    s_loc = jnp.einsum('brchd,brwkhd->bhrcwk', qg, kg).astype(jnp.float32) * scale + bias[None]
    s_ctx = jnp.einsum('brchd,bphd->bhrcp', qg, k_ctx).astype(jnp.float32) * scale
    n_loc = wr * GRID_W
    s = jnp.concatenate([s_loc.reshape(B, H, rows, GRID_W, n_loc), s_ctx], axis=-1)
    p = jax.nn.softmax(s, axis=-1).astype(v.dtype)
    p_loc = p[..., :n_loc].reshape(B, H, rows, GRID_W, wr, GRID_W)
    o = (jnp.einsum('bhrcwk,brwkhd->brchd', p_loc, vg)
         + jnp.einsum('bhrcp,bphd->brchd', p[..., n_loc:], v_ctx))
    return o.reshape(B, L, H, d)


def even_mixer(u, w_in, w_fnet, rpb, w_out, ctx_kv):
    B, L, _ = u.shape
    h = u @ w_in
    splits = np.cumsum([FN_WIDTH, FN_WIDTH, NA_WIDTH, NA_WIDTH, NA_WIDTH]).tolist()
    a, za, q, k, v, zb = jnp.split(h, splits, axis=-1)
    a = jnp.einsum('blgc,gce->blge', fourier_mix(a), w_fnet).reshape(B, L, FN_WIDTH) * jax.nn.silu(za)
    q = q.reshape(B, L, NA_HEADS, NA_HEAD_DIM)
    k = k.reshape(B, L, NA_HEADS, NA_HEAD_DIM)
    v = v.reshape(B, L, NA_HEADS, NA_HEAD_DIM)
    if ctx_kv is None:
        o = ctx_attention(q, k, v)
        kv = (k, v)
    else:
        o = neighbourhood_attention(q, k, v, ctx_kv[0], ctx_kv[1], rpb)
        kv = None
    o = o.reshape(B, L, NA_WIDTH) * jax.nn.silu(zb)
    return jnp.concatenate([a, o], axis=-1) @ w_out, kv


def rwkv_mixer(u, rw, init_state):
    B, L, D = u.shape
    H, N = RW_HEADS, RW_HEAD_DIM
    f32 = jnp.float32
    prev = jnp.pad(u, ((0, 0), (1, 0), (0, 0)))[:, :L]
    nxt = jnp.pad(u, ((0, 0), (0, 1), (0, 0)))[:, 1:]
    dx = 0.5 * (prev + nxt) - u
    xr, xw, xk, xv, xa, xg = [u + dx * rw['mu'][i] for i in range(N_LERP)]
    r = xr @ rw['w_rkvz'][0]
    k = xk @ rw['w_rkvz'][1]
    v = xv @ rw['w_rkvz'][2]
    z = u @ rw['w_rkvz'][3]
    wl = rw['w0'][:, None, None, :] + jnp.einsum(
        'eblr,erd->ebld', jnp.tanh(jnp.einsum('bld,edr->eblr', xw, rw['w1'])), rw['w2'])
    decay = jnp.exp(-DECAY_SCALE * jax.nn.sigmoid(wl.astype(f32)))
    a = jax.nn.sigmoid((rw['a0'][:, None, None, :] + jnp.einsum(
        'eblr,erd->ebld', jnp.einsum('bld,edr->eblr', xa, rw['a1']), rw['a2'])).astype(f32))
    g = jax.nn.sigmoid(xg @ rw['g1']) @ rw['g2']
    kf = k.astype(f32)
    rf = r.astype(f32)
    vf = v.astype(f32)

    def heads(t):
        return t.reshape(t.shape[:-1] + (H, N))

    kk = heads(kf * rw['k_k'].astype(f32))
    kk = kk * lax.rsqrt(jnp.sum(kk * kk, axis=-1, keepdims=True) + 1e-12)
    kd = kf[None] * (1.0 + (a - 1.0) * rw['k_a'].astype(f32))

    def both(t):
        return jnp.moveaxis(jnp.stack([t, jnp.flip(t, 1)]), 2, 0)

    def per_dir(t):
        return jnp.moveaxis(jnp.stack([t[0], jnp.flip(t[1], 1)]), 2, 0)

    xs = (both(heads(rf)), per_dir(heads(decay)), per_dir(heads(kd)),
          both(heads(vf)), both(kk), per_dir(heads(a)))

    def step(S, inp):
        r_t, w_t, k_t, v_t, kk_t, a_t = inp
        sa = jnp.einsum('ebhvk,ebhk->ebhv', S, kk_t)
        S = (S * w_t[..., None, :] - sa[..., None] * (kk_t * a_t)[..., None, :]
             + v_t[..., None] * k_t[..., None, :])
        return S, jnp.einsum('ebhvk,ebhk->ebhv', S, r_t)

    if init_state is None:
        S0 = jnp.zeros((2, B, H, N, N), f32)
    else:
        S0 = init_state.astype(f32)
    S_fin, y = lax.scan(step, S0, xs)
    y = jnp.moveaxis(y[:, 0] + jnp.flip(y[:, 1], 0), 0, 1)
    mu = y.mean(-1, keepdims=True)
    var = jnp.square(y - mu).mean(-1, keepdims=True)
    yn = (y - mu) * lax.rsqrt(var + GN_EPS)
    yn = yn * heads(rw['lnx_g'].astype(f32)) + heads(rw['lnx_b'].astype(f32))
    bonus = jnp.sum(heads(rf) * heads(kd.mean(0)) * rw['r_k'].astype(f32), axis=-1, keepdims=True) * heads(vf)
    o = (yn + bonus).reshape(B, L, D).astype(u.dtype) * g * jax.nn.silu(z)
    return o @ rw['w_out'], S_fin


def setup_inputs(seed: int = 0) -> dict:
    key = jax.random.key(seed)
    ks = iter(jax.random.split(key, 40))
    f32 = jnp.float32

    def nrm(shape, std):
        return std * jax.random.normal(next(ks), shape, f32)

    D = D_MODEL
    return {
        'x_prompt': nrm((BATCH, SEQ, D), 1.0),
        'x_sample': nrm((DEC_BATCH, DEC_SEQ, D), 1.0),
        'cache_k': nrm((DEC_BATCH, N_EVEN, PAST_LEN, NA_HEADS, NA_HEAD_DIM), 1.0),
        'cache_v': nrm((DEC_BATCH, N_EVEN, PAST_LEN, NA_HEADS, NA_HEAD_DIM), 1.0),
        'state_rwkv': nrm((DEC_BATCH, N_ODD, 2, RW_HEADS, RW_HEAD_DIM, RW_HEAD_DIM), 0.5),
        'c': nrm((DEC_BATCH, D), 1.0),
        'c_ctx': nrm((D,), 1.0),
        'ada_w': nrm((DEPTH, D, 3 * D), 0.1 * D ** -0.5),
        'ada_b': nrm((DEPTH, 3 * D), 0.01),
        'post_ln_g': 1.0 + nrm((DEPTH, D), 0.01),
        'post_ln_b': nrm((DEPTH, D), 0.01),
        'ev_w_in': nrm((N_EVEN, D, EVEN_IN), D ** -0.5),
        'ev_w_fnet': nrm((N_EVEN, FN_GROUPS, FN_CH, FN_CH), FN_CH ** -0.5),
        'ev_rpb': nrm((N_EVEN, NA_HEADS, 2 * WIN_R - 1, 2 * WIN_C - 1), 0.1),
        'ev_w_out': nrm((N_EVEN, FN_WIDTH + NA_WIDTH, D), BETA * (FN_WIDTH + NA_WIDTH) ** -0.5),
        'rw_mu': jax.random.uniform(next(ks), (N_ODD, N_LERP, D), f32),
        'rw_w_rkvz': nrm((N_ODD, 4, D, D), D ** -0.5),
        'rw_w0': nrm((N_ODD, 2, D), 0.5),
        'rw_w1': nrm((N_ODD, 2, D, DECAY_LORA), D ** -0.5),
        'rw_w2': nrm((N_ODD, 2, DECAY_LORA, D), 0.5 * DECAY_LORA ** -0.5),
        'rw_a0': nrm((N_ODD, 2, D), 0.5),
        'rw_a1': nrm((N_ODD, 2, D, AAA_LORA), D ** -0.5),
        'rw_a2': nrm((N_ODD, 2, AAA_LORA, D), 0.5 * AAA_LORA ** -0.5),
        'rw_g1': nrm((N_ODD, D, GATE_LORA), D ** -0.5),
        'rw_g2': nrm((N_ODD, GATE_LORA, D), GATE_LORA ** -0.5),
        'rw_k_k': 1.0 + nrm((N_ODD, D), 0.1),
        'rw_k_a': 1.0 + nrm((N_ODD, D), 0.1),
        'rw_r_k': nrm((N_ODD, RW_HEADS, RW_HEAD_DIM), 0.1),
        'rw_lnx_g': 1.0 + nrm((N_ODD, D), 0.01),
        'rw_lnx_b': nrm((N_ODD, D), 0.01),
        'rw_w_out': nrm((N_ODD, D, D), BETA * D ** -0.5),
    }


def reference(x_prompt, x_sample, cache_k, cache_v, state_rwkv, c, c_ctx,
              ada_w, ada_b, post_ln_g, post_ln_b,
              ev_w_in, ev_w_fnet, ev_rpb, ev_w_out,
              rw_mu, rw_w_rkvz, rw_w0, rw_w1, rw_w2, rw_a0, rw_a1, rw_a2,
              rw_g1, rw_g2, rw_k_k, rw_k_a, rw_r_k, rw_lnx_g, rw_lnx_b, rw_w_out):

    def rw_params(i):
        return dict(mu=rw_mu[i], w_rkvz=rw_w_rkvz[i], w0=rw_w0[i], w1=rw_w1[i], w2=rw_w2[i],
                    a0=rw_a0[i], a1=rw_a1[i], a2=rw_a2[i], g1=rw_g1[i], g2=rw_g2[i],
                    k_k=rw_k_k[i], k_a=rw_k_a[i], r_k=rw_r_k[i], lnx_g=rw_lnx_g[i],
                    lnx_b=rw_lnx_b[i], w_out=rw_w_out[i])

    def sublayer(l, x, cvec, ctx):
        shift, scale, gate = modulation(cvec, ada_w[l], ada_b[l])
        u = layer_norm(x) * (1 + scale) + shift
        i = l // 2
        if l % 2 == 0:
            out, st = even_mixer(u, ev_w_in[i], ev_w_fnet[i], ev_rpb[i], ev_w_out[i], ctx)
        else:
            out, st = rwkv_mixer(u, rw_params(i), ctx)
        x = layer_norm(ALPHA * x + (1 + gate) * out, post_ln_g[l], post_ln_b[l])
        return x, st

    x = x_prompt
    ks_, vs_, ss_ = [], [], []
    for l in range(DEPTH):
        x, st = sublayer(l, x, c_ctx[None, :], None)
        if l % 2 == 0:
            ks_.append(st[0])
            vs_.append(st[1])
        else:
            ss_.append(jnp.moveaxis(st, 0, 1))
    y_prompt = x
    new_k = jnp.stack(ks_, axis=1)
    new_v = jnp.stack(vs_, axis=1)
    new_state = jnp.stack(ss_, axis=1)

    x = x_sample
    for l in range(DEPTH):
        i = l // 2
        if l % 2 == 0:
            ctx = (cache_k[:, i], cache_v[:, i])
        else:
            ctx = jnp.moveaxis(state_rwkv[:, i], 1, 0)
        x, _ = sublayer(l, x, c, ctx)
    y_sample = x

    return (y_prompt, y_sample, new_k, new_v, new_state)
```

```cpp
#include <hip/hip_runtime.h>
#include <hip/hip_cooperative_groups.h>
#include <stdint.h>
#include <cstdio>
#include <cstring>
namespace cg = cooperative_groups;

#ifndef FUSED
#define FUSED 0
#endif

typedef unsigned short u16;
typedef __attribute__((ext_vector_type(8))) __bf16 b16x8;
typedef __attribute__((ext_vector_type(16))) float f32x16;
typedef __attribute__((ext_vector_type(4))) unsigned u32x4;
#define DEV __device__ __forceinline__

constexpr int T_CTX = 8192;
constexpr float ALPHA_DN = 1.41421356237f;
constexpr float LOG2E = 1.44269504089f;
constexpr size_t MiB = 1u << 20;
constexpr size_t OFF_MODS = 0, OFF_BSUM = 1 * MiB;
constexpr size_t OFF_FSMP = 2 * MiB, OFF_U = 66 * MiB, OFF_ABUF = 98 * MiB, OFF_Q = 114 * MiB, OFF_K = 130 * MiB;
constexpr size_t OFF_VTC = 146 * MiB, OFF_VTS = 154 * MiB, OFF_GBUF = 162 * MiB, OFF_BTC = 194 * MiB, OFF_BTS = 210 * MiB;
constexpr size_t OFF_WINT = 226 * MiB, OFF_WOUTT = 232 * MiB, OFF_MCAT = 234 * MiB, OFF_FCTX = 234 * MiB + 256 * 1024;
constexpr size_t OFF_CK = 234 * MiB + 512 * 1024, OFF_CVT = 235 * MiB + 512 * 1024;
constexpr size_t OFF_RKVZT = 237 * MiB, OFF_RWOUTT = 245 * MiB, OFF_W1T = 247 * MiB, OFF_A1T = OFF_W1T + 256 * 1024,
                 OFF_G1T = OFF_W1T + 512 * 1024, OFF_W2T = OFF_W1T + 768 * 1024, OFF_A2T = 248 * MiB,
                 OFF_G2T = 248 * MiB + 256 * 1024, OFF_HW = 248 * MiB + 512 * 1024;
constexpr size_t OFF_U1 = 2 * MiB, OFF_R = 34 * MiB, OFF_K2 = 66 * MiB, OFF_V2 = 98 * MiB, OFF_SZ = 130 * MiB,
                 OFF_YSUM = 162 * MiB, OFF_HA = 226 * MiB, OFF_HG = 230 * MiB;
constexpr size_t OUT_NK = 16777216, OUT_NV = 20971520, OUT_ST = 25165824;

constexpr int NTJ = 33;
struct TJob { const float* src; u16* dst; int lds, ldd, tk, tn, start, pad; };

struct Params {
  const float *x_prompt, *x_sample, *cache_k, *cache_v, *state_rwkv, *c, *c_ctx;
  const float *ada_w, *ada_b, *post_g, *post_b, *w_in, *w_fnet, *rpb, *w_out;
  const float *mu, *rkvz, *w0, *w1, *w2, *a0, *a1, *a2, *g1, *g2, *k_k, *k_a, *r_k, *lnx_g, *lnx_b, *rw_out;
  float* out; char* ws;
  int phase_lo, phase_hi, ntr, pad;
  TJob tj[NTJ];
};

DEV u16 f2bf(float f) { unsigned u = __float_as_uint(f); u += 0x7fffu + ((u >> 16) & 1u); return (u16)(u >> 16); }
DEV unsigned pack2(float a, float b) { return (unsigned)f2bf(a) | ((unsigned)f2bf(b) << 16); }
DEV float bflo(unsigned w) { return __uint_as_float(w << 16); }
DEV float bfhi(unsigned w) { return __uint_as_float(w & 0xffff0000u); }
DEV float sigm(float x) { return 1.f / (1.f + __expf(-x)); }
DEV float silu(float x) { return x / (1.f + __expf(-x)); }
DEV float tanh_f(float x) { return 1.f - 2.f / (__expf(2.f * x) + 1.f); }
DEV b16x8 ld16(const u16* p) { uint4 v = *(const uint4*)p; return *(b16x8*)&v; }
DEV b16x8 asb(uint4 v) { return *(b16x8*)&v; }
DEV float wave_sum(float x) {
#pragma unroll
  for (int o = 32; o > 0; o >>= 1) x += __shfl_xor(x, o);
  return x;
}
template <int CTRL> DEV float dpp_add(float x) {
  return x + __int_as_float(__builtin_amdgcn_update_dpp(0, __float_as_int(x), CTRL, 0xf, 0xf, true));
}
DEV float allsum16(float x) {
  x = dpp_add<0xB1>(x); x = dpp_add<0x4E>(x); x = dpp_add<0x124>(x); x = dpp_add<0x128>(x);
  return x;
}
DEV int mv_of(int token) { return token < T_CTX ? 0 : 1 + ((token - T_CTX) >> 12); }

template <bool LERP, class EP>
DEV void gemm_tile(const u16* __restrict__ A, int lda, const float* __restrict__ mu, int m0,
                   const u16* __restrict__ B, int ldb, int K, EP ep, char* smem) {
  u16(*sA)[72] = (u16(*)[72])smem;
  u16(*sB)[72] = (u16(*)[72])(smem + 128 * 72 * 2);
  int tid = threadIdx.x;
  asm volatile("" : "+v"(tid));
  const int lane = tid & 63, wave = tid >> 6, wm = wave >> 1, wn = wave & 1;
  const int lr = tid >> 3, lk = (tid & 7) * 8;
  f32x16 acc[2][2];
#pragma unroll
  for (int i = 0; i < 2; i++)
#pragma unroll
    for (int j = 0; j < 2; j++)
#pragma unroll
      for (int r = 0; r < 16; r++) acc[i][j][r] = 0.f;
  u32x4 ra[4], rb[4], rp[4], rn[4];
  float4 mu0, mu1;
  float pf = 1.f, nf = 1.f;
  if constexpr (LERP) {
    int l0 = m0 < T_CTX ? (m0 & 255) : ((m0 - T_CTX) & 4095);
    int len = m0 < T_CTX ? 256 : 4096;
    if (l0 == 0) pf = 0.f;
    if (l0 + 128 == len) nf = 0.f;
  }
#define GLOAD(K0)                                                                         \
  {                                                                                       \
    _Pragma("unroll") for (int i = 0; i < 4; i++) {                                       \
      int r = lr + 32 * i;                                                                \
      if constexpr (LERP) {                                                               \
        const u16* pa = A + (size_t)(m0 + r) * lda + (K0) + lk;                           \
        ra[i] = *(const u32x4*)pa;                                                        \
        int rpv = (r == 0 && pf == 0.f) ? 0 : -1;                                         \
        int rnv = (r == 127 && nf == 0.f) ? 0 : 1;                                        \
        rp[i] = *(const u32x4*)(pa + (ptrdiff_t)rpv * lda);                               \
        rn[i] = *(const u32x4*)(pa + (ptrdiff_t)rnv * lda);                               \
      } else {                                                                            \
        ra[i] = *(const u32x4*)(A + (size_t)r * lda + (K0) + lk);                         \
      }                                                                                   \
      rb[i] = *(const u32x4*)(B + (size_t)r * ldb + (K0) + lk);                           \
    }                                                                                     \
    if constexpr (LERP) {                                                                 \
      mu0 = *(const float4*)(mu + (K0) + lk);                                             \
      mu1 = *(const float4*)(mu + (K0) + lk + 4);                                         \
    }                                                                                     \
  }
  GLOAD(0);
#pragma unroll 1
  for (int k0 = 0; k0 < K; k0 += 64) {
    __syncthreads();
#pragma unroll
    for (int i = 0; i < 4; i++) {
      int r = lr + 32 * i;
      u32x4 av = ra[i];
      if constexpr (LERP) {
        float pfi = (r == 0) ? pf : 1.f, nfi = (r == 127) ? nf : 1.f;
        unsigned cu[4] = {ra[i].x, ra[i].y, ra[i].z, ra[i].w};
        unsigned pu[4] = {rp[i].x, rp[i].y, rp[i].z, rp[i].w};
        unsigned nu[4] = {rn[i].x, rn[i].y, rn[i].z, rn[i].w};
        float m[8] = {mu0.x, mu0.y, mu0.z, mu0.w, mu1.x, mu1.y, mu1.z, mu1.w};
        unsigned o[4];
#pragma unroll
        for (int q = 0; q < 4; q++) {
          float u0 = bflo(cu[q]), u1 = bfhi(cu[q]);
          float p0 = bflo(pu[q]) * pfi, p1 = bfhi(pu[q]) * pfi;
          float n0 = bflo(nu[q]) * nfi, n1 = bfhi(nu[q]) * nfi;
          float x0 = u0 + (0.5f * (p0 + n0) - u0) * m[2 * q];
          float x1 = u1 + (0.5f * (p1 + n1) - u1) * m[2 * q + 1];
          o[q] = pack2(x0, x1);
        }
        av = u32x4{o[0], o[1], o[2], o[3]};
      }
      *(u32x4*)&sA[r][lk] = av;
      *(u32x4*)&sB[r][lk] = rb[i];
    }
    __syncthreads();
    if (k0 + 64 < K) GLOAD(k0 + 64);
#pragma unroll
    for (int ks = 0; ks < 4; ks++) {
      b16x8 af[2], bf[2];
#pragma unroll
      for (int i = 0; i < 2; i++) {
        af[i] = *(const b16x8*)&sA[wm * 64 + i * 32 + (lane & 31)][ks * 16 + (lane >> 5) * 8];
        bf[i] = *(const b16x8*)&sB[wn * 64 + i * 32 + (lane & 31)][ks * 16 + (lane >> 5) * 8];
      }
#pragma unroll
      for (int i = 0; i < 2; i++)
#pragma unroll
        for (int j = 0; j < 2; j++) acc[i][j] = __builtin_amdgcn_mfma_f32_32x32x16_bf16(af[i], bf[j], acc[i][j], 0, 0, 0);
    }
  }
  int tide = tid;
  asm volatile("" : "+v"(tide));
  const int lane_e = tide & 63, wm_e = tide >> 7, wn_e = (tide >> 6) & 1;
#pragma unroll
  for (int i = 0; i < 2; i++)
#pragma unroll
    for (int j = 0; j < 2; j++)
#pragma unroll
      for (int q = 0; q < 4; q++) {
        int r = wm_e * 64 + i * 32 + q * 8 + (lane_e >> 5) * 4;
        int c = wn_e * 64 + j * 32 + (lane_e & 31);
        ep(r, c, acc[i][j][q * 4 + 0], acc[i][j][q * 4 + 1], acc[i][j][q * 4 + 2], acc[i][j][q * 4 + 3]);
      }
}

template <int ACT> struct EpStore {
  u16* dst; int ld; float scale;
  DEV void operator()(int r, int c, float v0, float v1, float v2, float v3) const {
    float v[4] = {v0, v1, v2, v3};
#pragma unroll
    for (int i = 0; i < 4; i++) {
      float x = v[i];
      if (ACT == 1) x = silu(x);
      else if (ACT == 2) x = tanh_f(x);
      else if (ACT == 3) x = sigm(x);
      else if (ACT == 4) x = x * scale;
      dst[(size_t)(r + i) * ld + c] = f2bf(x);
    }
  }
};
struct EpKeep {
  u16* dst; int ld; float* f32dst; int ldf;
  DEV void operator()(int r, int c, float v0, float v1, float v2, float v3) const {
    float v[4] = {v0, v1, v2, v3};
#pragma unroll
    for (int i = 0; i < 4; i++) {
      dst[(size_t)(r + i) * ld + c] = f2bf(v[i]);
      if (f32dst) f32dst[(size_t)(r + i) * ldf + c] = v[i];
    }
  }
};
struct EpTrans {
  u16* dst; size_t ldt; float* f32dst; int ldf;
  DEV void operator()(int r, int c, float v0, float v1, float v2, float v3) const {
    *(uint2*)(dst + (size_t)c * ldt + r) = make_uint2(pack2(v0, v1), pack2(v2, v3));
    if (f32dst) {
      f32dst[(size_t)(r + 0) * ldf + c] = v0; f32dst[(size_t)(r + 1) * ldf + c] = v1;
      f32dst[(size_t)(r + 2) * ldf + c] = v2; f32dst[(size_t)(r + 3) * ldf + c] = v3;
    }
  }
};
struct EpGate {
  u16* dst; const u16* gate; int ld;
  DEV void operator()(int r, int c, float v0, float v1, float v2, float v3) const {
    float v[4] = {v0, v1, v2, v3};
#pragma unroll
    for (int i = 0; i < 4; i++) {
      size_t o = (size_t)(r + i) * ld + c;
      dst[o] = f2bf(v[i] * __uint_as_float((unsigned)gate[o] << 16));
    }
  }
};
struct EpRes {
  float* dst; const float* xsrc; const float* gate;
  DEV void operator()(int r, int c, float v0, float v1, float v2, float v3) const {
    float v[4] = {v0, v1, v2, v3};
    float g = 1.f + gate[c];
#pragma unroll
    for (int i = 0; i < 4; i++) {
      size_t o = (size_t)(r + i) * 1024 + c;
      dst[o] = ALPHA_DN * xsrc[o] + g * v[i];
    }
  }
};

DEV void p0_prep(const Params& p, char* smem) {
  const int tid = threadIdx.x;
  const int njobs = 192 + p.ntr;
  for (int job = blockIdx.x; job < njobs; job += gridDim.x) {
    __syncthreads();
    if (job < 192) {
      float* sc = (float*)smem;
      float* red = sc + 3072;
      for (int i = tid; i < 3072; i += 256) {
        int m = i >> 10, k = i & 1023;
        float cv = m == 0 ? p.c_ctx[k] : p.c[(m - 1) * 1024 + k];
        sc[i] = silu(cv);
      }
      __syncthreads();
      int l = job / 96, col = (job % 96) * 32 + (tid & 31), ks = tid >> 5;
      const float* w = p.ada_w + (size_t)l * 1024 * 3072 + col;
      float a0 = 0, a1 = 0, a2 = 0;
#pragma unroll 8
      for (int k = ks * 128; k < ks * 128 + 128; k++) {
        float wv = w[(size_t)k * 3072];
        a0 += sc[k] * wv; a1 += sc[1024 + k] * wv; a2 += sc[2048 + k] * wv;
      }
      red[(ks * 32 + (tid & 31)) * 3 + 0] = a0; red[(ks * 32 + (tid & 31)) * 3 + 1] = a1; red[(ks * 32 + (tid & 31)) * 3 + 2] = a2;
      __syncthreads();
      if (tid < 96) {
        int cl = tid & 31, m = tid >> 5;
        float s = 0;
        for (int q = 0; q < 8; q++) s += red[(q * 32 + cl) * 3 + m];
        int cc = (job % 96) * 32 + cl;
        ((float*)(p.ws + OFF_MODS))[(l * 3 + m) * 3072 + cc] = s + p.ada_b[l * 3072 + cc];
      }
    } else {
      int tj = job - 192, e = 0;
      while (e + 1 < NTJ && p.tj[e + 1].start <= tj) e++;
      const TJob J = p.tj[e];
      int lt = tj - J.start, tkk = lt / J.tn, tnn = lt % J.tn;
      float(*tile)[65] = (float(*)[65])smem;
      const float* src = J.src + (size_t)(tkk * 64) * J.lds + tnn * 64;
#pragma unroll
      for (int i = 0; i < 4; i++) {
        int kk = (tid >> 4) + 16 * i, nn = (tid & 15) * 4;
        float4 v = *(const float4*)(src + (size_t)kk * J.lds + nn);
        tile[kk][nn] = v.x; tile[kk][nn + 1] = v.y; tile[kk][nn + 2] = v.z; tile[kk][nn + 3] = v.w;
      }
      __syncthreads();
      u16* dst = J.dst + (size_t)(tnn * 64) * J.ldd + tkk * 64;
#pragma unroll
      for (int i = 0; i < 2; i++) {
        int nn = (tid >> 3) + 32 * i, kk = (tid & 7) * 8;
        uint4 o;
        o.x = pack2(tile[kk][nn], tile[kk + 1][nn]); o.y = pack2(tile[kk + 2][nn], tile[kk + 3][nn]);
        o.z = pack2(tile[kk + 4][nn], tile[kk + 5][nn]); o.w = pack2(tile[kk + 6][nn], tile[kk + 7][nn]);
        *(uint4*)(dst + (size_t)nn * J.ldd + kk) = o;
      }
    }
  }
  const size_t gt = (size_t)blockIdx.x * 256 + tid, gs = (size_t)gridDim.x * 256;
  {
    u16* ck = (u16*)(p.ws + OFF_CK);
    for (size_t i = gt; i < 65536; i += gs) {
      float4 a = *(const float4*)(p.cache_k + i * 8), b = *(const float4*)(p.cache_k + i * 8 + 4);
      *(uint4*)(ck + i * 8) = make_uint4(pack2(a.x, a.y), pack2(a.z, a.w), pack2(b.x, b.y), pack2(b.z, b.w));
    }
  }
  {
    float4* bs = (float4*)(p.ws + OFF_BSUM);
    for (size_t i = gt; i < 65536; i += gs) bs[i] = make_float4(0, 0, 0, 0);
  }
  {
    u16* fs = (u16*)(p.ws + OFF_FSMP);
    const float sc = 0.001381067932f;
    for (size_t i = gt; i < 4194304; i += gs) {
      int lp = (int)(i >> 10), j0 = (int)(i & 1023) * 8;
      unsigned o[4];
#pragma unroll
      for (int q = 0; q < 4; q++) {
        float v[2];
#pragma unroll
        for (int z = 0; z < 2; z++) {
          int j = j0 + 2 * q + z;
          int ph = (lp * (j & 4095)) & 4095;
          float ang = (float)ph * (6.283185307179586f / 4096.f);
          v[z] = (j < 4096 ? __cosf(ang) : -__sinf(ang)) * sc;
        }
        o[q] = pack2(v[0], v[1]);
      }
      *(uint4*)(fs + i * 8) = make_uint4(o[0], o[1], o[2], o[3]);
    }
    u16* fc = (u16*)(p.ws + OFF_FCTX);
    const float sc2 = 0.005524271728f;
    for (size_t i = gt; i < 16384; i += gs) {
      int lp = (int)(i >> 6), j0 = (int)(i & 63) * 8;
      unsigned o[4];
#pragma unroll
      for (int q = 0; q < 4; q++) {
        float v[2];
#pragma unroll
        for (int z = 0; z < 2; z++) {
          int j = j0 + 2 * q + z;
          int ph = (lp * (j & 255)) & 255;
          float ang = (float)ph * (6.283185307179586f / 256.f);
          v[z] = (j < 256 ? __cosf(ang) : -__sinf(ang)) * sc2;
        }
        o[q] = pack2(v[0], v[1]);
      }
      *(uint4*)(fc + i * 8) = make_uint4(o[0], o[1], o[2], o[3]);
    }
  }
  {
    u16* mc = (u16*)(p.ws + OFF_MCAT);
    for (size_t i = gt; i < 131072; i += gs) {
      int c = (int)(i & 127), ep = (int)((i >> 7) & 255), g = (int)(i >> 15);
      const float* wf = p.w_fnet + (size_t)g * 16384 + (ep & 127);
      float s = 0;
      for (int cp = 0; cp < 128; cp++) {
        float ang = (float)((c * cp) & 127) * (6.283185307179586f / 128.f);
        float tw = ep < 128 ? __cosf(ang) : __sinf(ang);
        s += tw * wf[cp * 128];
      }
      mc[i] = f2bf(s);
    }
  }
}

DEV void ln_stats(const float4 (&x)[4], float& mean, float& rstd) {
  float s = 0;
#pragma unroll
  for (int i = 0; i < 4; i++) s += x[i].x + x[i].y + x[i].z + x[i].w;
  mean = wave_sum(s) * (1.f / 1024.f);
  float q = 0;
#pragma unroll
  for (int i = 0; i < 4; i++) {
    float a = x[i].x - mean, b = x[i].y - mean, c = x[i].z - mean, d = x[i].w - mean;
    q += a * a + b * b + c * c + d * d;
  }
  rstd = rsqrtf(wave_sum(q) * (1.f / 1024.f) + 1e-6f);
}

template <int MODE> DEV void ln_phase(const Params& p) {
  const int lane = threadIdx.x & 63;
  const int gw = blockIdx.x * 4 + (threadIdx.x >> 6), nw = gridDim.x * 4;
  const float* mods = (const float*)(p.ws + OFF_MODS);
  for (int row = gw; row < 16384; row += nw) {
    const float* src = MODE == 0 ? (row < T_CTX ? p.x_prompt + (size_t)row * 1024 : p.x_sample + (size_t)(row - T_CTX) * 1024)
                                 : p.out + (size_t)row * 1024;
    float4 x[4];
#pragma unroll
    for (int i = 0; i < 4; i++) x[i] = *(const float4*)(src + lane * 4 + 256 * i);
    float mean, rstd;
    ln_stats(x, mean, rstd);
    if (MODE >= 1) {
      const float* g = p.post_g + (MODE == 1 ? 0 : 1024);
      const float* b = p.post_b + (MODE == 1 ? 0 : 1024);
      float* dst = p.out + (size_t)row * 1024;
#pragma unroll
      for (int i = 0; i < 4; i++) {
        float4 gv = *(const float4*)(g + lane * 4 + 256 * i), bv = *(const float4*)(b + lane * 4 + 256 * i);
        x[i].x = (x[i].x - mean) * rstd * gv.x + bv.x; x[i].y = (x[i].y - mean) * rstd * gv.y + bv.y;
        x[i].z = (x[i].z - mean) * rstd * gv.z + bv.z; x[i].w = (x[i].w - mean) * rstd * gv.w + bv.w;
        *(float4*)(dst + lane * 4 + 256 * i) = x[i];
      }
      if (MODE == 2) continue;
      ln_stats(x, mean, rstd);
    }
    const float* md = mods + ((MODE == 0 ? 0 : 3) + mv_of(row)) * 3072;
    u16* ud = (u16*)(p.ws + (MODE == 0 ? OFF_U : OFF_U1)) + (size_t)row * 1024;
#pragma unroll
    for (int i = 0; i < 4; i++) {
      int k = lane * 4 + 256 * i;
      float4 sh = *(const float4*)(md + k), sc = *(const float4*)(md + 1024 + k);
      float a = (x[i].x - mean) * rstd * (1.f + sc.x) + sh.x, b = (x[i].y - mean) * rstd * (1.f + sc.y) + sh.y;
      float c = (x[i].z - mean) * rstd * (1.f + sc.z) + sh.z, d = (x[i].w - mean) * rstd * (1.f + sc.w) + sh.w;
      *(uint2*)(ud + k) = make_uint2(pack2(a, b), pack2(c, d));
    }
  }
}

DEV void p2_gemm1(const Params& p, char* smem) {
  const u16* U = (const u16*)(p.ws + OFF_U);
  const u16* W = (const u16*)(p.ws + OFF_WINT);
  for (int t = blockIdx.x; t < 128 * 24; t += gridDim.x) {
    int mt = t / 24, nt = t % 24, m0 = mt * 128, n0 = nt * 128, sec = nt >> 2, nc = (nt & 3) * 128;
    const u16* A = U + (size_t)m0 * 1024;
    const u16* B = W + (size_t)n0 * 1024;
    if (sec == 0) {
      gemm_tile<false>(A, 1024, nullptr, m0, B, 1024, 1024, EpStore<0>{(u16*)(p.ws + OFF_ABUF) + (size_t)m0 * 512 + nc, 512, 1.f}, smem);
    } else if (sec == 1 || sec == 5) {
      gemm_tile<false>(A, 1024, nullptr, m0, B, 1024, 1024,
                       EpStore<1>{(u16*)(p.ws + OFF_GBUF) + (size_t)m0 * 1024 + (sec == 5 ? 512 : 0) + nc, 1024, 1.f}, smem);
    } else if (sec == 2) {
      gemm_tile<false>(A, 1024, nullptr, m0, B, 1024, 1024, EpStore<4>{(u16*)(p.ws + OFF_Q) + (size_t)m0 * 512 + nc, 512, 0.125f * LOG2E}, smem);
    } else if (sec == 3) {
      float* f = m0 < T_CTX ? p.out + OUT_NK + (size_t)m0 * 512 + nc : nullptr;
      gemm_tile<false>(A, 1024, nullptr, m0, B, 1024, 1024, EpKeep{(u16*)(p.ws + OFF_K) + (size_t)m0 * 512 + nc, 512, f, 512}, smem);
    } else {
      float* f = m0 < T_CTX ? p.out + OUT_NV + (size_t)m0 * 512 + nc : nullptr;
      u16* d; size_t ldt;
      if (m0 < T_CTX) { int b = m0 >> 8, l = m0 & 255; ldt = 256; d = (u16*)(p.ws + OFF_VTC) + ((size_t)b * 512 + nc) * 256 + l; }
      else { int tt = m0 - T_CTX, b = tt >> 12, l = tt & 4095; ldt = 4096; d = (u16*)(p.ws + OFF_VTS) + ((size_t)b * 512 + nc) * 4096 + l; }
      gemm_tile<false>(A, 1024, nullptr, m0, B, 1024, 1024, EpTrans{d, ldt, f, 512}, smem);
    }
  }
}

struct AttnState { f32x16 o0, o1; float m, l; };

DEV void attn_tile(AttnState& st, const b16x8 (&qf)[4], const u16* kptr, const u16* vptr, int ldv, int mode, int dr, int kc0,
                   int c, const float* rpbh, int qi, int hh) {
  f32x16 s;
#pragma unroll
  for (int r = 0; r < 16; r++) s[r] = 0.f;
#pragma unroll
  for (int ks = 0; ks < 4; ks++) {
    b16x8 kf = ld16(kptr + (size_t)qi * 512 + ks * 16 + hh * 8);
    s = __builtin_amdgcn_mfma_f32_32x32x16_bf16(kf, qf[ks], s, 0, 0, 0);
  }
  if (mode) {
    int cs = min(max(c - 8, 0), 48);
#pragma unroll
    for (int r = 0; r < 16; r++) {
      int kc = kc0 + (r & 3) + 8 * (r >> 2) + 4 * hh;
      bool valid = (kc >= cs) && (kc < cs + 16);
      int dc = min(max(kc - c + 15, 0), 30);
      float bias = rpbh[dr * 31 + dc] * LOG2E;
      s[r] = valid ? s[r] + bias : -1e30f;
    }
  }
  float tm = s[0];
#pragma unroll
  for (int r = 1; r < 16; r++) tm = fmaxf(tm, s[r]);
  tm = fmaxf(tm, __shfl_xor(tm, 32));
  float mn = fmaxf(st.m, tm);
  float alpha = exp2f(st.m - mn);
  st.m = mn;
  float ps = 0;
#pragma unroll
  for (int r = 0; r < 16; r++) { float e = exp2f(s[r] - mn); ps += e; s[r] = e; }
  st.l = st.l * alpha + ps;
#pragma unroll
  for (int r = 0; r < 16; r++) { st.o0[r] *= alpha; st.o1[r] *= alpha; }
#pragma unroll
  for (int s2 = 0; s2 < 2; s2++) {
    uint4 pw = make_uint4(pack2(s[8 * s2 + 0], s[8 * s2 + 1]), pack2(s[8 * s2 + 2], s[8 * s2 + 3]),
                          pack2(s[8 * s2 + 4], s[8 * s2 + 5]), pack2(s[8 * s2 + 6], s[8 * s2 + 7]));
    b16x8 pfr = asb(pw);
#pragma unroll
    for (int dt = 0; dt < 2; dt++) {
      const u16* vr = vptr + (size_t)(dt * 32 + qi) * ldv + 16 * s2 + 4 * hh;
      uint2 lo = *(const uint2*)vr, hi = *(const uint2*)(vr + 8);
      b16x8 vf = asb(make_uint4(lo.x, lo.y, hi.x, hi.y));
      if (dt == 0) st.o0 = __builtin_amdgcn_mfma_f32_32x32x16_bf16(vf, pfr, st.o0, 0, 0, 0);
      else st.o1 = __builtin_amdgcn_mfma_f32_32x32x16_bf16(vf, pfr, st.o1, 0, 0, 0);
    }
  }
}

DEV void attn_unit(const Params& p, int u, int lane) {
  const u16* Qb = (const u16*)(p.ws + OFF_Q);
  const u16* Kb = (const u16*)(p.ws + OFF_K);
  const int qi = lane & 31, hh = lane >> 5;
  bool smp = u < 2048;
  int b, h, qg, tq0, r = 0, c0 = 0;
  if (smp) { b = u >> 10; h = (u >> 7) & 7; qg = u & 127; tq0 = T_CTX + b * 4096 + qg * 32; r = qg >> 1; c0 = (qg & 1) * 32; }
  else { int v = u - 2048; b = v >> 6; h = (v >> 3) & 7; qg = v & 7; tq0 = b * 256 + qg * 32; }
  b16x8 qf[4];
#pragma unroll
  for (int s = 0; s < 4; s++) qf[s] = ld16(Qb + (size_t)(tq0 + qi) * 512 + h * 64 + s * 16 + hh * 8);
  AttnState st;
#pragma unroll
  for (int i = 0; i < 16; i++) { st.o0[i] = 0.f; st.o1[i] = 0.f; }
  st.m = -INFINITY; st.l = 0.f;
  const float* rpbh = p.rpb + h * 465;
  if (smp) {
    const u16* ck = (const u16*)(p.ws + OFF_CK) + (size_t)b * 512 * 512 + h * 64;
    const u16* cvt = (const u16*)(p.ws + OFF_CVT) + (size_t)(b * 8 + h) * 64 * 512;
    for (int kt = 0; kt < 16; kt++) attn_tile(st, qf, ck + (size_t)kt * 32 * 512, cvt + kt * 32, 512, 0, 0, 0, 0, rpbh, qi, hh);
    int rs = min(max(r - 4, 0), 56);
    const u16* kl = Kb + (size_t)(T_CTX + b * 4096) * 512 + h * 64;
    const u16* vl = (const u16*)(p.ws + OFF_VTS) + (size_t)(b * 8 + h) * 64 * 4096;
    for (int kt = 0; kt < 16; kt++) {
      int kr = rs + (kt >> 1), kc0 = (kt & 1) * 32;
      attn_tile(st, qf, kl + (size_t)(kr * 64 + kc0) * 512, vl + kr * 64 + kc0, 4096, 1, kr - r + 7, kc0, c0 + qi, rpbh, qi, hh);
    }
  } else {
    const u16* kl = Kb + (size_t)(b * 256) * 512 + h * 64;
    const u16* vl = (const u16*)(p.ws + OFF_VTC) + (size_t)(b * 8 + h) * 64 * 256;
    for (int kt = 0; kt < 8; kt++) attn_tile(st, qf, kl + (size_t)kt * 32 * 512, vl + kt * 32, 256, 0, 0, 0, 0, rpbh, qi, hh);
  }
  float lt = st.l + __shfl_xor(st.l, 32);
  float inv = 1.f / lt;
  const size_t rowo = (size_t)(tq0 + qi) * 1024 + 512 + h * 64;
  const u16* gb = (const u16*)(p.ws + OFF_GBUF) + rowo;
  u16* cat = (u16*)(p.ws + OFF_U) + rowo;
#pragma unroll
  for (int dt = 0; dt < 2; dt++)
#pragma unroll
    for (int q = 0; q < 4; q++) {
      int d = dt * 32 + q * 8 + hh * 4;
      uint2 g = *(const uint2*)(gb + d);
      float v0 = (dt ? st.o1[q * 4 + 0] : st.o0[q * 4 + 0]) * inv * bflo(g.x);
      float v1 = (dt ? st.o1[q * 4 + 1] : st.o0[q * 4 + 1]) * inv * bfhi(g.x);
      float v2 = (dt ? st.o1[q * 4 + 2] : st.o0[q * 4 + 2]) * inv * bflo(g.y);
      float v3 = (dt ? st.o1[q * 4 + 3] : st.o0[q * 4 + 3]) * inv * bfhi(g.y);
      *(uint2*)(cat + d) = make_uint2(pack2(v0, v1), pack2(v2, v3));
    }
}

DEV void p3_mix(const Params& p, char* smem) {
  for (int t = blockIdx.x; t < 2048; t += gridDim.x) {
    if (t < 1024) {
      attn_unit(p, t * 4 + (threadIdx.x >> 6), threadIdx.x & 63);
    } else {
      int q = t - 1024, mt = q >> 3, g = (q >> 1) & 3, nh = q & 1, m0 = mt * 128;
      const u16* A = (const u16*)(p.ws + OFF_ABUF) + (size_t)m0 * 512 + g * 128;
      const u16* B = (const u16*)(p.ws + OFF_MCAT) + (size_t)(g * 256 + nh * 128) * 128;
      u16* d; size_t ldt;
      if (m0 < T_CTX) { int b = m0 >> 8, l = m0 & 255; ldt = 512; d = (u16*)(p.ws + OFF_BTC) + ((size_t)b * 512 + g * 128) * 512 + nh * 256 + l; }
      else { int tt = m0 - T_CTX, b = tt >> 12, l = tt & 4095; ldt = 8192; d = (u16*)(p.ws + OFF_BTS) + ((size_t)b * 512 + g * 128) * 8192 + nh * 4096 + l; }
      gemm_tile<false>(A, 512, nullptr, m0, B, 128, 128, EpTrans{d, ldt, nullptr, 0}, smem);
    }
  }
}

DEV void p4_fnet(const Params& p, char* smem) {
  for (int t = blockIdx.x; t < 512; t += gridDim.x) {
    if (t < 256) {
      int b = t >> 7, mt = (t >> 2) & 31, nt = t & 3;
      int tok0 = T_CTX + b * 4096 + mt * 128;
      const u16* A = (const u16*)(p.ws + OFF_FSMP) + (size_t)(mt * 128) * 8192;
      const u16* B = (const u16*)(p.ws + OFF_BTS) + ((size_t)b * 512 + nt * 128) * 8192;
      size_t o = (size_t)tok0 * 1024 + nt * 128;
      gemm_tile<false>(A, 8192, nullptr, 0, B, 8192, 8192, EpGate{(u16*)(p.ws + OFF_U) + o, (const u16*)(p.ws + OFF_GBUF) + o, 1024}, smem);
    } else {
      int q = t - 256, b = q >> 3, mt = (q >> 2) & 1, nt = q & 3;
      int tok0 = b * 256 + mt * 128;
      const u16* A = (const u16*)(p.ws + OFF_FCTX) + (size_t)(mt * 128) * 512;
      const u16* B = (const u16*)(p.ws + OFF_BTC) + ((size_t)b * 512 + nt * 128) * 512;
      size_t o = (size_t)tok0 * 1024 + nt * 128;
      gemm_tile<false>(A, 512, nullptr, 0, B, 512, 512, EpGate{(u16*)(p.ws + OFF_U) + o, (const u16*)(p.ws + OFF_GBUF) + o, 1024}, smem);
    }
  }
}

template <int LAYER> DEV void p_outproj(const Params& p, char* smem) {
  const u16* Aall = (const u16*)(p.ws + (LAYER == 0 ? OFF_U : OFF_U1));
  const u16* W = (const u16*)(p.ws + (LAYER == 0 ? OFF_WOUTT : OFF_RWOUTT));
  const float* mods = (const float*)(p.ws + OFF_MODS);
  for (int t = blockIdx.x; t < 1024; t += gridDim.x) {
    int mt = t >> 3, nt = t & 7, m0 = mt * 128, n0 = nt * 128;
    const float* xs;
    if (LAYER == 0) xs = (m0 < T_CTX ? p.x_prompt + (size_t)m0 * 1024 : p.x_sample + (size_t)(m0 - T_CTX) * 1024) + n0;
    else xs = p.out + (size_t)m0 * 1024 + n0;
    const float* gate = mods + (LAYER * 3 + mv_of(m0)) * 3072 + 2048 + n0;
    gemm_tile<false>(Aall + (size_t)m0 * 1024, 1024, nullptr, m0, W + (size_t)n0 * 1024, 1024, 1024,
                     EpRes{p.out + (size_t)m0 * 1024 + n0, xs, gate}, smem);
  }
}

DEV void p7_rwkv_proj(const Params& p, char* smem) {
  {
    float4* ys = (float4*)(p.ws + OFF_YSUM);
    const size_t gt = (size_t)blockIdx.x * 256 + threadIdx.x, gs = (size_t)gridDim.x * 256;
    for (size_t i = gt; i < 4194304; i += gs) ys[i] = make_float4(0, 0, 0, 0);
  }
  const u16* U1 = (const u16*)(p.ws + OFF_U1);
  for (int t = blockIdx.x; t < 128 * 35; t += gridDim.x) {
    int mt = t / 35, nt = t % 35, m0 = mt * 128;
    if (nt < 32) {
      int which = nt >> 3, n0 = (nt & 7) * 128;
      const u16* B = (const u16*)(p.ws + OFF_RKVZT) + (size_t)which * 1048576 + (size_t)n0 * 1024;
      if (which == 3) {
        gemm_tile<false>(U1 + (size_t)m0 * 1024, 1024, nullptr, m0, B, 1024, 1024,
                         EpStore<1>{(u16*)(p.ws + OFF_SZ) + (size_t)m0 * 1024 + n0, 1024, 1.f}, smem);
      } else {
        size_t off = which == 0 ? OFF_R : (which == 1 ? OFF_K2 : OFF_V2);
        const float* mu = p.mu + (which == 0 ? 0 : (which == 1 ? 2 : 3)) * 1024;
        gemm_tile<true>(U1, 1024, mu, m0, B, 1024, 1024, EpStore<0>{(u16*)(p.ws + off) + (size_t)m0 * 1024 + n0, 1024, 1.f}, smem);
      }
    } else {
      int w = nt - 32;
      if (w == 0)
        gemm_tile<true>(U1, 1024, p.mu + 1 * 1024, m0, (const u16*)(p.ws + OFF_W1T), 1024, 1024, EpStore<2>{(u16*)(p.ws + OFF_HW) + (size_t)m0 * 128, 128, 1.f}, smem);
      else if (w == 1)
        gemm_tile<true>(U1, 1024, p.mu + 4 * 1024, m0, (const u16*)(p.ws + OFF_A1T), 1024, 1024, EpStore<0>{(u16*)(p.ws + OFF_HA) + (size_t)m0 * 128, 128, 1.f}, smem);
      else
        gemm_tile<true>(U1, 1024, p.mu + 5 * 1024, m0, (const u16*)(p.ws + OFF_G1T), 1024, 1024, EpStore<3>{(u16*)(p.ws + OFF_HG) + (size_t)m0 * 128, 128, 1.f}, smem);
    }
  }
}

DEV void scan_tile(const Params& p, int t, char* smem) {
  float(*sW)[64] = (float(*)[64])smem;
  float(*sB)[64] = (float(*)[64])(smem + 8192);
  float(*sKK)[64] = (float(*)[64])(smem + 16384);
  float(*sKD)[64] = (float(*)[64])(smem + 24576);
  float(*sR)[64] = (float(*)[64])(smem + 32768);
  float(*sV)[64] = (float(*)[64])(smem + 40960);
  const int tid = threadIdx.x, lane = tid & 63, wave = tid >> 6, vg = tid >> 4, kg = tid & 15;
  int e, b, h, tb, L;
  bool smp = t < 64;
  if (smp) { e = t >> 5; b = (t >> 4) & 1; h = t & 15; tb = T_CTX + b * 4096; L = 4096; }
  else { int v = t - 64; e = v >> 9; b = (v >> 4) & 31; h = v & 15; tb = b * 256; L = 256; }
  float S[4][4];
  const size_t soff = ((size_t)(b * 2 + e) * 16 + h) * 4096 + (size_t)(vg * 4) * 64 + kg * 4;
#pragma unroll
  for (int i = 0; i < 4; i++) {
    if (smp) {
      float4 v = *(const float4*)(p.state_rwkv + soff + i * 64);
      S[i][0] = v.x; S[i][1] = v.y; S[i][2] = v.z; S[i][3] = v.w;
    } else { S[i][0] = S[i][1] = S[i][2] = S[i][3] = 0.f; }
  }
  const u16* HW = (const u16*)(p.ws + OFF_HW);
  const u16* HA = (const u16*)(p.ws + OFF_HA);
  const u16* Rb = (const u16*)(p.ws + OFF_R);
  const u16* Kb = (const u16*)(p.ws + OFF_K2);
  const u16* Vb = (const u16*)(p.ws + OFF_V2);
  float* Ysum = (float*)(p.ws + OFF_YSUM);
  float* Bsum = (float*)(p.ws + OFF_BSUM);
  const int nch = L / 32;
  for (int ci = 0; ci < nch; ci++) {
    const int lo = e ? L - 32 * (ci + 1) : 32 * ci;
    const int tok0 = tb + lo;
    {
      const int arr = wave >> 1, ct = wave & 1, qi = lane & 31, hh = lane >> 5;
      const u16* X = (arr ? HA : HW) + (size_t)(tok0 + qi) * 128 + e * 64 + hh * 8;
      const u16* Wt = (const u16*)(p.ws + (arr ? OFF_A2T : OFF_W2T)) + (size_t)e * 65536 + (size_t)(h * 64 + ct * 32 + qi) * 64 + hh * 8;
      f32x16 acc;
#pragma unroll
      for (int r = 0; r < 16; r++) acc[r] = 0.f;
#pragma unroll
      for (int ks = 0; ks < 4; ks++) acc = __builtin_amdgcn_mfma_f32_32x32x16_bf16(ld16(X + ks * 16), ld16(Wt + ks * 16), acc, 0, 0, 0);
      const int ch = ct * 32 + qi;
      const float b0 = (arr ? p.a0 : p.w0)[e * 1024 + h * 64 + ch];
#pragma unroll
      for (int r = 0; r < 16; r++) {
        int row = (r & 3) + 8 * (r >> 2) + 4 * hh;
        float val = acc[r] + b0;
        if (arr == 0) sW[row][ch] = __expf(-0.606531f * sigm(val));
        else sB[row][ch] = sigm(val);
      }
    }
    __syncthreads();
    {
      const int i = tid >> 3, cb = (tid & 7) * 8, token = tok0 + i, chg = h * 64 + cb;
      uint4 kq = *(const uint4*)(Kb + (size_t)token * 1024 + chg);
      uint4 rq = *(const uint4*)(Rb + (size_t)token * 1024 + chg);
      uint4 vq = *(const uint4*)(Vb + (size_t)token * 1024 + chg);
      const unsigned* ku = (const unsigned*)&kq; const unsigned* ru = (const unsigned*)&rq; const unsigned* vu = (const unsigned*)&vq;
      float k[8], r[8], v[8], kkr[8];
#pragma unroll
      for (int q = 0; q < 4; q++) {
        k[2 * q] = bflo(ku[q]); k[2 * q + 1] = bfhi(ku[q]);
        r[2 * q] = bflo(ru[q]); r[2 * q + 1] = bfhi(ru[q]);
        v[2 * q] = bflo(vu[q]); v[2 * q + 1] = bfhi(vu[q]);
      }
      float ss = 0;
#pragma unroll
      for (int j = 0; j < 8; j++) { kkr[j] = k[j] * p.k_k[chg + j]; ss += kkr[j] * kkr[j]; }
      ss += __shfl_xor(ss, 1); ss += __shfl_xor(ss, 2); ss += __shfl_xor(ss, 4);
      float inv = rsqrtf(ss + 1e-12f), bon = 0;
#pragma unroll
      for (int j = 0; j < 8; j++) {
        float a = sB[i][cb + j];
        float kd = k[j] * (1.f + (a - 1.f) * p.k_a[chg + j]);
        float kk = kkr[j] * inv;
        bon += r[j] * kd * p.r_k[chg + j];
        sKK[i][cb + j] = kk; sB[i][cb + j] = kk * a; sKD[i][cb + j] = kd; sR[i][cb + j] = r[j]; sV[i][cb + j] = v[j];
      }
      bon += __shfl_xor(bon, 1); bon += __shfl_xor(bon, 2); bon += __shfl_xor(bon, 4);
      if ((tid & 7) == 0) atomicAdd(Bsum + (size_t)token * 16 + h, 0.5f * bon);
    }
    __syncthreads();
#pragma unroll 2
    for (int s = 0; s < 32; s++) {
      const int i = e ? 31 - s : s;
      float4 w4 = *(const float4*)&sW[i][4 * kg], k4 = *(const float4*)&sKK[i][4 * kg], b4 = *(const float4*)&sB[i][4 * kg];
      float4 d4 = *(const float4*)&sKD[i][4 * kg], r4 = *(const float4*)&sR[i][4 * kg], v4 = *(const float4*)&sV[i][4 * vg];
      float vv[4] = {v4.x, v4.y, v4.z, v4.w};
      float y[4];
#pragma unroll
      for (int a = 0; a < 4; a++) {
        float sa = S[a][0] * k4.x + S[a][1] * k4.y + S[a][2] * k4.z + S[a][3] * k4.w;
        sa = allsum16(sa);
        S[a][0] = S[a][0] * w4.x + (vv[a] * d4.x - sa * b4.x);
        S[a][1] = S[a][1] * w4.y + (vv[a] * d4.y - sa * b4.y);
        S[a][2] = S[a][2] * w4.z + (vv[a] * d4.z - sa * b4.z);
        S[a][3] = S[a][3] * w4.w + (vv[a] * d4.w - sa * b4.w);
        y[a] = allsum16(S[a][0] * r4.x + S[a][1] * r4.y + S[a][2] * r4.z + S[a][3] * r4.w);
      }
      if (kg == 0) *(float4*)&sV[i][4 * vg] = make_float4(y[0], y[1], y[2], y[3]);
    }
    __syncthreads();
#pragma unroll
    for (int q = 0; q < 8; q++) {
      int idx = tid + 256 * q, i = idx >> 6, v = idx & 63;
      atomicAdd(Ysum + (size_t)(tok0 + i) * 1024 + h * 64 + v, sV[i][v]);
    }
  }
  if (!smp) {
#pragma unroll
    for (int i = 0; i < 4; i++) *(float4*)(p.out + OUT_ST + soff + i * 64) = make_float4(S[i][0], S[i][1], S[i][2], S[i][3]);
  }
  __syncthreads();
}

DEV void p8_scan(const Params& p, char* smem) {
  if (blockIdx.x < 64) { scan_tile(p, blockIdx.x, smem); return; }
  for (int t = blockIdx.x - 64; t < 2048; t += gridDim.x - 64) {
    if (t < 1024) scan_tile(p, 64 + t, smem);
    else {
      int q = t - 1024, mt = q >> 3, nt = q & 7, m0 = mt * 128, n0 = nt * 128;
      gemm_tile<false>((const u16*)(p.ws + OFF_HG) + (size_t)m0 * 128, 128, nullptr, m0, (const u16*)(p.ws + OFF_G2T) + (size_t)n0 * 128, 128, 128,
                       EpStore<0>{(u16*)(p.ws + OFF_U1) + (size_t)m0 * 1024 + n0, 1024, 1.f}, smem);
    }
  }
}

DEV void p9_post(const Params& p) {
  const int lane = threadIdx.x & 63;
  const int gw = blockIdx.x * 4 + (threadIdx.x >> 6), nw = gridDim.x * 4;
  const float* Ysum = (const float*)(p.ws + OFF_YSUM);
  const float* Bsum = (const float*)(p.ws + OFF_BSUM);
  for (int row = gw; row < 16384; row += nw) {
    const size_t o = (size_t)row * 1024 + lane * 16;
    float y[16];
#pragma unroll
    for (int i = 0; i < 4; i++) { float4 v = *(const float4*)(Ysum + o + 4 * i); y[4 * i] = v.x; y[4 * i + 1] = v.y; y[4 * i + 2] = v.z; y[4 * i + 3] = v.w; }
    float s = 0;
#pragma unroll
    for (int i = 0; i < 16; i++) s += y[i];
    s += __shfl_xor(s, 1); s += __shfl_xor(s, 2);
    float mean = s * (1.f / 64.f), q = 0;
#pragma unroll
    for (int i = 0; i < 16; i++) { float d = y[i] - mean; q += d * d; }
    q += __shfl_xor(q, 1); q += __shfl_xor(q, 2);
    float rstd = rsqrtf(q * (1.f / 64.f) + 64e-5f);
    float bon = Bsum[(size_t)row * 16 + (lane >> 2)];
    u16* G = (u16*)(p.ws + OFF_U1) + o;
    const u16* V = (const u16*)(p.ws + OFF_V2) + o;
    const u16* Z = (const u16*)(p.ws + OFF_SZ) + o;
#pragma unroll
    for (int hlf = 0; hlf < 2; hlf++) {
      uint4 gq = *(const uint4*)(G + 8 * hlf), vq = *(const uint4*)(V + 8 * hlf), zq = *(const uint4*)(Z + 8 * hlf);
      const unsigned* gu = (const unsigned*)&gq; const unsigned* vu = (const unsigned*)&vq; const unsigned* zu = (const unsigned*)&zq;
      unsigned ow[4];
#pragma unroll
      for (int w = 0; w < 4; w++) {
        int c = lane * 16 + hlf * 8 + 2 * w;
        float y0 = (y[hlf * 8 + 2 * w] - mean) * rstd * p.lnx_g[c] + p.lnx_b[c] + bon * bflo(vu[w]);
        float y1 = (y[hlf * 8 + 2 * w + 1] - mean) * rstd * p.lnx_g[c + 1] + p.lnx_b[c + 1] + bon * bfhi(vu[w]);
        ow[w] = pack2(y0 * bflo(gu[w]) * bflo(zu[w]), y1 * bfhi(gu[w]) * bfhi(zu[w]));
      }
      *(uint4*)(G + 8 * hlf) = make_uint4(ow[0], ow[1], ow[2], ow[3]);
    }
  }
}

__global__ void __launch_bounds__(256, 2) fwd_kernel(Params p) {
  __shared__ __attribute__((aligned(16))) char smem[49152];
#if FUSED
  cg::grid_group grid = cg::this_grid();
#define SYNC() grid.sync()
#else
#define SYNC()
#endif
#define PH(n, call) if (p.phase_lo <= n && n <= p.phase_hi) { call; if (n < p.phase_hi) { SYNC(); } }
  PH(0, p0_prep(p, smem))
  PH(1, ln_phase<0>(p))
  PH(2, p2_gemm1(p, smem))
  PH(3, p3_mix(p, smem))
  PH(4, p4_fnet(p, smem))
  PH(5, p_outproj<0>(p, smem))
  PH(6, ln_phase<1>(p))
  PH(7, p7_rwkv_proj(p, smem))
  PH(8, p8_scan(p, smem))
  PH(9, p9_post(p))
  PH(10, p_outproj<1>(p, smem))
  PH(11, ln_phase<2>(p))
}

extern "C" void kernel_launch(void* const* d_in, const int* in_sizes, int n_in, void* d_out, int out_size, void* d_ws,
                              size_t ws_size, hipStream_t stream) {
  Params p;
  memset(&p, 0, sizeof(p));
  const float* const* in = (const float* const*)d_in;
  p.x_prompt = in[0]; p.x_sample = in[1]; p.cache_k = in[2]; p.cache_v = in[3]; p.state_rwkv = in[4]; p.c = in[5]; p.c_ctx = in[6];
  p.ada_w = in[7]; p.ada_b = in[8]; p.post_g = in[9]; p.post_b = in[10]; p.w_in = in[11]; p.w_fnet = in[12]; p.rpb = in[13]; p.w_out = in[14];
  p.mu = in[15]; p.rkvz = in[16]; p.w0 = in[17]; p.w1 = in[18]; p.w2 = in[19]; p.a0 = in[20]; p.a1 = in[21]; p.a2 = in[22];
  p.g1 = in[23]; p.g2 = in[24]; p.k_k = in[25]; p.k_a = in[26]; p.r_k = in[27]; p.lnx_g = in[28]; p.lnx_b = in[29]; p.rw_out = in[30];
  p.out = (float*)d_out; p.ws = (char*)d_ws;
  char* ws = (char*)d_ws;
  int n = 0, start = 0;
  auto add = [&](const float* src, size_t dstoff, int lds, int ldd, int tk, int tn) {
    p.tj[n].src = src; p.tj[n].dst = (u16*)(ws + dstoff); p.tj[n].lds = lds; p.tj[n].ldd = ldd; p.tj[n].tk = tk; p.tj[n].tn = tn;
    p.tj[n].start = start; p.tj[n].pad = 0; start += tk * tn; n++;
  };
  add(p.w_in, OFF_WINT, 3072, 1024, 16, 48);
  add(p.w_out, OFF_WOUTT, 1024, 1024, 16, 16);
  for (int i = 0; i < 4; i++) add(p.rkvz + (size_t)i * 1048576, OFF_RKVZT + (size_t)i * 2097152, 1024, 1024, 16, 16);
  add(p.rw_out, OFF_RWOUTT, 1024, 1024, 16, 16);
  for (int e = 0; e < 2; e++) add(p.w1 + e * 65536, OFF_W1T + (size_t)e * 64 * 1024 * 2, 64, 1024, 16, 1);
  for (int e = 0; e < 2; e++) add(p.a1 + e * 65536, OFF_A1T + (size_t)e * 64 * 1024 * 2, 64, 1024, 16, 1);
  add(p.g1, OFF_G1T, 128, 1024, 16, 2);
  for (int e = 0; e < 2; e++) add(p.w2 + e * 65536, OFF_W2T + (size_t)e * 65536 * 2, 1024, 64, 1, 16);
  for (int e = 0; e < 2; e++) add(p.a2 + e * 65536, OFF_A2T + (size_t)e * 65536 * 2, 1024, 64, 1, 16);
  add(p.g2, OFF_G2T, 1024, 128, 2, 16);
  for (int b = 0; b < 2; b++)
    for (int h = 0; h < 8; h++) add(p.cache_v + (size_t)b * 262144 + h * 64, OFF_CVT + (size_t)(b * 8 + h) * 64 * 512 * 2, 512, 512, 8, 1);
  p.ntr = start;

  static int grid_blocks = 0;
  if (!grid_blocks) {
    int dev = 0, cus = 0, per_cu = 0;
    (void)hipGetDevice(&dev);
    (void)hipDeviceGetAttribute(&cus, hipDeviceAttributeMultiprocessorCount, dev);
    (void)hipOccupancyMaxActiveBlocksPerMultiprocessor(&per_cu, fwd_kernel, 256, 0);
    if (per_cu > 2) per_cu = 2;
    if (per_cu < 1) per_cu = 1;
    grid_blocks = cus * per_cu;
  }
#if FUSED
  p.phase_lo = 0; p.phase_hi = 11;
  void* args[] = {&p};
  hipError_t e = hipLaunchCooperativeKernel((void*)fwd_kernel, dim3(grid_blocks), dim3(256), args, 0, stream);
  if (e != hipSuccess) fprintf(stderr, "cooperative launch failed: %s (grid %d)\n", hipGetErrorString(e), grid_blocks);
#else
  for (int ph = 0; ph <= 11; ph++) {
    p.phase_lo = ph; p.phase_hi = ph;
    fwd_kernel<<<grid_blocks, 256, 0, stream>>>(p);
  }
#endif
}
```

```cpp
#include <hip/hip_runtime.h>
#include <hip/hip_cooperative_groups.h>
#include <stdint.h>
#include <cstdio>
#include <cstring>
namespace cg = cooperative_groups;

#ifndef FUSED
#define FUSED 1
#endif

typedef unsigned short u16;
typedef __attribute__((ext_vector_type(8))) __bf16 b16x8;
typedef __attribute__((ext_vector_type(16))) float f32x16;
typedef __attribute__((ext_vector_type(4))) unsigned u32x4;
typedef __attribute__((ext_vector_type(2))) unsigned u32x2;
#define DEV __device__ __forceinline__

constexpr int T_CTX = 8192;
constexpr float ALPHA_DN = 1.41421356237f;
constexpr float LOG2E = 1.44269504089f;
constexpr size_t MiB = 1u << 20;
constexpr size_t OFF_MODS = 0, OFF_BAR = 512 * 1024, OFF_BSUM = 1 * MiB;
constexpr size_t OFF_FSMP = 2 * MiB, OFF_U = 66 * MiB, OFF_ABUF = 98 * MiB, OFF_Q = 114 * MiB, OFF_K = 130 * MiB;
constexpr size_t OFF_VTC = 146 * MiB, OFF_VTS = 154 * MiB, OFF_GBUF = 162 * MiB, OFF_BTC = 194 * MiB, OFF_BTS = 210 * MiB;
constexpr size_t OFF_WINT = 226 * MiB, OFF_WOUTT = 232 * MiB, OFF_MCAT = 234 * MiB, OFF_FCTX = 234 * MiB + 256 * 1024;
constexpr size_t OFF_CK = 234 * MiB + 512 * 1024, OFF_CVT = 235 * MiB + 512 * 1024;
constexpr size_t OFF_RKVZT = 237 * MiB, OFF_RWOUTT = 245 * MiB, OFF_W1T = 247 * MiB, OFF_A1T = OFF_W1T + 256 * 1024,
                 OFF_G1T = OFF_W1T + 512 * 1024, OFF_W2T = OFF_W1T + 768 * 1024, OFF_A2T = 248 * MiB,
                 OFF_G2T = 248 * MiB + 256 * 1024, OFF_HW = 248 * MiB + 512 * 1024;
constexpr size_t OFF_U1 = 2 * MiB, OFF_R = 34 * MiB, OFF_K2 = 66 * MiB, OFF_V2 = 98 * MiB, OFF_SZ = 130 * MiB,
                 OFF_YSUM = 162 * MiB, OFF_HA = 226 * MiB, OFF_HG = 230 * MiB;
constexpr size_t OFF_BFOLD = 98 * MiB;
constexpr size_t OFF_Y0B = 98 * MiB, OFF_Y1B = 34 * MiB;
constexpr size_t OFF_DX = 162 * MiB;
constexpr size_t OFF_SEGP = 2 * MiB, OFF_SEGQ = 6 * MiB, OFF_SEGZ = 14 * MiB;
constexpr size_t OUT_NK = 16777216, OUT_NV = 20971520, OUT_ST = 25165824;

constexpr int NTJ = 33;
struct TJob { const float* src; u16* dst; int lds, ldd, tk, tn, start, pad; };

struct Params {
  const float *x_prompt, *x_sample, *cache_k, *cache_v, *state_rwkv, *c, *c_ctx;
  const float *ada_w, *ada_b, *post_g, *post_b, *w_in, *w_fnet, *rpb, *w_out;
  const float *mu, *rkvz, *w0, *w1, *w2, *a0, *a1, *a2, *g1, *g2, *k_k, *k_a, *r_k, *lnx_g, *lnx_b, *rw_out;
  float* out; char* ws;
  int phase_lo, phase_hi, ntr, pad;
  TJob tj[NTJ];
};

typedef __attribute__((ext_vector_type(2))) __bf16 bf16x2_t;
typedef __attribute__((ext_vector_type(2))) float f32x2_t;
DEV unsigned pack2(float a, float b) {
  f32x2_t f = {a, b};
  bf16x2_t r = __builtin_convertvector(f, bf16x2_t);
  return *(unsigned*)&r;
}
DEV u16 f2bf(float f) { return (u16)(pack2(f, 0.f) & 0xffffu); }
DEV float bflo(unsigned w) { return __uint_as_float(w << 16); }
DEV float bfhi(unsigned w) { return __uint_as_float(w & 0xffff0000u); }
DEV float rcp_f(float x) { return __builtin_amdgcn_rcpf(x); }
DEV float sigm(float x) { return rcp_f(1.f + __expf(-x)); }
DEV float silu(float x) { return x * rcp_f(1.f + __expf(-x)); }
DEV float tanh_f(float x) { return 1.f - 2.f * rcp_f(__expf(2.f * x) + 1.f); }
DEV b16x8 ld16(const u16* p) { uint4 v = *(const uint4*)p; return *(b16x8*)&v; }
DEV b16x8 asb(uint4 v) { return *(b16x8*)&v; }
template <int CTRL> DEV float dpp_add(float x) {
  return x + __int_as_float(__builtin_amdgcn_update_dpp(0, __float_as_int(x), CTRL, 0xf, 0xf, true));
}
DEV float allsum8(float x) {
  x = dpp_add<0xB1>(x); x = dpp_add<0x4E>(x); x = dpp_add<0x141>(x);
  return x;
}
DEV float wave_sum(float x) {
  x = dpp_add<0xB1>(x); x = dpp_add<0x4E>(x); x = dpp_add<0x141>(x); x = dpp_add<0x140>(x);
  x += __shfl_xor(x, 16); x += __shfl_xor(x, 32);
  return x;
}
DEV float allsum16(float x) {
  x = dpp_add<0xB1>(x); x = dpp_add<0x4E>(x); x = dpp_add<0x124>(x); x = dpp_add<0x128>(x);
  return x;
}
DEV void lds_barrier() { asm volatile("s_waitcnt lgkmcnt(0)\n\ts_barrier" ::: "memory"); }
DEV int mv_of(int token) { return token < T_CTX ? 0 : 1 + ((token - T_CTX) >> 12); }

template <bool LERP, class EP>
DEV void gemm_tile(const u16* __restrict__ A, int lda, const float* __restrict__ mu, int m0,
                   const u16* __restrict__ B, int ldb, int K, EP ep, char* smem) {
  u16(*sA)[72] = (u16(*)[72])smem;
  u16(*sB)[72] = (u16(*)[72])(smem + 128 * 72 * 2);
  int tid = threadIdx.x;
  asm volatile("" : "+v"(tid));
  const int lane = tid & 63, wave = tid >> 6, wm = wave >> 1, wn = wave & 1;
  const int lr = tid >> 3, lk = (tid & 7) * 8;
  f32x16 acc[2][2];
#pragma unroll
  for (int i = 0; i < 2; i++)
#pragma unroll
    for (int j = 0; j < 2; j++)
#pragma unroll
      for (int r = 0; r < 16; r++) acc[i][j][r] = 0.f;
  u32x4 ra0[4], rb0[4], rp0[4], ra1[4], rb1[4], rp1[4];
  float4 mu00, mu01, mu10, mu11;
  const u16* DXp = nullptr;
  if constexpr (LERP) DXp = (const u16*)(A) + (OFF_DX - OFF_U1) / 2;
#define GLOAD(K0, RA, RB, RP, M0, M1)                                                     \
  {                                                                                       \
    _Pragma("unroll") for (int i = 0; i < 4; i++) {                                       \
      int r = lr + 32 * i;                                                                \
      if constexpr (LERP) {                                                               \
        RA[i] = *(const u32x4*)(A + (size_t)(m0 + r) * lda + (K0) + lk);                  \
        RP[i] = *(const u32x4*)(DXp + (size_t)(m0 + r) * lda + (K0) + lk);                \
      } else {                                                                            \
        RA[i] = *(const u32x4*)(A + (size_t)r * lda + (K0) + lk);                         \
      }                                                                                   \
      RB[i] = *(const u32x4*)(B + (size_t)r * ldb + (K0) + lk);                           \
    }                                                                                     \
    if constexpr (LERP) {                                                                 \
      M0 = *(const float4*)(mu + (K0) + lk);                                              \
      M1 = *(const float4*)(mu + (K0) + lk + 4);                                          \
    }                                                                                     \
  }
#define GSTORE(RA, RB, RP, M0, M1)                                                        \
  {                                                                                       \
    _Pragma("unroll") for (int i = 0; i < 4; i++) {                                       \
      int r = lr + 32 * i;                                                                \
      u32x4 av = RA[i];                                                                   \
      if constexpr (LERP) {                                                               \
        unsigned cu[4] = {RA[i].x, RA[i].y, RA[i].z, RA[i].w};                            \
        unsigned du[4] = {RP[i].x, RP[i].y, RP[i].z, RP[i].w};                            \
        float m[8] = {M0.x, M0.y, M0.z, M0.w, M1.x, M1.y, M1.z, M1.w};                    \
        unsigned o[4];                                                                    \
        _Pragma("unroll") for (int q = 0; q < 4; q++) {                                   \
          const f32x2_t u2 = {bflo(cu[q]), bfhi(cu[q])}, d2 = {bflo(du[q]), bfhi(du[q])}, m2 = {m[2 * q], m[2 * q + 1]}; \
          const f32x2_t x2 = u2 + d2 * m2;                                \
          const bf16x2_t xb = __builtin_convertvector(x2, bf16x2_t);                      \
          o[q] = *(const unsigned*)&xb;                                                   \
        }                                                                                 \
        av = u32x4{o[0], o[1], o[2], o[3]};                                               \
      }                                                                                   \
      *(u32x4*)&sA[r][lk] = av;                                                           \
      *(u32x4*)&sB[r][lk] = RB[i];                                                        \
    }                                                                                     \
  }
#define GCOMPUTE()                                                                        \
  {                                                                                       \
    _Pragma("unroll") for (int ks = 0; ks < 4; ks++) {                                    \
      b16x8 af[2], bf[2];                                                                 \
      _Pragma("unroll") for (int i = 0; i < 2; i++) {                                     \
        af[i] = *(const b16x8*)&sA[wm * 64 + i * 32 + (lane & 31)][ks * 16 + (lane >> 5) * 8]; \
        bf[i] = *(const b16x8*)&sB[wn * 64 + i * 32 + (lane & 31)][ks * 16 + (lane >> 5) * 8]; \
      }                                                                                   \
      _Pragma("unroll") for (int i = 0; i < 2; i++)                                       \
        _Pragma("unroll") for (int j = 0; j < 2; j++)                                     \
          acc[i][j] = __builtin_amdgcn_mfma_f32_32x32x16_bf16(af[i], bf[j], acc[i][j], 0, 0, 0); \
    }                                                                                     \
  }
  GLOAD(0, ra0, rb0, rp0, mu00, mu01);
  GLOAD(64, ra1, rb1, rp1, mu10, mu11);
#pragma unroll 1
  for (int k0 = 0; k0 < K; k0 += 128) {
    __syncthreads();
    GSTORE(ra0, rb0, rp0, mu00, mu01);
    __syncthreads();
    if (k0 + 128 < K) GLOAD(k0 + 128, ra0, rb0, rp0, mu00, mu01);
    GCOMPUTE();
    __syncthreads();
    GSTORE(ra1, rb1, rp1, mu10, mu11);
    __syncthreads();
    if (k0 + 192 < K) GLOAD(k0 + 192, ra1, rb1, rp1, mu10, mu11);
    GCOMPUTE();
  }
#undef GLOAD
#undef GSTORE
#undef GCOMPUTE
  __syncthreads();
  int tide = tid;
  asm volatile("" : "+v"(tide));
  const int lane_e = tide & 63, wv_e = tide >> 6, wm_e = wv_e >> 1, wn_e = wv_e & 1;
  u16* stg = (u16*)smem + wv_e * (64 * 72);
#pragma unroll
  for (int i = 0; i < 2; i++)
#pragma unroll
    for (int j = 0; j < 2; j++)
#pragma unroll
      for (int q = 0; q < 4; q++) {
        const int r = i * 32 + q * 8 + (lane_e >> 5) * 4, c = j * 32 + (lane_e & 31);
        const float v0 = acc[i][j][q * 4 + 0], v1 = acc[i][j][q * 4 + 1], v2 = acc[i][j][q * 4 + 2], v3 = acc[i][j][q * 4 + 3];
        ep.direct(wm_e * 64 + r, wn_e * 64 + c, v0, v1, v2, v3);
        if constexpr (EP::TRANS) {
          *(uint2*)(stg + c * 72 + r) = make_uint2(pack2(ep.act(v0), ep.act(v1)), pack2(ep.act(v2), ep.act(v3)));
        } else {
          const unsigned p01 = pack2(ep.act(v0), ep.act(v1)), p23 = pack2(ep.act(v2), ep.act(v3));
          stg[(r + 0) * 72 + c] = (u16)(p01 & 0xffffu); stg[(r + 1) * 72 + c] = (u16)(p01 >> 16);
          stg[(r + 2) * 72 + c] = (u16)(p23 & 0xffffu); stg[(r + 3) * 72 + c] = (u16)(p23 >> 16);
        }
      }
#pragma unroll
  for (int n = 0; n < 8; n++) {
    const int id = lane_e + 64 * n, rr = id >> 3, cc = (id & 7) * 8;
    const u32x4 v = *(const u32x4*)(stg + rr * 72 + cc);
    if constexpr (EP::TRANS) ep.store(wn_e * 64 + rr, wm_e * 64 + cc, v);
    else ep.store(wm_e * 64 + rr, wn_e * 64 + cc, v);
  }
}

template <int ACT> struct EpStore {
  static constexpr bool TRANS = false;
  u16* dst; int ld; float scale;
  DEV float act(float x) const {
    if (ACT == 1) return silu(x);
    if (ACT == 2) return tanh_f(x);
    if (ACT == 3) return sigm(x);
    if (ACT == 4) return x * scale;
    return x;
  }
  DEV void direct(int, int, float, float, float, float) const {}
  DEV void store(int R, int C, u32x4 v) const { *(u32x4*)(dst + (size_t)R * ld + C) = v; }
};
struct EpNull {
  static constexpr bool TRANS = false;
  DEV float act(float x) const { return x; }
  DEV void direct(int, int, float, float, float, float) const {}
  DEV void store(int, int, u32x4) const {}
};
struct EpKeep {
  static constexpr bool TRANS = false;
  u16* dst; int ld; float* f32dst; int ldf;
  DEV float act(float x) const { return x; }
  DEV void direct(int r, int c, float v0, float v1, float v2, float v3) const {
    if (f32dst) {
      f32dst[(size_t)(r + 0) * ldf + c] = v0; f32dst[(size_t)(r + 1) * ldf + c] = v1;
      f32dst[(size_t)(r + 2) * ldf + c] = v2; f32dst[(size_t)(r + 3) * ldf + c] = v3;
    }
  }
  DEV void store(int R, int C, u32x4 v) const { *(u32x4*)(dst + (size_t)R * ld + C) = v; }
};
struct EpTrans {
  static constexpr bool TRANS = true;
  u16* dst; size_t ldt; float* f32dst; int ldf;
  DEV float act(float x) const { return x; }
  DEV void direct(int r, int c, float v0, float v1, float v2, float v3) const {
    if (f32dst) {
      f32dst[(size_t)(r + 0) * ldf + c] = v0; f32dst[(size_t)(r + 1) * ldf + c] = v1;
      f32dst[(size_t)(r + 2) * ldf + c] = v2; f32dst[(size_t)(r + 3) * ldf + c] = v3;
    }
  }
  DEV void store(int Rc, int Cr, u32x4 v) const { *(u32x4*)(dst + (size_t)Rc * ldt + Cr) = v; }
};
struct EpGate {
  static constexpr bool TRANS = false;
  u16* dst; const u16* gate; int ld;
  DEV float act(float x) const { return x; }
  DEV void direct(int, int, float, float, float, float) const {}
  DEV void store(int R, int C, u32x4 v) const {
    const size_t o = (size_t)R * ld + C;
    const u32x4 g = *(const u32x4*)(gate + o);
    u32x4 r;
    r.x = pack2(bflo(v.x) * bflo(g.x), bfhi(v.x) * bfhi(g.x)); r.y = pack2(bflo(v.y) * bflo(g.y), bfhi(v.y) * bfhi(g.y));
    r.z = pack2(bflo(v.z) * bflo(g.z), bfhi(v.z) * bfhi(g.z)); r.w = pack2(bflo(v.w) * bflo(g.w), bfhi(v.w) * bfhi(g.w));
    *(u32x4*)(dst + o) = r;
  }
};
struct EpRes {
  static constexpr bool TRANS = false;
  u16* dst; const float* xsrc; const float* gate;
  DEV float act(float x) const { return x; }
  DEV void direct(int, int, float, float, float, float) const {}
  DEV void store(int R, int C, u32x4 v) const {
    const size_t o = (size_t)R * 1024 + C;
    const float4 x0 = *(const float4*)(xsrc + o), x1 = *(const float4*)(xsrc + o + 4);
    const float4 g0 = *(const float4*)(gate + C), g1 = *(const float4*)(gate + C + 4);
    u32x4 r;
    r.x = pack2(ALPHA_DN * x0.x + (1.f + g0.x) * bflo(v.x), ALPHA_DN * x0.y + (1.f + g0.y) * bfhi(v.x));
    r.y = pack2(ALPHA_DN * x0.z + (1.f + g0.z) * bflo(v.y), ALPHA_DN * x0.w + (1.f + g0.w) * bfhi(v.y));
    r.z = pack2(ALPHA_DN * x1.x + (1.f + g1.x) * bflo(v.z), ALPHA_DN * x1.y + (1.f + g1.y) * bfhi(v.z));
    r.w = pack2(ALPHA_DN * x1.z + (1.f + g1.z) * bflo(v.w), ALPHA_DN * x1.w + (1.f + g1.w) * bfhi(v.w));
    *(u32x4*)(dst + o) = r;
  }
};

DEV void p0_prep(const Params& p, char* smem) {
  const int tid = threadIdx.x;
  const int njobs = 192 + p.ntr;
  for (int job = blockIdx.x; job < njobs; job += gridDim.x) {
    __syncthreads();
    if (job < 192) {
      float* sc = (float*)smem;
      float* red = sc + 3072;
      for (int i = tid; i < 3072; i += 256) {
        int m = i >> 10, k = i & 1023;
        float cv = m == 0 ? p.c_ctx[k] : p.c[(m - 1) * 1024 + k];
        sc[i] = silu(cv);
      }
      __syncthreads();
      int l = job / 96, col = (job % 96) * 32 + (tid & 31), ks = tid >> 5;
      const float* w = p.ada_w + (size_t)l * 1024 * 3072 + col;
      float a0 = 0, a1 = 0, a2 = 0;
#pragma unroll 8
      for (int k = ks * 128; k < ks * 128 + 128; k++) {
        float wv = w[(size_t)k * 3072];
        a0 += sc[k] * wv; a1 += sc[1024 + k] * wv; a2 += sc[2048 + k] * wv;
      }
      red[(ks * 32 + (tid & 31)) * 3 + 0] = a0; red[(ks * 32 + (tid & 31)) * 3 + 1] = a1; red[(ks * 32 + (tid & 31)) * 3 + 2] = a2;
      __syncthreads();
      if (tid < 96) {
        int cl = tid & 31, m = tid >> 5;
        float s = 0;
        for (int q = 0; q < 8; q++) s += red[(q * 32 + cl) * 3 + m];
        int cc = (job % 96) * 32 + cl;
        ((float*)(p.ws + OFF_MODS))[(l * 3 + m) * 3072 + cc] = s + p.ada_b[l * 3072 + cc];
      }
    } else {
      int tj = job - 192, e = 0;
      while (e + 1 < NTJ && p.tj[e + 1].start <= tj) e++;
      const TJob J = p.tj[e];
      int lt = tj - J.start, tkk = lt / J.tn, tnn = lt % J.tn;
      float(*tile)[65] = (float(*)[65])smem;
      const float* src = J.src + (size_t)(tkk * 64) * J.lds + tnn * 64;
#pragma unroll
      for (int i = 0; i < 4; i++) {
        int kk = (tid >> 4) + 16 * i, nn = (tid & 15) * 4;
        float4 v = *(const float4*)(src + (size_t)kk * J.lds + nn);
        tile[kk][nn] = v.x; tile[kk][nn + 1] = v.y; tile[kk][nn + 2] = v.z; tile[kk][nn + 3] = v.w;
      }
      __syncthreads();
      u16* dst = J.dst + (size_t)(tnn * 64) * J.ldd + tkk * 64;
#pragma unroll
      for (int i = 0; i < 2; i++) {
        int nn = (tid >> 3) + 32 * i, kk = (tid & 7) * 8;
        uint4 o;
        o.x = pack2(tile[kk][nn], tile[kk + 1][nn]); o.y = pack2(tile[kk + 2][nn], tile[kk + 3][nn]);
        o.z = pack2(tile[kk + 4][nn], tile[kk + 5][nn]); o.w = pack2(tile[kk + 6][nn], tile[kk + 7][nn]);
        *(uint4*)(dst + (size_t)nn * J.ldd + kk) = o;
      }
    }
  }
  const size_t gt = (size_t)blockIdx.x * 256 + tid, gs = (size_t)gridDim.x * 256;
  {
    u16* ck = (u16*)(p.ws + OFF_CK);
    for (size_t i = gt; i < 65536; i += gs) {
      float4 a = *(const float4*)(p.cache_k + i * 8), b = *(const float4*)(p.cache_k + i * 8 + 4);
      *(uint4*)(ck + i * 8) = make_uint4(pack2(a.x, a.y), pack2(a.z, a.w), pack2(b.x, b.y), pack2(b.z, b.w));
    }
  }
  {
    u16* fs = (u16*)(p.ws + OFF_FSMP);
    const float sc = 0.001381067932f;
    for (size_t i = gt; i < 2097152; i += gs) {
      int lp = (int)(i >> 9), j0 = (int)(i & 511) * 8;
      unsigned o[4];
#pragma unroll
      for (int q = 0; q < 4; q++) {
        float v[2];
#pragma unroll
        for (int z = 0; z < 2; z++) {
          int j = j0 + 2 * q + z;
          bool cs = j <= 2048;
          int ph = (lp * (cs ? j : j - 2048)) & 4095;
          float ang = (float)ph * (6.283185307179586f / 4096.f);
          v[z] = (cs ? __cosf(ang) : -__sinf(ang)) * sc;
        }
        o[q] = pack2(v[0], v[1]);
      }
      *(uint4*)(fs + i * 8) = make_uint4(o[0], o[1], o[2], o[3]);
    }
    u16* fc = (u16*)(p.ws + OFF_FCTX);
    const float sc2 = 0.005524271728f;
    for (size_t i = gt; i < 16384; i += gs) {
      int lp = (int)(i >> 6), j0 = (int)(i & 63) * 8;
      unsigned o[4];
#pragma unroll
      for (int q = 0; q < 4; q++) {
        float v[2];
#pragma unroll
        for (int z = 0; z < 2; z++) {
          int j = j0 + 2 * q + z;
          int ph = (lp * (j & 255)) & 255;
          float ang = (float)ph * (6.283185307179586f / 256.f);
          v[z] = (j < 256 ? __cosf(ang) : -__sinf(ang)) * sc2;
        }
        o[q] = pack2(v[0], v[1]);
      }
      *(uint4*)(fc + i * 8) = make_uint4(o[0], o[1], o[2], o[3]);
    }
  }
  {
    u16* mc = (u16*)(p.ws + OFF_MCAT);
    for (size_t i = gt; i < 131072; i += gs) {
      int c = (int)(i & 127), ep = (int)((i >> 7) & 255), g = (int)(i >> 15);
      const float* wf = p.w_fnet + (size_t)g * 16384 + (ep & 127);
      float s = 0;
      for (int cp = 0; cp < 128; cp++) {
        float ang = (float)((c * cp) & 127) * (6.283185307179586f / 128.f);
        float tw = ep < 128 ? __cosf(ang) : __sinf(ang);
        s += tw * wf[cp * 128];
      }
      mc[i] = f2bf(s);
    }
  }
}

DEV void ln_stats(const float4 (&x)[4], float& mean, float& rstd) {
  float s = 0;
#pragma unroll
  for (int i = 0; i < 4; i++) s += x[i].x + x[i].y + x[i].z + x[i].w;
  mean = wave_sum(s) * (1.f / 1024.f);
  float q = 0;
#pragma unroll
  for (int i = 0; i < 4; i++) {
    float a = x[i].x - mean, b = x[i].y - mean, c = x[i].z - mean, d = x[i].w - mean;
    q += a * a + b * b + c * c + d * d;
  }
  rstd = rsqrtf(wave_sum(q) * (1.f / 1024.f) + 1e-6f);
}

template <int MODE> DEV void ln_phase(const Params& p) {
  const int lane = threadIdx.x & 63;
  const int gw = blockIdx.x * 4 + (threadIdx.x >> 6), nw = gridDim.x * 4;
  const float* mods = (const float*)(p.ws + OFF_MODS);
  typedef __attribute__((ext_vector_type(4))) float f32x4v;
  f32x4v xn[4];
  u32x2 wn[4];
  auto fetch = [&](int row) {
    if (MODE == 0) {
      const float* src = row < T_CTX ? p.x_prompt + (size_t)row * 1024 : p.x_sample + (size_t)(row - T_CTX) * 1024;
#pragma unroll
      for (int i = 0; i < 4; i++) xn[i] = *(const f32x4v*)(src + lane * 4 + 256 * i);
    } else {
      const u16* sb = (const u16*)(p.ws + (MODE == 1 ? OFF_Y0B : OFF_Y1B)) + (size_t)row * 1024;
#pragma unroll
      for (int i = 0; i < 4; i++) wn[i] = *(const u32x2*)(sb + lane * 4 + 256 * i);
    }
  };
  if (gw < 16384) fetch(gw);
  for (int row = gw; row < 16384; row += nw) {
    float4 x[4];
#pragma unroll
    for (int i = 0; i < 4; i++) {
      if (MODE == 0) x[i] = make_float4(xn[i].x, xn[i].y, xn[i].z, xn[i].w);
      else x[i] = make_float4(bflo(wn[i].x), bfhi(wn[i].x), bflo(wn[i].y), bfhi(wn[i].y));
    }
    if (row + nw < 16384) fetch(row + nw);
    float mean, rstd;
    ln_stats(x, mean, rstd);
    if (MODE >= 1) {
      const float* g = p.post_g + (MODE == 1 ? 0 : 1024);
      const float* b = p.post_b + (MODE == 1 ? 0 : 1024);
      float* dst = p.out + (size_t)row * 1024;
#pragma unroll
      for (int i = 0; i < 4; i++) {
        float4 gv = *(const float4*)(g + lane * 4 + 256 * i), bv = *(const float4*)(b + lane * 4 + 256 * i);
        x[i].x = (x[i].x - mean) * rstd * gv.x + bv.x; x[i].y = (x[i].y - mean) * rstd * gv.y + bv.y;
        x[i].z = (x[i].z - mean) * rstd * gv.z + bv.z; x[i].w = (x[i].w - mean) * rstd * gv.w + bv.w;
        *(float4*)(dst + lane * 4 + 256 * i) = x[i];
      }
      if (MODE == 2) continue;
      ln_stats(x, mean, rstd);
    }
    const float* md = mods + ((MODE == 0 ? 0 : 3) + mv_of(row)) * 3072;
    u16* ud = (u16*)(p.ws + (MODE == 0 ? OFF_U : OFF_U1)) + (size_t)row * 1024;
#pragma unroll
    for (int i = 0; i < 4; i++) {
      int k = lane * 4 + 256 * i;
      float4 sh = *(const float4*)(md + k), sc = *(const float4*)(md + 1024 + k);
      float a = (x[i].x - mean) * rstd * (1.f + sc.x) + sh.x, b = (x[i].y - mean) * rstd * (1.f + sc.y) + sh.y;
      float c = (x[i].z - mean) * rstd * (1.f + sc.z) + sh.z, d = (x[i].w - mean) * rstd * (1.f + sc.w) + sh.w;
      *(uint2*)(ud + k) = make_uint2(pack2(a, b), pack2(c, d));
    }
  }
}

DEV void p2_gemm1(const Params& p, char* smem) {
  const u16* U = (const u16*)(p.ws + OFF_U);
  const u16* W = (const u16*)(p.ws + OFF_WINT);
  const int xcd = blockIdx.x & 7, jx = blockIdx.x >> 3, nbx = gridDim.x >> 3;
  for (int q = jx; q < 16 * 24; q += nbx) {
    int st = q >> 6, w = q & 63, sm = st / 3, sn = st % 3;
    int mt = xcd * 16 + sm * 8 + (w >> 3), nt = sn * 8 + (w & 7);
    int m0 = mt * 128, n0 = nt * 128, sec = nt >> 2, nc = (nt & 3) * 128;
    const u16* A = U + (size_t)m0 * 1024;
    const u16* B = W + (size_t)n0 * 1024;
    if (sec == 0) {
      gemm_tile<false>(A, 1024, nullptr, m0, B, 1024, 1024, EpStore<0>{(u16*)(p.ws + OFF_ABUF) + (size_t)m0 * 512 + nc, 512, 1.f}, smem);
    } else if (sec == 1 || sec == 5) {
      gemm_tile<false>(A, 1024, nullptr, m0, B, 1024, 1024,
                       EpStore<1>{(u16*)(p.ws + OFF_GBUF) + (size_t)m0 * 1024 + (sec == 5 ? 512 : 0) + nc, 1024, 1.f}, smem);
    } else if (sec == 2) {
      gemm_tile<false>(A, 1024, nullptr, m0, B, 1024, 1024, EpStore<4>{(u16*)(p.ws + OFF_Q) + (size_t)m0 * 512 + nc, 512, 0.125f * LOG2E}, smem);
    } else if (sec == 3) {
      float* f = m0 < T_CTX ? p.out + OUT_NK + (size_t)m0 * 512 + nc : nullptr;
      gemm_tile<false>(A, 1024, nullptr, m0, B, 1024, 1024, EpKeep{(u16*)(p.ws + OFF_K) + (size_t)m0 * 512 + nc, 512, f, 512}, smem);
    } else {
      float* f = m0 < T_CTX ? p.out + OUT_NV + (size_t)m0 * 512 + nc : nullptr;
      u16* d; size_t ldt;
      if (m0 < T_CTX) { int b = m0 >> 8, l = m0 & 255; ldt = 256; d = (u16*)(p.ws + OFF_VTC) + ((size_t)b * 512 + nc) * 256 + l; }
      else { int tt = m0 - T_CTX, b = tt >> 12, l = tt & 4095; ldt = 4096; d = (u16*)(p.ws + OFF_VTS) + ((size_t)b * 512 + nc) * 4096 + l; }
      gemm_tile<false>(A, 1024, nullptr, m0, B, 1024, 1024, EpTrans{d, ldt, f, 512}, smem);
    }
  }
}

struct AttnState { f32x16 o0, o1; float m, l; };

DEV void attn_tile(AttnState& st, const b16x8 (&qf)[4], const u16* kS, const u16* vS, int mode, int dr, int kc0, int c,
                   const float* rpbh, int qi, int hh) {
  f32x16 s;
#pragma unroll
  for (int r = 0; r < 16; r++) s[r] = 0.f;
#pragma unroll
  for (int ks = 0; ks < 4; ks++) s = __builtin_amdgcn_mfma_f32_32x32x16_bf16(*(const b16x8*)(kS + qi * 72 + ks * 16 + hh * 8), qf[ks], s, 0, 0, 0);
  if (mode) {
    int cs = min(max(c - 8, 0), 48);
#pragma unroll
    for (int r = 0; r < 16; r++) {
      int kc = kc0 + (r & 3) + 8 * (r >> 2) + 4 * hh;
      bool valid = (kc >= cs) && (kc < cs + 16);
      int dc = min(max(kc - c + 15, 0), 30);
      float bias = rpbh[dr * 31 + dc] * LOG2E;
      s[r] = valid ? s[r] + bias : -1e30f;
    }
  }
  float tm = s[0];
#pragma unroll
  for (int r = 1; r < 16; r++) tm = fmaxf(tm, s[r]);
  tm = fmaxf(tm, __shfl_xor(tm, 32));
  float mn = fmaxf(st.m, tm);
  float alpha = __builtin_amdgcn_exp2f(st.m - mn);
  st.m = mn;
  float ps = 0;
#pragma unroll
  for (int r = 0; r < 16; r++) { float e = __builtin_amdgcn_exp2f(s[r] - mn); ps += e; s[r] = e; }
  st.l = st.l * alpha + ps;
#pragma unroll
  for (int r = 0; r < 16; r++) { st.o0[r] *= alpha; st.o1[r] *= alpha; }
#pragma unroll
  for (int s2 = 0; s2 < 2; s2++) {
    u32x4 pw = {pack2(s[8 * s2 + 0], s[8 * s2 + 1]), pack2(s[8 * s2 + 2], s[8 * s2 + 3]),
                pack2(s[8 * s2 + 4], s[8 * s2 + 5]), pack2(s[8 * s2 + 6], s[8 * s2 + 7])};
    b16x8 pfr = *(b16x8*)&pw;
#pragma unroll
    for (int dt = 0; dt < 2; dt++) {
      const u16* vr = vS + (dt * 32 + qi) * 40 + 16 * s2 + 4 * hh;
      const uint2 lo = *(const uint2*)vr, hi = *(const uint2*)(vr + 8);
      u32x4 vw = {lo.x, lo.y, hi.x, hi.y};
      b16x8 vf = *(b16x8*)&vw;
      if (dt == 0) st.o0 = __builtin_amdgcn_mfma_f32_32x32x16_bf16(vf, pfr, st.o0, 0, 0, 0);
      else st.o1 = __builtin_amdgcn_mfma_f32_32x32x16_bf16(vf, pfr, st.o1, 0, 0, 0);
    }
  }
}

DEV void attn_unit(const Params& p, int u, int lane, char* smem) {
  const u16* Qb = (const u16*)(p.ws + OFF_Q);
  const u16* Kb = (const u16*)(p.ws + OFF_K);
  const int qi = lane & 31, hh = lane >> 5;
  u16* kS = (u16*)smem + (threadIdx.x >> 6) * 4864;
  u16* vS = kS + 32 * 72;
  bool smp = u < 2048;
  int b, h, qg, tq0, r = 0, c0 = 0;
  if (smp) { b = u >> 10; h = (u >> 7) & 7; qg = u & 127; tq0 = T_CTX + b * 4096 + qg * 32; r = qg >> 1; c0 = (qg & 1) * 32; }
  else { int v = u - 2048; b = v >> 6; h = (v >> 3) & 7; qg = v & 7; tq0 = b * 256 + qg * 32; }
  b16x8 qf[4];
#pragma unroll
  for (int s = 0; s < 4; s++) qf[s] = ld16(Qb + (size_t)(tq0 + qi) * 512 + h * 64 + s * 16 + hh * 8);
  AttnState st;
#pragma unroll
  for (int i = 0; i < 16; i++) { st.o0[i] = 0.f; st.o1[i] = 0.f; }
  st.m = -INFINITY; st.l = 0.f;
  const float* rpbh = p.rpb + h * 465;
  const int rs = min(max(r - 4, 0), 56);
  const u16* ck = (const u16*)(p.ws + OFF_CK) + (size_t)b * 512 * 512 + h * 64;
  const u16* cvt = (const u16*)(p.ws + OFF_CVT) + (size_t)(b * 8 + h) * 64 * 512;
  const u16* kls = Kb + (size_t)(T_CTX + b * 4096) * 512 + h * 64;
  const u16* vls = (const u16*)(p.ws + OFF_VTS) + (size_t)(b * 8 + h) * 64 * 4096;
  const u16* klc = Kb + (size_t)(b * 256) * 512 + h * 64;
  const u16* vlc = (const u16*)(p.ws + OFF_VTC) + (size_t)(b * 8 + h) * 64 * 256;
  const int ntile = smp ? 32 : 8;
  u32x4 kr[4], vr[4];
  auto issue = [&](int tt) {
    int ll = lane;
    asm volatile("" : "+v"(ll));
    const u16 *kp, *vp; int ldv;
    if (!smp) { kp = klc + (size_t)tt * 32 * 512; vp = vlc + tt * 32; ldv = 256; }
    else if (tt < 16) { kp = ck + (size_t)tt * 32 * 512; vp = cvt + tt * 32; ldv = 512; }
    else { int kt = tt - 16, krow = rs + (kt >> 1), kc0 = (kt & 1) * 32; kp = kls + (size_t)(krow * 64 + kc0) * 512; vp = vls + krow * 64 + kc0; ldv = 4096; }
#pragma unroll
    for (int n = 0; n < 4; n++) {
      const int id = ll + 64 * n;
      kr[n] = *(const u32x4*)(kp + (size_t)(id >> 3) * 512 + (id & 7) * 8);
      vr[n] = *(const u32x4*)(vp + (size_t)(id >> 2) * ldv + (id & 3) * 8);
    }
  };
  issue(0);
#pragma unroll 1
  for (int tt = 0; tt < ntile; tt++) {
    {
      int ll = lane;
      asm volatile("" : "+v"(ll));
#pragma unroll
      for (int n = 0; n < 4; n++) {
        const int id = ll + 64 * n;
        *(u32x4*)(kS + (id >> 3) * 72 + (id & 7) * 8) = kr[n];
        *(u32x4*)(vS + (id >> 2) * 40 + (id & 3) * 8) = vr[n];
      }
    }
    if (tt + 1 < ntile) issue(tt + 1);
    const bool loc = smp && tt >= 16;
    const int kt = tt - 16;
    attn_tile(st, qf, kS, vS, loc ? 1 : 0, loc ? rs + (kt >> 1) - r + 7 : 0, loc ? (kt & 1) * 32 : 0, c0 + qi, rpbh, qi, hh);
  }
  float lt = st.l + __shfl_xor(st.l, 32);
  float inv = 1.f / lt;
  const size_t rowo = (size_t)(tq0 + qi) * 1024 + 512 + h * 64;
  const u16* gb = (const u16*)(p.ws + OFF_GBUF) + rowo;
  u16* cat = (u16*)(p.ws + OFF_U) + rowo;
#pragma unroll
  for (int dt = 0; dt < 2; dt++)
#pragma unroll
    for (int q = 0; q < 4; q++) {
      int d = dt * 32 + q * 8 + hh * 4;
      uint2 g = *(const uint2*)(gb + d);
      float v0 = (dt ? st.o1[q * 4 + 0] : st.o0[q * 4 + 0]) * inv * bflo(g.x);
      float v1 = (dt ? st.o1[q * 4 + 1] : st.o0[q * 4 + 1]) * inv * bfhi(g.x);
      float v2 = (dt ? st.o1[q * 4 + 2] : st.o0[q * 4 + 2]) * inv * bflo(g.y);
      float v3 = (dt ? st.o1[q * 4 + 3] : st.o0[q * 4 + 3]) * inv * bfhi(g.y);
      *(uint2*)(cat + d) = make_uint2(pack2(v0, v1), pack2(v2, v3));
    }
}

DEV void p3_mix(const Params& p, char* smem) {
  for (int t = blockIdx.x; t < 2048; t += gridDim.x) {
    if (t < 1024) {
      __syncthreads();
      attn_unit(p, t * 4 + (threadIdx.x >> 6), threadIdx.x & 63, smem);
    } else {
      int q = t - 1024, mt = q >> 3, g = (q >> 1) & 3, nh = q & 1, m0 = mt * 128;
      const u16* A = (const u16*)(p.ws + OFF_ABUF) + (size_t)m0 * 512 + g * 128;
      const u16* B = (const u16*)(p.ws + OFF_MCAT) + (size_t)(g * 256 + nh * 128) * 128;
      u16* d; size_t ldt;
      if (m0 < T_CTX) { int b = m0 >> 8, l = m0 & 255; ldt = 512; d = (u16*)(p.ws + OFF_BTC) + ((size_t)b * 512 + g * 128) * 512 + nh * 256 + l; }
      else { int tt = m0 - T_CTX, b = tt >> 12, l = tt & 4095; ldt = 8192; d = (u16*)(p.ws + OFF_BTS) + ((size_t)b * 512 + g * 128) * 8192 + nh * 4096 + l; }
      gemm_tile<false>(A, 512, nullptr, m0, B, 128, 128, EpTrans{d, ldt, nullptr, 0}, smem);
    }
  }
}

DEV void p3b_fold(const Params& p) {
  const u16* bt = (const u16*)(p.ws + OFF_BTS);
  u16* bf = (u16*)(p.ws + OFF_BFOLD);
  const size_t gt = (size_t)blockIdx.x * 256 + threadIdx.x, gs = (size_t)gridDim.x * 256;
  for (size_t i = gt; i < 4194304; i += gs) {
    const int jj = (int)(i & 4095);
    const u16* row = bt + (i >> 12) * 8192;
    float v;
    if (jj <= 2048) {
      v = __uint_as_float((unsigned)row[jj] << 16);
      if (jj >= 1 && jj <= 2047) v += __uint_as_float((unsigned)row[4096 - jj] << 16);
    } else {
      const int j = jj - 2048;
      v = __uint_as_float((unsigned)row[4096 + j] << 16) - __uint_as_float((unsigned)row[8192 - j] << 16);
    }
    bf[i] = f2bf(v);
  }
}

DEV void p4_fnet(const Params& p, char* smem) {
  for (int t = blockIdx.x; t < 512; t += gridDim.x) {
    if (t < 256) {
      int b = t >> 7, mt = (t >> 2) & 31, nt = t & 3;
      int tok0 = T_CTX + b * 4096 + mt * 128;
      const u16* A = (const u16*)(p.ws + OFF_FSMP) + (size_t)(mt * 128) * 4096;
      const u16* B = (const u16*)(p.ws + OFF_BFOLD) + ((size_t)b * 512 + nt * 128) * 4096;
      size_t o = (size_t)tok0 * 1024 + nt * 128;
      gemm_tile<false>(A, 4096, nullptr, 0, B, 4096, 4096, EpGate{(u16*)(p.ws + OFF_U) + o, (const u16*)(p.ws + OFF_GBUF) + o, 1024}, smem);
    } else {
      int q = t - 256, b = q >> 3, mt = (q >> 2) & 1, nt = q & 3;
      int tok0 = b * 256 + mt * 128;
      const u16* A = (const u16*)(p.ws + OFF_FCTX) + (size_t)(mt * 128) * 512;
      const u16* B = (const u16*)(p.ws + OFF_BTC) + ((size_t)b * 512 + nt * 128) * 512;
      size_t o = (size_t)tok0 * 1024 + nt * 128;
      gemm_tile<false>(A, 512, nullptr, 0, B, 512, 512, EpGate{(u16*)(p.ws + OFF_U) + o, (const u16*)(p.ws + OFF_GBUF) + o, 1024}, smem);
    }
  }
}

template <int LAYER> DEV void p_outproj(const Params& p, char* smem) {
  const u16* Aall = (const u16*)(p.ws + (LAYER == 0 ? OFF_U : OFF_U1));
  const u16* W = (const u16*)(p.ws + (LAYER == 0 ? OFF_WOUTT : OFF_RWOUTT));
  const float* mods = (const float*)(p.ws + OFF_MODS);
  for (int t = blockIdx.x; t < 1024; t += gridDim.x) {
    int mt = t >> 3, nt = t & 7, m0 = mt * 128, n0 = nt * 128;
    const float* xs;
    if (LAYER == 0) xs = (m0 < T_CTX ? p.x_prompt + (size_t)m0 * 1024 : p.x_sample + (size_t)(m0 - T_CTX) * 1024) + n0;
    else xs = p.out + (size_t)m0 * 1024 + n0;
    const float* gate = mods + (LAYER * 3 + mv_of(m0)) * 3072 + 2048 + n0;
    gemm_tile<false>(Aall + (size_t)m0 * 1024, 1024, nullptr, m0, W + (size_t)n0 * 1024, 1024, 1024,
                     EpRes{(u16*)(p.ws + (LAYER == 0 ? OFF_Y0B : OFF_Y1B)) + (size_t)m0 * 1024 + n0, xs, gate}, smem);
  }
}

DEV void p6b_dx(const Params& p) {
  const int lane = threadIdx.x & 63;
  const int gw = blockIdx.x * 4 + (threadIdx.x >> 6), nw = gridDim.x * 4;
  const u16* U = (const u16*)(p.ws + OFF_U1);
  u16* DX = (u16*)(p.ws + OFF_DX);
  for (int row = gw; row < 16384; row += nw) {
    const int l = row < T_CTX ? (row & 255) : ((row - T_CTX) & 4095);
    const int len = row < T_CTX ? 256 : 4096;
    const float pf = l > 0 ? 1.f : 0.f, nf = l + 1 < len ? 1.f : 0.f;
    const u16* uc = U + (size_t)row * 1024 + lane * 16;
    const u16* up = l > 0 ? uc - 1024 : uc;
    const u16* un = l + 1 < len ? uc + 1024 : uc;
#pragma unroll
    for (int hlf = 0; hlf < 2; hlf++) {
      uint4 c = *(const uint4*)(uc + 8 * hlf), a = *(const uint4*)(up + 8 * hlf), n = *(const uint4*)(un + 8 * hlf);
      const unsigned cu[4] = {c.x, c.y, c.z, c.w}, au[4] = {a.x, a.y, a.z, a.w}, nu[4] = {n.x, n.y, n.z, n.w};
      unsigned o[4];
#pragma unroll
      for (int q = 0; q < 4; q++)
        o[q] = pack2(0.5f * (bflo(au[q]) * pf + bflo(nu[q]) * nf) - bflo(cu[q]), 0.5f * (bfhi(au[q]) * pf + bfhi(nu[q]) * nf) - bfhi(cu[q]));
      *(uint4*)(DX + (size_t)row * 1024 + lane * 16 + 8 * hlf) = make_uint4(o[0], o[1], o[2], o[3]);
    }
  }
}

DEV void p7_rwkv_proj(const Params& p, char* smem) {
  const u16* U1 = (const u16*)(p.ws + OFF_U1);
  const int xcd = blockIdx.x & 7, jx = blockIdx.x >> 3, nbx = gridDim.x >> 3;
  for (int q = jx; q < 16 * 35; q += nbx) {
    int mt, nt;
    if (q < 512) { int st = q >> 6, w = q & 63; mt = xcd * 16 + (st >> 2) * 8 + (w >> 3); nt = (st & 3) * 8 + (w & 7); }
    else { int w = q - 512; mt = xcd * 16 + w / 3; nt = 32 + w % 3; }
    const int m0 = mt * 128;
    if (nt < 32) {
      int which = nt >> 3, n0 = (nt & 7) * 128;
      const u16* B = (const u16*)(p.ws + OFF_RKVZT) + (size_t)which * 1048576 + (size_t)n0 * 1024;
      if (which == 3) {
        gemm_tile<false>(U1 + (size_t)m0 * 1024, 1024, nullptr, m0, B, 1024, 1024,
                         EpStore<1>{(u16*)(p.ws + OFF_SZ) + (size_t)m0 * 1024 + n0, 1024, 1.f}, smem);
      } else {
        size_t off = which == 0 ? OFF_R : (which == 1 ? OFF_K2 : OFF_V2);
        const float* mu = p.mu + (which == 0 ? 0 : (which == 1 ? 2 : 3)) * 1024;
        gemm_tile<true>(U1, 1024, mu, m0, B, 1024, 1024, EpStore<0>{(u16*)(p.ws + off) + (size_t)m0 * 1024 + n0, 1024, 1.f}, smem);
      }
    } else {
      int w = nt - 32;
      if (w == 0)
        gemm_tile<true>(U1, 1024, p.mu + 1 * 1024, m0, (const u16*)(p.ws + OFF_W1T), 1024, 1024, EpStore<2>{(u16*)(p.ws + OFF_HW) + (size_t)m0 * 128, 128, 1.f}, smem);
      else if (w == 1)
        gemm_tile<true>(U1, 1024, p.mu + 4 * 1024, m0, (const u16*)(p.ws + OFF_A1T), 1024, 1024, EpStore<0>{(u16*)(p.ws + OFF_HA) + (size_t)m0 * 128, 128, 1.f}, smem);
      else
        gemm_tile<true>(U1, 1024, p.mu + 5 * 1024, m0, (const u16*)(p.ws + OFF_G1T), 1024, 1024, EpStore<3>{(u16*)(p.ws + OFF_HG) + (size_t)m0 * 128, 128, 1.f}, smem);
    }
  }
}

DEV b16x8 lds_perm(const u16* M, int ld, int row, int s, int hh) {
  const u16* q = M + row * ld + 16 * s + 4 * hh;
  uint2 lo = *(const uint2*)q, hi = *(const uint2*)(q + 8);
  u32x4 v = {lo.x, lo.y, hi.x, hi.y};
  return *(b16x8*)&v;
}
DEV b16x8 lds_norm(const u16* M, int ld, int row, int s, int hh) { return *(const b16x8*)(M + row * ld + 16 * s + 8 * hh); }
template <int OFF> DEV b16x8 pack8(const f32x16& a) {
  u32x4 v = {pack2(a[OFF], a[OFF + 1]), pack2(a[OFF + 2], a[OFF + 3]), pack2(a[OFF + 4], a[OFF + 5]), pack2(a[OFF + 6], a[OFF + 7])};
  return *(b16x8*)&v;
}
#define MFMA32(a, b, c) __builtin_amdgcn_mfma_f32_32x32x16_bf16(a, b, c, 0, 0, 0)

DEV int swz_idx(int row, int col) { return row * 40 + ((row >> 5) & 1) * 32 + ((((col >> 3) ^ (row >> 3)) & 3) << 3) + (col & 7); }
DEV b16x8 swz_norm(const u16* M, int row, int s, int hh) { return *(const b16x8*)(M + swz_idx(row, 16 * s + 8 * hh)); }
DEV b16x8 swz_perm(const u16* M, int row, int s, int hh) {
  uint2 lo = *(const uint2*)(M + swz_idx(row, 16 * s) + 4 * hh), hi = *(const uint2*)(M + swz_idx(row, 16 * s + 8) + 4 * hh);
  u32x4 v = {lo.x, lo.y, hi.x, hi.y};
  return *(b16x8*)&v;
}
struct ScanJob {
  int e, b, hd, tb, L, step0, nch, pq;
  int ncomb, seq;
  const float* zin;
  float* zout;
  u16* pout;
  float* qout;
};
DEV void scan_job(const Params& p, const ScanJob& J, char* smem) {
  float* sCum = (float*)smem;
  float* sAa = (float*)(smem + 8320);
  float* sNN = (float*)(smem + 8320);
  float* sT11 = (float*)(smem + 12544);
  float* sT22 = (float*)(smem + 13632);
  float* sWm = (float*)(smem + 14720);
  u16* AT = (u16*)(smem + 16640);
  u16* RT = (u16*)(smem + 21248);
  u16* BTl = (u16*)(smem + 25856);
  u16* KTl = (u16*)(smem + 30464);
  u16* BH = (u16*)(smem + 35072);
  u16* KH = (u16*)(smem + 40256);
  u16* VT = (u16*)(smem + 45440);
  u16* MkaT = (u16*)(smem + 50624);
  u16* MbrT = (u16*)(smem + 53184);
  u16* MkrT = (u16*)(smem + 55744);
  u16* TT = (u16*)(smem + 58304);
  float* gC = (float*)(smem + 60864);
  const int tid = threadIdx.x, wave = __builtin_amdgcn_readfirstlane(threadIdx.x >> 6);
  float* sKc = (float*)(smem + 61120);
  const int e = J.e, hd = J.hd, tb = J.tb, L = J.L, step0 = J.step0;
  const bool pq = J.pq != 0;
  const bool chainw = pq || wave < 2;
  const bool useV = pq ? (wave >= 2) : true;
  const int rb = wave & 1;
  const u16* HW = (const u16*)(p.ws + OFF_HW);
  const u16* HA = (const u16*)(p.ws + OFF_HA);
  const u16* Rb = (const u16*)(p.ws + OFF_R);
  const u16* Kb = (const u16*)(p.ws + OFF_K2);
  const u16* Vb = (const u16*)(p.ws + OFF_V2);
  float* Ysum = (float*)(p.ws + OFF_YSUM);
  float* Bsum = (float*)(p.ws + OFF_BSUM);
  const int arr = wave >> 1, ct = wave & 1;
  const u16* Xb = (arr ? HA : HW) + e * 64;
  b16x8 wf[4];
  {
    const int qi = tid & 31, hh = (tid >> 5) & 1;
    const u16* Wt = (const u16*)(p.ws + (arr ? OFF_A2T : OFF_W2T)) + (size_t)e * 65536 + (size_t)(hd * 64 + ct * 32 + qi) * 64 + hh * 8;
#pragma unroll
    for (int ks = 0; ks < 4; ks++) wf[ks] = ld16(Wt + ks * 16);
  }
  const float bias0 = (arr ? p.a0 : p.w0)[e * 1024 + hd * 64 + ct * 32 + (tid & 31)];
  if (tid < 64) { sKc[tid] = p.k_k[hd * 64 + tid]; sKc[64 + tid] = p.k_a[hd * 64 + tid]; sKc[128 + tid] = p.r_k[hd * 64 + tid]; }
  f32x16 z0, z1;
#pragma unroll
  for (int q = 0; q < 4; q++) {
    const int qi = tid & 31, hh = (tid >> 5) & 1;
    float4 v0 = make_float4(0, 0, 0, 0), v1 = v0;
    if (pq) {
      if (wave < 2) {
#pragma unroll
        for (int i = 0; i < 4; i++) {
          const int k = 8 * q + 4 * hh + i, col = rb * 32 + qi;
          ((float*)&v0)[i] = (k == col) ? 1.f : 0.f;
          ((float*)&v1)[i] = (k + 32 == col) ? 1.f : 0.f;
        }
      }
    } else if (J.zin && wave < 2) {
      const float* sp = J.zin + (size_t)(wave * 32 + qi) * 64 + 8 * q + 4 * hh;
      v0 = *(const float4*)sp; v1 = *(const float4*)(sp + 32);
    }
    z0[4 * q] = v0.x; z0[4 * q + 1] = v0.y; z0[4 * q + 2] = v0.z; z0[4 * q + 3] = v0.w;
    z1[4 * q] = v1.x; z1[4 * q + 1] = v1.y; z1[4 * q + 2] = v1.z; z1[4 * q + 3] = v1.w;
  }
  if (!pq && wave < 2) {
    const int qi = tid & 31, hh = (tid >> 5) & 1;
#pragma unroll 1
    for (int g = 0; g < J.ncomb; g++) {
      const u16* P = (const u16*)(p.ws + OFF_SEGP) + (size_t)(J.seq * 7 + g) * 4096;
      const float* Q = (const float*)(p.ws + OFF_SEGQ) + (size_t)(J.seq * 7 + g) * 4096;
      b16x8 zb[4] = {pack8<0>(z0), pack8<8>(z0), pack8<0>(z1), pack8<8>(z1)};
      f32x16 n0, n1;
#pragma unroll
      for (int q = 0; q < 4; q++) {
        const float* sp = Q + (size_t)(wave * 32 + qi) * 64 + 8 * q + 4 * hh;
        float4 v0 = *(const float4*)sp, v1 = *(const float4*)(sp + 32);
        n0[4 * q] = v0.x; n0[4 * q + 1] = v0.y; n0[4 * q + 2] = v0.z; n0[4 * q + 3] = v0.w;
        n1[4 * q] = v1.x; n1[4 * q + 1] = v1.y; n1[4 * q + 2] = v1.z; n1[4 * q + 3] = v1.w;
      }
#pragma unroll
      for (int s2 = 0; s2 < 4; s2++) {
        const u16* r0 = P + (size_t)qi * 64 + 16 * s2 + 4 * hh;
        const u16* r1 = P + (size_t)(32 + qi) * 64 + 16 * s2 + 4 * hh;
        uint2 a = *(const uint2*)r0, c = *(const uint2*)(r0 + 8), d = *(const uint2*)r1, f = *(const uint2*)(r1 + 8);
        u32x4 fa = {a.x, a.y, c.x, c.y}, fb = {d.x, d.y, f.x, f.y};
        n0 = MFMA32(*(b16x8*)&fa, zb[s2], n0);
        n1 = MFMA32(*(b16x8*)&fb, zb[s2], n1);
      }
      z0 = n0; z1 = n1;
    }
  }
  const int nch = J.nch;
  b16x8 xf[4];
  u32x4 kq, rq, vq;
  int tokC;
  {
    const int qi = tid & 31, hh = (tid >> 5) & 1, ci_ = tid >> 3, chg = hd * 64 + (tid & 7) * 8;
    const int tok0 = tb + (e ? L - step0 - 32 : step0);
    const int tokA = tok0 + (e ? 31 - qi : qi);
#pragma unroll
    for (int ks = 0; ks < 4; ks++) xf[ks] = ld16(Xb + (size_t)tokA * 128 + hh * 8 + ks * 16);
    tokC = tok0 + (e ? 31 - ci_ : ci_);
    kq = *(const u32x4*)(Kb + (size_t)tokC * 1024 + chg);
    rq = *(const u32x4*)(Rb + (size_t)tokC * 1024 + chg);
    vq = *(const u32x4*)(Vb + (size_t)tokC * 1024 + chg);
  }
#pragma unroll 1
  for (int ci = 0; ci < nch; ci++) {
    const int tok0 = tb + (e ? L - step0 - 32 * (ci + 1) : step0 + 32 * ci);
    const int tokn0 = tb + (e ? L - step0 - 32 * (ci + 2) : step0 + 32 * (ci + 1));
    const bool more = ci + 1 < nch;
    int tl = tid;
    asm volatile("" : "+v"(tl));
    const int lane = tl & 63, qi = lane & 31, hh = lane >> 5, ci_ = tl >> 3, cb = (tl & 7) * 8, chg = hd * 64 + cb;
    {
      f32x16 acc;
#pragma unroll
      for (int r = 0; r < 16; r++) acc[r] = 0.f;
#pragma unroll
      for (int ks = 0; ks < 4; ks++) acc = MFMA32(xf[ks], wf[ks], acc);
      if (more) {
        const int tokA = tokn0 + (e ? 31 - qi : qi);
#pragma unroll
        for (int ks = 0; ks < 4; ks++) xf[ks] = ld16(Xb + (size_t)tokA * 128 + hh * 8 + ks * 16);
      }
      const int ch = ct * 32 + qi;
      if (arr == 0) {
        float lw[16], gs[4], og[4];
#pragma unroll
        for (int r = 0; r < 16; r++) lw[r] = -0.606531f * sigm(acc[r] + bias0);
#pragma unroll
        for (int q = 0; q < 4; q++) { gs[q] = (lw[4 * q] + lw[4 * q + 1]) + (lw[4 * q + 2] + lw[4 * q + 3]); og[q] = __shfl_xor(gs[q], 32); }
        float pre = 0.f;
#pragma unroll
        for (int q = 0; q < 4; q++) {
          float run = pre + (hh ? og[q] : 0.f);
#pragma unroll
          for (int i = 0; i < 4; i++) { run += lw[4 * q + i]; sCum[(8 * q + 4 * hh + i) * 65 + ch] = run; }
          pre += gs[q] + og[q];
        }
      } else {
#pragma unroll
        for (int r = 0; r < 16; r++) {
          int row = (r & 3) + 8 * (r >> 2) + 4 * hh;
          sAa[row * 65 + ch] = sigm(acc[r] + bias0);
        }
      }
    }
    lds_barrier();
    {
      const int i = ci_;
      const unsigned ku[4] = {kq.x, kq.y, kq.z, kq.w}, ru[4] = {rq.x, rq.y, rq.z, rq.w}, vu[4] = {vq.x, vq.y, vq.z, vq.w};
      float k[8], r[8], kkr[8];
#pragma unroll
      for (int q = 0; q < 4; q++) {
        k[2 * q] = bflo(ku[q]); k[2 * q + 1] = bfhi(ku[q]);
        r[2 * q] = bflo(ru[q]); r[2 * q + 1] = bfhi(ru[q]);
      }
      float kkc[8], kac[8], rkc[8];
#pragma unroll
      for (int j = 0; j < 8; j++) { kkc[j] = sKc[cb + j]; kac[j] = sKc[64 + cb + j]; rkc[j] = sKc[128 + cb + j]; }
      float ss = 0;
#pragma unroll
      for (int j = 0; j < 8; j++) { kkr[j] = k[j] * kkc[j]; ss += kkr[j] * kkr[j]; }
      ss = allsum8(ss);
      const float inv = rsqrtf(ss + 1e-12f);
      float bon = 0;
      float oa[8], orr[8], ob[8], ok[8];
#pragma unroll
      for (int j = 0; j < 8; j++) {
        const float a = sAa[i * 65 + cb + j];
        const float cm = sCum[i * 65 + cb + j];
        const float cp = i > 0 ? sCum[(i - 1) * 65 + cb + j] : 0.f;
        const float cl = sCum[31 * 65 + cb + j];
        const float kd = k[j] * (1.f + (a - 1.f) * kac[j]);
        const float kk = kkr[j] * inv;
        const float bb = kk * a;
        bon += r[j] * kd * rkc[j];
        const float em = __expf(-cm), eC = __expf(cl - cm);
        oa[j] = -kk * __expf(cp);
        orr[j] = pq ? 0.f : r[j] * __expf(cm);
        ob[j] = bb * em;
        ok[j] = kd * em;
        BH[swz_idx(cb + j, i)] = f2bf(bb * eC);
        KH[swz_idx(cb + j, i)] = f2bf(kd * eC);
        if (i == 31) gC[cb + j] = __expf(cl);
      }
#pragma unroll
      for (int q = 0; q < 4; q++) {
        VT[swz_idx(cb + 2 * q, i)] = (u16)(vu[q] & 0xffffu);
        VT[swz_idx(cb + 2 * q + 1, i)] = (u16)(vu[q] >> 16);
      }
      *(u32x4*)(AT + i * 72 + cb) = u32x4{pack2(oa[0], oa[1]), pack2(oa[2], oa[3]), pack2(oa[4], oa[5]), pack2(oa[6], oa[7])};
      if (!pq) *(u32x4*)(RT + i * 72 + cb) = u32x4{pack2(orr[0], orr[1]), pack2(orr[2], orr[3]), pack2(orr[4], orr[5]), pack2(orr[6], orr[7])};
      *(u32x4*)(BTl + i * 72 + cb) = u32x4{pack2(ob[0], ob[1]), pack2(ob[2], ob[3]), pack2(ob[4], ob[5]), pack2(ob[6], ob[7])};
      *(u32x4*)(KTl + i * 72 + cb) = u32x4{pack2(ok[0], ok[1]), pack2(ok[2], ok[3]), pack2(ok[4], ok[5]), pack2(ok[6], ok[7])};
      bon = allsum8(bon);
      if (!pq && (tl & 7) == 0) atomicAdd(Bsum + (size_t)tokC * 16 + hd, 0.5f * bon);
      if (more) {
        tokC = tokn0 + (e ? 31 - ci_ : ci_);
        kq = *(const u32x4*)(Kb + (size_t)tokC * 1024 + chg);
        rq = *(const u32x4*)(Rb + (size_t)tokC * 1024 + chg);
        vq = *(const u32x4*)(Vb + (size_t)tokC * 1024 + chg);
      }
    }
    lds_barrier();
    if (!(pq && wave >= 2)) {
      const u16* Am = (wave < 2) ? AT : RT;
      const u16* Bm = (wave & 1) ? KTl : BTl;
      f32x16 acc;
#pragma unroll
      for (int r = 0; r < 16; r++) acc[r] = 0.f;
#pragma unroll
      for (int s = 0; s < 4; s++) acc = MFMA32(lds_norm(Am, 72, qi, s, hh), lds_norm(Bm, 72, qi, s, hh), acc);
      u16* dst = wave == 1 ? MkaT : (wave == 2 ? MbrT : MkrT);
#pragma unroll
      for (int r = 0; r < 16; r++) {
        const int tt = (r & 3) + 8 * (r >> 2) + 4 * hh, j = qi;
        const bool keep = (wave < 2) ? (j < tt) : (j <= tt);
        const float val = keep ? acc[r] : 0.f;
        if (wave == 0) sNN[j * 33 + tt] = val;
        else dst[tt * 40 + j] = f2bf(val);
      }
    }
    if (tl < 32) {
      const int i = tl & 15, base = (tl >> 4) * 16;
      float Tr[16];
#pragma unroll
      for (int q = 0; q < 16; q++) Tr[q] = (q == i) ? 1.f : 0.f;
#pragma unroll
      for (int q = 1; q < 16; q++) {
        float s0 = 0.f, s1 = 0.f, s2 = 0.f, s3 = 0.f;
#pragma unroll
        for (int j = 0; j < q; j++) {
          const float pr = Tr[j] * sNN[(base + j) * 33 + base + q];
          if ((j & 3) == 0) s0 += pr; else if ((j & 3) == 1) s1 += pr; else if ((j & 3) == 2) s2 += pr; else s3 += pr;
        }
        if (q > i) Tr[q] = (s0 + s1) + (s2 + s3);
      }
      float* sT = (tl >> 4) ? sT22 : sT11;
#pragma unroll
      for (int q = 0; q < 16; q++) { sT[i * 17 + q] = Tr[q]; TT[(base + q) * 40 + base + i] = f2bf(Tr[q]); }
    }
    lds_barrier();
    {
      const int i = tl >> 4, q = tl & 15;
      float s = 0.f;
#pragma unroll
      for (int j = 0; j < 16; j++) s += sT11[i * 17 + j] * sNN[j * 33 + 16 + q];
      sWm[i * 17 + q] = s;
      TT[i * 40 + 16 + q] = 0;
    }
    lds_barrier();
    {
      const int i = tl >> 4, q = tl & 15;
      float s = 0.f;
#pragma unroll
      for (int j = 0; j < 16; j++) s += sWm[i * 17 + j] * sT22[j * 17 + q];
      TT[(16 + q) * 40 + i] = f2bf(s);
    }
    lds_barrier();
    if (chainw) {
      const int vrow = rb * 32 + qi;
      b16x8 zb0 = pack8<0>(z0), zb1 = pack8<8>(z0), zb2 = pack8<0>(z1), zb3 = pack8<8>(z1);
      b16x8 vt0 = swz_norm(VT, vrow, 0, hh), vt1 = swz_norm(VT, vrow, 1, hh);
      f32x16 x;
#pragma unroll
      for (int r = 0; r < 16; r++) x[r] = 0.f;
      x = MFMA32(lds_perm(AT, 72, qi, 0, hh), zb0, x);
      x = MFMA32(lds_perm(AT, 72, qi, 1, hh), zb1, x);
      x = MFMA32(lds_perm(AT, 72, qi, 2, hh), zb2, x);
      x = MFMA32(lds_perm(AT, 72, qi, 3, hh), zb3, x);
      if (useV) {
        x = MFMA32(lds_norm(MkaT, 40, qi, 0, hh), vt0, x);
        x = MFMA32(lds_norm(MkaT, 40, qi, 1, hh), vt1, x);
      }
      f32x16 y;
#pragma unroll
      for (int r = 0; r < 16; r++) y[r] = 0.f;
      if (!pq) {
        y = MFMA32(lds_perm(RT, 72, qi, 0, hh), zb0, y);
        y = MFMA32(lds_perm(RT, 72, qi, 1, hh), zb1, y);
        y = MFMA32(lds_perm(RT, 72, qi, 2, hh), zb2, y);
        y = MFMA32(lds_perm(RT, 72, qi, 3, hh), zb3, y);
        y = MFMA32(lds_norm(MkrT, 40, qi, 0, hh), vt0, y);
        y = MFMA32(lds_norm(MkrT, 40, qi, 1, hh), vt1, y);
      }
#pragma unroll
      for (int q = 0; q < 4; q++) {
        float4 g0 = *(const float4*)(gC + 8 * q + 4 * hh), g1 = *(const float4*)(gC + 32 + 8 * q + 4 * hh);
        z0[4 * q] *= g0.x; z0[4 * q + 1] *= g0.y; z0[4 * q + 2] *= g0.z; z0[4 * q + 3] *= g0.w;
        z1[4 * q] *= g1.x; z1[4 * q + 1] *= g1.y; z1[4 * q + 2] *= g1.z; z1[4 * q + 3] *= g1.w;
      }
      if (useV) {
        z0 = MFMA32(swz_norm(KH, qi, 0, hh), vt0, z0);
        z0 = MFMA32(swz_norm(KH, qi, 1, hh), vt1, z0);
        z1 = MFMA32(swz_norm(KH, 32 + qi, 0, hh), vt0, z1);
        z1 = MFMA32(swz_norm(KH, 32 + qi, 1, hh), vt1, z1);
      }
      b16x8 xb0 = pack8<0>(x), xb1 = pack8<8>(x);
      f32x16 u;
#pragma unroll
      for (int r = 0; r < 16; r++) u[r] = 0.f;
      u = MFMA32(lds_perm(TT, 40, qi, 0, hh), xb0, u);
      u = MFMA32(lds_perm(TT, 40, qi, 1, hh), xb1, u);
      b16x8 ub0 = pack8<0>(u), ub1 = pack8<8>(u);
      z0 = MFMA32(swz_perm(BH, qi, 0, hh), ub0, z0);
      z0 = MFMA32(swz_perm(BH, qi, 1, hh), ub1, z0);
      z1 = MFMA32(swz_perm(BH, 32 + qi, 0, hh), ub0, z1);
      z1 = MFMA32(swz_perm(BH, 32 + qi, 1, hh), ub1, z1);
      if (!pq) {
        y = MFMA32(lds_perm(MbrT, 40, qi, 0, hh), ub0, y);
        y = MFMA32(lds_perm(MbrT, 40, qi, 1, hh), ub1, y);
#pragma unroll
        for (int r = 0; r < 16; r++) {
          const int st = (r & 3) + 8 * (r >> 2) + 4 * hh;
          const int tok = tok0 + (e ? 31 - st : st);
          atomicAdd(Ysum + (size_t)tok * 1024 + hd * 64 + vrow, y[r]);
        }
      }
    }
  }
  {
    const int qi = tid & 31, hh = (tid >> 5) & 1;
    if (pq) {
      if (wave < 2) {
#pragma unroll
        for (int r = 0; r < 16; r++) {
          const int k = (r & 3) + 8 * (r >> 2) + 4 * hh;
          J.pout[k * 64 + rb * 32 + qi] = f2bf(z0[r]);
          J.pout[(k + 32) * 64 + rb * 32 + qi] = f2bf(z1[r]);
        }
      } else {
#pragma unroll
        for (int q = 0; q < 4; q++) {
          float* sp = J.qout + (size_t)(rb * 32 + qi) * 64 + 8 * q + 4 * hh;
          *(float4*)sp = make_float4(z0[4 * q], z0[4 * q + 1], z0[4 * q + 2], z0[4 * q + 3]);
          *(float4*)(sp + 32) = make_float4(z1[4 * q], z1[4 * q + 1], z1[4 * q + 2], z1[4 * q + 3]);
        }
      }
    } else if (J.zout && wave < 2) {
#pragma unroll
      for (int q = 0; q < 4; q++) {
        float* sp = J.zout + (size_t)(wave * 32 + qi) * 64 + 8 * q + 4 * hh;
        *(float4*)sp = make_float4(z0[4 * q], z0[4 * q + 1], z0[4 * q + 2], z0[4 * q + 3]);
        *(float4*)(sp + 32) = make_float4(z1[4 * q], z1[4 * q + 1], z1[4 * q + 2], z1[4 * q + 3]);
      }
    }
  }
  __syncthreads();
}

DEV void scan_combine(const Params& p, int seq) {
  const int tid = threadIdx.x, wave = tid >> 6, qi = tid & 31, hh = (tid >> 5) & 1;
  if (wave >= 2) return;
  const int e = seq >> 5, b = (seq >> 4) & 1, hd = seq & 15;
  const float* zin = p.state_rwkv + ((size_t)(b * 2 + e) * 16 + hd) * 4096;
  f32x16 z0, z1;
#pragma unroll
  for (int q = 0; q < 4; q++) {
    const float* sp = zin + (size_t)(wave * 32 + qi) * 64 + 8 * q + 4 * hh;
    float4 v0 = *(const float4*)sp, v1 = *(const float4*)(sp + 32);
    z0[4 * q] = v0.x; z0[4 * q + 1] = v0.y; z0[4 * q + 2] = v0.z; z0[4 * q + 3] = v0.w;
    z1[4 * q] = v1.x; z1[4 * q + 1] = v1.y; z1[4 * q + 2] = v1.z; z1[4 * q + 3] = v1.w;
  }
#pragma unroll 1
  for (int g = 0; g < 7; g++) {
    const u16* P = (const u16*)(p.ws + OFF_SEGP) + (size_t)(seq * 7 + g) * 4096;
    const float* Q = (const float*)(p.ws + OFF_SEGQ) + (size_t)(seq * 7 + g) * 4096;
    b16x8 zb[4] = {pack8<0>(z0), pack8<8>(z0), pack8<0>(z1), pack8<8>(z1)};
    f32x16 n0, n1;
#pragma unroll
    for (int q = 0; q < 4; q++) {
      const float* sp = Q + (size_t)(wave * 32 + qi) * 64 + 8 * q + 4 * hh;
      float4 v0 = *(const float4*)sp, v1 = *(const float4*)(sp + 32);
      n0[4 * q] = v0.x; n0[4 * q + 1] = v0.y; n0[4 * q + 2] = v0.z; n0[4 * q + 3] = v0.w;
      n1[4 * q] = v1.x; n1[4 * q + 1] = v1.y; n1[4 * q + 2] = v1.z; n1[4 * q + 3] = v1.w;
    }
#pragma unroll
    for (int s = 0; s < 4; s++) {
      const u16* r0 = P + (size_t)qi * 64 + 16 * s + 4 * hh;
      const u16* r1 = P + (size_t)(32 + qi) * 64 + 16 * s + 4 * hh;
      uint2 a = *(const uint2*)r0, c = *(const uint2*)(r0 + 8), d = *(const uint2*)r1, f = *(const uint2*)(r1 + 8);
      u32x4 fa = {a.x, a.y, c.x, c.y}, fb = {d.x, d.y, f.x, f.y};
      n0 = MFMA32(*(b16x8*)&fa, zb[s], n0);
      n1 = MFMA32(*(b16x8*)&fb, zb[s], n1);
    }
    z0 = n0; z1 = n1;
    float* zs = (float*)(p.ws + OFF_SEGZ) + (size_t)(seq * 7 + g) * 4096;
#pragma unroll
    for (int q = 0; q < 4; q++) {
      float* sp = zs + (size_t)(wave * 32 + qi) * 64 + 8 * q + 4 * hh;
      *(float4*)sp = make_float4(z0[4 * q], z0[4 * q + 1], z0[4 * q + 2], z0[4 * q + 3]);
      *(float4*)(sp + 32) = make_float4(z1[4 * q], z1[4 * q + 1], z1[4 * q + 2], z1[4 * q + 3]);
    }
  }
}

DEV ScanJob ctx_job(const Params& p, int v) {
  ScanJob J;
  J.e = v >> 9; J.b = (v >> 4) & 31; J.hd = v & 15; J.tb = J.b * 256; J.L = 256; J.step0 = 0; J.nch = 8; J.pq = 0;
  J.zin = nullptr; J.zout = p.out + OUT_ST + ((size_t)(J.b * 2 + J.e) * 16 + J.hd) * 4096; J.pout = nullptr; J.qout = nullptr;
  J.ncomb = 0; J.seq = 0;
  return J;
}
DEV ScanJob smp_job(const Params& p, int seq, int g, int pq) {
  ScanJob J;
  J.e = seq >> 5; J.b = (seq >> 4) & 1; J.hd = seq & 15; J.tb = T_CTX + J.b * 4096; J.L = 4096; J.step0 = g * 512; J.nch = 16; J.pq = pq;
  J.zin = p.state_rwkv + ((size_t)(J.b * 2 + J.e) * 16 + J.hd) * 4096;
  J.ncomb = pq ? 0 : g; J.seq = seq;
  J.zout = nullptr;
  J.pout = (u16*)(p.ws + OFF_SEGP) + (size_t)(seq * 7 + g) * 4096;
  J.qout = (float*)(p.ws + OFF_SEGQ) + (size_t)(seq * 7 + g) * 4096;
  return J;
}

DEV void p8a_scan(const Params& p, char* smem) {
  if (blockIdx.x < 448) {
    for (int j = blockIdx.x; j < 448; j += 448) scan_job(p, smp_job(p, j / 7, j % 7, 1), smem);
  } else {
    {
      float4* ys = (float4*)(p.ws + OFF_YSUM);
      float4* bs = (float4*)(p.ws + OFF_BSUM);
      const size_t gt = (size_t)(blockIdx.x - 448) * 256 + threadIdx.x, gs = (size_t)(gridDim.x - 448) * 256;
      for (size_t i = gt; i < 4194304; i += gs) ys[i] = make_float4(0, 0, 0, 0);
      for (size_t i = gt; i < 65536; i += gs) bs[i] = make_float4(0, 0, 0, 0);
    }
    for (int q = blockIdx.x - 448; q < 1024; q += gridDim.x - 448) {
      int mt = q >> 3, nt = q & 7, m0 = mt * 128, n0 = nt * 128;
      u16* sz = (u16*)(p.ws + OFF_SZ) + (size_t)m0 * 1024 + n0;
      gemm_tile<false>((const u16*)(p.ws + OFF_HG) + (size_t)m0 * 128, 128, nullptr, m0, (const u16*)(p.ws + OFF_G2T) + (size_t)n0 * 128, 128, 128,
                       EpGate{sz, sz, 1024}, smem);
    }
  }
}
DEV void p8b_scan(const Params& p, char* smem) {
  if (blockIdx.x < 64) scan_combine(p, blockIdx.x);
}
DEV void p8c_scan(const Params& p, char* smem) {
  for (int j = blockIdx.x; j < 512 + 1024; j += gridDim.x) {
    if (j < 512) scan_job(p, smp_job(p, j >> 3, j & 7, 0), smem);
    else scan_job(p, ctx_job(p, j - 512), smem);
  }
}

DEV void p9_post(const Params& p) {
  const int lane = threadIdx.x & 63;
  const int gw = blockIdx.x * 4 + (threadIdx.x >> 6), nw = gridDim.x * 4;
  const float* Ysum = (const float*)(p.ws + OFF_YSUM);
  const float* Bsum = (const float*)(p.ws + OFF_BSUM);
  for (int row = gw; row < 16384; row += nw) {
    const size_t o = (size_t)row * 1024 + lane * 16;
    float y[16];
#pragma unroll
    for (int i = 0; i < 4; i++) { float4 v = *(const float4*)(Ysum + o + 4 * i); y[4 * i] = v.x; y[4 * i + 1] = v.y; y[4 * i + 2] = v.z; y[4 * i + 3] = v.w; }
    float s = 0;
#pragma unroll
    for (int i = 0; i < 16; i++) s += y[i];
    s += __shfl_xor(s, 1); s += __shfl_xor(s, 2);
    float mean = s * (1.f / 64.f), q = 0;
#pragma unroll
    for (int i = 0; i < 16; i++) { float d = y[i] - mean; q += d * d; }
    q += __shfl_xor(q, 1); q += __shfl_xor(q, 2);
    float rstd = rsqrtf(q * (1.f / 64.f) + 64e-5f);
    float bon = Bsum[(size_t)row * 16 + (lane >> 2)];
    u16* O = (u16*)(p.ws + OFF_U1) + o;
    const u16* V = (const u16*)(p.ws + OFF_V2) + o;
    const u16* Z = (const u16*)(p.ws + OFF_SZ) + o;
#pragma unroll
    for (int hlf = 0; hlf < 2; hlf++) {
      uint4 vq = *(const uint4*)(V + 8 * hlf), zq = *(const uint4*)(Z + 8 * hlf);
      const unsigned vu[4] = {vq.x, vq.y, vq.z, vq.w}, zu[4] = {zq.x, zq.y, zq.z, zq.w};
      unsigned ow[4];
#pragma unroll
      for (int w = 0; w < 4; w++) {
        int c = lane * 16 + hlf * 8 + 2 * w;
        float y0 = (y[hlf * 8 + 2 * w] - mean) * rstd * p.lnx_g[c] + p.lnx_b[c] + bon * bflo(vu[w]);
        float y1 = (y[hlf * 8 + 2 * w + 1] - mean) * rstd * p.lnx_g[c + 1] + p.lnx_b[c + 1] + bon * bfhi(vu[w]);
        ow[w] = pack2(y0 * bflo(zu[w]), y1 * bfhi(zu[w]));
      }
      *(uint4*)(O + 8 * hlf) = make_uint4(ow[0], ow[1], ow[2], ow[3]);
    }
  }
}


#define XB_TMO 128
#define XB_XCNT(j) (256 + 64 * (j))
#define XB_XSUB(j) (1280 + 64 * (j))
#define XB_XGEN(j) (2304 + 64 * (j))
#define XB_TOP 3328
#define XB_TOPGEN 3392
#define XCD_BAR_WORDS 3456
#define XB_SPIN_CAP (1u << 22)
#define LAS __attribute__((address_space(3)))
DEV unsigned xb_ld(unsigned* p) { return __hip_atomic_load(p, __ATOMIC_RELAXED, __HIP_MEMORY_SCOPE_AGENT); }
DEV unsigned xb_add(unsigned* p, unsigned v) { return __hip_atomic_fetch_add(p, v, __ATOMIC_RELAXED, __HIP_MEMORY_SCOPE_AGENT); }
DEV unsigned xb_xcc_id() { return (unsigned)__builtin_amdgcn_s_getreg((3 << 11) | 20) & 0xFu; }
#define XB_SPIN(cond, bar) do { unsigned _sp = 0; while (cond) { __builtin_amdgcn_s_sleep(4); \
    if ((++_sp & 255u) == 0u) { if (xb_ld(&(bar)[XB_TMO])) break; if (_sp > XB_SPIN_CAP) { atomicAdd(&(bar)[XB_TMO], 1u); break; } } } } while (0)
struct XcdBarrier { unsigned* bar; unsigned x; volatile LAS unsigned* st; };
DEV XcdBarrier xcd_barrier_post(unsigned* bar, volatile LAS unsigned* st) {
  XcdBarrier b; b.bar = bar; b.x = xb_xcc_id(); b.st = st;
  if (threadIdx.x == 0) (void)xb_add(&bar[XB_XCNT(b.x)], 1u);
  return b;
}
DEV void xcd_barrier_complete(unsigned* bar, unsigned x, unsigned& nloc, unsigned& nx) {
  const unsigned G = gridDim.x * gridDim.y * gridDim.z;
  unsigned sum, cnt, mine, sp = 0u;
  for (;;) {
    sum = 0u; cnt = 0u; mine = 0u;
#pragma unroll
    for (unsigned j = 0; j < 16; ++j) { const unsigned c = xb_ld(&bar[XB_XCNT(j)]); sum += c; cnt += (c > 0u) ? 1u : 0u; mine = (j == x) ? c : mine; }
    if (sum == G) break;
    __builtin_amdgcn_s_sleep(1);
    if ((++sp & 255u) == 0u) { if (xb_ld(&bar[XB_TMO])) break; if (sp > XB_SPIN_CAP) { atomicAdd(&bar[XB_TMO], 1u); break; } }
  }
  nloc = mine > 0u ? mine : 1u; nx = cnt > 0u ? cnt : 1u;
}
DEV void xcd_barrier(const XcdBarrier& b) {
  asm volatile("s_waitcnt vmcnt(0)" ::: "memory");
  __syncthreads();
  if (threadIdx.x == 0) {
    unsigned* bar = b.bar;
    __builtin_amdgcn_s_waitcnt(0);
    unsigned nloc = b.st[0], nx = b.st[1];
    if (nloc == 0u) { xcd_barrier_complete(bar, b.x, nloc, nx); b.st[0] = nloc; b.st[1] = nx; }
    const unsigned old = xb_add(&bar[XB_XSUB(b.x)], 1u);
    const unsigned gen = old / nloc;
    if (old + 1u == (gen + 1u) * nloc) {
      __builtin_amdgcn_fence(__ATOMIC_RELEASE, "agent");
      asm volatile("s_waitcnt vmcnt(0)" ::: "memory");
      const unsigned og = xb_add(&bar[XB_TOP], 1u);
      const unsigned tg = og / nx;
      if (og + 1u == (tg + 1u) * nx) xb_add(&bar[XB_TOPGEN], 1u);
      else XB_SPIN(xb_ld(&bar[XB_TOPGEN]) == tg, bar);
      __builtin_amdgcn_fence(__ATOMIC_ACQUIRE, "agent");
      xb_add(&bar[XB_XGEN(b.x)], 1u);
      asm volatile("s_waitcnt vmcnt(0)" ::: "memory");
    } else {
      XB_SPIN(xb_ld(&bar[XB_XGEN(b.x)]) == gen, bar);
      __builtin_amdgcn_fence(__ATOMIC_ACQUIRE, "agent");
      asm volatile("s_waitcnt vmcnt(0)" ::: "memory");
    }
  }
  __syncthreads();
}

__global__ void __launch_bounds__(256, 2) fwd_kernel(Params p) {
  __shared__ __attribute__((aligned(16))) char smem[61888];
#if FUSED
  __shared__ unsigned xb_st[4];
  if (threadIdx.x < 4) xb_st[threadIdx.x] = 0u;
  __syncthreads();
  const XcdBarrier xb = xcd_barrier_post((unsigned*)(p.ws + OFF_BAR), (volatile LAS unsigned*)xb_st);
  if (p.phase_hi > 1000) cg::this_grid().sync();
#define SYNC() xcd_barrier(xb)
#else
#define SYNC()
#endif
#define PH(n, call) if (p.phase_lo <= n && n <= p.phase_hi) { call; if (n < p.phase_hi) { SYNC(); } }
  PH(0, p0_prep(p, smem))
  PH(1, ln_phase<0>(p))
  PH(2, p2_gemm1(p, smem))
  PH(3, p3_mix(p, smem))
  PH(4, p3b_fold(p))
  PH(5, p4_fnet(p, smem))
  PH(6, p_outproj<0>(p, smem))
  PH(7, ln_phase<1>(p))
  PH(8, p6b_dx(p))
  PH(9, p7_rwkv_proj(p, smem))
  PH(10, p8a_scan(p, smem))
  PH(11, p8c_scan(p, smem))
  PH(12, p9_post(p))
  PH(13, p_outproj<1>(p, smem))
  PH(14, ln_phase<2>(p))
}

extern "C" void kernel_launch(void* const* d_in, const int* in_sizes, int n_in, void* d_out, int out_size, void* d_ws,
                              size_t ws_size, hipStream_t stream) {
  Params p;
  memset(&p, 0, sizeof(p));
  const float* const* in = (const float* const*)d_in;
  p.x_prompt = in[0]; p.x_sample = in[1]; p.cache_k = in[2]; p.cache_v = in[3]; p.state_rwkv = in[4]; p.c = in[5]; p.c_ctx = in[6];
  p.ada_w = in[7]; p.ada_b = in[8]; p.post_g = in[9]; p.post_b = in[10]; p.w_in = in[11]; p.w_fnet = in[12]; p.rpb = in[13]; p.w_out = in[14];
  p.mu = in[15]; p.rkvz = in[16]; p.w0 = in[17]; p.w1 = in[18]; p.w2 = in[19]; p.a0 = in[20]; p.a1 = in[21]; p.a2 = in[22];
  p.g1 = in[23]; p.g2 = in[24]; p.k_k = in[25]; p.k_a = in[26]; p.r_k = in[27]; p.lnx_g = in[28]; p.lnx_b = in[29]; p.rw_out = in[30];
  p.out = (float*)d_out; p.ws = (char*)d_ws;
  char* ws = (char*)d_ws;
  int n = 0, start = 0;
  auto add = [&](const float* src, size_t dstoff, int lds, int ldd, int tk, int tn) {
    p.tj[n].src = src; p.tj[n].dst = (u16*)(ws + dstoff); p.tj[n].lds = lds; p.tj[n].ldd = ldd; p.tj[n].tk = tk; p.tj[n].tn = tn;
    p.tj[n].start = start; p.tj[n].pad = 0; start += tk * tn; n++;
  };
  add(p.w_in, OFF_WINT, 3072, 1024, 16, 48);
  add(p.w_out, OFF_WOUTT, 1024, 1024, 16, 16);
  for (int i = 0; i < 4; i++) add(p.rkvz + (size_t)i * 1048576, OFF_RKVZT + (size_t)i * 2097152, 1024, 1024, 16, 16);
  add(p.rw_out, OFF_RWOUTT, 1024, 1024, 16, 16);
  for (int e = 0; e < 2; e++) add(p.w1 + e * 65536, OFF_W1T + (size_t)e * 64 * 1024 * 2, 64, 1024, 16, 1);
  for (int e = 0; e < 2; e++) add(p.a1 + e * 65536, OFF_A1T + (size_t)e * 64 * 1024 * 2, 64, 1024, 16, 1);
  add(p.g1, OFF_G1T, 128, 1024, 16, 2);
  for (int e = 0; e < 2; e++) add(p.w2 + e * 65536, OFF_W2T + (size_t)e * 65536 * 2, 1024, 64, 1, 16);
  for (int e = 0; e < 2; e++) add(p.a2 + e * 65536, OFF_A2T + (size_t)e * 65536 * 2, 1024, 64, 1, 16);
  add(p.g2, OFF_G2T, 1024, 128, 2, 16);
  for (int b = 0; b < 2; b++)
    for (int h = 0; h < 8; h++) add(p.cache_v + (size_t)b * 262144 + h * 64, OFF_CVT + (size_t)(b * 8 + h) * 64 * 512 * 2, 512, 512, 8, 1);
  p.ntr = start;

  static int grid_blocks = 0;
  if (!grid_blocks) {
    int dev = 0, cus = 0, per_cu = 0;
    (void)hipGetDevice(&dev);
    (void)hipDeviceGetAttribute(&cus, hipDeviceAttributeMultiprocessorCount, dev);
    (void)hipOccupancyMaxActiveBlocksPerMultiprocessor(&per_cu, fwd_kernel, 256, 0);
    if (per_cu > 2) per_cu = 2;
    if (per_cu < 1) per_cu = 1;
    grid_blocks = cus * per_cu;
  }
#if FUSED
  p.phase_lo = 0; p.phase_hi = 14;
  void* args[] = {&p};
  (void)hipMemsetAsync((char*)d_ws + OFF_BAR, 0, 16384, stream);
  hipError_t e = hipLaunchCooperativeKernel((void*)fwd_kernel, dim3(grid_blocks), dim3(256), args, 0, stream);
  if (e != hipSuccess) fprintf(stderr, "cooperative launch failed: %s (grid %d)\n", hipGetErrorString(e), grid_blocks);
#else
#ifndef PROBE_SEQ
#define PROBE_SEQ 0,1,2,3,4,5,6,7,8,9,10,11,12,13,14
#endif
  const int seq[] = {PROBE_SEQ};
  for (int i = 0; i < (int)(sizeof(seq) / sizeof(int)); i++) {
    p.phase_lo = seq[i]; p.phase_hi = seq[i];
    fwd_kernel<<<grid_blocks, 256, 0, stream>>>(p);
  }
#endif
}
```

```cpp
#include <hip/hip_runtime.h>
#include <hip/hip_cooperative_groups.h>
#include <stdint.h>
#include <cstdio>
#include <cstring>
namespace cg = cooperative_groups;

#ifndef FUSED
#define FUSED 1
#endif

typedef unsigned short u16;
typedef __attribute__((ext_vector_type(8))) __bf16 b16x8;
typedef __attribute__((ext_vector_type(16))) float f32x16;
typedef __attribute__((ext_vector_type(4))) unsigned u32x4;
typedef __attribute__((ext_vector_type(2))) unsigned u32x2;
#define DEV __device__ __forceinline__

constexpr int T_CTX = 8192;
constexpr float ALPHA_DN = 1.41421356237f;
constexpr float LOG2E = 1.44269504089f;
constexpr size_t MiB = 1u << 20;
constexpr size_t OFF_MODS = 0, OFF_BAR = 512 * 1024, OFF_BSUM = 1 * MiB;
constexpr size_t OFF_FSMP = 2 * MiB, OFF_U = 66 * MiB, OFF_ABUF = 98 * MiB, OFF_Q = 114 * MiB, OFF_K = 130 * MiB;
constexpr size_t OFF_VTC = 146 * MiB, OFF_VTS = 154 * MiB, OFF_GBUF = 162 * MiB, OFF_BTC = 194 * MiB, OFF_BTS = 210 * MiB;
constexpr size_t OFF_WINT = 226 * MiB, OFF_WOUTT = 232 * MiB, OFF_MCAT = 234 * MiB, OFF_FCTX = 234 * MiB + 256 * 1024;
constexpr size_t OFF_CK = 234 * MiB + 512 * 1024, OFF_CVT = 235 * MiB + 512 * 1024;
constexpr size_t OFF_RKVZT = 237 * MiB, OFF_RWOUTT = 245 * MiB, OFF_W1T = 247 * MiB, OFF_A1T = OFF_W1T + 256 * 1024,
                 OFF_G1T = OFF_W1T + 512 * 1024, OFF_W2T = OFF_W1T + 768 * 1024, OFF_A2T = 248 * MiB,
                 OFF_G2T = 248 * MiB + 256 * 1024, OFF_HW = 248 * MiB + 512 * 1024;
constexpr size_t OFF_U1 = 2 * MiB, OFF_R = 34 * MiB, OFF_K2 = 66 * MiB, OFF_V2 = 98 * MiB, OFF_SZ = 130 * MiB,
                 OFF_YSUM = 162 * MiB, OFF_HA = 226 * MiB, OFF_HG = 230 * MiB;
constexpr size_t OFF_BFOLD = 98 * MiB;
constexpr size_t OFF_Y0B = 98 * MiB, OFF_Y1B = 34 * MiB;
constexpr size_t OFF_DX = 162 * MiB;
constexpr size_t OFF_SEGP = 2 * MiB, OFF_SEGQ = 6 * MiB, OFF_SEGZ = 14 * MiB;
constexpr size_t OUT_NK = 16777216, OUT_NV = 20971520, OUT_ST = 25165824;

constexpr int NTJ = 33;
struct TJob { const float* src; u16* dst; int lds, ldd, tk, tn, start, pad; };

struct Params {
  const float *x_prompt, *x_sample, *cache_k, *cache_v, *state_rwkv, *c, *c_ctx;
  const float *ada_w, *ada_b, *post_g, *post_b, *w_in, *w_fnet, *rpb, *w_out;
  const float *mu, *rkvz, *w0, *w1, *w2, *a0, *a1, *a2, *g1, *g2, *k_k, *k_a, *r_k, *lnx_g, *lnx_b, *rw_out;
  float* out; char* ws;
  int phase_lo, phase_hi, ntr, pad;
  TJob tj[NTJ];
};

typedef __attribute__((ext_vector_type(2))) __bf16 bf16x2_t;
typedef __attribute__((ext_vector_type(2))) float f32x2_t;
DEV unsigned pack2(float a, float b) {
  f32x2_t f = {a, b};
  bf16x2_t r = __builtin_convertvector(f, bf16x2_t);
  return *(unsigned*)&r;
}
DEV u16 f2bf(float f) { return (u16)(pack2(f, 0.f) & 0xffffu); }
DEV float bflo(unsigned w) { return __uint_as_float(w << 16); }
DEV float bfhi(unsigned w) { return __uint_as_float(w & 0xffff0000u); }
DEV float rcp_f(float x) { return __builtin_amdgcn_rcpf(x); }
DEV float sigm(float x) { return rcp_f(1.f + __expf(-x)); }
DEV float silu(float x) { return x * rcp_f(1.f + __expf(-x)); }
DEV float tanh_f(float x) { return 1.f - 2.f * rcp_f(__expf(2.f * x) + 1.f); }
DEV b16x8 ld16(const u16* p) { uint4 v = *(const uint4*)p; return *(b16x8*)&v; }
DEV b16x8 asb(uint4 v) { return *(b16x8*)&v; }
template <int CTRL> DEV float dpp_add(float x) {
  return x + __int_as_float(__builtin_amdgcn_update_dpp(0, __float_as_int(x), CTRL, 0xf, 0xf, true));
}
DEV float allsum8(float x) {
  x = dpp_add<0xB1>(x); x = dpp_add<0x4E>(x); x = dpp_add<0x141>(x);
  return x;
}
DEV float wave_sum(float x) {
  x = dpp_add<0xB1>(x); x = dpp_add<0x4E>(x); x = dpp_add<0x141>(x); x = dpp_add<0x140>(x);
  x += __shfl_xor(x, 16); x += __shfl_xor(x, 32);
  return x;
}
DEV float allsum16(float x) {
  x = dpp_add<0xB1>(x); x = dpp_add<0x4E>(x); x = dpp_add<0x124>(x); x = dpp_add<0x128>(x);
  return x;
}
DEV void lds_barrier() { asm volatile("s_waitcnt lgkmcnt(0)\n\ts_barrier" ::: "memory"); }
DEV int mv_of(int token) { return token < T_CTX ? 0 : 1 + ((token - T_CTX) >> 12); }

template <bool LERP, class EP>
DEV void gemm_tile(const u16* __restrict__ A, int lda, const float* __restrict__ mu, int m0,
                   const u16* __restrict__ B, int ldb, int K, EP ep, char* smem) {
  u16(*sA0)[72] = (u16(*)[72])smem;
  u16(*sB0)[72] = (u16(*)[72])(smem + 18432);
  u16(*sA1)[72] = (u16(*)[72])(smem + 36864);
  u16(*sB1)[72] = (u16(*)[72])(smem + 36864 + 18432);
  int tid = threadIdx.x;
  asm volatile("" : "+v"(tid));
  const int lane = tid & 63, wave = tid >> 6, wm = wave >> 1, wn = wave & 1;
  const int lr = tid >> 3, lk = (tid & 7) * 8;
  f32x16 acc[2][2];
#pragma unroll
  for (int i = 0; i < 2; i++)
#pragma unroll
    for (int j = 0; j < 2; j++)
#pragma unroll
      for (int r = 0; r < 16; r++) acc[i][j][r] = 0.f;
  u32x4 ra0[4], rb0[4], rp0[4], ra1[4], rb1[4], rp1[4];
  float4 mu00, mu01, mu10, mu11;
  const u16* DXp = nullptr;
  if constexpr (LERP) DXp = (const u16*)(A) + (OFF_DX - OFF_U1) / 2;
#define GLOAD(K0, RA, RB, RP, M0, M1)                                                     \
  {                                                                                       \
    _Pragma("unroll") for (int i = 0; i < 4; i++) {                                       \
      int r = lr + 32 * i;                                                                \
      if constexpr (LERP) {                                                               \
        RA[i] = *(const u32x4*)(A + (size_t)(m0 + r) * lda + (K0) + lk);                  \
        RP[i] = *(const u32x4*)(DXp + (size_t)(m0 + r) * lda + (K0) + lk);                \
      } else {                                                                            \
        RA[i] = *(const u32x4*)(A + (size_t)r * lda + (K0) + lk);                         \
      }                                                                                   \
      RB[i] = *(const u32x4*)(B + (size_t)r * ldb + (K0) + lk);                           \
    }                                                                                     \
    if constexpr (LERP) {                                                                 \
      M0 = *(const float4*)(mu + (K0) + lk);                                              \
      M1 = *(const float4*)(mu + (K0) + lk + 4);                                          \
    }                                                                                     \
  }
#define GSTORE(RA, RB, RP, M0, M1, sA, sB)                                                     \
  {                                                                                       \
    _Pragma("unroll") for (int i = 0; i < 4; i++) {                                       \
      int r = lr + 32 * i;                                                                \
      u32x4 av = RA[i];                                                                   \
      if constexpr (LERP) {                                                               \
        unsigned cu[4] = {RA[i].x, RA[i].y, RA[i].z, RA[i].w};                            \
        unsigned du[4] = {RP[i].x, RP[i].y, RP[i].z, RP[i].w};                            \
        float m[8] = {M0.x, M0.y, M0.z, M0.w, M1.x, M1.y, M1.z, M1.w};                    \
        unsigned o[4];                                                                    \
        _Pragma("unroll") for (int q = 0; q < 4; q++)                                     \
          o[q] = pack2(bflo(cu[q]) + bflo(du[q]) * m[2 * q], bfhi(cu[q]) + bfhi(du[q]) * m[2 * q + 1]); \
        av = u32x4{o[0], o[1], o[2], o[3]};                                               \
      }                                                                                   \
      *(u32x4*)&sA[r][lk] = av;                                                           \
      *(u32x4*)&sB[r][lk] = RB[i];                                                        \
    }                                                                                     \
  }
#define GCOMPUTE(sA, sB)                                                                  \
  {                                                                                       \
    _Pragma("unroll") for (int ks = 0; ks < 4; ks++) {                                    \
      b16x8 af[2], bf[2];                                                                 \
      _Pragma("unroll") for (int i = 0; i < 2; i++) {                                     \
        af[i] = *(const b16x8*)&sA[wm * 64 + i * 32 + (lane & 31)][ks * 16 + (lane >> 5) * 8]; \
        bf[i] = *(const b16x8*)&sB[wn * 64 + i * 32 + (lane & 31)][ks * 16 + (lane >> 5) * 8]; \
      }                                                                                   \
      _Pragma("unroll") for (int i = 0; i < 2; i++)                                       \
        _Pragma("unroll") for (int j = 0; j < 2; j++)                                     \
          acc[i][j] = __builtin_amdgcn_mfma_f32_32x32x16_bf16(af[i], bf[j], acc[i][j], 0, 0, 0); \
    }                                                                                     \
  }
  GLOAD(0, ra0, rb0, rp0, mu00, mu01);
  GLOAD(64, ra1, rb1, rp1, mu10, mu11);
  __syncthreads();
  GSTORE(ra0, rb0, rp0, mu00, mu01, sA0, sB0);
  if (128 < K) GLOAD(128, ra0, rb0, rp0, mu00, mu01);
  __syncthreads();
#pragma unroll 1
  for (int k0 = 0; k0 < K; k0 += 128) {
    GSTORE(ra1, rb1, rp1, mu10, mu11, sA1, sB1);
    if (k0 + 192 < K) GLOAD(k0 + 192, ra1, rb1, rp1, mu10, mu11);
    GCOMPUTE(sA0, sB0);
    __syncthreads();
    if (k0 + 128 < K) {
      GSTORE(ra0, rb0, rp0, mu00, mu01, sA0, sB0);
      if (k0 + 256 < K) GLOAD(k0 + 256, ra0, rb0, rp0, mu00, mu01);
    }
    GCOMPUTE(sA1, sB1);
    __syncthreads();
  }
#undef GLOAD
#undef GSTORE
#undef GCOMPUTE
  __syncthreads();
  int tide = tid;
  asm volatile("" : "+v"(tide));
  const int lane_e = tide & 63, wv_e = tide >> 6, wm_e = wv_e >> 1, wn_e = wv_e & 1;
  u16* stg = (u16*)smem + wv_e * (64 * 72);
#pragma unroll
  for (int i = 0; i < 2; i++)
#pragma unroll
    for (int j = 0; j < 2; j++)
#pragma unroll
      for (int q = 0; q < 4; q++) {
        const int r = i * 32 + q * 8 + (lane_e >> 5) * 4, c = j * 32 + (lane_e & 31);
        const float v0 = acc[i][j][q * 4 + 0], v1 = acc[i][j][q * 4 + 1], v2 = acc[i][j][q * 4 + 2], v3 = acc[i][j][q * 4 + 3];
        ep.direct(wm_e * 64 + r, wn_e * 64 + c, v0, v1, v2, v3);
        if constexpr (EP::TRANS) {
          *(uint2*)(stg + c * 72 + r) = make_uint2(pack2(ep.act(v0), ep.act(v1)), pack2(ep.act(v2), ep.act(v3)));
        } else {
          const unsigned p01 = pack2(ep.act(v0), ep.act(v1)), p23 = pack2(ep.act(v2), ep.act(v3));
          stg[(r + 0) * 72 + c] = (u16)(p01 & 0xffffu); stg[(r + 1) * 72 + c] = (u16)(p01 >> 16);
          stg[(r + 2) * 72 + c] = (u16)(p23 & 0xffffu); stg[(r + 3) * 72 + c] = (u16)(p23 >> 16);
        }
      }
#pragma unroll
  for (int n = 0; n < 8; n++) {
    const int id = lane_e + 64 * n, rr = id >> 3, cc = (id & 7) * 8;
    const u32x4 v = *(const u32x4*)(stg + rr * 72 + cc);
    if constexpr (EP::TRANS) ep.store(wn_e * 64 + rr, wm_e * 64 + cc, v);
    else ep.store(wm_e * 64 + rr, wn_e * 64 + cc, v);
  }
}

template <int ACT> struct EpStore {
  static constexpr bool TRANS = false;
  u16* dst; int ld; float scale;
  DEV float act(float x) const {
    if (ACT == 1) return silu(x);
    if (ACT == 2) return tanh_f(x);
    if (ACT == 3) return sigm(x);
    if (ACT == 4) return x * scale;
    return x;
  }
  DEV void direct(int, int, float, float, float, float) const {}
  DEV void store(int R, int C, u32x4 v) const { *(u32x4*)(dst + (size_t)R * ld + C) = v; }
};
struct EpNull {
  static constexpr bool TRANS = false;
  DEV float act(float x) const { return x; }
  DEV void direct(int, int, float, float, float, float) const {}
  DEV void store(int, int, u32x4) const {}
};
struct EpKeep {
  static constexpr bool TRANS = false;
  u16* dst; int ld; float* f32dst; int ldf;
  DEV float act(float x) const { return x; }
  DEV void direct(int r, int c, float v0, float v1, float v2, float v3) const {
    if (f32dst) {
      f32dst[(size_t)(r + 0) * ldf + c] = v0; f32dst[(size_t)(r + 1) * ldf + c] = v1;
      f32dst[(size_t)(r + 2) * ldf + c] = v2; f32dst[(size_t)(r + 3) * ldf + c] = v3;
    }
  }
  DEV void store(int R, int C, u32x4 v) const { *(u32x4*)(dst + (size_t)R * ld + C) = v; }
};
struct EpTrans {
  static constexpr bool TRANS = true;
  u16* dst; size_t ldt; float* f32dst; int ldf;
  DEV float act(float x) const { return x; }
  DEV void direct(int r, int c, float v0, float v1, float v2, float v3) const {
    if (f32dst) {
      f32dst[(size_t)(r + 0) * ldf + c] = v0; f32dst[(size_t)(r + 1) * ldf + c] = v1;
      f32dst[(size_t)(r + 2) * ldf + c] = v2; f32dst[(size_t)(r + 3) * ldf + c] = v3;
    }
  }
  DEV void store(int Rc, int Cr, u32x4 v) const { *(u32x4*)(dst + (size_t)Rc * ldt + Cr) = v; }
};
struct EpGate {
  static constexpr bool TRANS = false;
  u16* dst; const u16* gate; int ld;
  DEV float act(float x) const { return x; }
  DEV void direct(int, int, float, float, float, float) const {}
  DEV void store(int R, int C, u32x4 v) const {
    const size_t o = (size_t)R * ld + C;
    const u32x4 g = *(const u32x4*)(gate + o);
    u32x4 r;
    r.x = pack2(bflo(v.x) * bflo(g.x), bfhi(v.x) * bfhi(g.x)); r.y = pack2(bflo(v.y) * bflo(g.y), bfhi(v.y) * bfhi(g.y));
    r.z = pack2(bflo(v.z) * bflo(g.z), bfhi(v.z) * bfhi(g.z)); r.w = pack2(bflo(v.w) * bflo(g.w), bfhi(v.w) * bfhi(g.w));
    *(u32x4*)(dst + o) = r;
  }
};
struct EpRes {
  static constexpr bool TRANS = false;
  u16* dst; const float* xsrc; const float* gate;
  DEV float act(float x) const { return x; }
  DEV void direct(int, int, float, float, float, float) const {}
  DEV void store(int R, int C, u32x4 v) const {
    const size_t o = (size_t)R * 1024 + C;
    const float4 x0 = *(const float4*)(xsrc + o), x1 = *(const float4*)(xsrc + o + 4);
    const float4 g0 = *(const float4*)(gate + C), g1 = *(const float4*)(gate + C + 4);
    u32x4 r;
    r.x = pack2(ALPHA_DN * x0.x + (1.f + g0.x) * bflo(v.x), ALPHA_DN * x0.y + (1.f + g0.y) * bfhi(v.x));
    r.y = pack2(ALPHA_DN * x0.z + (1.f + g0.z) * bflo(v.y), ALPHA_DN * x0.w + (1.f + g0.w) * bfhi(v.y));
    r.z = pack2(ALPHA_DN * x1.x + (1.f + g1.x) * bflo(v.z), ALPHA_DN * x1.y + (1.f + g1.y) * bfhi(v.z));
    r.w = pack2(ALPHA_DN * x1.z + (1.f + g1.z) * bflo(v.w), ALPHA_DN * x1.w + (1.f + g1.w) * bfhi(v.w));
    *(u32x4*)(dst + o) = r;
  }
};

DEV void p0_prep(const Params& p, char* smem) {
  const int tid = threadIdx.x;
  const int njobs = 192 + p.ntr;
  for (int job = blockIdx.x; job < njobs; job += gridDim.x) {
    __syncthreads();
    if (job < 192) {
      float* sc = (float*)smem;
      float* red = sc + 3072;
      for (int i = tid; i < 3072; i += 256) {
        int m = i >> 10, k = i & 1023;
        float cv = m == 0 ? p.c_ctx[k] : p.c[(m - 1) * 1024 + k];
        sc[i] = silu(cv);
      }
      __syncthreads();
      int l = job / 96, col = (job % 96) * 32 + (tid & 31), ks = tid >> 5;
      const float* w = p.ada_w + (size_t)l * 1024 * 3072 + col;
      float a0 = 0, a1 = 0, a2 = 0;
#pragma unroll 8
      for (int k = ks * 128; k < ks * 128 + 128; k++) {
        float wv = w[(size_t)k * 3072];
        a0 += sc[k] * wv; a1 += sc[1024 + k] * wv; a2 += sc[2048 + k] * wv;
      }
      red[(ks * 32 + (tid & 31)) * 3 + 0] = a0; red[(ks * 32 + (tid & 31)) * 3 + 1] = a1; red[(ks * 32 + (tid & 31)) * 3 + 2] = a2;
      __syncthreads();
      if (tid < 96) {
        int cl = tid & 31, m = tid >> 5;
        float s = 0;
        for (int q = 0; q < 8; q++) s += red[(q * 32 + cl) * 3 + m];
        int cc = (job % 96) * 32 + cl;
        ((float*)(p.ws + OFF_MODS))[(l * 3 + m) * 3072 + cc] = s + p.ada_b[l * 3072 + cc];
      }
    } else {
      int tj = job - 192, e = 0;
      while (e + 1 < NTJ && p.tj[e + 1].start <= tj) e++;
      const TJob J = p.tj[e];
      int lt = tj - J.start, tkk = lt / J.tn, tnn = lt % J.tn;
      float(*tile)[65] = (float(*)[65])smem;
      const float* src = J.src + (size_t)(tkk * 64) * J.lds + tnn * 64;
#pragma unroll
      for (int i = 0; i < 4; i++) {
        int kk = (tid >> 4) + 16 * i, nn = (tid & 15) * 4;
        float4 v = *(const float4*)(src + (size_t)kk * J.lds + nn);
        tile[kk][nn] = v.x; tile[kk][nn + 1] = v.y; tile[kk][nn + 2] = v.z; tile[kk][nn + 3] = v.w;
      }
      __syncthreads();
      u16* dst = J.dst + (size_t)(tnn * 64) * J.ldd + tkk * 64;
#pragma unroll
      for (int i = 0; i < 2; i++) {
        int nn = (tid >> 3) + 32 * i, kk = (tid & 7) * 8;
        uint4 o;
        o.x = pack2(tile[kk][nn], tile[kk + 1][nn]); o.y = pack2(tile[kk + 2][nn], tile[kk + 3][nn]);
        o.z = pack2(tile[kk + 4][nn], tile[kk + 5][nn]); o.w = pack2(tile[kk + 6][nn], tile[kk + 7][nn]);
        *(uint4*)(dst + (size_t)nn * J.ldd + kk) = o;
      }
    }
  }
  const size_t gt = (size_t)blockIdx.x * 256 + tid, gs = (size_t)gridDim.x * 256;
  {
    u16* ck = (u16*)(p.ws + OFF_CK);
    for (size_t i = gt; i < 65536; i += gs) {
      float4 a = *(const float4*)(p.cache_k + i * 8), b = *(const float4*)(p.cache_k + i * 8 + 4);
      *(uint4*)(ck + i * 8) = make_uint4(pack2(a.x, a.y), pack2(a.z, a.w), pack2(b.x, b.y), pack2(b.z, b.w));
    }
  }
  {
    u16* fs = (u16*)(p.ws + OFF_FSMP);
    const float sc = 0.001381067932f;
    for (size_t i = gt; i < 2097152; i += gs) {
      int lp = (int)(i >> 9), j0 = (int)(i & 511) * 8;
      unsigned o[4];
#pragma unroll
      for (int q = 0; q < 4; q++) {
        float v[2];
#pragma unroll
        for (int z = 0; z < 2; z++) {
          int j = j0 + 2 * q + z;
          bool cs = j <= 2048;
          int ph = (lp * (cs ? j : j - 2048)) & 4095;
          float ang = (float)ph * (6.283185307179586f / 4096.f);
          v[z] = (cs ? __cosf(ang) : -__sinf(ang)) * sc;
        }
        o[q] = pack2(v[0], v[1]);
      }
      *(uint4*)(fs + i * 8) = make_uint4(o[0], o[1], o[2], o[3]);
    }
    u16* fc = (u16*)(p.ws + OFF_FCTX);
    const float sc2 = 0.005524271728f;
    for (size_t i = gt; i < 16384; i += gs) {
      int lp = (int)(i >> 6), j0 = (int)(i & 63) * 8;
      unsigned o[4];
#pragma unroll
      for (int q = 0; q < 4; q++) {
        float v[2];
#pragma unroll
        for (int z = 0; z < 2; z++) {
          int j = j0 + 2 * q + z;
          int ph = (lp * (j & 255)) & 255;
          float ang = (float)ph * (6.283185307179586f / 256.f);
          v[z] = (j < 256 ? __cosf(ang) : -__sinf(ang)) * sc2;
        }
        o[q] = pack2(v[0], v[1]);
      }
      *(uint4*)(fc + i * 8) = make_uint4(o[0], o[1], o[2], o[3]);
    }
  }
  {
    u16* mc = (u16*)(p.ws + OFF_MCAT);
    for (size_t i = gt; i < 131072; i += gs) {
      int c = (int)(i & 127), ep = (int)((i >> 7) & 255), g = (int)(i >> 15);
      const float* wf = p.w_fnet + (size_t)g * 16384 + (ep & 127);
      float s = 0;
      for (int cp = 0; cp < 128; cp++) {
        float ang = (float)((c * cp) & 127) * (6.283185307179586f / 128.f);
        float tw = ep < 128 ? __cosf(ang) : __sinf(ang);
        s += tw * wf[cp * 128];
      }
      mc[i] = f2bf(s);
    }
  }
}

DEV void ln_stats(const float4 (&x)[4], float& mean, float& rstd) {
  float s = 0;
#pragma unroll
  for (int i = 0; i < 4; i++) s += x[i].x + x[i].y + x[i].z + x[i].w;
  mean = wave_sum(s) * (1.f / 1024.f);
  float q = 0;
#pragma unroll
  for (int i = 0; i < 4; i++) {
    float a = x[i].x - mean, b = x[i].y - mean, c = x[i].z - mean, d = x[i].w - mean;
    q += a * a + b * b + c * c + d * d;
  }
  rstd = rsqrtf(wave_sum(q) * (1.f / 1024.f) + 1e-6f);
}

template <int MODE> DEV void ln_phase(const Params& p) {
  const int lane = threadIdx.x & 63;
  const int gw = blockIdx.x * 4 + (threadIdx.x >> 6), nw = gridDim.x * 4;
  const float* mods = (const float*)(p.ws + OFF_MODS);
  typedef __attribute__((ext_vector_type(4))) float f32x4v;
  f32x4v xn[4];
  u32x2 wn[4];
  auto fetch = [&](int row) {
    if (MODE == 0) {
      const float* src = row < T_CTX ? p.x_prompt + (size_t)row * 1024 : p.x_sample + (size_t)(row - T_CTX) * 1024;
#pragma unroll
      for (int i = 0; i < 4; i++) xn[i] = *(const f32x4v*)(src + lane * 4 + 256 * i);
    } else {
      const u16* sb = (const u16*)(p.ws + (MODE == 1 ? OFF_Y0B : OFF_Y1B)) + (size_t)row * 1024;
#pragma unroll
      for (int i = 0; i < 4; i++) wn[i] = *(const u32x2*)(sb + lane * 4 + 256 * i);
    }
  };
  if (gw < 16384) fetch(gw);
  for (int row = gw; row < 16384; row += nw) {
    float4 x[4];
#pragma unroll
    for (int i = 0; i < 4; i++) {
      if (MODE == 0) x[i] = make_float4(xn[i].x, xn[i].y, xn[i].z, xn[i].w);
      else x[i] = make_float4(bflo(wn[i].x), bfhi(wn[i].x), bflo(wn[i].y), bfhi(wn[i].y));
    }
    if (row + nw < 16384) fetch(row + nw);
    float mean, rstd;
    ln_stats(x, mean, rstd);
    if (MODE >= 1) {
      const float* g = p.post_g + (MODE == 1 ? 0 : 1024);
      const float* b = p.post_b + (MODE == 1 ? 0 : 1024);
      float* dst = p.out + (size_t)row * 1024;
#pragma unroll
      for (int i = 0; i < 4; i++) {
        float4 gv = *(const float4*)(g + lane * 4 + 256 * i), bv = *(const float4*)(b + lane * 4 + 256 * i);
        x[i].x = (x[i].x - mean) * rstd * gv.x + bv.x; x[i].y = (x[i].y - mean) * rstd * gv.y + bv.y;
        x[i].z = (x[i].z - mean) * rstd * gv.z + bv.z; x[i].w = (x[i].w - mean) * rstd * gv.w + bv.w;
        *(float4*)(dst + lane * 4 + 256 * i) = x[i];
      }
      if (MODE == 2) continue;
      ln_stats(x, mean, rstd);
    }
    const float* md = mods + ((MODE == 0 ? 0 : 3) + mv_of(row)) * 3072;
    u16* ud = (u16*)(p.ws + (MODE == 0 ? OFF_U : OFF_U1)) + (size_t)row * 1024;
#pragma unroll
    for (int i = 0; i < 4; i++) {
      int k = lane * 4 + 256 * i;
      float4 sh = *(const float4*)(md + k), sc = *(const float4*)(md + 1024 + k);
      float a = (x[i].x - mean) * rstd * (1.f + sc.x) + sh.x, b = (x[i].y - mean) * rstd * (1.f + sc.y) + sh.y;
      float c = (x[i].z - mean) * rstd * (1.f + sc.z) + sh.z, d = (x[i].w - mean) * rstd * (1.f + sc.w) + sh.w;
      *(uint2*)(ud + k) = make_uint2(pack2(a, b), pack2(c, d));
    }
  }
}

DEV void p2_gemm1(const Params& p, char* smem) {
  const u16* U = (const u16*)(p.ws + OFF_U);
  const u16* W = (const u16*)(p.ws + OFF_WINT);
  const int xcd = blockIdx.x & 7, jx = blockIdx.x >> 3, nbx = gridDim.x >> 3;
  for (int q = jx; q < 16 * 24; q += nbx) {
    int st = q >> 6, w = q & 63, sm = st / 3, sn = st % 3;
    int mt = xcd * 16 + sm * 8 + (w >> 3), nt = sn * 8 + (w & 7);
    int m0 = mt * 128, n0 = nt * 128, sec = nt >> 2, nc = (nt & 3) * 128;
    const u16* A = U + (size_t)m0 * 1024;
    const u16* B = W + (size_t)n0 * 1024;
    if (sec == 0) {
      gemm_tile<false>(A, 1024, nullptr, m0, B, 1024, 1024, EpStore<0>{(u16*)(p.ws + OFF_ABUF) + (size_t)m0 * 512 + nc, 512, 1.f}, smem);
    } else if (sec == 1 || sec == 5) {
      gemm_tile<false>(A, 1024, nullptr, m0, B, 1024, 1024,
                       EpStore<1>{(u16*)(p.ws + OFF_GBUF) + (size_t)m0 * 1024 + (sec == 5 ? 512 : 0) + nc, 1024, 1.f}, smem);
    } else if (sec == 2) {
      gemm_tile<false>(A, 1024, nullptr, m0, B, 1024, 1024, EpStore<4>{(u16*)(p.ws + OFF_Q) + (size_t)m0 * 512 + nc, 512, 0.125f * LOG2E}, smem);
    } else if (sec == 3) {
      float* f = m0 < T_CTX ? p.out + OUT_NK + (size_t)m0 * 512 + nc : nullptr;
      gemm_tile<false>(A, 1024, nullptr, m0, B, 1024, 1024, EpKeep{(u16*)(p.ws + OFF_K) + (size_t)m0 * 512 + nc, 512, f, 512}, smem);
    } else {
      float* f = m0 < T_CTX ? p.out + OUT_NV + (size_t)m0 * 512 + nc : nullptr;
      u16* d; size_t ldt;
      if (m0 < T_CTX) { int b = m0 >> 8, l = m0 & 255; ldt = 256; d = (u16*)(p.ws + OFF_VTC) + ((size_t)b * 512 + nc) * 256 + l; }
      else { int tt = m0 - T_CTX, b = tt >> 12, l = tt & 4095; ldt = 4096; d = (u16*)(p.ws + OFF_VTS) + ((size_t)b * 512 + nc) * 4096 + l; }
      gemm_tile<false>(A, 1024, nullptr, m0, B, 1024, 1024, EpTrans{d, ldt, f, 512}, smem);
    }
  }
}

struct AttnState { f32x16 o0, o1; float m, l; };

DEV void attn_tile(AttnState& st, const b16x8 (&qf)[4], const u16* kS, const u16* vS, int mode, int dr, int kc0, int c,
                   const float* rpbh, int qi, int hh) {
  f32x16 s;
#pragma unroll
  for (int r = 0; r < 16; r++) s[r] = 0.f;
#pragma unroll
  for (int ks = 0; ks < 4; ks++) s = __builtin_amdgcn_mfma_f32_32x32x16_bf16(*(const b16x8*)(kS + qi * 72 + ks * 16 + hh * 8), qf[ks], s, 0, 0, 0);
  if (mode) {
    int cs = min(max(c - 8, 0), 48);
#pragma unroll
    for (int r = 0; r < 16; r++) {
      int kc = kc0 + (r & 3) + 8 * (r >> 2) + 4 * hh;
      bool valid = (kc >= cs) && (kc < cs + 16);
      int dc = min(max(kc - c + 15, 0), 30);
      float bias = rpbh[dr * 31 + dc] * LOG2E;
      s[r] = valid ? s[r] + bias : -1e30f;
    }
  }
  float tm = s[0];
#pragma unroll
  for (int r = 1; r < 16; r++) tm = fmaxf(tm, s[r]);
  tm = fmaxf(tm, __shfl_xor(tm, 32));
  float mn = fmaxf(st.m, tm);
  float alpha = __builtin_amdgcn_exp2f(st.m - mn);
  st.m = mn;
  float ps = 0;
#pragma unroll
  for (int r = 0; r < 16; r++) { float e = __builtin_amdgcn_exp2f(s[r] - mn); ps += e; s[r] = e; }
  st.l = st.l * alpha + ps;
#pragma unroll
  for (int r = 0; r < 16; r++) { st.o0[r] *= alpha; st.o1[r] *= alpha; }
#pragma unroll
  for (int s2 = 0; s2 < 2; s2++) {
    u32x4 pw = {pack2(s[8 * s2 + 0], s[8 * s2 + 1]), pack2(s[8 * s2 + 2], s[8 * s2 + 3]),
                pack2(s[8 * s2 + 4], s[8 * s2 + 5]), pack2(s[8 * s2 + 6], s[8 * s2 + 7])};
    b16x8 pfr = *(b16x8*)&pw;
#pragma unroll
    for (int dt = 0; dt < 2; dt++) {
      const u16* vr = vS + (dt * 32 + qi) * 40 + 16 * s2 + 4 * hh;
      const uint2 lo = *(const uint2*)vr, hi = *(const uint2*)(vr + 8);
      u32x4 vw = {lo.x, lo.y, hi.x, hi.y};
      b16x8 vf = *(b16x8*)&vw;
      if (dt == 0) st.o0 = __builtin_amdgcn_mfma_f32_32x32x16_bf16(vf, pfr, st.o0, 0, 0, 0);
      else st.o1 = __builtin_amdgcn_mfma_f32_32x32x16_bf16(vf, pfr, st.o1, 0, 0, 0);
    }
  }
}

DEV void attn_unit(const Params& p, int u, int lane, char* smem) {
  const u16* Qb = (const u16*)(p.ws + OFF_Q);
  const u16* Kb = (const u16*)(p.ws + OFF_K);
  const int qi = lane & 31, hh = lane >> 5;
  u16* kS = (u16*)smem + (threadIdx.x >> 6) * 4864;
  u16* vS = kS + 32 * 72;
  bool smp = u < 2048;
  int b, h, qg, tq0, r = 0, c0 = 0;
  if (smp) { b = u >> 10; h = (u >> 7) & 7; qg = u & 127; tq0 = T_CTX + b * 4096 + qg * 32; r = qg >> 1; c0 = (qg & 1) * 32; }
  else { int v = u - 2048; b = v >> 6; h = (v >> 3) & 7; qg = v & 7; tq0 = b * 256 + qg * 32; }
  b16x8 qf[4];
#pragma unroll
  for (int s = 0; s < 4; s++) qf[s] = ld16(Qb + (size_t)(tq0 + qi) * 512 + h * 64 + s * 16 + hh * 8);
  AttnState st;
#pragma unroll
  for (int i = 0; i < 16; i++) { st.o0[i] = 0.f; st.o1[i] = 0.f; }
  st.m = -INFINITY; st.l = 0.f;
  const float* rpbh = p.rpb + h * 465;
  const int rs = min(max(r - 4, 0), 56);
  const u16* ck = (const u16*)(p.ws + OFF_CK) + (size_t)b * 512 * 512 + h * 64;
  const u16* cvt = (const u16*)(p.ws + OFF_CVT) + (size_t)(b * 8 + h) * 64 * 512;
  const u16* kls = Kb + (size_t)(T_CTX + b * 4096) * 512 + h * 64;
  const u16* vls = (const u16*)(p.ws + OFF_VTS) + (size_t)(b * 8 + h) * 64 * 4096;
  const u16* klc = Kb + (size_t)(b * 256) * 512 + h * 64;
  const u16* vlc = (const u16*)(p.ws + OFF_VTC) + (size_t)(b * 8 + h) * 64 * 256;
  const int ntile = smp ? 32 : 8;
  u32x4 kr[4], vr[4];
  auto issue = [&](int tt) {
    int ll = lane;
    asm volatile("" : "+v"(ll));
    const u16 *kp, *vp; int ldv;
    if (!smp) { kp = klc + (size_t)tt * 32 * 512; vp = vlc + tt * 32; ldv = 256; }
    else if (tt < 16) { kp = ck + (size_t)tt * 32 * 512; vp = cvt + tt * 32; ldv = 512; }
    else { int kt = tt - 16, krow = rs + (kt >> 1), kc0 = (kt & 1) * 32; kp = kls + (size_t)(krow * 64 + kc0) * 512; vp = vls + krow * 64 + kc0; ldv = 4096; }
#pragma unroll
    for (int n = 0; n < 4; n++) {
      const int id = ll + 64 * n;
      kr[n] = *(const u32x4*)(kp + (size_t)(id >> 3) * 512 + (id & 7) * 8);
      vr[n] = *(const u32x4*)(vp + (size_t)(id >> 2) * ldv + (id & 3) * 8);
    }
  };
  issue(0);
#pragma unroll 1
  for (int tt = 0; tt < ntile; tt++) {
    {
      int ll = lane;
      asm volatile("" : "+v"(ll));
#pragma unroll
      for (int n = 0; n < 4; n++) {
        const int id = ll + 64 * n;
        *(u32x4*)(kS + (id >> 3) * 72 + (id & 7) * 8) = kr[n];
        *(u32x4*)(vS + (id >> 2) * 40 + (id & 3) * 8) = vr[n];
      }
    }
    if (tt + 1 < ntile) issue(tt + 1);
    const bool loc = smp && tt >= 16;
    const int kt = tt - 16;
    attn_tile(st, qf, kS, vS, loc ? 1 : 0, loc ? rs + (kt >> 1) - r + 7 : 0, loc ? (kt & 1) * 32 : 0, c0 + qi, rpbh, qi, hh);
  }
  float lt = st.l + __shfl_xor(st.l, 32);
  float inv = 1.f / lt;
  const size_t rowo = (size_t)(tq0 + qi) * 1024 + 512 + h * 64;
  const u16* gb = (const u16*)(p.ws + OFF_GBUF) + rowo;
  u16* cat = (u16*)(p.ws + OFF_U) + rowo;
#pragma unroll
  for (int dt = 0; dt < 2; dt++)
#pragma unroll
    for (int q = 0; q < 4; q++) {
      int d = dt * 32 + q * 8 + hh * 4;
      uint2 g = *(const uint2*)(gb + d);
      float v0 = (dt ? st.o1[q * 4 + 0] : st.o0[q * 4 + 0]) * inv * bflo(g.x);
      float v1 = (dt ? st.o1[q * 4 + 1] : st.o0[q * 4 + 1]) * inv * bfhi(g.x);
      float v2 = (dt ? st.o1[q * 4 + 2] : st.o0[q * 4 + 2]) * inv * bflo(g.y);
      float v3 = (dt ? st.o1[q * 4 + 3] : st.o0[q * 4 + 3]) * inv * bfhi(g.y);
      *(uint2*)(cat + d) = make_uint2(pack2(v0, v1), pack2(v2, v3));
    }
}

DEV void p3_mix(const Params& p, char* smem) {
  for (int t = blockIdx.x; t < 2048; t += gridDim.x) {
    if (t < 1024) {
      __syncthreads();
      attn_unit(p, t * 4 + (threadIdx.x >> 6), threadIdx.x & 63, smem);
    } else {
      int q = t - 1024, mt = q >> 3, g = (q >> 1) & 3, nh = q & 1, m0 = mt * 128;
      const u16* A = (const u16*)(p.ws + OFF_ABUF) + (size_t)m0 * 512 + g * 128;
      const u16* B = (const u16*)(p.ws + OFF_MCAT) + (size_t)(g * 256 + nh * 128) * 128;
      u16* d; size_t ldt;
      if (m0 < T_CTX) { int b = m0 >> 8, l = m0 & 255; ldt = 512; d = (u16*)(p.ws + OFF_BTC) + ((size_t)b * 512 + g * 128) * 512 + nh * 256 + l; }
      else { int tt = m0 - T_CTX, b = tt >> 12, l = tt & 4095; ldt = 8192; d = (u16*)(p.ws + OFF_BTS) + ((size_t)b * 512 + g * 128) * 8192 + nh * 4096 + l; }
      gemm_tile<false>(A, 512, nullptr, m0, B, 128, 128, EpTrans{d, ldt, nullptr, 0}, smem);
    }
  }
}

DEV void p3b_fold(const Params& p) {
  const u16* bt = (const u16*)(p.ws + OFF_BTS);
  u16* bf = (u16*)(p.ws + OFF_BFOLD);
  const size_t gt = (size_t)blockIdx.x * 256 + threadIdx.x, gs = (size_t)gridDim.x * 256;
  for (size_t i = gt; i < 4194304; i += gs) {
    const int jj = (int)(i & 4095);
    const u16* row = bt + (i >> 12) * 8192;
    float v;
    if (jj <= 2048) {
      v = __uint_as_float((unsigned)row[jj] << 16);
      if (jj >= 1 && jj <= 2047) v += __uint_as_float((unsigned)row[4096 - jj] << 16);
    } else {
      const int j = jj - 2048;
      v = __uint_as_float((unsigned)row[4096 + j] << 16) - __uint_as_float((unsigned)row[8192 - j] << 16);
    }
    bf[i] = f2bf(v);
  }
}

DEV void p4_fnet(const Params& p, char* smem) {
  for (int t = blockIdx.x; t < 512; t += gridDim.x) {
    if (t < 256) {
      int b = t >> 7, mt = (t >> 2) & 31, nt = t & 3;
      int tok0 = T_CTX + b * 4096 + mt * 128;
      const u16* A = (const u16*)(p.ws + OFF_FSMP) + (size_t)(mt * 128) * 4096;
      const u16* B = (const u16*)(p.ws + OFF_BFOLD) + ((size_t)b * 512 + nt * 128) * 4096;
      size_t o = (size_t)tok0 * 1024 + nt * 128;
      gemm_tile<false>(A, 4096, nullptr, 0, B, 4096, 4096, EpGate{(u16*)(p.ws + OFF_U) + o, (const u16*)(p.ws + OFF_GBUF) + o, 1024}, smem);
    } else {
      int q = t - 256, b = q >> 3, mt = (q >> 2) & 1, nt = q & 3;
      int tok0 = b * 256 + mt * 128;
      const u16* A = (const u16*)(p.ws + OFF_FCTX) + (size_t)(mt * 128) * 512;
      const u16* B = (const u16*)(p.ws + OFF_BTC) + ((size_t)b * 512 + nt * 128) * 512;
      size_t o = (size_t)tok0 * 1024 + nt * 128;
      gemm_tile<false>(A, 512, nullptr, 0, B, 512, 512, EpGate{(u16*)(p.ws + OFF_U) + o, (const u16*)(p.ws + OFF_GBUF) + o, 1024}, smem);
    }
  }
}

template <int LAYER> DEV void p_outproj(const Params& p, char* smem) {
  const u16* Aall = (const u16*)(p.ws + (LAYER == 0 ? OFF_U : OFF_U1));
  const u16* W = (const u16*)(p.ws + (LAYER == 0 ? OFF_WOUTT : OFF_RWOUTT));
  const float* mods = (const float*)(p.ws + OFF_MODS);
  for (int t = blockIdx.x; t < 1024; t += gridDim.x) {
    int mt = t >> 3, nt = t & 7, m0 = mt * 128, n0 = nt * 128;
    const float* xs;
    if (LAYER == 0) xs = (m0 < T_CTX ? p.x_prompt + (size_t)m0 * 1024 : p.x_sample + (size_t)(m0 - T_CTX) * 1024) + n0;
    else xs = p.out + (size_t)m0 * 1024 + n0;
    const float* gate = mods + (LAYER * 3 + mv_of(m0)) * 3072 + 2048 + n0;
    gemm_tile<false>(Aall + (size_t)m0 * 1024, 1024, nullptr, m0, W + (size_t)n0 * 1024, 1024, 1024,
                     EpRes{(u16*)(p.ws + (LAYER == 0 ? OFF_Y0B : OFF_Y1B)) + (size_t)m0 * 1024 + n0, xs, gate}, smem);
  }
}

DEV void p6b_dx(const Params& p) {
  const int lane = threadIdx.x & 63;
  const int gw = blockIdx.x * 4 + (threadIdx.x >> 6), nw = gridDim.x * 4;
  const u16* U = (const u16*)(p.ws + OFF_U1);
  u16* DX = (u16*)(p.ws + OFF_DX);
  for (int row = gw; row < 16384; row += nw) {
    const int l = row < T_CTX ? (row & 255) : ((row - T_CTX) & 4095);
    const int len = row < T_CTX ? 256 : 4096;
    const float pf = l > 0 ? 1.f : 0.f, nf = l + 1 < len ? 1.f : 0.f;
    const u16* uc = U + (size_t)row * 1024 + lane * 16;
    const u16* up = l > 0 ? uc - 1024 : uc;
    const u16* un = l + 1 < len ? uc + 1024 : uc;
#pragma unroll
    for (int hlf = 0; hlf < 2; hlf++) {
      uint4 c = *(const uint4*)(uc + 8 * hlf), a = *(const uint4*)(up + 8 * hlf), n = *(const uint4*)(un + 8 * hlf);
      const unsigned cu[4] = {c.x, c.y, c.z, c.w}, au[4] = {a.x, a.y, a.z, a.w}, nu[4] = {n.x, n.y, n.z, n.w};
      unsigned o[4];
#pragma unroll
      for (int q = 0; q < 4; q++)
        o[q] = pack2(0.5f * (bflo(au[q]) * pf + bflo(nu[q]) * nf) - bflo(cu[q]), 0.5f * (bfhi(au[q]) * pf + bfhi(nu[q]) * nf) - bfhi(cu[q]));
      *(uint4*)(DX + (size_t)row * 1024 + lane * 16 + 8 * hlf) = make_uint4(o[0], o[1], o[2], o[3]);
    }
  }
}

DEV void p7_rwkv_proj(const Params& p, char* smem) {
  const u16* U1 = (const u16*)(p.ws + OFF_U1);
  const int xcd = blockIdx.x & 7, jx = blockIdx.x >> 3, nbx = gridDim.x >> 3;
  for (int q = jx; q < 16 * 35; q += nbx) {
    int mt, nt;
    if (q < 512) { int st = q >> 6, w = q & 63; mt = xcd * 16 + (st >> 2) * 8 + (w >> 3); nt = (st & 3) * 8 + (w & 7); }
    else { int w = q - 512; mt = xcd * 16 + w / 3; nt = 32 + w % 3; }
    const int m0 = mt * 128;
    if (nt < 32) {
      int which = nt >> 3, n0 = (nt & 7) * 128;
      const u16* B = (const u16*)(p.ws + OFF_RKVZT) + (size_t)which * 1048576 + (size_t)n0 * 1024;
      if (which == 3) {
        gemm_tile<false>(U1 + (size_t)m0 * 1024, 1024, nullptr, m0, B, 1024, 1024,
                         EpStore<1>{(u16*)(p.ws + OFF_SZ) + (size_t)m0 * 1024 + n0, 1024, 1.f}, smem);
      } else {
        size_t off = which == 0 ? OFF_R : (which == 1 ? OFF_K2 : OFF_V2);
        const float* mu = p.mu + (which == 0 ? 0 : (which == 1 ? 2 : 3)) * 1024;
        gemm_tile<true>(U1, 1024, mu, m0, B, 1024, 1024, EpStore<0>{(u16*)(p.ws + off) + (size_t)m0 * 1024 + n0, 1024, 1.f}, smem);
      }
    } else {
      int w = nt - 32;
      if (w == 0)
        gemm_tile<true>(U1, 1024, p.mu + 1 * 1024, m0, (const u16*)(p.ws + OFF_W1T), 1024, 1024, EpStore<2>{(u16*)(p.ws + OFF_HW) + (size_t)m0 * 128, 128, 1.f}, smem);
      else if (w == 1)
        gemm_tile<true>(U1, 1024, p.mu + 4 * 1024, m0, (const u16*)(p.ws + OFF_A1T), 1024, 1024, EpStore<0>{(u16*)(p.ws + OFF_HA) + (size_t)m0 * 128, 128, 1.f}, smem);
      else
        gemm_tile<true>(U1, 1024, p.mu + 5 * 1024, m0, (const u16*)(p.ws + OFF_G1T), 1024, 1024, EpStore<3>{(u16*)(p.ws + OFF_HG) + (size_t)m0 * 128, 128, 1.f}, smem);
    }
  }
}

DEV b16x8 lds_perm(const u16* M, int ld, int row, int s, int hh) {
  const u16* q = M + row * ld + 16 * s + 4 * hh;
  uint2 lo = *(const uint2*)q, hi = *(const uint2*)(q + 8);
  u32x4 v = {lo.x, lo.y, hi.x, hi.y};
  return *(b16x8*)&v;
}
DEV b16x8 lds_norm(const u16* M, int ld, int row, int s, int hh) { return *(const b16x8*)(M + row * ld + 16 * s + 8 * hh); }
template <int OFF> DEV b16x8 pack8(const f32x16& a) {
  u32x4 v = {pack2(a[OFF], a[OFF + 1]), pack2(a[OFF + 2], a[OFF + 3]), pack2(a[OFF + 4], a[OFF + 5]), pack2(a[OFF + 6], a[OFF + 7])};
  return *(b16x8*)&v;
}
#define MFMA32(a, b, c) __builtin_amdgcn_mfma_f32_32x32x16_bf16(a, b, c, 0, 0, 0)

DEV int swz_idx(int row, int col) { return row * 40 + ((row >> 5) & 1) * 32 + ((((col >> 3) ^ (row >> 3)) & 3) << 3) + (col & 7); }
DEV b16x8 swz_norm(const u16* M, int row, int s, int hh) { return *(const b16x8*)(M + swz_idx(row, 16 * s + 8 * hh)); }
DEV b16x8 swz_perm(const u16* M, int row, int s, int hh) {
  uint2 lo = *(const uint2*)(M + swz_idx(row, 16 * s) + 4 * hh), hi = *(const uint2*)(M + swz_idx(row, 16 * s + 8) + 4 * hh);
  u32x4 v = {lo.x, lo.y, hi.x, hi.y};
  return *(b16x8*)&v;
}
struct ScanJob {
  int e, b, hd, tb, L, step0, nch, pq;
  int ncomb, seq;
  const float* zin;
  float* zout;
  u16* pout;
  float* qout;
};
DEV void scan_job(const Params& p, const ScanJob& J, char* smem) {
  float* sCum = (float*)smem;
  float* sAa = (float*)(smem + 8320);
  float* sNN = (float*)(smem + 8320);
  float* sT11 = (float*)(smem + 12544);
  float* sT22 = (float*)(smem + 13632);
  float* sWm = (float*)(smem + 14720);
  u16* AT = (u16*)(smem + 16640);
  u16* RT = (u16*)(smem + 21248);
  u16* BTl = (u16*)(smem + 25856);
  u16* KTl = (u16*)(smem + 30464);
  u16* BH = (u16*)(smem + 35072);
  u16* KH = (u16*)(smem + 40256);
  u16* VT = (u16*)(smem + 45440);
  u16* MkaT = (u16*)(smem + 50624);
  u16* MbrT = (u16*)(smem + 53184);
  u16* MkrT = (u16*)(smem + 55744);
  u16* TT = (u16*)(smem + 58304);
  float* gC = (float*)(smem + 60864);
  const int tid = threadIdx.x, wave = __builtin_amdgcn_readfirstlane(threadIdx.x >> 6);
  float* sKc = (float*)(smem + 61120);
  const int e = J.e, hd = J.hd, tb = J.tb, L = J.L, step0 = J.step0;
  const bool pq = J.pq != 0;
  const bool chainw = pq || wave < 2;
  const bool useV = pq ? (wave >= 2) : true;
  const int rb = wave & 1;
  const u16* HW = (const u16*)(p.ws + OFF_HW);
  const u16* HA = (const u16*)(p.ws + OFF_HA);
  const u16* Rb = (const u16*)(p.ws + OFF_R);
  const u16* Kb = (const u16*)(p.ws + OFF_K2);
  const u16* Vb = (const u16*)(p.ws + OFF_V2);
  float* Ysum = (float*)(p.ws + OFF_YSUM);
  float* Bsum = (float*)(p.ws + OFF_BSUM);
  const int arr = wave >> 1, ct = wave & 1;
  const u16* Xb = (arr ? HA : HW) + e * 64;
  b16x8 wf[4];
  {
    const int qi = tid & 31, hh = (tid >> 5) & 1;
    const u16* Wt = (const u16*)(p.ws + (arr ? OFF_A2T : OFF_W2T)) + (size_t)e * 65536 + (size_t)(hd * 64 + ct * 32 + qi) * 64 + hh * 8;
#pragma unroll
    for (int ks = 0; ks < 4; ks++) wf[ks] = ld16(Wt + ks * 16);
  }
  const float bias0 = (arr ? p.a0 : p.w0)[e * 1024 + hd * 64 + ct * 32 + (tid & 31)];
  if (tid < 64) { sKc[tid] = p.k_k[hd * 64 + tid]; sKc[64 + tid] = p.k_a[hd * 64 + tid]; sKc[128 + tid] = p.r_k[hd * 64 + tid]; }
  f32x16 z0, z1;
#pragma unroll
  for (int q = 0; q < 4; q++) {
    const int qi = tid & 31, hh = (tid >> 5) & 1;
    float4 v0 = make_float4(0, 0, 0, 0), v1 = v0;
    if (pq) {
      if (wave < 2) {
#pragma unroll
        for (int i = 0; i < 4; i++) {
          const int k = 8 * q + 4 * hh + i, col = rb * 32 + qi;
          ((float*)&v0)[i] = (k == col) ? 1.f : 0.f;
          ((float*)&v1)[i] = (k + 32 == col) ? 1.f : 0.f;
        }
      }
    } else if (J.zin && wave < 2) {
      const float* sp = J.zin + (size_t)(wave * 32 + qi) * 64 + 8 * q + 4 * hh;
      v0 = *(const float4*)sp; v1 = *(const float4*)(sp + 32);
    }
    z0[4 * q] = v0.x; z0[4 * q + 1] = v0.y; z0[4 * q + 2] = v0.z; z0[4 * q + 3] = v0.w;
    z1[4 * q] = v1.x; z1[4 * q + 1] = v1.y; z1[4 * q + 2] = v1.z; z1[4 * q + 3] = v1.w;
  }
  if (!pq && wave < 2) {
    const int qi = tid & 31, hh = (tid >> 5) & 1;
#pragma unroll 1
    for (int g = 0; g < J.ncomb; g++) {
      const u16* P = (const u16*)(p.ws + OFF_SEGP) + (size_t)(J.seq * 7 + g) * 4096;
      const float* Q = (const float*)(p.ws + OFF_SEGQ) + (size_t)(J.seq * 7 + g) * 4096;
      b16x8 zb[4] = {pack8<0>(z0), pack8<8>(z0), pack8<0>(z1), pack8<8>(z1)};
      f32x16 n0, n1;
#pragma unroll
      for (int q = 0; q < 4; q++) {
        const float* sp = Q + (size_t)(wave * 32 + qi) * 64 + 8 * q + 4 * hh;
        float4 v0 = *(const float4*)sp, v1 = *(const float4*)(sp + 32);
        n0[4 * q] = v0.x; n0[4 * q + 1] = v0.y; n0[4 * q + 2] = v0.z; n0[4 * q + 3] = v0.w;
        n1[4 * q] = v1.x; n1[4 * q + 1] = v1.y; n1[4 * q + 2] = v1.z; n1[4 * q + 3] = v1.w;
      }
#pragma unroll
      for (int s2 = 0; s2 < 4; s2++) {
        const u16* r0 = P + (size_t)qi * 64 + 16 * s2 + 4 * hh;
        const u16* r1 = P + (size_t)(32 + qi) * 64 + 16 * s2 + 4 * hh;
        uint2 a = *(const uint2*)r0, c = *(const uint2*)(r0 + 8), d = *(const uint2*)r1, f = *(const uint2*)(r1 + 8);
        u32x4 fa = {a.x, a.y, c.x, c.y}, fb = {d.x, d.y, f.x, f.y};
        n0 = MFMA32(*(b16x8*)&fa, zb[s2], n0);
        n1 = MFMA32(*(b16x8*)&fb, zb[s2], n1);
      }
      z0 = n0; z1 = n1;
    }
  }
  const int nch = J.nch;
  b16x8 xf[4];
  u32x4 kq, rq, vq;
  int tokC;
  {
    const int qi = tid & 31, hh = (tid >> 5) & 1, ci_ = tid >> 3, chg = hd * 64 + (tid & 7) * 8;
    const int tok0 = tb + (e ? L - step0 - 32 : step0);
    const int tokA = tok0 + (e ? 31 - qi : qi);
#pragma unroll
    for (int ks = 0; ks < 4; ks++) xf[ks] = ld16(Xb + (size_t)tokA * 128 + hh * 8 + ks * 16);
    tokC = tok0 + (e ? 31 - ci_ : ci_);
    kq = *(const u32x4*)(Kb + (size_t)tokC * 1024 + chg);
    rq = *(const u32x4*)(Rb + (size_t)tokC * 1024 + chg);
    vq = *(const u32x4*)(Vb + (size_t)tokC * 1024 + chg);
  }
#pragma unroll 1
  for (int ci = 0; ci < nch; ci++) {
    const int tok0 = tb + (e ? L - step0 - 32 * (ci + 1) : step0 + 32 * ci);
    const int tokn0 = tb + (e ? L - step0 - 32 * (ci + 2) : step0 + 32 * (ci + 1));
    const bool more = ci + 1 < nch;
    int tl = tid;
    asm volatile("" : "+v"(tl));
    const int lane = tl & 63, qi = lane & 31, hh = lane >> 5, ci_ = tl >> 3, cb = (tl & 7) * 8, chg = hd * 64 + cb;
    {
      f32x16 acc;
#pragma unroll
      for (int r = 0; r < 16; r++) acc[r] = 0.f;
#pragma unroll
      for (int ks = 0; ks < 4; ks++) acc = MFMA32(xf[ks], wf[ks], acc);
      if (more) {
        const int tokA = tokn0 + (e ? 31 - qi : qi);
#pragma unroll
        for (int ks = 0; ks < 4; ks++) xf[ks] = ld16(Xb + (size_t)tokA * 128 + hh * 8 + ks * 16);
      }
      const int ch = ct * 32 + qi;
      if (arr == 0) {
        float lw[16], gs[4], og[4];
#pragma unroll
        for (int r = 0; r < 16; r++) lw[r] = -0.606531f * sigm(acc[r] + bias0);
#pragma unroll
        for (int q = 0; q < 4; q++) { gs[q] = (lw[4 * q] + lw[4 * q + 1]) + (lw[4 * q + 2] + lw[4 * q + 3]); og[q] = __shfl_xor(gs[q], 32); }
        float pre = 0.f;
#pragma unroll
        for (int q = 0; q < 4; q++) {
          float run = pre + (hh ? og[q] : 0.f);
#pragma unroll
          for (int i = 0; i < 4; i++) { run += lw[4 * q + i]; sCum[(8 * q + 4 * hh + i) * 65 + ch] = run; }
          pre += gs[q] + og[q];
        }
      } else {
#pragma unroll
        for (int r = 0; r < 16; r++) {
          int row = (r & 3) + 8 * (r >> 2) + 4 * hh;
          sAa[row * 65 + ch] = sigm(acc[r] + bias0);
        }
      }
    }
    lds_barrier();
    {
      const int i = ci_;
      const unsigned ku[4] = {kq.x, kq.y, kq.z, kq.w}, ru[4] = {rq.x, rq.y, rq.z, rq.w}, vu[4] = {vq.x, vq.y, vq.z, vq.w};
      float k[8], r[8], kkr[8];
#pragma unroll
      for (int q = 0; q < 4; q++) {
        k[2 * q] = bflo(ku[q]); k[2 * q + 1] = bfhi(ku[q]);
        r[2 * q] = bflo(ru[q]); r[2 * q + 1] = bfhi(ru[q]);
      }
      float kkc[8], kac[8], rkc[8];
#pragma unroll
      for (int j = 0; j < 8; j++) { kkc[j] = sKc[cb + j]; kac[j] = sKc[64 + cb + j]; rkc[j] = sKc[128 + cb + j]; }
      float ss = 0;
#pragma unroll
      for (int j = 0; j < 8; j++) { kkr[j] = k[j] * kkc[j]; ss += kkr[j] * kkr[j]; }
      ss = allsum8(ss);
      const float inv = rsqrtf(ss + 1e-12f);
      float bon = 0;
      float oa[8], orr[8], ob[8], ok[8];
#pragma unroll
      for (int j = 0; j < 8; j++) {
        const float a = sAa[i * 65 + cb + j];
        const float cm = sCum[i * 65 + cb + j];
        const float cp = i > 0 ? sCum[(i - 1) * 65 + cb + j] : 0.f;
        const float cl = sCum[31 * 65 + cb + j];
        const float kd = k[j] * (1.f + (a - 1.f) * kac[j]);
        const float kk = kkr[j] * inv;
        const float bb = kk * a;
        bon += r[j] * kd * rkc[j];
        const float em = __expf(-cm), eC = __expf(cl - cm);
        oa[j] = -kk * __expf(cp);
        orr[j] = pq ? 0.f : r[j] * __expf(cm);
        ob[j] = bb * em;
        ok[j] = kd * em;
        BH[swz_idx(cb + j, i)] = f2bf(bb * eC);
        KH[swz_idx(cb + j, i)] = f2bf(kd * eC);
        if (i == 31) gC[cb + j] = __expf(cl);
      }
#pragma unroll
      for (int q = 0; q < 4; q++) {
        VT[swz_idx(cb + 2 * q, i)] = (u16)(vu[q] & 0xffffu);
        VT[swz_idx(cb + 2 * q + 1, i)] = (u16)(vu[q] >> 16);
      }
      *(u32x4*)(AT + i * 72 + cb) = u32x4{pack2(oa[0], oa[1]), pack2(oa[2], oa[3]), pack2(oa[4], oa[5]), pack2(oa[6], oa[7])};
      if (!pq) *(u32x4*)(RT + i * 72 + cb) = u32x4{pack2(orr[0], orr[1]), pack2(orr[2], orr[3]), pack2(orr[4], orr[5]), pack2(orr[6], orr[7])};
      *(u32x4*)(BTl + i * 72 + cb) = u32x4{pack2(ob[0], ob[1]), pack2(ob[2], ob[3]), pack2(ob[4], ob[5]), pack2(ob[6], ob[7])};
      *(u32x4*)(KTl + i * 72 + cb) = u32x4{pack2(ok[0], ok[1]), pack2(ok[2], ok[3]), pack2(ok[4], ok[5]), pack2(ok[6], ok[7])};
      bon = allsum8(bon);
      if (!pq && (tl & 7) == 0) atomicAdd(Bsum + (size_t)tokC * 16 + hd, 0.5f * bon);
      if (more) {
        tokC = tokn0 + (e ? 31 - ci_ : ci_);
        kq = *(const u32x4*)(Kb + (size_t)tokC * 1024 + chg);
        rq = *(const u32x4*)(Rb + (size_t)tokC * 1024 + chg);
        vq = *(const u32x4*)(Vb + (size_t)tokC * 1024 + chg);
      }
    }
    lds_barrier();
    if (!(pq && wave >= 2)) {
      const u16* Am = (wave < 2) ? AT : RT;
      const u16* Bm = (wave & 1) ? KTl : BTl;
      f32x16 acc;
#pragma unroll
      for (int r = 0; r < 16; r++) acc[r] = 0.f;
#pragma unroll
      for (int s = 0; s < 4; s++) acc = MFMA32(lds_norm(Am, 72, qi, s, hh), lds_norm(Bm, 72, qi, s, hh), acc);
      u16* dst = wave == 1 ? MkaT : (wave == 2 ? MbrT : MkrT);
#pragma unroll
      for (int r = 0; r < 16; r++) {
        const int tt = (r & 3) + 8 * (r >> 2) + 4 * hh, j = qi;
        const bool keep = (wave < 2) ? (j < tt) : (j <= tt);
        const float val = keep ? acc[r] : 0.f;
        if (wave == 0) sNN[j * 33 + tt] = val;
        else dst[tt * 40 + j] = f2bf(val);
      }
    }
    if (tl < 32) {
      const int i = tl & 15, base = (tl >> 4) * 16;
      float Tr[16];
#pragma unroll
      for (int q = 0; q < 16; q++) Tr[q] = (q == i) ? 1.f : 0.f;
#pragma unroll
      for (int q = 1; q < 16; q++) {
        float s0 = 0.f, s1 = 0.f, s2 = 0.f, s3 = 0.f;
#pragma unroll
        for (int j = 0; j < q; j++) {
          const float pr = Tr[j] * sNN[(base + j) * 33 + base + q];
          if ((j & 3) == 0) s0 += pr; else if ((j & 3) == 1) s1 += pr; else if ((j & 3) == 2) s2 += pr; else s3 += pr;
        }
        if (q > i) Tr[q] = (s0 + s1) + (s2 + s3);
      }
      float* sT = (tl >> 4) ? sT22 : sT11;
#pragma unroll
      for (int q = 0; q < 16; q++) { sT[i * 17 + q] = Tr[q]; TT[(base + q) * 40 + base + i] = f2bf(Tr[q]); }
    }
    lds_barrier();
    {
      const int i = tl >> 4, q = tl & 15;
      float s = 0.f;
#pragma unroll
      for (int j = 0; j < 16; j++) s += sT11[i * 17 + j] * sNN[j * 33 + 16 + q];
      sWm[i * 17 + q] = s;
      TT[i * 40 + 16 + q] = 0;
    }
    lds_barrier();
    {
      const int i = tl >> 4, q = tl & 15;
      float s = 0.f;
#pragma unroll
      for (int j = 0; j < 16; j++) s += sWm[i * 17 + j] * sT22[j * 17 + q];
      TT[(16 + q) * 40 + i] = f2bf(s);
    }
    lds_barrier();
    if (chainw) {
      const int vrow = rb * 32 + qi;
      b16x8 zb0 = pack8<0>(z0), zb1 = pack8<8>(z0), zb2 = pack8<0>(z1), zb3 = pack8<8>(z1);
      b16x8 vt0 = swz_norm(VT, vrow, 0, hh), vt1 = swz_norm(VT, vrow, 1, hh);
      f32x16 x;
#pragma unroll
      for (int r = 0; r < 16; r++) x[r] = 0.f;
      x = MFMA32(lds_perm(AT, 72, qi, 0, hh), zb0, x);
      x = MFMA32(lds_perm(AT, 72, qi, 1, hh), zb1, x);
      x = MFMA32(lds_perm(AT, 72, qi, 2, hh), zb2, x);
      x = MFMA32(lds_perm(AT, 72, qi, 3, hh), zb3, x);
      if (useV) {
        x = MFMA32(lds_norm(MkaT, 40, qi, 0, hh), vt0, x);
        x = MFMA32(lds_norm(MkaT, 40, qi, 1, hh), vt1, x);
      }
      f32x16 y;
#pragma unroll
      for (int r = 0; r < 16; r++) y[r] = 0.f;
      if (!pq) {
        y = MFMA32(lds_perm(RT, 72, qi, 0, hh), zb0, y);
        y = MFMA32(lds_perm(RT, 72, qi, 1, hh), zb1, y);
        y = MFMA32(lds_perm(RT, 72, qi, 2, hh), zb2, y);
        y = MFMA32(lds_perm(RT, 72, qi, 3, hh), zb3, y);
        y = MFMA32(lds_norm(MkrT, 40, qi, 0, hh), vt0, y);
        y = MFMA32(lds_norm(MkrT, 40, qi, 1, hh), vt1, y);
      }
#pragma unroll
      for (int q = 0; q < 4; q++) {
        float4 g0 = *(const float4*)(gC + 8 * q + 4 * hh), g1 = *(const float4*)(gC + 32 + 8 * q + 4 * hh);
        z0[4 * q] *= g0.x; z0[4 * q + 1] *= g0.y; z0[4 * q + 2] *= g0.z; z0[4 * q + 3] *= g0.w;
        z1[4 * q] *= g1.x; z1[4 * q + 1] *= g1.y; z1[4 * q + 2] *= g1.z; z1[4 * q + 3] *= g1.w;
      }
      if (useV) {
        z0 = MFMA32(swz_norm(KH, qi, 0, hh), vt0, z0);
        z0 = MFMA32(swz_norm(KH, qi, 1, hh), vt1, z0);
        z1 = MFMA32(swz_norm(KH, 32 + qi, 0, hh), vt0, z1);
        z1 = MFMA32(swz_norm(KH, 32 + qi, 1, hh), vt1, z1);
      }
      b16x8 xb0 = pack8<0>(x), xb1 = pack8<8>(x);
      f32x16 u;
#pragma unroll
      for (int r = 0; r < 16; r++) u[r] = 0.f;
      u = MFMA32(lds_perm(TT, 40, qi, 0, hh), xb0, u);
      u = MFMA32(lds_perm(TT, 40, qi, 1, hh), xb1, u);
      b16x8 ub0 = pack8<0>(u), ub1 = pack8<8>(u);
      z0 = MFMA32(swz_perm(BH, qi, 0, hh), ub0, z0);
      z0 = MFMA32(swz_perm(BH, qi, 1, hh), ub1, z0);
      z1 = MFMA32(swz_perm(BH, 32 + qi, 0, hh), ub0, z1);
      z1 = MFMA32(swz_perm(BH, 32 + qi, 1, hh), ub1, z1);
      if (!pq) {
        y = MFMA32(lds_perm(MbrT, 40, qi, 0, hh), ub0, y);
        y = MFMA32(lds_perm(MbrT, 40, qi, 1, hh), ub1, y);
#pragma unroll
        for (int r = 0; r < 16; r++) {
          const int st = (r & 3) + 8 * (r >> 2) + 4 * hh;
          const int tok = tok0 + (e ? 31 - st : st);
          atomicAdd(Ysum + (size_t)tok * 1024 + hd * 64 + vrow, y[r]);
        }
      }
    }
  }
  {
    const int qi = tid & 31, hh = (tid >> 5) & 1;
    if (pq) {
      if (wave < 2) {
#pragma unroll
        for (int r = 0; r < 16; r++) {
          const int k = (r & 3) + 8 * (r >> 2) + 4 * hh;
          J.pout[k * 64 + rb * 32 + qi] = f2bf(z0[r]);
          J.pout[(k + 32) * 64 + rb * 32 + qi] = f2bf(z1[r]);
        }
      } else {
#pragma unroll
        for (int q = 0; q < 4; q++) {
          float* sp = J.qout + (size_t)(rb * 32 + qi) * 64 + 8 * q + 4 * hh;
          *(float4*)sp = make_float4(z0[4 * q], z0[4 * q + 1], z0[4 * q + 2], z0[4 * q + 3]);
          *(float4*)(sp + 32) = make_float4(z1[4 * q], z1[4 * q + 1], z1[4 * q + 2], z1[4 * q + 3]);
        }
      }
    } else if (J.zout && wave < 2) {
#pragma unroll
      for (int q = 0; q < 4; q++) {
        float* sp = J.zout + (size_t)(wave * 32 + qi) * 64 + 8 * q + 4 * hh;
        *(float4*)sp = make_float4(z0[4 * q], z0[4 * q + 1], z0[4 * q + 2], z0[4 * q + 3]);
        *(float4*)(sp + 32) = make_float4(z1[4 * q], z1[4 * q + 1], z1[4 * q + 2], z1[4 * q + 3]);
      }
    }
  }
  __syncthreads();
}

DEV void scan_combine(const Params& p, int seq) {
  const int tid = threadIdx.x, wave = tid >> 6, qi = tid & 31, hh = (tid >> 5) & 1;
  if (wave >= 2) return;
  const int e = seq >> 5, b = (seq >> 4) & 1, hd = seq & 15;
  const float* zin = p.state_rwkv + ((size_t)(b * 2 + e) * 16 + hd) * 4096;
  f32x16 z0, z1;
#pragma unroll
  for (int q = 0; q < 4; q++) {
    const float* sp = zin + (size_t)(wave * 32 + qi) * 64 + 8 * q + 4 * hh;
    float4 v0 = *(const float4*)sp, v1 = *(const float4*)(sp + 32);
    z0[4 * q] = v0.x; z0[4 * q + 1] = v0.y; z0[4 * q + 2] = v0.z; z0[4 * q + 3] = v0.w;
    z1[4 * q] = v1.x; z1[4 * q + 1] = v1.y; z1[4 * q + 2] = v1.z; z1[4 * q + 3] = v1.w;
  }
#pragma unroll 1
  for (int g = 0; g < 7; g++) {
    const u16* P = (const u16*)(p.ws + OFF_SEGP) + (size_t)(seq * 7 + g) * 4096;
    const float* Q = (const float*)(p.ws + OFF_SEGQ) + (size_t)(seq * 7 + g) * 4096;
    b16x8 zb[4] = {pack8<0>(z0), pack8<8>(z0), pack8<0>(z1), pack8<8>(z1)};
    f32x16 n0, n1;
#pragma unroll
    for (int q = 0; q < 4; q++) {
      const float* sp = Q + (size_t)(wave * 32 + qi) * 64 + 8 * q + 4 * hh;
      float4 v0 = *(const float4*)sp, v1 = *(const float4*)(sp + 32);
      n0[4 * q] = v0.x; n0[4 * q + 1] = v0.y; n0[4 * q + 2] = v0.z; n0[4 * q + 3] = v0.w;
      n1[4 * q] = v1.x; n1[4 * q + 1] = v1.y; n1[4 * q + 2] = v1.z; n1[4 * q + 3] = v1.w;
    }
#pragma unroll
    for (int s = 0; s < 4; s++) {
      const u16* r0 = P + (size_t)qi * 64 + 16 * s + 4 * hh;
      const u16* r1 = P + (size_t)(32 + qi) * 64 + 16 * s + 4 * hh;
      uint2 a = *(const uint2*)r0, c = *(const uint2*)(r0 + 8), d = *(const uint2*)r1, f = *(const uint2*)(r1 + 8);
      u32x4 fa = {a.x, a.y, c.x, c.y}, fb = {d.x, d.y, f.x, f.y};
      n0 = MFMA32(*(b16x8*)&fa, zb[s], n0);
      n1 = MFMA32(*(b16x8*)&fb, zb[s], n1);
    }
    z0 = n0; z1 = n1;
    float* zs = (float*)(p.ws + OFF_SEGZ) + (size_t)(seq * 7 + g) * 4096;
#pragma unroll
    for (int q = 0; q < 4; q++) {
      float* sp = zs + (size_t)(wave * 32 + qi) * 64 + 8 * q + 4 * hh;
      *(float4*)sp = make_float4(z0[4 * q], z0[4 * q + 1], z0[4 * q + 2], z0[4 * q + 3]);
      *(float4*)(sp + 32) = make_float4(z1[4 * q], z1[4 * q + 1], z1[4 * q + 2], z1[4 * q + 3]);
    }
  }
}

DEV ScanJob ctx_job(const Params& p, int v) {
  ScanJob J;
  J.e = v >> 9; J.b = (v >> 4) & 31; J.hd = v & 15; J.tb = J.b * 256; J.L = 256; J.step0 = 0; J.nch = 8; J.pq = 0;
  J.zin = nullptr; J.zout = p.out + OUT_ST + ((size_t)(J.b * 2 + J.e) * 16 + J.hd) * 4096; J.pout = nullptr; J.qout = nullptr;
  J.ncomb = 0; J.seq = 0;
  return J;
}
DEV ScanJob smp_job(const Params& p, int seq, int g, int pq) {
  ScanJob J;
  J.e = seq >> 5; J.b = (seq >> 4) & 1; J.hd = seq & 15; J.tb = T_CTX + J.b * 4096; J.L = 4096; J.step0 = g * 512; J.nch = 16; J.pq = pq;
  J.zin = p.state_rwkv + ((size_t)(J.b * 2 + J.e) * 16 + J.hd) * 4096;
  J.ncomb = pq ? 0 : g; J.seq = seq;
  J.zout = nullptr;
  J.pout = (u16*)(p.ws + OFF_SEGP) + (size_t)(seq * 7 + g) * 4096;
  J.qout = (float*)(p.ws + OFF_SEGQ) + (size_t)(seq * 7 + g) * 4096;
  return J;
}

DEV void p8a_scan(const Params& p, char* smem) {
  if (blockIdx.x < 448) {
    for (int j = blockIdx.x; j < 448; j += 448) scan_job(p, smp_job(p, j / 7, j % 7, 1), smem);
  } else {
    {
      float4* ys = (float4*)(p.ws + OFF_YSUM);
      float4* bs = (float4*)(p.ws + OFF_BSUM);
      const size_t gt = (size_t)(blockIdx.x - 448) * 256 + threadIdx.x, gs = (size_t)(gridDim.x - 448) * 256;
      for (size_t i = gt; i < 4194304; i += gs) ys[i] = make_float4(0, 0, 0, 0);
      for (size_t i = gt; i < 65536; i += gs) bs[i] = make_float4(0, 0, 0, 0);
    }
    for (int q = blockIdx.x - 448; q < 1024; q += gridDim.x - 448) {
      int mt = q >> 3, nt = q & 7, m0 = mt * 128, n0 = nt * 128;
      u16* sz = (u16*)(p.ws + OFF_SZ) + (size_t)m0 * 1024 + n0;
      gemm_tile<false>((const u16*)(p.ws + OFF_HG) + (size_t)m0 * 128, 128, nullptr, m0, (const u16*)(p.ws + OFF_G2T) + (size_t)n0 * 128, 128, 128,
                       EpGate{sz, sz, 1024}, smem);
    }
  }
}
DEV void p8b_scan(const Params& p, char* smem) {
  if (blockIdx.x < 64) scan_combine(p, blockIdx.x);
}
DEV void p8c_scan(const Params& p, char* smem) {
  for (int j = blockIdx.x; j < 512 + 1024; j += gridDim.x) {
    if (j < 512) scan_job(p, smp_job(p, j >> 3, j & 7, 0), smem);
    else scan_job(p, ctx_job(p, j - 512), smem);
  }
}

DEV void p9_post(const Params& p) {
  const int lane = threadIdx.x & 63;
  const int gw = blockIdx.x * 4 + (threadIdx.x >> 6), nw = gridDim.x * 4;
  const float* Ysum = (const float*)(p.ws + OFF_YSUM);
  const float* Bsum = (const float*)(p.ws + OFF_BSUM);
  for (int row = gw; row < 16384; row += nw) {
    const size_t o = (size_t)row * 1024 + lane * 16;
    float y[16];
#pragma unroll
    for (int i = 0; i < 4; i++) { float4 v = *(const float4*)(Ysum + o + 4 * i); y[4 * i] = v.x; y[4 * i + 1] = v.y; y[4 * i + 2] = v.z; y[4 * i + 3] = v.w; }
    float s = 0;
#pragma unroll
    for (int i = 0; i < 16; i++) s += y[i];
    s += __shfl_xor(s, 1); s += __shfl_xor(s, 2);
    float mean = s * (1.f / 64.f), q = 0;
#pragma unroll
    for (int i = 0; i < 16; i++) { float d = y[i] - mean; q += d * d; }
    q += __shfl_xor(q, 1); q += __shfl_xor(q, 2);
    float rstd = rsqrtf(q * (1.f / 64.f) + 64e-5f);
    float bon = Bsum[(size_t)row * 16 + (lane >> 2)];
    u16* O = (u16*)(p.ws + OFF_U1) + o;
    const u16* V = (const u16*)(p.ws + OFF_V2) + o;
    const u16* Z = (const u16*)(p.ws + OFF_SZ) + o;
#pragma unroll
    for (int hlf = 0; hlf < 2; hlf++) {
      uint4 vq = *(const uint4*)(V + 8 * hlf), zq = *(const uint4*)(Z + 8 * hlf);
      const unsigned vu[4] = {vq.x, vq.y, vq.z, vq.w}, zu[4] = {zq.x, zq.y, zq.z, zq.w};
      unsigned ow[4];
#pragma unroll
      for (int w = 0; w < 4; w++) {
        int c = lane * 16 + hlf * 8 + 2 * w;
        float y0 = (y[hlf * 8 + 2 * w] - mean) * rstd * p.lnx_g[c] + p.lnx_b[c] + bon * bflo(vu[w]);
        float y1 = (y[hlf * 8 + 2 * w + 1] - mean) * rstd * p.lnx_g[c + 1] + p.lnx_b[c + 1] + bon * bfhi(vu[w]);
        ow[w] = pack2(y0 * bflo(zu[w]), y1 * bfhi(zu[w]));
      }
      *(uint4*)(O + 8 * hlf) = make_uint4(ow[0], ow[1], ow[2], ow[3]);
    }
  }
}


#define XB_TMO 128
#define XB_XCNT(j) (256 + 64 * (j))
#define XB_XSUB(j) (1280 + 64 * (j))
#define XB_XGEN(j) (2304 + 64 * (j))
#define XB_TOP 3328
#define XB_TOPGEN 3392
#define XCD_BAR_WORDS 3456
#define XB_SPIN_CAP (1u << 22)
#define LAS __attribute__((address_space(3)))
DEV unsigned xb_ld(unsigned* p) { return __hip_atomic_load(p, __ATOMIC_RELAXED, __HIP_MEMORY_SCOPE_AGENT); }
DEV unsigned xb_add(unsigned* p, unsigned v) { return __hip_atomic_fetch_add(p, v, __ATOMIC_RELAXED, __HIP_MEMORY_SCOPE_AGENT); }
DEV unsigned xb_xcc_id() { return (unsigned)__builtin_amdgcn_s_getreg((3 << 11) | 20) & 0xFu; }
#define XB_SPIN(cond, bar) do { unsigned _sp = 0; while (cond) { __builtin_amdgcn_s_sleep(4); \
    if ((++_sp & 255u) == 0u) { if (xb_ld(&(bar)[XB_TMO])) break; if (_sp > XB_SPIN_CAP) { atomicAdd(&(bar)[XB_TMO], 1u); break; } } } } while (0)
struct XcdBarrier { unsigned* bar; unsigned x; volatile LAS unsigned* st; };
DEV XcdBarrier xcd_barrier_post(unsigned* bar, volatile LAS unsigned* st) {
  XcdBarrier b; b.bar = bar; b.x = xb_xcc_id(); b.st = st;
  if (threadIdx.x == 0) (void)xb_add(&bar[XB_XCNT(b.x)], 1u);
  return b;
}
DEV void xcd_barrier_complete(unsigned* bar, unsigned x, unsigned& nloc, unsigned& nx) {
  const unsigned G = gridDim.x * gridDim.y * gridDim.z;
  unsigned sum, cnt, mine, sp = 0u;
  for (;;) {
    sum = 0u; cnt = 0u; mine = 0u;
#pragma unroll
    for (unsigned j = 0; j < 16; ++j) { const unsigned c = xb_ld(&bar[XB_XCNT(j)]); sum += c; cnt += (c > 0u) ? 1u : 0u; mine = (j == x) ? c : mine; }
    if (sum == G) break;
    __builtin_amdgcn_s_sleep(1);
    if ((++sp & 255u) == 0u) { if (xb_ld(&bar[XB_TMO])) break; if (sp > XB_SPIN_CAP) { atomicAdd(&bar[XB_TMO], 1u); break; } }
  }
  nloc = mine > 0u ? mine : 1u; nx = cnt > 0u ? cnt : 1u;
}
DEV void xcd_barrier(const XcdBarrier& b) {
  asm volatile("s_waitcnt vmcnt(0)" ::: "memory");
  __syncthreads();
  if (threadIdx.x == 0) {
    unsigned* bar = b.bar;
    __builtin_amdgcn_s_waitcnt(0);
    unsigned nloc = b.st[0], nx = b.st[1];
    if (nloc == 0u) { xcd_barrier_complete(bar, b.x, nloc, nx); b.st[0] = nloc; b.st[1] = nx; }
    const unsigned old = xb_add(&bar[XB_XSUB(b.x)], 1u);
    const unsigned gen = old / nloc;
    if (old + 1u == (gen + 1u) * nloc) {
      __builtin_amdgcn_fence(__ATOMIC_RELEASE, "agent");
      asm volatile("s_waitcnt vmcnt(0)" ::: "memory");
      const unsigned og = xb_add(&bar[XB_TOP], 1u);
      const unsigned tg = og / nx;
      if (og + 1u == (tg + 1u) * nx) xb_add(&bar[XB_TOPGEN], 1u);
      else XB_SPIN(xb_ld(&bar[XB_TOPGEN]) == tg, bar);
      __builtin_amdgcn_fence(__ATOMIC_ACQUIRE, "agent");
      xb_add(&bar[XB_XGEN(b.x)], 1u);
      asm volatile("s_waitcnt vmcnt(0)" ::: "memory");
    } else {
      XB_SPIN(xb_ld(&bar[XB_XGEN(b.x)]) == gen, bar);
      __builtin_amdgcn_fence(__ATOMIC_ACQUIRE, "agent");
      asm volatile("s_waitcnt vmcnt(0)" ::: "memory");
    }
  }
  __syncthreads();
}

__global__ void __launch_bounds__(256, 2) fwd_kernel(Params p) {
  __shared__ __attribute__((aligned(16))) char smem[73728];
#if FUSED
  __shared__ unsigned xb_st[4];
  if (threadIdx.x < 4) xb_st[threadIdx.x] = 0u;
  __syncthreads();
  const XcdBarrier xb = xcd_barrier_post((unsigned*)(p.ws + OFF_BAR), (volatile LAS unsigned*)xb_st);
  if (p.phase_hi > 1000) cg::this_grid().sync();
#define SYNC() xcd_barrier(xb)
#else
#define SYNC()
#endif
#define PH(n, call) if (p.phase_lo <= n && n <= p.phase_hi) { call; if (n < p.phase_hi) { SYNC(); } }
  PH(0, p0_prep(p, smem))
  PH(1, ln_phase<0>(p))
  PH(2, p2_gemm1(p, smem))
  PH(3, p3_mix(p, smem))
  PH(4, p3b_fold(p))
  PH(5, p4_fnet(p, smem))
  PH(6, p_outproj<0>(p, smem))
  PH(7, ln_phase<1>(p))
  PH(8, p6b_dx(p))
  PH(9, p7_rwkv_proj(p, smem))
  PH(10, p8a_scan(p, smem))
  PH(11, p8c_scan(p, smem))
  PH(12, p9_post(p))
  PH(13, p_outproj<1>(p, smem))
  PH(14, ln_phase<2>(p))
}

extern "C" void kernel_launch(void* const* d_in, const int* in_sizes, int n_in, void* d_out, int out_size, void* d_ws,
                              size_t ws_size, hipStream_t stream) {
  Params p;
  memset(&p, 0, sizeof(p));
  const float* const* in = (const float* const*)d_in;
  p.x_prompt = in[0]; p.x_sample = in[1]; p.cache_k = in[2]; p.cache_v = in[3]; p.state_rwkv = in[4]; p.c = in[5]; p.c_ctx = in[6];
  p.ada_w = in[7]; p.ada_b = in[8]; p.post_g = in[9]; p.post_b = in[10]; p.w_in = in[11]; p.w_fnet = in[12]; p.rpb = in[13]; p.w_out = in[14];
  p.mu = in[15]; p.rkvz = in[16]; p.w0 = in[17]; p.w1 = in[18]; p.w2 = in[19]; p.a0 = in[20]; p.a1 = in[21]; p.a2 = in[22];
  p.g1 = in[23]; p.g2 = in[24]; p.k_k = in[25]; p.k_a = in[26]; p.r_k = in[27]; p.lnx_g = in[28]; p.lnx_b = in[29]; p.rw_out = in[30];
  p.out = (float*)d_out; p.ws = (char*)d_ws;
  char* ws = (char*)d_ws;
  int n = 0, start = 0;
  auto add = [&](const float* src, size_t dstoff, int lds, int ldd, int tk, int tn) {
    p.tj[n].src = src; p.tj[n].dst = (u16*)(ws + dstoff); p.tj[n].lds = lds; p.tj[n].ldd = ldd; p.tj[n].tk = tk; p.tj[n].tn = tn;
    p.tj[n].start = start; p.tj[n].pad = 0; start += tk * tn; n++;
  };
  add(p.w_in, OFF_WINT, 3072, 1024, 16, 48);
  add(p.w_out, OFF_WOUTT, 1024, 1024, 16, 16);
  for (int i = 0; i < 4; i++) add(p.rkvz + (size_t)i * 1048576, OFF_RKVZT + (size_t)i * 2097152, 1024, 1024, 16, 16);
  add(p.rw_out, OFF_RWOUTT, 1024, 1024, 16, 16);
  for (int e = 0; e < 2; e++) add(p.w1 + e * 65536, OFF_W1T + (size_t)e * 64 * 1024 * 2, 64, 1024, 16, 1);
  for (int e = 0; e < 2; e++) add(p.a1 + e * 65536, OFF_A1T + (size_t)e * 64 * 1024 * 2, 64, 1024, 16, 1);
  add(p.g1, OFF_G1T, 128, 1024, 16, 2);
  for (int e = 0; e < 2; e++) add(p.w2 + e * 65536, OFF_W2T + (size_t)e * 65536 * 2, 1024, 64, 1, 16);
  for (int e = 0; e < 2; e++) add(p.a2 + e * 65536, OFF_A2T + (size_t)e * 65536 * 2, 1024, 64, 1, 16);
  add(p.g2, OFF_G2T, 1024, 128, 2, 16);
  for (int b = 0; b < 2; b++)
    for (int h = 0; h < 8; h++) add(p.cache_v + (size_t)b * 262144 + h * 64, OFF_CVT + (size_t)(b * 8 + h) * 64 * 512 * 2, 512, 512, 8, 1);
  p.ntr = start;

  static int grid_blocks = 0;
  if (!grid_blocks) {
    int dev = 0, cus = 0, per_cu = 0;
    (void)hipGetDevice(&dev);
    (void)hipDeviceGetAttribute(&cus, hipDeviceAttributeMultiprocessorCount, dev);
    (void)hipOccupancyMaxActiveBlocksPerMultiprocessor(&per_cu, fwd_kernel, 256, 0);
    if (per_cu > 2) per_cu = 2;
    if (per_cu < 1) per_cu = 1;
    grid_blocks = cus * per_cu;
  }
#if FUSED
  p.phase_lo = 0; p.phase_hi = 14;
  void* args[] = {&p};
  (void)hipMemsetAsync((char*)d_ws + OFF_BAR, 0, 16384, stream);
  hipError_t e = hipLaunchCooperativeKernel((void*)fwd_kernel, dim3(grid_blocks), dim3(256), args, 0, stream);
  if (e != hipSuccess) fprintf(stderr, "cooperative launch failed: %s (grid %d)\n", hipGetErrorString(e), grid_blocks);
#else
#ifndef PROBE_SEQ
#define PROBE_SEQ 0,1,2,3,4,5,6,7,8,9,10,11,12,13,14
#endif
  const int seq[] = {PROBE_SEQ};
  for (int i = 0; i < (int)(sizeof(seq) / sizeof(int)); i++) {
    p.phase_lo = seq[i]; p.phase_hi = seq[i];
    fwd_kernel<<<grid_blocks, 256, 0, stream>>>(p);
  }
#endif
}
```

```cpp
#include <hip/hip_runtime.h>
#include <hip/hip_cooperative_groups.h>
#include <stdint.h>
#include <cstdio>
#include <cstring>
namespace cg = cooperative_groups;

#ifndef FUSED
#define FUSED 1
#endif

typedef unsigned short u16;
typedef __attribute__((ext_vector_type(8))) __bf16 b16x8;
typedef __attribute__((ext_vector_type(16))) float f32x16;
typedef __attribute__((ext_vector_type(4))) unsigned u32x4;
typedef __attribute__((ext_vector_type(2))) unsigned u32x2;
#define DEV __device__ __forceinline__

constexpr int T_CTX = 8192;
constexpr float ALPHA_DN = 1.41421356237f;
constexpr float LOG2E = 1.44269504089f;
constexpr size_t MiB = 1u << 20;
constexpr size_t OFF_MODS = 0, OFF_BAR = 512 * 1024, OFF_BSUM = 1 * MiB;
constexpr size_t OFF_FSMP = 2 * MiB, OFF_U = 66 * MiB, OFF_ABUF = 98 * MiB, OFF_Q = 114 * MiB, OFF_K = 130 * MiB;
constexpr size_t OFF_VTC = 146 * MiB, OFF_VTS = 154 * MiB, OFF_GBUF = 162 * MiB, OFF_BTC = 194 * MiB, OFF_BTS = 210 * MiB;
constexpr size_t OFF_WINT = 226 * MiB, OFF_WOUTT = 232 * MiB, OFF_MCAT = 234 * MiB, OFF_FCTX = 234 * MiB + 256 * 1024;
constexpr size_t OFF_CK = 234 * MiB + 512 * 1024, OFF_CVT = 235 * MiB + 512 * 1024;
constexpr size_t OFF_RKVZT = 237 * MiB, OFF_RWOUTT = 245 * MiB, OFF_W1T = 247 * MiB, OFF_A1T = OFF_W1T + 256 * 1024,
                 OFF_G1T = OFF_W1T + 512 * 1024, OFF_W2T = OFF_W1T + 768 * 1024, OFF_A2T = 248 * MiB,
                 OFF_G2T = 248 * MiB + 256 * 1024, OFF_HW = 248 * MiB + 512 * 1024;
constexpr size_t OFF_U1 = 2 * MiB, OFF_R = 34 * MiB, OFF_K2 = 66 * MiB, OFF_V2 = 98 * MiB, OFF_SZ = 130 * MiB,
                 OFF_YSUM = 162 * MiB, OFF_HA = 226 * MiB, OFF_HG = 230 * MiB;
constexpr size_t OFF_BFOLD = 98 * MiB;
constexpr size_t OFF_Y0B = 98 * MiB, OFF_Y1B = 34 * MiB;
constexpr size_t OFF_DX = 162 * MiB;
constexpr size_t OFF_SEGP = 2 * MiB, OFF_SEGQ = 6 * MiB, OFF_SEGZ = 14 * MiB;
constexpr size_t OUT_NK = 16777216, OUT_NV = 20971520, OUT_ST = 25165824;

constexpr int NTJ = 33;
struct TJob { const float* src; u16* dst; int lds, ldd, tk, tn, start, pad; };

struct Params {
  const float *x_prompt, *x_sample, *cache_k, *cache_v, *state_rwkv, *c, *c_ctx;
  const float *ada_w, *ada_b, *post_g, *post_b, *w_in, *w_fnet, *rpb, *w_out;
  const float *mu, *rkvz, *w0, *w1, *w2, *a0, *a1, *a2, *g1, *g2, *k_k, *k_a, *r_k, *lnx_g, *lnx_b, *rw_out;
  float* out; char* ws;
  int phase_lo, phase_hi, ntr, pad;
  TJob tj[NTJ];
};

typedef __attribute__((ext_vector_type(2))) __bf16 bf16x2_t;
typedef __attribute__((ext_vector_type(2))) float f32x2_t;
DEV unsigned pack2(float a, float b) {
  f32x2_t f = {a, b};
  bf16x2_t r = __builtin_convertvector(f, bf16x2_t);
  return *(unsigned*)&r;
}
DEV u16 f2bf(float f) { return (u16)(pack2(f, 0.f) & 0xffffu); }
DEV float bflo(unsigned w) { return __uint_as_float(w << 16); }
DEV float bfhi(unsigned w) { return __uint_as_float(w & 0xffff0000u); }
DEV float rcp_f(float x) { return __builtin_amdgcn_rcpf(x); }
DEV float sigm(float x) { return rcp_f(1.f + __expf(-x)); }
DEV float silu(float x) { return x * rcp_f(1.f + __expf(-x)); }
DEV float tanh_f(float x) { return 1.f - 2.f * rcp_f(__expf(2.f * x) + 1.f); }
DEV b16x8 ld16(const u16* p) { uint4 v = *(const uint4*)p; return *(b16x8*)&v; }
DEV b16x8 asb(uint4 v) { return *(b16x8*)&v; }
template <int CTRL> DEV float dpp_add(float x) {
  return x + __int_as_float(__builtin_amdgcn_update_dpp(0, __float_as_int(x), CTRL, 0xf, 0xf, true));
}
DEV float allsum8(float x) {
  x = dpp_add<0xB1>(x); x = dpp_add<0x4E>(x); x = dpp_add<0x141>(x);
  return x;
}
DEV float wave_sum(float x) {
  x = dpp_add<0xB1>(x); x = dpp_add<0x4E>(x); x = dpp_add<0x141>(x); x = dpp_add<0x140>(x);
  x += __shfl_xor(x, 16); x += __shfl_xor(x, 32);
  return x;
}
DEV float allsum16(float x) {
  x = dpp_add<0xB1>(x); x = dpp_add<0x4E>(x); x = dpp_add<0x124>(x); x = dpp_add<0x128>(x);
  return x;
}
DEV void lds_barrier() { asm volatile("s_waitcnt lgkmcnt(0)\n\ts_barrier" ::: "memory"); }
DEV int mv_of(int token) { return token < T_CTX ? 0 : 1 + ((token - T_CTX) >> 12); }

template <bool LERP, class EP>
DEV void gemm_tile(const u16* __restrict__ A, int lda, const float* __restrict__ mu, int m0,
                   const u16* __restrict__ B, int ldb, int K, EP ep, char* smem) {
  u16(*sA0)[72] = (u16(*)[72])smem;
  u16(*sB0)[72] = (u16(*)[72])(smem + 18432);
  u16(*sA1)[72] = (u16(*)[72])(smem + 36864);
  u16(*sB1)[72] = (u16(*)[72])(smem + 36864 + 18432);
  int tid = threadIdx.x;
  asm volatile("" : "+v"(tid));
  const int lane = tid & 63, wave = tid >> 6, wm = wave >> 1, wn = wave & 1;
  const int lr = tid >> 3, lk = (tid & 7) * 8;
  f32x16 acc[2][2];
#pragma unroll
  for (int i = 0; i < 2; i++)
#pragma unroll
    for (int j = 0; j < 2; j++)
#pragma unroll
      for (int r = 0; r < 16; r++) acc[i][j][r] = 0.f;
  u32x4 ra0[4], rb0[4], rp0[4], ra1[4], rb1[4], rp1[4];
  float4 mu00, mu01, mu10, mu11;
  const u16* DXp = nullptr;
  if constexpr (LERP) DXp = (const u16*)(A) + (OFF_DX - OFF_U1) / 2;
#define GLOAD(K0, RA, RB, RP, M0, M1)                                                     \
  {                                                                                       \
    _Pragma("unroll") for (int i = 0; i < 4; i++) {                                       \
      int r = lr + 32 * i;                                                                \
      if constexpr (LERP) {                                                               \
        RA[i] = *(const u32x4*)(A + (size_t)(m0 + r) * lda + (K0) + lk);                  \
        RP[i] = *(const u32x4*)(DXp + (size_t)(m0 + r) * lda + (K0) + lk);                \
      } else {                                                                            \
        RA[i] = *(const u32x4*)(A + (size_t)r * lda + (K0) + lk);                         \
      }                                                                                   \
      RB[i] = *(const u32x4*)(B + (size_t)r * ldb + (K0) + lk);                           \
    }                                                                                     \
    if constexpr (LERP) {                                                                 \
      M0 = *(const float4*)(mu + (K0) + lk);                                              \
      M1 = *(const float4*)(mu + (K0) + lk + 4);                                          \
    }                                                                                     \
  }
#define GSTORE(RA, RB, RP, M0, M1, sA, sB)                                                     \
  {                                                                                       \
    _Pragma("unroll") for (int i = 0; i < 4; i++) {                                       \
      int r = lr + 32 * i;                                                                \
      u32x4 av = RA[i];                                                                   \
      if constexpr (LERP) {                                                               \
        unsigned cu[4] = {RA[i].x, RA[i].y, RA[i].z, RA[i].w};                            \
        unsigned du[4] = {RP[i].x, RP[i].y, RP[i].z, RP[i].w};                            \
        float m[8] = {M0.x, M0.y, M0.z, M0.w, M1.x, M1.y, M1.z, M1.w};                    \
        unsigned o[4];                                                                    \
        _Pragma("unroll") for (int q = 0; q < 4; q++)                                     \
          o[q] = pack2(bflo(cu[q]) + bflo(du[q]) * m[2 * q], bfhi(cu[q]) + bfhi(du[q]) * m[2 * q + 1]); \
        av = u32x4{o[0], o[1], o[2], o[3]};                                               \
      }                                                                                   \
      *(u32x4*)&sA[r][lk] = av;                                                           \
      *(u32x4*)&sB[r][lk] = RB[i];                                                        \
    }                                                                                     \
  }
#define GCOMPUTE(sA, sB)                                                                  \
  {                                                                                       \
    _Pragma("unroll") for (int ks = 0; ks < 4; ks++) {                                    \
      b16x8 af[2], bf[2];                                                                 \
      _Pragma("unroll") for (int i = 0; i < 2; i++) {                                     \
        af[i] = *(const b16x8*)&sA[wm * 64 + i * 32 + (lane & 31)][ks * 16 + (lane >> 5) * 8]; \
        bf[i] = *(const b16x8*)&sB[wn * 64 + i * 32 + (lane & 31)][ks * 16 + (lane >> 5) * 8]; \
      }                                                                                   \
      _Pragma("unroll") for (int i = 0; i < 2; i++)                                       \
        _Pragma("unroll") for (int j = 0; j < 2; j++)                                     \
          acc[i][j] = __builtin_amdgcn_mfma_f32_32x32x16_bf16(af[i], bf[j], acc[i][j], 0, 0, 0); \
    }                                                                                     \
  }
  GLOAD(0, ra0, rb0, rp0, mu00, mu01);
  GLOAD(64, ra1, rb1, rp1, mu10, mu11);
  __syncthreads();
  GSTORE(ra0, rb0, rp0, mu00, mu01, sA0, sB0);
  if (128 < K) GLOAD(128, ra0, rb0, rp0, mu00, mu01);
  __syncthreads();
#pragma unroll 1
  for (int k0 = 0; k0 < K; k0 += 128) {
    GSTORE(ra1, rb1, rp1, mu10, mu11, sA1, sB1);
    if (k0 + 192 < K) GLOAD(k0 + 192, ra1, rb1, rp1, mu10, mu11);
    __builtin_amdgcn_s_setprio(1);
    GCOMPUTE(sA0, sB0);
    __builtin_amdgcn_s_setprio(0);
    __syncthreads();
    if (k0 + 128 < K) {
      GSTORE(ra0, rb0, rp0, mu00, mu01, sA0, sB0);
      if (k0 + 256 < K) GLOAD(k0 + 256, ra0, rb0, rp0, mu00, mu01);
    }
    __builtin_amdgcn_s_setprio(1);
    GCOMPUTE(sA1, sB1);
    __builtin_amdgcn_s_setprio(0);
    __syncthreads();
  }
#undef GLOAD
#undef GSTORE
#undef GCOMPUTE
  __syncthreads();
  int tide = tid;
  asm volatile("" : "+v"(tide));
  const int lane_e = tide & 63, wv_e = tide >> 6, wm_e = wv_e >> 1, wn_e = wv_e & 1;
  u16* stg = (u16*)smem + wv_e * (64 * 72);
#pragma unroll
  for (int i = 0; i < 2; i++)
#pragma unroll
    for (int j = 0; j < 2; j++)
#pragma unroll
      for (int q = 0; q < 4; q++) {
        const int r = i * 32 + q * 8 + (lane_e >> 5) * 4, c = j * 32 + (lane_e & 31);
        const float v0 = acc[i][j][q * 4 + 0], v1 = acc[i][j][q * 4 + 1], v2 = acc[i][j][q * 4 + 2], v3 = acc[i][j][q * 4 + 3];
        ep.direct(wm_e * 64 + r, wn_e * 64 + c, v0, v1, v2, v3);
        if constexpr (EP::TRANS) {
          *(uint2*)(stg + c * 72 + r) = make_uint2(pack2(ep.act(v0), ep.act(v1)), pack2(ep.act(v2), ep.act(v3)));
        } else {
          const unsigned p01 = pack2(ep.act(v0), ep.act(v1)), p23 = pack2(ep.act(v2), ep.act(v3));
          stg[(r + 0) * 72 + c] = (u16)(p01 & 0xffffu); stg[(r + 1) * 72 + c] = (u16)(p01 >> 16);
          stg[(r + 2) * 72 + c] = (u16)(p23 & 0xffffu); stg[(r + 3) * 72 + c] = (u16)(p23 >> 16);
        }
      }
#pragma unroll
  for (int n = 0; n < 8; n++) {
    const int id = lane_e + 64 * n, rr = id >> 3, cc = (id & 7) * 8;
    const u32x4 v = *(const u32x4*)(stg + rr * 72 + cc);
    if constexpr (EP::TRANS) ep.store(wn_e * 64 + rr, wm_e * 64 + cc, v);
    else ep.store(wm_e * 64 + rr, wn_e * 64 + cc, v);
  }
}

template <int ACT> struct EpStore {
  static constexpr bool TRANS = false;
  u16* dst; int ld; float scale;
  DEV float act(float x) const {
    if (ACT == 1) return silu(x);
    if (ACT == 2) return tanh_f(x);
    if (ACT == 3) return sigm(x);
    if (ACT == 4) return x * scale;
    return x;
  }
  DEV void direct(int, int, float, float, float, float) const {}
  DEV void store(int R, int C, u32x4 v) const { *(u32x4*)(dst + (size_t)R * ld + C) = v; }
};
struct EpNull {
  static constexpr bool TRANS = false;
  DEV float act(float x) const { return x; }
  DEV void direct(int, int, float, float, float, float) const {}
  DEV void store(int, int, u32x4) const {}
};
struct EpKeep {
  static constexpr bool TRANS = false;
  u16* dst; int ld; float* f32dst; int ldf;
  DEV float act(float x) const { return x; }
  DEV void direct(int r, int c, float v0, float v1, float v2, float v3) const {
    if (f32dst) {
      f32dst[(size_t)(r + 0) * ldf + c] = v0; f32dst[(size_t)(r + 1) * ldf + c] = v1;
      f32dst[(size_t)(r + 2) * ldf + c] = v2; f32dst[(size_t)(r + 3) * ldf + c] = v3;
    }
  }
  DEV void store(int R, int C, u32x4 v) const { *(u32x4*)(dst + (size_t)R * ld + C) = v; }
};
struct EpTrans {
  static constexpr bool TRANS = true;
  u16* dst; size_t ldt; float* f32dst; int ldf;
  DEV float act(float x) const { return x; }
  DEV void direct(int r, int c, float v0, float v1, float v2, float v3) const {
    if (f32dst) {
      f32dst[(size_t)(r + 0) * ldf + c] = v0; f32dst[(size_t)(r + 1) * ldf + c] = v1;
      f32dst[(size_t)(r + 2) * ldf + c] = v2; f32dst[(size_t)(r + 3) * ldf + c] = v3;
    }
  }
  DEV void store(int Rc, int Cr, u32x4 v) const { *(u32x4*)(dst + (size_t)Rc * ldt + Cr) = v; }
};
struct EpGate {
  static constexpr bool TRANS = false;
  u16* dst; const u16* gate; int ld;
  DEV float act(float x) const { return x; }
  DEV void direct(int, int, float, float, float, float) const {}
  DEV void store(int R, int C, u32x4 v) const {
    const size_t o = (size_t)R * ld + C;
    const u32x4 g = *(const u32x4*)(gate + o);
    u32x4 r;
    r.x = pack2(bflo(v.x) * bflo(g.x), bfhi(v.x) * bfhi(g.x)); r.y = pack2(bflo(v.y) * bflo(g.y), bfhi(v.y) * bfhi(g.y));
    r.z = pack2(bflo(v.z) * bflo(g.z), bfhi(v.z) * bfhi(g.z)); r.w = pack2(bflo(v.w) * bflo(g.w), bfhi(v.w) * bfhi(g.w));
    *(u32x4*)(dst + o) = r;
  }
};
struct EpRes {
  static constexpr bool TRANS = false;
  u16* dst; const float* xsrc; const float* gate;
  DEV float act(float x) const { return x; }
  DEV void direct(int, int, float, float, float, float) const {}
  DEV void store(int R, int C, u32x4 v) const {
    const size_t o = (size_t)R * 1024 + C;
    const float4 x0 = *(const float4*)(xsrc + o), x1 = *(const float4*)(xsrc + o + 4);
    const float4 g0 = *(const float4*)(gate + C), g1 = *(const float4*)(gate + C + 4);
    u32x4 r;
    r.x = pack2(ALPHA_DN * x0.x + (1.f + g0.x) * bflo(v.x), ALPHA_DN * x0.y + (1.f + g0.y) * bfhi(v.x));
    r.y = pack2(ALPHA_DN * x0.z + (1.f + g0.z) * bflo(v.y), ALPHA_DN * x0.w + (1.f + g0.w) * bfhi(v.y));
    r.z = pack2(ALPHA_DN * x1.x + (1.f + g1.x) * bflo(v.z), ALPHA_DN * x1.y + (1.f + g1.y) * bfhi(v.z));
    r.w = pack2(ALPHA_DN * x1.z + (1.f + g1.z) * bflo(v.w), ALPHA_DN * x1.w + (1.f + g1.w) * bfhi(v.w));
    *(u32x4*)(dst + o) = r;
  }
};

DEV void p0_prep(const Params& p, char* smem) {
  const int tid = threadIdx.x;
  const int njobs = 192 + p.ntr;
  for (int job = blockIdx.x; job < njobs; job += gridDim.x) {
    __syncthreads();
    if (job < 192) {
      float* sc = (float*)smem;
      float* red = sc + 3072;
      for (int i = tid; i < 3072; i += 256) {
        int m = i >> 10, k = i & 1023;
        float cv = m == 0 ? p.c_ctx[k] : p.c[(m - 1) * 1024 + k];
        sc[i] = silu(cv);
      }
      __syncthreads();
      int l = job / 96, col = (job % 96) * 32 + (tid & 31), ks = tid >> 5;
      const float* w = p.ada_w + (size_t)l * 1024 * 3072 + col;
      float a0 = 0, a1 = 0, a2 = 0;
#pragma unroll 8
      for (int k = ks * 128; k < ks * 128 + 128; k++) {
        float wv = w[(size_t)k * 3072];
        a0 += sc[k] * wv; a1 += sc[1024 + k] * wv; a2 += sc[2048 + k] * wv;
      }
      red[(ks * 32 + (tid & 31)) * 3 + 0] = a0; red[(ks * 32 + (tid & 31)) * 3 + 1] = a1; red[(ks * 32 + (tid & 31)) * 3 + 2] = a2;
      __syncthreads();
      if (tid < 96) {
        int cl = tid & 31, m = tid >> 5;
        float s = 0;
        for (int q = 0; q < 8; q++) s += red[(q * 32 + cl) * 3 + m];
        int cc = (job % 96) * 32 + cl;
        ((float*)(p.ws + OFF_MODS))[(l * 3 + m) * 3072 + cc] = s + p.ada_b[l * 3072 + cc];
      }
    } else {
      int tj = job - 192, e = 0;
      while (e + 1 < NTJ && p.tj[e + 1].start <= tj) e++;
      const TJob J = p.tj[e];
      int lt = tj - J.start, tkk = lt / J.tn, tnn = lt % J.tn;
      float(*tile)[65] = (float(*)[65])smem;
      const float* src = J.src + (size_t)(tkk * 64) * J.lds + tnn * 64;
#pragma unroll
      for (int i = 0; i < 4; i++) {
        int kk = (tid >> 4) + 16 * i, nn = (tid & 15) * 4;
        float4 v = *(const float4*)(src + (size_t)kk * J.lds + nn);
        tile[kk][nn] = v.x; tile[kk][nn + 1] = v.y; tile[kk][nn + 2] = v.z; tile[kk][nn + 3] = v.w;
      }
      __syncthreads();
      u16* dst = J.dst + (size_t)(tnn * 64) * J.ldd + tkk * 64;
#pragma unroll
      for (int i = 0; i < 2; i++) {
        int nn = (tid >> 3) + 32 * i, kk = (tid & 7) * 8;
        uint4 o;
        o.x = pack2(tile[kk][nn], tile[kk + 1][nn]); o.y = pack2(tile[kk + 2][nn], tile[kk + 3][nn]);
        o.z = pack2(tile[kk + 4][nn], tile[kk + 5][nn]); o.w = pack2(tile[kk + 6][nn], tile[kk + 7][nn]);
        *(uint4*)(dst + (size_t)nn * J.ldd + kk) = o;
      }
    }
  }
  const size_t gt = (size_t)blockIdx.x * 256 + tid, gs = (size_t)gridDim.x * 256;
  {
    u16* ck = (u16*)(p.ws + OFF_CK);
    for (size_t i = gt; i < 65536; i += gs) {
      float4 a = *(const float4*)(p.cache_k + i * 8), b = *(const float4*)(p.cache_k + i * 8 + 4);
      *(uint4*)(ck + i * 8) = make_uint4(pack2(a.x, a.y), pack2(a.z, a.w), pack2(b.x, b.y), pack2(b.z, b.w));
    }
  }
  {
    u16* fs = (u16*)(p.ws + OFF_FSMP);
    const float sc = 0.001381067932f;
    for (size_t i = gt; i < 2097152; i += gs) {
      int lp = (int)(i >> 9), j0 = (int)(i & 511) * 8;
      unsigned o[4];
#pragma unroll
      for (int q = 0; q < 4; q++) {
        float v[2];
#pragma unroll
        for (int z = 0; z < 2; z++) {
          int j = j0 + 2 * q + z;
          bool cs = j <= 2048;
          int ph = (lp * (cs ? j : j - 2048)) & 4095;
          float ang = (float)ph * (6.283185307179586f / 4096.f);
          v[z] = (cs ? __cosf(ang) : -__sinf(ang)) * sc;
        }
        o[q] = pack2(v[0], v[1]);
      }
      *(uint4*)(fs + i * 8) = make_uint4(o[0], o[1], o[2], o[3]);
    }
    u16* fc = (u16*)(p.ws + OFF_FCTX);
    const float sc2 = 0.005524271728f;
    for (size_t i = gt; i < 16384; i += gs) {
      int lp = (int)(i >> 6), j0 = (int)(i & 63) * 8;
      unsigned o[4];
#pragma unroll
      for (int q = 0; q < 4; q++) {
        float v[2];
#pragma unroll
        for (int z = 0; z < 2; z++) {
          int j = j0 + 2 * q + z;
          int ph = (lp * (j & 255)) & 255;
          float ang = (float)ph * (6.283185307179586f / 256.f);
          v[z] = (j < 256 ? __cosf(ang) : -__sinf(ang)) * sc2;
        }
        o[q] = pack2(v[0], v[1]);
      }
      *(uint4*)(fc + i * 8) = make_uint4(o[0], o[1], o[2], o[3]);
    }
  }
  {
    u16* mc = (u16*)(p.ws + OFF_MCAT);
    for (size_t i = gt; i < 131072; i += gs) {
      int c = (int)(i & 127), ep = (int)((i >> 7) & 255), g = (int)(i >> 15);
      const float* wf = p.w_fnet + (size_t)g * 16384 + (ep & 127);
      float s = 0;
      for (int cp = 0; cp < 128; cp++) {
        float ang = (float)((c * cp) & 127) * (6.283185307179586f / 128.f);
        float tw = ep < 128 ? __cosf(ang) : __sinf(ang);
        s += tw * wf[cp * 128];
      }
      mc[i] = f2bf(s);
    }
  }
}

DEV void ln_stats(const float4 (&x)[4], float& mean, float& rstd) {
  float s = 0;
#pragma unroll
  for (int i = 0; i < 4; i++) s += x[i].x + x[i].y + x[i].z + x[i].w;
  mean = wave_sum(s) * (1.f / 1024.f);
  float q = 0;
#pragma unroll
  for (int i = 0; i < 4; i++) {
    float a = x[i].x - mean, b = x[i].y - mean, c = x[i].z - mean, d = x[i].w - mean;
    q += a * a + b * b + c * c + d * d;
  }
  rstd = rsqrtf(wave_sum(q) * (1.f / 1024.f) + 1e-6f);
}

template <int MODE> DEV void ln_phase(const Params& p) {
  const int lane = threadIdx.x & 63;
  const int gw = blockIdx.x * 4 + (threadIdx.x >> 6), nw = gridDim.x * 4;
  const float* mods = (const float*)(p.ws + OFF_MODS);
  typedef __attribute__((ext_vector_type(4))) float f32x4v;
  f32x4v xn[4];
  u32x2 wn[4];
  auto fetch = [&](int row) {
    if (MODE == 0) {
      const float* src = row < T_CTX ? p.x_prompt + (size_t)row * 1024 : p.x_sample + (size_t)(row - T_CTX) * 1024;
#pragma unroll
      for (int i = 0; i < 4; i++) xn[i] = *(const f32x4v*)(src + lane * 4 + 256 * i);
    } else {
      const u16* sb = (const u16*)(p.ws + (MODE == 1 ? OFF_Y0B : OFF_Y1B)) + (size_t)row * 1024;
#pragma unroll
      for (int i = 0; i < 4; i++) wn[i] = *(const u32x2*)(sb + lane * 4 + 256 * i);
    }
  };
  if (gw < 16384) fetch(gw);
  for (int row = gw; row < 16384; row += nw) {
    float4 x[4];
#pragma unroll
    for (int i = 0; i < 4; i++) {
      if (MODE == 0) x[i] = make_float4(xn[i].x, xn[i].y, xn[i].z, xn[i].w);
      else x[i] = make_float4(bflo(wn[i].x), bfhi(wn[i].x), bflo(wn[i].y), bfhi(wn[i].y));
    }
    if (row + nw < 16384) fetch(row + nw);
    float mean, rstd;
    ln_stats(x, mean, rstd);
    if (MODE >= 1) {
      const float* g = p.post_g + (MODE == 1 ? 0 : 1024);
      const float* b = p.post_b + (MODE == 1 ? 0 : 1024);
      float* dst = p.out + (size_t)row * 1024;
#pragma unroll
      for (int i = 0; i < 4; i++) {
        float4 gv = *(const float4*)(g + lane * 4 + 256 * i), bv = *(const float4*)(b + lane * 4 + 256 * i);
        x[i].x = (x[i].x - mean) * rstd * gv.x + bv.x; x[i].y = (x[i].y - mean) * rstd * gv.y + bv.y;
        x[i].z = (x[i].z - mean) * rstd * gv.z + bv.z; x[i].w = (x[i].w - mean) * rstd * gv.w + bv.w;
        *(float4*)(dst + lane * 4 + 256 * i) = x[i];
      }
      if (MODE == 2) continue;
      ln_stats(x, mean, rstd);
    }
    const float* md = mods + ((MODE == 0 ? 0 : 3) + mv_of(row)) * 3072;
    u16* ud = (u16*)(p.ws + (MODE == 0 ? OFF_U : OFF_U1)) + (size_t)row * 1024;
#pragma unroll
    for (int i = 0; i < 4; i++) {
      int k = lane * 4 + 256 * i;
      float4 sh = *(const float4*)(md + k), sc = *(const float4*)(md + 1024 + k);
      float a = (x[i].x - mean) * rstd * (1.f + sc.x) + sh.x, b = (x[i].y - mean) * rstd * (1.f + sc.y) + sh.y;
      float c = (x[i].z - mean) * rstd * (1.f + sc.z) + sh.z, d = (x[i].w - mean) * rstd * (1.f + sc.w) + sh.w;
      *(uint2*)(ud + k) = make_uint2(pack2(a, b), pack2(c, d));
    }
  }
}

DEV void p2_gemm1(const Params& p, char* smem) {
  const u16* U = (const u16*)(p.ws + OFF_U);
  const u16* W = (const u16*)(p.ws + OFF_WINT);
  const int xcd = blockIdx.x & 7, jx = blockIdx.x >> 3, nbx = gridDim.x >> 3;
  for (int q = jx; q < 16 * 24; q += nbx) {
    int st = q >> 6, w = q & 63, sm = st / 3, sn = st % 3;
    int mt = xcd * 16 + sm * 8 + (w >> 3), nt = sn * 8 + (w & 7);
    int m0 = mt * 128, n0 = nt * 128, sec = nt >> 2, nc = (nt & 3) * 128;
    const u16* A = U + (size_t)m0 * 1024;
    const u16* B = W + (size_t)n0 * 1024;
    if (sec == 0) {
      gemm_tile<false>(A, 1024, nullptr, m0, B, 1024, 1024, EpStore<0>{(u16*)(p.ws + OFF_ABUF) + (size_t)m0 * 512 + nc, 512, 1.f}, smem);
    } else if (sec == 1 || sec == 5) {
      gemm_tile<false>(A, 1024, nullptr, m0, B, 1024, 1024,
                       EpStore<1>{(u16*)(p.ws + OFF_GBUF) + (size_t)m0 * 1024 + (sec == 5 ? 512 : 0) + nc, 1024, 1.f}, smem);
    } else if (sec == 2) {
      gemm_tile<false>(A, 1024, nullptr, m0, B, 1024, 1024, EpStore<4>{(u16*)(p.ws + OFF_Q) + (size_t)m0 * 512 + nc, 512, 0.125f * LOG2E}, smem);
    } else if (sec == 3) {
      float* f = m0 < T_CTX ? p.out + OUT_NK + (size_t)m0 * 512 + nc : nullptr;
      gemm_tile<false>(A, 1024, nullptr, m0, B, 1024, 1024, EpKeep{(u16*)(p.ws + OFF_K) + (size_t)m0 * 512 + nc, 512, f, 512}, smem);
    } else {
      float* f = m0 < T_CTX ? p.out + OUT_NV + (size_t)m0 * 512 + nc : nullptr;
      u16* d; size_t ldt;
      if (m0 < T_CTX) { int b = m0 >> 8, l = m0 & 255; ldt = 256; d = (u16*)(p.ws + OFF_VTC) + ((size_t)b * 512 + nc) * 256 + l; }
      else { int tt = m0 - T_CTX, b = tt >> 12, l = tt & 4095; ldt = 4096; d = (u16*)(p.ws + OFF_VTS) + ((size_t)b * 512 + nc) * 4096 + l; }
      gemm_tile<false>(A, 1024, nullptr, m0, B, 1024, 1024, EpTrans{d, ldt, f, 512}, smem);
    }
  }
}

struct AttnState { f32x16 o0, o1; float m, l; };

DEV void attn_tile(AttnState& st, const b16x8 (&qf)[4], const u16* kS, const u16* vS, int mode, int dr, int kc0, int c,
                   const float* rpbh, int qi, int hh) {
  f32x16 s;
#pragma unroll
  for (int r = 0; r < 16; r++) s[r] = 0.f;
#pragma unroll
  for (int ks = 0; ks < 4; ks++) s = __builtin_amdgcn_mfma_f32_32x32x16_bf16(*(const b16x8*)(kS + qi * 72 + ks * 16 + hh * 8), qf[ks], s, 0, 0, 0);
  if (mode) {
    int cs = min(max(c - 8, 0), 48);
#pragma unroll
    for (int r = 0; r < 16; r++) {
      int kc = kc0 + (r & 3) + 8 * (r >> 2) + 4 * hh;
      bool valid = (kc >= cs) && (kc < cs + 16);
      int dc = min(max(kc - c + 15, 0), 30);
      float bias = rpbh[dr * 31 + dc] * LOG2E;
      s[r] = valid ? s[r] + bias : -1e30f;
    }
  }
  float tm = s[0];
#pragma unroll
  for (int r = 1; r < 16; r++) tm = fmaxf(tm, s[r]);
  tm = fmaxf(tm, __shfl_xor(tm, 32));
  float mn = fmaxf(st.m, tm);
  float alpha = __builtin_amdgcn_exp2f(st.m - mn);
  st.m = mn;
  float ps = 0;
#pragma unroll
  for (int r = 0; r < 16; r++) { float e = __builtin_amdgcn_exp2f(s[r] - mn); ps += e; s[r] = e; }
  st.l = st.l * alpha + ps;
#pragma unroll
  for (int r = 0; r < 16; r++) { st.o0[r] *= alpha; st.o1[r] *= alpha; }
#pragma unroll
  for (int s2 = 0; s2 < 2; s2++) {
    u32x4 pw = {pack2(s[8 * s2 + 0], s[8 * s2 + 1]), pack2(s[8 * s2 + 2], s[8 * s2 + 3]),
                pack2(s[8 * s2 + 4], s[8 * s2 + 5]), pack2(s[8 * s2 + 6], s[8 * s2 + 7])};
    b16x8 pfr = *(b16x8*)&pw;
#pragma unroll
    for (int dt = 0; dt < 2; dt++) {
      const u16* vr = vS + (dt * 32 + qi) * 40 + 16 * s2 + 4 * hh;
      const uint2 lo = *(const uint2*)vr, hi = *(const uint2*)(vr + 8);
      u32x4 vw = {lo.x, lo.y, hi.x, hi.y};
      b16x8 vf = *(b16x8*)&vw;
      if (dt == 0) st.o0 = __builtin_amdgcn_mfma_f32_32x32x16_bf16(vf, pfr, st.o0, 0, 0, 0);
      else st.o1 = __builtin_amdgcn_mfma_f32_32x32x16_bf16(vf, pfr, st.o1, 0, 0, 0);
    }
  }
}

DEV void attn_unit(const Params& p, int u, int lane, char* smem) {
  const u16* Qb = (const u16*)(p.ws + OFF_Q);
  const u16* Kb = (const u16*)(p.ws + OFF_K);
  const int qi = lane & 31, hh = lane >> 5;
  u16* kS = (u16*)smem + (threadIdx.x >> 6) * 4864;
  u16* vS = kS + 32 * 72;
  bool smp = u < 2048;
  int b, h, qg, tq0, r = 0, c0 = 0;
  if (smp) { b = u >> 10; h = (u >> 7) & 7; qg = u & 127; tq0 = T_CTX + b * 4096 + qg * 32; r = qg >> 1; c0 = (qg & 1) * 32; }
  else { int v = u - 2048; b = v >> 6; h = (v >> 3) & 7; qg = v & 7; tq0 = b * 256 + qg * 32; }
  b16x8 qf[4];
#pragma unroll
  for (int s = 0; s < 4; s++) qf[s] = ld16(Qb + (size_t)(tq0 + qi) * 512 + h * 64 + s * 16 + hh * 8);
  AttnState st;
#pragma unroll
  for (int i = 0; i < 16; i++) { st.o0[i] = 0.f; st.o1[i] = 0.f; }
  st.m = -INFINITY; st.l = 0.f;
  const float* rpbh = p.rpb + h * 465;
  const int rs = min(max(r - 4, 0), 56);
  const u16* ck = (const u16*)(p.ws + OFF_CK) + (size_t)b * 512 * 512 + h * 64;
  const u16* cvt = (const u16*)(p.ws + OFF_CVT) + (size_t)(b * 8 + h) * 64 * 512;
  const u16* kls = Kb + (size_t)(T_CTX + b * 4096) * 512 + h * 64;
  const u16* vls = (const u16*)(p.ws + OFF_VTS) + (size_t)(b * 8 + h) * 64 * 4096;
  const u16* klc = Kb + (size_t)(b * 256) * 512 + h * 64;
  const u16* vlc = (const u16*)(p.ws + OFF_VTC) + (size_t)(b * 8 + h) * 64 * 256;
  const int ntile = smp ? 32 : 8;
  u32x4 kr[4], vr[4];
  auto issue = [&](int tt) {
    int ll = lane;
    asm volatile("" : "+v"(ll));
    const u16 *kp, *vp; int ldv;
    if (!smp) { kp = klc + (size_t)tt * 32 * 512; vp = vlc + tt * 32; ldv = 256; }
    else if (tt < 16) { kp = ck + (size_t)tt * 32 * 512; vp = cvt + tt * 32; ldv = 512; }
    else { int kt = tt - 16, krow = rs + (kt >> 1), kc0 = (kt & 1) * 32; kp = kls + (size_t)(krow * 64 + kc0) * 512; vp = vls + krow * 64 + kc0; ldv = 4096; }
#pragma unroll
    for (int n = 0; n < 4; n++) {
      const int id = ll + 64 * n;
      kr[n] = *(const u32x4*)(kp + (size_t)(id >> 3) * 512 + (id & 7) * 8);
      vr[n] = *(const u32x4*)(vp + (size_t)(id >> 2) * ldv + (id & 3) * 8);
    }
  };
  issue(0);
#pragma unroll 1
  for (int tt = 0; tt < ntile; tt++) {
    {
      int ll = lane;
      asm volatile("" : "+v"(ll));
#pragma unroll
      for (int n = 0; n < 4; n++) {
        const int id = ll + 64 * n;
        *(u32x4*)(kS + (id >> 3) * 72 + (id & 7) * 8) = kr[n];
        *(u32x4*)(vS + (id >> 2) * 40 + (id & 3) * 8) = vr[n];
      }
    }
    if (tt + 1 < ntile) issue(tt + 1);
    const bool loc = smp && tt >= 16;
    const int kt = tt - 16;
    attn_tile(st, qf, kS, vS, loc ? 1 : 0, loc ? rs + (kt >> 1) - r + 7 : 0, loc ? (kt & 1) * 32 : 0, c0 + qi, rpbh, qi, hh);
  }
  float lt = st.l + __shfl_xor(st.l, 32);
  float inv = 1.f / lt;
  const size_t rowo = (size_t)(tq0 + qi) * 1024 + 512 + h * 64;
  const u16* gb = (const u16*)(p.ws + OFF_GBUF) + rowo;
  u16* cat = (u16*)(p.ws + OFF_U) + rowo;
#pragma unroll
  for (int dt = 0; dt < 2; dt++)
#pragma unroll
    for (int q = 0; q < 4; q++) {
      int d = dt * 32 + q * 8 + hh * 4;
      uint2 g = *(const uint2*)(gb + d);
      float v0 = (dt ? st.o1[q * 4 + 0] : st.o0[q * 4 + 0]) * inv * bflo(g.x);
      float v1 = (dt ? st.o1[q * 4 + 1] : st.o0[q * 4 + 1]) * inv * bfhi(g.x);
      float v2 = (dt ? st.o1[q * 4 + 2] : st.o0[q * 4 + 2]) * inv * bflo(g.y);
      float v3 = (dt ? st.o1[q * 4 + 3] : st.o0[q * 4 + 3]) * inv * bfhi(g.y);
      *(uint2*)(cat + d) = make_uint2(pack2(v0, v1), pack2(v2, v3));
    }
}

DEV void p3_mix(const Params& p, char* smem) {
  for (int t = blockIdx.x; t < 2048; t += gridDim.x) {
    if (t < 1024) {
      __syncthreads();
      attn_unit(p, t * 4 + (threadIdx.x >> 6), threadIdx.x & 63, smem);
    } else {
      int q = t - 1024, mt = q >> 3, g = (q >> 1) & 3, nh = q & 1, m0 = mt * 128;
      const u16* A = (const u16*)(p.ws + OFF_ABUF) + (size_t)m0 * 512 + g * 128;
      const u16* B = (const u16*)(p.ws + OFF_MCAT) + (size_t)(g * 256 + nh * 128) * 128;
      u16* d; size_t ldt;
      if (m0 < T_CTX) { int b = m0 >> 8, l = m0 & 255; ldt = 512; d = (u16*)(p.ws + OFF_BTC) + ((size_t)b * 512 + g * 128) * 512 + nh * 256 + l; }
      else { int tt = m0 - T_CTX, b = tt >> 12, l = tt & 4095; ldt = 8192; d = (u16*)(p.ws + OFF_BTS) + ((size_t)b * 512 + g * 128) * 8192 + nh * 4096 + l; }
      gemm_tile<false>(A, 512, nullptr, m0, B, 128, 128, EpTrans{d, ldt, nullptr, 0}, smem);
    }
  }
}

DEV void p3b_fold(const Params& p) {
  const u16* bt = (const u16*)(p.ws + OFF_BTS);
  u16* bf = (u16*)(p.ws + OFF_BFOLD);
  const size_t gt = (size_t)blockIdx.x * 256 + threadIdx.x, gs = (size_t)gridDim.x * 256;
  for (size_t i = gt; i < 4194304; i += gs) {
    const int jj = (int)(i & 4095);
    const u16* row = bt + (i >> 12) * 8192;
    float v;
    if (jj <= 2048) {
      v = __uint_as_float((unsigned)row[jj] << 16);
      if (jj >= 1 && jj <= 2047) v += __uint_as_float((unsigned)row[4096 - jj] << 16);
    } else {
      const int j = jj - 2048;
      v = __uint_as_float((unsigned)row[4096 + j] << 16) - __uint_as_float((unsigned)row[8192 - j] << 16);
    }
    bf[i] = f2bf(v);
  }
}

DEV void p4_fnet(const Params& p, char* smem) {
  for (int t = blockIdx.x; t < 512; t += gridDim.x) {
    if (t < 256) {
      int b = t >> 7, mt = (t >> 2) & 31, nt = t & 3;
      int tok0 = T_CTX + b * 4096 + mt * 128;
      const u16* A = (const u16*)(p.ws + OFF_FSMP) + (size_t)(mt * 128) * 4096;
      const u16* B = (const u16*)(p.ws + OFF_BFOLD) + ((size_t)b * 512 + nt * 128) * 4096;
      size_t o = (size_t)tok0 * 1024 + nt * 128;
      gemm_tile<false>(A, 4096, nullptr, 0, B, 4096, 4096, EpGate{(u16*)(p.ws + OFF_U) + o, (const u16*)(p.ws + OFF_GBUF) + o, 1024}, smem);
    } else {
      int q = t - 256, b = q >> 3, mt = (q >> 2) & 1, nt = q & 3;
      int tok0 = b * 256 + mt * 128;
      const u16* A = (const u16*)(p.ws + OFF_FCTX) + (size_t)(mt * 128) * 512;
      const u16* B = (const u16*)(p.ws + OFF_BTC) + ((size_t)b * 512 + nt * 128) * 512;
      size_t o = (size_t)tok0 * 1024 + nt * 128;
      gemm_tile<false>(A, 512, nullptr, 0, B, 512, 512, EpGate{(u16*)(p.ws + OFF_U) + o, (const u16*)(p.ws + OFF_GBUF) + o, 1024}, smem);
    }
  }
}

template <int LAYER> DEV void p_outproj(const Params& p, char* smem) {
  const u16* Aall = (const u16*)(p.ws + (LAYER == 0 ? OFF_U : OFF_U1));
  const u16* W = (const u16*)(p.ws + (LAYER == 0 ? OFF_WOUTT : OFF_RWOUTT));
  const float* mods = (const float*)(p.ws + OFF_MODS);
  for (int t = blockIdx.x; t < 1024; t += gridDim.x) {
    int mt = t >> 3, nt = t & 7, m0 = mt * 128, n0 = nt * 128;
    const float* xs;
    if (LAYER == 0) xs = (m0 < T_CTX ? p.x_prompt + (size_t)m0 * 1024 : p.x_sample + (size_t)(m0 - T_CTX) * 1024) + n0;
    else xs = p.out + (size_t)m0 * 1024 + n0;
    const float* gate = mods + (LAYER * 3 + mv_of(m0)) * 3072 + 2048 + n0;
    gemm_tile<false>(Aall + (size_t)m0 * 1024, 1024, nullptr, m0, W + (size_t)n0 * 1024, 1024, 1024,
                     EpRes{(u16*)(p.ws + (LAYER == 0 ? OFF_Y0B : OFF_Y1B)) + (size_t)m0 * 1024 + n0, xs, gate}, smem);
  }
}

DEV void p6b_dx(const Params& p) {
  const int lane = threadIdx.x & 63;
  const int gw = blockIdx.x * 4 + (threadIdx.x >> 6), nw = gridDim.x * 4;
  const u16* U = (const u16*)(p.ws + OFF_U1);
  u16* DX = (u16*)(p.ws + OFF_DX);
  for (int row = gw; row < 16384; row += nw) {
    const int l = row < T_CTX ? (row & 255) : ((row - T_CTX) & 4095);
    const int len = row < T_CTX ? 256 : 4096;
    const float pf = l > 0 ? 1.f : 0.f, nf = l + 1 < len ? 1.f : 0.f;
    const u16* uc = U + (size_t)row * 1024 + lane * 16;
    const u16* up = l > 0 ? uc - 1024 : uc;
    const u16* un = l + 1 < len ? uc + 1024 : uc;
#pragma unroll
    for (int hlf = 0; hlf < 2; hlf++) {
      uint4 c = *(const uint4*)(uc + 8 * hlf), a = *(const uint4*)(up + 8 * hlf), n = *(const uint4*)(un + 8 * hlf);
      const unsigned cu[4] = {c.x, c.y, c.z, c.w}, au[4] = {a.x, a.y, a.z, a.w}, nu[4] = {n.x, n.y, n.z, n.w};
      unsigned o[4];
#pragma unroll
      for (int q = 0; q < 4; q++)
        o[q] = pack2(0.5f * (bflo(au[q]) * pf + bflo(nu[q]) * nf) - bflo(cu[q]), 0.5f * (bfhi(au[q]) * pf + bfhi(nu[q]) * nf) - bfhi(cu[q]));
      *(uint4*)(DX + (size_t)row * 1024 + lane * 16 + 8 * hlf) = make_uint4(o[0], o[1], o[2], o[3]);
    }
  }
}

DEV void p7_rwkv_proj(const Params& p, char* smem) {
  const u16* U1 = (const u16*)(p.ws + OFF_U1);
  const int xcd = blockIdx.x & 7, jx = blockIdx.x >> 3, nbx = gridDim.x >> 3;
  for (int q = jx; q < 16 * 35; q += nbx) {
    int mt, nt;
    if (q < 512) { int st = q >> 6, w = q & 63; mt = xcd * 16 + (st >> 2) * 8 + (w >> 3); nt = (st & 3) * 8 + (w & 7); }
    else { int w = q - 512; mt = xcd * 16 + w / 3; nt = 32 + w % 3; }
    const int m0 = mt * 128;
    if (nt < 32) {
      int which = nt >> 3, n0 = (nt & 7) * 128;
      const u16* B = (const u16*)(p.ws + OFF_RKVZT) + (size_t)which * 1048576 + (size_t)n0 * 1024;
      if (which == 3) {
        gemm_tile<false>(U1 + (size_t)m0 * 1024, 1024, nullptr, m0, B, 1024, 1024,
                         EpStore<1>{(u16*)(p.ws + OFF_SZ) + (size_t)m0 * 1024 + n0, 1024, 1.f}, smem);
      } else {
        size_t off = which == 0 ? OFF_R : (which == 1 ? OFF_K2 : OFF_V2);
        const float* mu = p.mu + (which == 0 ? 0 : (which == 1 ? 2 : 3)) * 1024;
        gemm_tile<true>(U1, 1024, mu, m0, B, 1024, 1024, EpStore<0>{(u16*)(p.ws + off) + (size_t)m0 * 1024 + n0, 1024, 1.f}, smem);
      }
    } else {
      int w = nt - 32;
      if (w == 0)
        gemm_tile<true>(U1, 1024, p.mu + 1 * 1024, m0, (const u16*)(p.ws + OFF_W1T), 1024, 1024, EpStore<2>{(u16*)(p.ws + OFF_HW) + (size_t)m0 * 128, 128, 1.f}, smem);
      else if (w == 1)
        gemm_tile<true>(U1, 1024, p.mu + 4 * 1024, m0, (const u16*)(p.ws + OFF_A1T), 1024, 1024, EpStore<0>{(u16*)(p.ws + OFF_HA) + (size_t)m0 * 128, 128, 1.f}, smem);
      else
        gemm_tile<true>(U1, 1024, p.mu + 5 * 1024, m0, (const u16*)(p.ws + OFF_G1T), 1024, 1024, EpStore<3>{(u16*)(p.ws + OFF_HG) + (size_t)m0 * 128, 128, 1.f}, smem);
    }
  }
}

DEV b16x8 lds_perm(const u16* M, int ld, int row, int s, int hh) {
  const u16* q = M + row * ld + 16 * s + 4 * hh;
  uint2 lo = *(const uint2*)q, hi = *(const uint2*)(q + 8);
  u32x4 v = {lo.x, lo.y, hi.x, hi.y};
  return *(b16x8*)&v;
}
DEV b16x8 lds_norm(const u16* M, int ld, int row, int s, int hh) { return *(const b16x8*)(M + row * ld + 16 * s + 8 * hh); }
template <int OFF> DEV b16x8 pack8(const f32x16& a) {
  u32x4 v = {pack2(a[OFF], a[OFF + 1]), pack2(a[OFF + 2], a[OFF + 3]), pack2(a[OFF + 4], a[OFF + 5]), pack2(a[OFF + 6], a[OFF + 7])};
  return *(b16x8*)&v;
}
#define MFMA32(a, b, c) __builtin_amdgcn_mfma_f32_32x32x16_bf16(a, b, c, 0, 0, 0)

DEV int swz_idx(int row, int col) { return row * 40 + ((row >> 5) & 1) * 32 + ((((col >> 3) ^ (row >> 3)) & 3) << 3) + (col & 7); }
DEV b16x8 swz_norm(const u16* M, int row, int s, int hh) { return *(const b16x8*)(M + swz_idx(row, 16 * s + 8 * hh)); }
DEV b16x8 swz_perm(const u16* M, int row, int s, int hh) {
  uint2 lo = *(const uint2*)(M + swz_idx(row, 16 * s) + 4 * hh), hi = *(const uint2*)(M + swz_idx(row, 16 * s + 8) + 4 * hh);
  u32x4 v = {lo.x, lo.y, hi.x, hi.y};
  return *(b16x8*)&v;
}
struct ScanJob {
  int e, b, hd, tb, L, step0, nch, pq;
  int ncomb, seq;
  const float* zin;
  float* zout;
  u16* pout;
  float* qout;
};
DEV void scan_job(const Params& p, const ScanJob& J, char* smem) {
  float* sCum = (float*)smem;
  float* sAa = (float*)(smem + 8320);
  float* sNN = (float*)(smem + 8320);
  float* sT11 = (float*)(smem + 12544);
  float* sT22 = (float*)(smem + 13632);
  float* sWm = (float*)(smem + 14720);
  u16* AT = (u16*)(smem + 16640);
  u16* RT = (u16*)(smem + 21248);
  u16* BTl = (u16*)(smem + 25856);
  u16* KTl = (u16*)(smem + 30464);
  u16* BH = (u16*)(smem + 35072);
  u16* KH = (u16*)(smem + 40256);
  u16* VT = (u16*)(smem + 45440);
  u16* MkaT = (u16*)(smem + 50624);
  u16* MbrT = (u16*)(smem + 53184);
  u16* MkrT = (u16*)(smem + 55744);
  u16* TT = (u16*)(smem + 58304);
  float* gC = (float*)(smem + 60864);
  const int tid = threadIdx.x, wave = __builtin_amdgcn_readfirstlane(threadIdx.x >> 6);
  float* sKc = (float*)(smem + 61120);
  const int e = J.e, hd = J.hd, tb = J.tb, L = J.L, step0 = J.step0;
  const bool pq = J.pq != 0;
  const bool chainw = pq || wave < 2;
  const bool useV = pq ? (wave >= 2) : true;
  const int rb = wave & 1;
  const u16* HW = (const u16*)(p.ws + OFF_HW);
  const u16* HA = (const u16*)(p.ws + OFF_HA);
  const u16* Rb = (const u16*)(p.ws + OFF_R);
  const u16* Kb = (const u16*)(p.ws + OFF_K2);
  const u16* Vb = (const u16*)(p.ws + OFF_V2);
  float* Ysum = (float*)(p.ws + OFF_YSUM);
  float* Bsum = (float*)(p.ws + OFF_BSUM);
  const int arr = wave >> 1, ct = wave & 1;
  const u16* Xb = (arr ? HA : HW) + e * 64;
  b16x8 wf[4];
  {
    const int qi = tid & 31, hh = (tid >> 5) & 1;
    const u16* Wt = (const u16*)(p.ws + (arr ? OFF_A2T : OFF_W2T)) + (size_t)e * 65536 + (size_t)(hd * 64 + ct * 32 + qi) * 64 + hh * 8;
#pragma unroll
    for (int ks = 0; ks < 4; ks++) wf[ks] = ld16(Wt + ks * 16);
  }
  const float bias0 = (arr ? p.a0 : p.w0)[e * 1024 + hd * 64 + ct * 32 + (tid & 31)];
  if (tid < 64) { sKc[tid] = p.k_k[hd * 64 + tid]; sKc[64 + tid] = p.k_a[hd * 64 + tid]; sKc[128 + tid] = p.r_k[hd * 64 + tid]; }
  f32x16 z0, z1;
#pragma unroll
  for (int q = 0; q < 4; q++) {
    const int qi = tid & 31, hh = (tid >> 5) & 1;
    float4 v0 = make_float4(0, 0, 0, 0), v1 = v0;
    if (pq) {
      if (wave < 2) {
#pragma unroll
        for (int i = 0; i < 4; i++) {
          const int k = 8 * q + 4 * hh + i, col = rb * 32 + qi;
          ((float*)&v0)[i] = (k == col) ? 1.f : 0.f;
          ((float*)&v1)[i] = (k + 32 == col) ? 1.f : 0.f;
        }
      }
    } else if (J.zin && wave < 2) {
      const float* sp = J.zin + (size_t)(wave * 32 + qi) * 64 + 8 * q + 4 * hh;
      v0 = *(const float4*)sp; v1 = *(const float4*)(sp + 32);
    }
    z0[4 * q] = v0.x; z0[4 * q + 1] = v0.y; z0[4 * q + 2] = v0.z; z0[4 * q + 3] = v0.w;
    z1[4 * q] = v1.x; z1[4 * q + 1] = v1.y; z1[4 * q + 2] = v1.z; z1[4 * q + 3] = v1.w;
  }
  if (!pq && wave < 2) {
    const int qi = tid & 31, hh = (tid >> 5) & 1;
#pragma unroll 1
    for (int g = 0; g < J.ncomb; g++) {
      const u16* P = (const u16*)(p.ws + OFF_SEGP) + (size_t)(J.seq * 7 + g) * 4096;
      const float* Q = (const float*)(p.ws + OFF_SEGQ) + (size_t)(J.seq * 7 + g) * 4096;
      b16x8 zb[4] = {pack8<0>(z0), pack8<8>(z0), pack8<0>(z1), pack8<8>(z1)};
      f32x16 n0, n1;
#pragma unroll
      for (int q = 0; q < 4; q++) {
        const float* sp = Q + (size_t)(wave * 32 + qi) * 64 + 8 * q + 4 * hh;
        float4 v0 = *(const float4*)sp, v1 = *(const float4*)(sp + 32);
        n0[4 * q] = v0.x; n0[4 * q + 1] = v0.y; n0[4 * q + 2] = v0.z; n0[4 * q + 3] = v0.w;
        n1[4 * q] = v1.x; n1[4 * q + 1] = v1.y; n1[4 * q + 2] = v1.z; n1[4 * q + 3] = v1.w;
      }
#pragma unroll
      for (int s2 = 0; s2 < 4; s2++) {
        const u16* r0 = P + (size_t)qi * 64 + 16 * s2 + 4 * hh;
        const u16* r1 = P + (size_t)(32 + qi) * 64 + 16 * s2 + 4 * hh;
        uint2 a = *(const uint2*)r0, c = *(const uint2*)(r0 + 8), d = *(const uint2*)r1, f = *(const uint2*)(r1 + 8);
        u32x4 fa = {a.x, a.y, c.x, c.y}, fb = {d.x, d.y, f.x, f.y};
        n0 = MFMA32(*(b16x8*)&fa, zb[s2], n0);
        n1 = MFMA32(*(b16x8*)&fb, zb[s2], n1);
      }
      z0 = n0; z1 = n1;
    }
  }
  const int nch = J.nch;
  b16x8 xf[4];
  u32x4 kq, rq, vq;
  int tokC;
  {
    const int qi = tid & 31, hh = (tid >> 5) & 1, ci_ = tid >> 3, chg = hd * 64 + (tid & 7) * 8;
    const int tok0 = tb + (e ? L - step0 - 32 : step0);
    const int tokA = tok0 + (e ? 31 - qi : qi);
#pragma unroll
    for (int ks = 0; ks < 4; ks++) xf[ks] = ld16(Xb + (size_t)tokA * 128 + hh * 8 + ks * 16);
    tokC = tok0 + (e ? 31 - ci_ : ci_);
    kq = *(const u32x4*)(Kb + (size_t)tokC * 1024 + chg);
    rq = *(const u32x4*)(Rb + (size_t)tokC * 1024 + chg);
    vq = *(const u32x4*)(Vb + (size_t)tokC * 1024 + chg);
  }
#pragma unroll 1
  for (int ci = 0; ci < nch; ci++) {
    const int tok0 = tb + (e ? L - step0 - 32 * (ci + 1) : step0 + 32 * ci);
    const int tokn0 = tb + (e ? L - step0 - 32 * (ci + 2) : step0 + 32 * (ci + 1));
    const bool more = ci + 1 < nch;
    int tl = tid;
    asm volatile("" : "+v"(tl));
    const int lane = tl & 63, qi = lane & 31, hh = lane >> 5, ci_ = tl >> 3, cb = (tl & 7) * 8, chg = hd * 64 + cb;
    {
      f32x16 acc;
#pragma unroll
      for (int r = 0; r < 16; r++) acc[r] = 0.f;
#pragma unroll
      for (int ks = 0; ks < 4; ks++) acc = MFMA32(xf[ks], wf[ks], acc);
      if (more) {
        const int tokA = tokn0 + (e ? 31 - qi : qi);
#pragma unroll
        for (int ks = 0; ks < 4; ks++) xf[ks] = ld16(Xb + (size_t)tokA * 128 + hh * 8 + ks * 16);
      }
      const int ch = ct * 32 + qi;
      if (arr == 0) {
        float lw[16], gs[4], og[4];
#pragma unroll
        for (int r = 0; r < 16; r++) lw[r] = -0.606531f * sigm(acc[r] + bias0);
#pragma unroll
        for (int q = 0; q < 4; q++) { gs[q] = (lw[4 * q] + lw[4 * q + 1]) + (lw[4 * q + 2] + lw[4 * q + 3]); og[q] = __shfl_xor(gs[q], 32); }
        float pre = 0.f;
#pragma unroll
        for (int q = 0; q < 4; q++) {
          float run = pre + (hh ? og[q] : 0.f);
#pragma unroll
          for (int i = 0; i < 4; i++) { run += lw[4 * q + i]; sCum[(8 * q + 4 * hh + i) * 65 + ch] = run; }
          pre += gs[q] + og[q];
        }
      } else {
#pragma unroll
        for (int r = 0; r < 16; r++) {
          int row = (r & 3) + 8 * (r >> 2) + 4 * hh;
          sAa[row * 65 + ch] = sigm(acc[r] + bias0);
        }
      }
    }
    lds_barrier();
    {
      const int i = ci_;
      const unsigned ku[4] = {kq.x, kq.y, kq.z, kq.w}, ru[4] = {rq.x, rq.y, rq.z, rq.w}, vu[4] = {vq.x, vq.y, vq.z, vq.w};
      float k[8], r[8], kkr[8];
#pragma unroll
      for (int q = 0; q < 4; q++) {
        k[2 * q] = bflo(ku[q]); k[2 * q + 1] = bfhi(ku[q]);
        r[2 * q] = bflo(ru[q]); r[2 * q + 1] = bfhi(ru[q]);
      }
      float kkc[8], kac[8], rkc[8];
#pragma unroll
      for (int j = 0; j < 8; j++) { kkc[j] = sKc[cb + j]; kac[j] = sKc[64 + cb + j]; rkc[j] = sKc[128 + cb + j]; }
      float ss = 0;
#pragma unroll
      for (int j = 0; j < 8; j++) { kkr[j] = k[j] * kkc[j]; ss += kkr[j] * kkr[j]; }
      ss = allsum8(ss);
      const float inv = rsqrtf(ss + 1e-12f);
      float bon = 0;
      float oa[8], orr[8], ob[8], ok[8];
#pragma unroll
      for (int j = 0; j < 8; j++) {
        const float a = sAa[i * 65 + cb + j];
        const float cm = sCum[i * 65 + cb + j];
        const float cp = i > 0 ? sCum[(i - 1) * 65 + cb + j] : 0.f;
        const float cl = sCum[31 * 65 + cb + j];
        const float kd = k[j] * (1.f + (a - 1.f) * kac[j]);
        const float kk = kkr[j] * inv;
        const float bb = kk * a;
        bon += r[j] * kd * rkc[j];
        const float em = __expf(-cm), eC = __expf(cl - cm);
        oa[j] = -kk * __expf(cp);
        orr[j] = pq ? 0.f : r[j] * __expf(cm);
        ob[j] = bb * em;
        ok[j] = kd * em;
        BH[swz_idx(cb + j, i)] = f2bf(bb * eC);
        KH[swz_idx(cb + j, i)] = f2bf(kd * eC);
        if (i == 31) gC[cb + j] = __expf(cl);
      }
#pragma unroll
      for (int q = 0; q < 4; q++) {
        VT[swz_idx(cb + 2 * q, i)] = (u16)(vu[q] & 0xffffu);
        VT[swz_idx(cb + 2 * q + 1, i)] = (u16)(vu[q] >> 16);
      }
      *(u32x4*)(AT + i * 72 + cb) = u32x4{pack2(oa[0], oa[1]), pack2(oa[2], oa[3]), pack2(oa[4], oa[5]), pack2(oa[6], oa[7])};
      if (!pq) *(u32x4*)(RT + i * 72 + cb) = u32x4{pack2(orr[0], orr[1]), pack2(orr[2], orr[3]), pack2(orr[4], orr[5]), pack2(orr[6], orr[7])};
      *(u32x4*)(BTl + i * 72 + cb) = u32x4{pack2(ob[0], ob[1]), pack2(ob[2], ob[3]), pack2(ob[4], ob[5]), pack2(ob[6], ob[7])};
      *(u32x4*)(KTl + i * 72 + cb) = u32x4{pack2(ok[0], ok[1]), pack2(ok[2], ok[3]), pack2(ok[4], ok[5]), pack2(ok[6], ok[7])};
      bon = allsum8(bon);
      if (!pq && (tl & 7) == 0) atomicAdd(Bsum + (size_t)tokC * 16 + hd, 0.5f * bon);
      if (more) {
        tokC = tokn0 + (e ? 31 - ci_ : ci_);
        kq = *(const u32x4*)(Kb + (size_t)tokC * 1024 + chg);
        rq = *(const u32x4*)(Rb + (size_t)tokC * 1024 + chg);
        vq = *(const u32x4*)(Vb + (size_t)tokC * 1024 + chg);
      }
    }
    lds_barrier();
    if (!(pq && wave >= 2)) {
      const u16* Am = (wave < 2) ? AT : RT;
      const u16* Bm = (wave & 1) ? KTl : BTl;
      f32x16 acc;
#pragma unroll
      for (int r = 0; r < 16; r++) acc[r] = 0.f;
#pragma unroll
      for (int s = 0; s < 4; s++) acc = MFMA32(lds_norm(Am, 72, qi, s, hh), lds_norm(Bm, 72, qi, s, hh), acc);
      u16* dst = wave == 1 ? MkaT : (wave == 2 ? MbrT : MkrT);
#pragma unroll
      for (int r = 0; r < 16; r++) {
        const int tt = (r & 3) + 8 * (r >> 2) + 4 * hh, j = qi;
        const bool keep = (wave < 2) ? (j < tt) : (j <= tt);
        const float val = keep ? acc[r] : 0.f;
        if (wave == 0) sNN[j * 33 + tt] = val;
        else dst[tt * 40 + j] = f2bf(val);
      }
    }
    if (tl < 32) {
      const int i = tl & 15, base = (tl >> 4) * 16;
      float Tr[16];
#pragma unroll
      for (int q = 0; q < 16; q++) Tr[q] = (q == i) ? 1.f : 0.f;
#pragma unroll
      for (int q = 1; q < 16; q++) {
        float s0 = 0.f, s1 = 0.f, s2 = 0.f, s3 = 0.f;
#pragma unroll
        for (int j = 0; j < q; j++) {
          const float pr = Tr[j] * sNN[(base + j) * 33 + base + q];
          if ((j & 3) == 0) s0 += pr; else if ((j & 3) == 1) s1 += pr; else if ((j & 3) == 2) s2 += pr; else s3 += pr;
        }
        if (q > i) Tr[q] = (s0 + s1) + (s2 + s3);
      }
      float* sT = (tl >> 4) ? sT22 : sT11;
#pragma unroll
      for (int q = 0; q < 16; q++) { sT[i * 17 + q] = Tr[q]; TT[(base + q) * 40 + base + i] = f2bf(Tr[q]); }
    }
    lds_barrier();
    {
      const int i = tl >> 4, q = tl & 15;
      float s = 0.f;
#pragma unroll
      for (int j = 0; j < 16; j++) s += sT11[i * 17 + j] * sNN[j * 33 + 16 + q];
      sWm[i * 17 + q] = s;
      TT[i * 40 + 16 + q] = 0;
    }
    lds_barrier();
    {
      const int i = tl >> 4, q = tl & 15;
      float s = 0.f;
#pragma unroll
      for (int j = 0; j < 16; j++) s += sWm[i * 17 + j] * sT22[j * 17 + q];
      TT[(16 + q) * 40 + i] = f2bf(s);
    }
    lds_barrier();
    if (chainw) {
      const int vrow = rb * 32 + qi;
      b16x8 zb0 = pack8<0>(z0), zb1 = pack8<8>(z0), zb2 = pack8<0>(z1), zb3 = pack8<8>(z1);
      b16x8 vt0 = swz_norm(VT, vrow, 0, hh), vt1 = swz_norm(VT, vrow, 1, hh);
      f32x16 x;
#pragma unroll
      for (int r = 0; r < 16; r++) x[r] = 0.f;
      x = MFMA32(lds_perm(AT, 72, qi, 0, hh), zb0, x);
      x = MFMA32(lds_perm(AT, 72, qi, 1, hh), zb1, x);
      x = MFMA32(lds_perm(AT, 72, qi, 2, hh), zb2, x);
      x = MFMA32(lds_perm(AT, 72, qi, 3, hh), zb3, x);
      if (useV) {
        x = MFMA32(lds_norm(MkaT, 40, qi, 0, hh), vt0, x);
        x = MFMA32(lds_norm(MkaT, 40, qi, 1, hh), vt1, x);
      }
      f32x16 y;
#pragma unroll
      for (int r = 0; r < 16; r++) y[r] = 0.f;
      if (!pq) {
        y = MFMA32(lds_perm(RT, 72, qi, 0, hh), zb0, y);
        y = MFMA32(lds_perm(RT, 72, qi, 1, hh), zb1, y);
        y = MFMA32(lds_perm(RT, 72, qi, 2, hh), zb2, y);
        y = MFMA32(lds_perm(RT, 72, qi, 3, hh), zb3, y);
        y = MFMA32(lds_norm(MkrT, 40, qi, 0, hh), vt0, y);
        y = MFMA32(lds_norm(MkrT, 40, qi, 1, hh), vt1, y);
      }
#pragma unroll
      for (int q = 0; q < 4; q++) {
        float4 g0 = *(const float4*)(gC + 8 * q + 4 * hh), g1 = *(const float4*)(gC + 32 + 8 * q + 4 * hh);
        z0[4 * q] *= g0.x; z0[4 * q + 1] *= g0.y; z0[4 * q + 2] *= g0.z; z0[4 * q + 3] *= g0.w;
        z1[4 * q] *= g1.x; z1[4 * q + 1] *= g1.y; z1[4 * q + 2] *= g1.z; z1[4 * q + 3] *= g1.w;
      }
      if (useV) {
        z0 = MFMA32(swz_norm(KH, qi, 0, hh), vt0, z0);
        z0 = MFMA32(swz_norm(KH, qi, 1, hh), vt1, z0);
        z1 = MFMA32(swz_norm(KH, 32 + qi, 0, hh), vt0, z1);
        z1 = MFMA32(swz_norm(KH, 32 + qi, 1, hh), vt1, z1);
      }
      b16x8 xb0 = pack8<0>(x), xb1 = pack8<8>(x);
      f32x16 u;
#pragma unroll
      for (int r = 0; r < 16; r++) u[r] = 0.f;
      u = MFMA32(lds_perm(TT, 40, qi, 0, hh), xb0, u);
      u = MFMA32(lds_perm(TT, 40, qi, 1, hh), xb1, u);
      b16x8 ub0 = pack8<0>(u), ub1 = pack8<8>(u);
      z0 = MFMA32(swz_perm(BH, qi, 0, hh), ub0, z0);
      z0 = MFMA32(swz_perm(BH, qi, 1, hh), ub1, z0);
      z1 = MFMA32(swz_perm(BH, 32 + qi, 0, hh), ub0, z1);
      z1 = MFMA32(swz_perm(BH, 32 + qi, 1, hh), ub1, z1);
      if (!pq) {
        y = MFMA32(lds_perm(MbrT, 40, qi, 0, hh), ub0, y);
        y = MFMA32(lds_perm(MbrT, 40, qi, 1, hh), ub1, y);
#pragma unroll
        for (int r = 0; r < 16; r++) {
          const int st = (r & 3) + 8 * (r >> 2) + 4 * hh;
          const int tok = tok0 + (e ? 31 - st : st);
          atomicAdd(Ysum + (size_t)tok * 1024 + hd * 64 + vrow, y[r]);
        }
      }
    }
  }
  {
    const int qi = tid & 31, hh = (tid >> 5) & 1;
    if (pq) {
      if (wave < 2) {
#pragma unroll
        for (int r = 0; r < 16; r++) {
          const int k = (r & 3) + 8 * (r >> 2) + 4 * hh;
          J.pout[k * 64 + rb * 32 + qi] = f2bf(z0[r]);
          J.pout[(k + 32) * 64 + rb * 32 + qi] = f2bf(z1[r]);
        }
      } else {
#pragma unroll
        for (int q = 0; q < 4; q++) {
          float* sp = J.qout + (size_t)(rb * 32 + qi) * 64 + 8 * q + 4 * hh;
          *(float4*)sp = make_float4(z0[4 * q], z0[4 * q + 1], z0[4 * q + 2], z0[4 * q + 3]);
          *(float4*)(sp + 32) = make_float4(z1[4 * q], z1[4 * q + 1], z1[4 * q + 2], z1[4 * q + 3]);
        }
      }
    } else if (J.zout && wave < 2) {
#pragma unroll
      for (int q = 0; q < 4; q++) {
        float* sp = J.zout + (size_t)(wave * 32 + qi) * 64 + 8 * q + 4 * hh;
        *(float4*)sp = make_float4(z0[4 * q], z0[4 * q + 1], z0[4 * q + 2], z0[4 * q + 3]);
        *(float4*)(sp + 32) = make_float4(z1[4 * q], z1[4 * q + 1], z1[4 * q + 2], z1[4 * q + 3]);
      }
    }
  }
  __syncthreads();
}

DEV void scan_combine(const Params& p, int seq) {
  const int tid = threadIdx.x, wave = tid >> 6, qi = tid & 31, hh = (tid >> 5) & 1;
  if (wave >= 2) return;
  const int e = seq >> 5, b = (seq >> 4) & 1, hd = seq & 15;
  const float* zin = p.state_rwkv + ((size_t)(b * 2 + e) * 16 + hd) * 4096;
  f32x16 z0, z1;
#pragma unroll
  for (int q = 0; q < 4; q++) {
    const float* sp = zin + (size_t)(wave * 32 + qi) * 64 + 8 * q + 4 * hh;
    float4 v0 = *(const float4*)sp, v1 = *(const float4*)(sp + 32);
    z0[4 * q] = v0.x; z0[4 * q + 1] = v0.y; z0[4 * q + 2] = v0.z; z0[4 * q + 3] = v0.w;
    z1[4 * q] = v1.x; z1[4 * q + 1] = v1.y; z1[4 * q + 2] = v1.z; z1[4 * q + 3] = v1.w;
  }
#pragma unroll 1
  for (int g = 0; g < 7; g++) {
    const u16* P = (const u16*)(p.ws + OFF_SEGP) + (size_t)(seq * 7 + g) * 4096;
    const float* Q = (const float*)(p.ws + OFF_SEGQ) + (size_t)(seq * 7 + g) * 4096;
    b16x8 zb[4] = {pack8<0>(z0), pack8<8>(z0), pack8<0>(z1), pack8<8>(z1)};
    f32x16 n0, n1;
#pragma unroll
    for (int q = 0; q < 4; q++) {
      const float* sp = Q + (size_t)(wave * 32 + qi) * 64 + 8 * q + 4 * hh;
      float4 v0 = *(const float4*)sp, v1 = *(const float4*)(sp + 32);
      n0[4 * q] = v0.x; n0[4 * q + 1] = v0.y; n0[4 * q + 2] = v0.z; n0[4 * q + 3] = v0.w;
      n1[4 * q] = v1.x; n1[4 * q + 1] = v1.y; n1[4 * q + 2] = v1.z; n1[4 * q + 3] = v1.w;
    }
#pragma unroll
    for (int s = 0; s < 4; s++) {
      const u16* r0 = P + (size_t)qi * 64 + 16 * s + 4 * hh;
      const u16* r1 = P + (size_t)(32 + qi) * 64 + 16 * s + 4 * hh;
      uint2 a = *(const uint2*)r0, c = *(const uint2*)(r0 + 8), d = *(const uint2*)r1, f = *(const uint2*)(r1 + 8);
      u32x4 fa = {a.x, a.y, c.x, c.y}, fb = {d.x, d.y, f.x, f.y};
      n0 = MFMA32(*(b16x8*)&fa, zb[s], n0);
      n1 = MFMA32(*(b16x8*)&fb, zb[s], n1);
    }
    z0 = n0; z1 = n1;
    float* zs = (float*)(p.ws + OFF_SEGZ) + (size_t)(seq * 7 + g) * 4096;
#pragma unroll
    for (int q = 0; q < 4; q++) {
      float* sp = zs + (size_t)(wave * 32 + qi) * 64 + 8 * q + 4 * hh;
      *(float4*)sp = make_float4(z0[4 * q], z0[4 * q + 1], z0[4 * q + 2], z0[4 * q + 3]);
      *(float4*)(sp + 32) = make_float4(z1[4 * q], z1[4 * q + 1], z1[4 * q + 2], z1[4 * q + 3]);
    }
  }
}

DEV ScanJob ctx_job(const Params& p, int v) {
  ScanJob J;
  J.e = v >> 9; J.b = (v >> 4) & 31; J.hd = v & 15; J.tb = J.b * 256; J.L = 256; J.step0 = 0; J.nch = 8; J.pq = 0;
  J.zin = nullptr; J.zout = p.out + OUT_ST + ((size_t)(J.b * 2 + J.e) * 16 + J.hd) * 4096; J.pout = nullptr; J.qout = nullptr;
  J.ncomb = 0; J.seq = 0;
  return J;
}
DEV ScanJob smp_job(const Params& p, int seq, int g, int pq) {
  ScanJob J;
  J.e = seq >> 5; J.b = (seq >> 4) & 1; J.hd = seq & 15; J.tb = T_CTX + J.b * 4096; J.L = 4096; J.step0 = g * 512; J.nch = 16; J.pq = pq;
  J.zin = p.state_rwkv + ((size_t)(J.b * 2 + J.e) * 16 + J.hd) * 4096;
  J.ncomb = pq ? 0 : g; J.seq = seq;
  J.zout = nullptr;
  J.pout = (u16*)(p.ws + OFF_SEGP) + (size_t)(seq * 7 + g) * 4096;
  J.qout = (float*)(p.ws + OFF_SEGQ) + (size_t)(seq * 7 + g) * 4096;
  return J;
}

DEV void p8a_scan(const Params& p, char* smem) {
  if (blockIdx.x < 448) {
    for (int j = blockIdx.x; j < 448; j += 448) scan_job(p, smp_job(p, j / 7, j % 7, 1), smem);
  } else {
    {
      float4* ys = (float4*)(p.ws + OFF_YSUM);
      float4* bs = (float4*)(p.ws + OFF_BSUM);
      const size_t gt = (size_t)(blockIdx.x - 448) * 256 + threadIdx.x, gs = (size_t)(gridDim.x - 448) * 256;
      for (size_t i = gt; i < 4194304; i += gs) ys[i] = make_float4(0, 0, 0, 0);
      for (size_t i = gt; i < 65536; i += gs) bs[i] = make_float4(0, 0, 0, 0);
    }
    for (int q = blockIdx.x - 448; q < 1024; q += gridDim.x - 448) {
      int mt = q >> 3, nt = q & 7, m0 = mt * 128, n0 = nt * 128;
      u16* sz = (u16*)(p.ws + OFF_SZ) + (size_t)m0 * 1024 + n0;
      gemm_tile<false>((const u16*)(p.ws + OFF_HG) + (size_t)m0 * 128, 128, nullptr, m0, (const u16*)(p.ws + OFF_G2T) + (size_t)n0 * 128, 128, 128,
                       EpGate{sz, sz, 1024}, smem);
    }
  }
}
DEV void p8b_scan(const Params& p, char* smem) {
  if (blockIdx.x < 64) scan_combine(p, blockIdx.x);
}
DEV void p8c_scan(const Params& p, char* smem) {
  for (int j = blockIdx.x; j < 512 + 1024; j += gridDim.x) {
    if (j < 512) scan_job(p, smp_job(p, j >> 3, j & 7, 0), smem);
    else scan_job(p, ctx_job(p, j - 512), smem);
  }
}

DEV void p9_post(const Params& p) {
  const int lane = threadIdx.x & 63;
  const int gw = blockIdx.x * 4 + (threadIdx.x >> 6), nw = gridDim.x * 4;
  const float* Ysum = (const float*)(p.ws + OFF_YSUM);
  const float* Bsum = (const float*)(p.ws + OFF_BSUM);
  for (int row = gw; row < 16384; row += nw) {
    const size_t o = (size_t)row * 1024 + lane * 16;
    float y[16];
#pragma unroll
    for (int i = 0; i < 4; i++) { float4 v = *(const float4*)(Ysum + o + 4 * i); y[4 * i] = v.x; y[4 * i + 1] = v.y; y[4 * i + 2] = v.z; y[4 * i + 3] = v.w; }
    float s = 0;
#pragma unroll
    for (int i = 0; i < 16; i++) s += y[i];
    s += __shfl_xor(s, 1); s += __shfl_xor(s, 2);
    float mean = s * (1.f / 64.f), q = 0;
#pragma unroll
    for (int i = 0; i < 16; i++) { float d = y[i] - mean; q += d * d; }
    q += __shfl_xor(q, 1); q += __shfl_xor(q, 2);
    float rstd = rsqrtf(q * (1.f / 64.f) + 64e-5f);
    float bon = Bsum[(size_t)row * 16 + (lane >> 2)];
    u16* O = (u16*)(p.ws + OFF_U1) + o;
    const u16* V = (const u16*)(p.ws + OFF_V2) + o;
    const u16* Z = (const u16*)(p.ws + OFF_SZ) + o;
#pragma unroll
    for (int hlf = 0; hlf < 2; hlf++) {
      uint4 vq = *(const uint4*)(V + 8 * hlf), zq = *(const uint4*)(Z + 8 * hlf);
      const unsigned vu[4] = {vq.x, vq.y, vq.z, vq.w}, zu[4] = {zq.x, zq.y, zq.z, zq.w};
      unsigned ow[4];
#pragma unroll
      for (int w = 0; w < 4; w++) {
        int c = lane * 16 + hlf * 8 + 2 * w;
        float y0 = (y[hlf * 8 + 2 * w] - mean) * rstd * p.lnx_g[c] + p.lnx_b[c] + bon * bflo(vu[w]);
        float y1 = (y[hlf * 8 + 2 * w + 1] - mean) * rstd * p.lnx_g[c + 1] + p.lnx_b[c + 1] + bon * bfhi(vu[w]);
        ow[w] = pack2(y0 * bflo(zu[w]), y1 * bfhi(zu[w]));
      }
      *(uint4*)(O + 8 * hlf) = make_uint4(ow[0], ow[1], ow[2], ow[3]);
    }
  }
}


#define XB_TMO 128
#define XB_XCNT(j) (256 + 64 * (j))
#define XB_XSUB(j) (1280 + 64 * (j))
#define XB_XGEN(j) (2304 + 64 * (j))
#define XB_TOP 3328
#define XB_TOPGEN 3392
#define XCD_BAR_WORDS 3456
#define XB_SPIN_CAP (1u << 22)
#define LAS __attribute__((address_space(3)))
DEV unsigned xb_ld(unsigned* p) { return __hip_atomic_load(p, __ATOMIC_RELAXED, __HIP_MEMORY_SCOPE_AGENT); }
DEV unsigned xb_add(unsigned* p, unsigned v) { return __hip_atomic_fetch_add(p, v, __ATOMIC_RELAXED, __HIP_MEMORY_SCOPE_AGENT); }
DEV unsigned xb_xcc_id() { return (unsigned)__builtin_amdgcn_s_getreg((3 << 11) | 20) & 0xFu; }
#define XB_SPIN(cond, bar) do { unsigned _sp = 0; while (cond) { __builtin_amdgcn_s_sleep(4); \
    if ((++_sp & 255u) == 0u) { if (xb_ld(&(bar)[XB_TMO])) break; if (_sp > XB_SPIN_CAP) { atomicAdd(&(bar)[XB_TMO], 1u); break; } } } } while (0)
struct XcdBarrier { unsigned* bar; unsigned x; volatile LAS unsigned* st; };
DEV XcdBarrier xcd_barrier_post(unsigned* bar, volatile LAS unsigned* st) {
  XcdBarrier b; b.bar = bar; b.x = xb_xcc_id(); b.st = st;
  if (threadIdx.x == 0) (void)xb_add(&bar[XB_XCNT(b.x)], 1u);
  return b;
}
DEV void xcd_barrier_complete(unsigned* bar, unsigned x, unsigned& nloc, unsigned& nx) {
  const unsigned G = gridDim.x * gridDim.y * gridDim.z;
  unsigned sum, cnt, mine, sp = 0u;
  for (;;) {
    sum = 0u; cnt = 0u; mine = 0u;
#pragma unroll
    for (unsigned j = 0; j < 16; ++j) { const unsigned c = xb_ld(&bar[XB_XCNT(j)]); sum += c; cnt += (c > 0u) ? 1u : 0u; mine = (j == x) ? c : mine; }
    if (sum == G) break;
    __builtin_amdgcn_s_sleep(1);
    if ((++sp & 255u) == 0u) { if (xb_ld(&bar[XB_TMO])) break; if (sp > XB_SPIN_CAP) { atomicAdd(&bar[XB_TMO], 1u); break; } }
  }
  nloc = mine > 0u ? mine : 1u; nx = cnt > 0u ? cnt : 1u;
}
DEV void xcd_barrier(const XcdBarrier& b) {
  asm volatile("s_waitcnt vmcnt(0)" ::: "memory");
  __syncthreads();
  if (threadIdx.x == 0) {
    unsigned* bar = b.bar;
    __builtin_amdgcn_s_waitcnt(0);
    unsigned nloc = b.st[0], nx = b.st[1];
    if (nloc == 0u) { xcd_barrier_complete(bar, b.x, nloc, nx); b.st[0] = nloc; b.st[1] = nx; }
    const unsigned old = xb_add(&bar[XB_XSUB(b.x)], 1u);
    const unsigned gen = old / nloc;
    if (old + 1u == (gen + 1u) * nloc) {
      __builtin_amdgcn_fence(__ATOMIC_RELEASE, "agent");
      asm volatile("s_waitcnt vmcnt(0)" ::: "memory");
      const unsigned og = xb_add(&bar[XB_TOP], 1u);
      const unsigned tg = og / nx;
      if (og + 1u == (tg + 1u) * nx) xb_add(&bar[XB_TOPGEN], 1u);
      else XB_SPIN(xb_ld(&bar[XB_TOPGEN]) == tg, bar);
      __builtin_amdgcn_fence(__ATOMIC_ACQUIRE, "agent");
      xb_add(&bar[XB_XGEN(b.x)], 1u);
      asm volatile("s_waitcnt vmcnt(0)" ::: "memory");
    } else {
      XB_SPIN(xb_ld(&bar[XB_XGEN(b.x)]) == gen, bar);
      __builtin_amdgcn_fence(__ATOMIC_ACQUIRE, "agent");
      asm volatile("s_waitcnt vmcnt(0)" ::: "memory");
    }
  }
  __syncthreads();
}

__global__ void __launch_bounds__(256, 2) fwd_kernel(Params p) {
  __shared__ __attribute__((aligned(16))) char smem[73728];
#if FUSED
  __shared__ unsigned xb_st[4];
  if (threadIdx.x < 4) xb_st[threadIdx.x] = 0u;
  __syncthreads();
  const XcdBarrier xb = xcd_barrier_post((unsigned*)(p.ws + OFF_BAR), (volatile LAS unsigned*)xb_st);
  if (p.phase_hi > 1000) cg::this_grid().sync();
#define SYNC() xcd_barrier(xb)
#else
#define SYNC()
#endif
#define PH(n, call) if (p.phase_lo <= n && n <= p.phase_hi) { call; if (n < p.phase_hi) { SYNC(); } }
  PH(0, p0_prep(p, smem))
  PH(1, ln_phase<0>(p))
  PH(2, p2_gemm1(p, smem))
  PH(3, p3_mix(p, smem))
  PH(4, p3b_fold(p))
  PH(5, p4_fnet(p, smem))
  PH(6, p_outproj<0>(p, smem))
  PH(7, ln_phase<1>(p))
  PH(8, p6b_dx(p))
  PH(9, p7_rwkv_proj(p, smem))
  PH(10, p8a_scan(p, smem))
  PH(11, p8c_scan(p, smem))
  PH(12, p9_post(p))
  PH(13, p_outproj<1>(p, smem))
  PH(14, ln_phase<2>(p))
}

extern "C" void kernel_launch(void* const* d_in, const int* in_sizes, int n_in, void* d_out, int out_size, void* d_ws,
                              size_t ws_size, hipStream_t stream) {
  Params p;
  memset(&p, 0, sizeof(p));
  const float* const* in = (const float* const*)d_in;
  p.x_prompt = in[0]; p.x_sample = in[1]; p.cache_k = in[2]; p.cache_v = in[3]; p.state_rwkv = in[4]; p.c = in[5]; p.c_ctx = in[6];
  p.ada_w = in[7]; p.ada_b = in[8]; p.post_g = in[9]; p.post_b = in[10]; p.w_in = in[11]; p.w_fnet = in[12]; p.rpb = in[13]; p.w_out = in[14];
  p.mu = in[15]; p.rkvz = in[16]; p.w0 = in[17]; p.w1 = in[18]; p.w2 = in[19]; p.a0 = in[20]; p.a1 = in[21]; p.a2 = in[22];
  p.g1 = in[23]; p.g2 = in[24]; p.k_k = in[25]; p.k_a = in[26]; p.r_k = in[27]; p.lnx_g = in[28]; p.lnx_b = in[29]; p.rw_out = in[30];
  p.out = (float*)d_out; p.ws = (char*)d_ws;
  char* ws = (char*)d_ws;
  int n = 0, start = 0;
  auto add = [&](const float* src, size_t dstoff, int lds, int ldd, int tk, int tn) {
    p.tj[n].src = src; p.tj[n].dst = (u16*)(ws + dstoff); p.tj[n].lds = lds; p.tj[n].ldd = ldd; p.tj[n].tk = tk; p.tj[n].tn = tn;
    p.tj[n].start = start; p.tj[n].pad = 0; start += tk * tn; n++;
  };
  add(p.w_in, OFF_WINT, 3072, 1024, 16, 48);
  add(p.w_out, OFF_WOUTT, 1024, 1024, 16, 16);
  for (int i = 0; i < 4; i++) add(p.rkvz + (size_t)i * 1048576, OFF_RKVZT + (size_t)i * 2097152, 1024, 1024, 16, 16);
  add(p.rw_out, OFF_RWOUTT, 1024, 1024, 16, 16);
  for (int e = 0; e < 2; e++) add(p.w1 + e * 65536, OFF_W1T + (size_t)e * 64 * 1024 * 2, 64, 1024, 16, 1);
  for (int e = 0; e < 2; e++) add(p.a1 + e * 65536, OFF_A1T + (size_t)e * 64 * 1024 * 2, 64, 1024, 16, 1);
  add(p.g1, OFF_G1T, 128, 1024, 16, 2);
  for (int e = 0; e < 2; e++) add(p.w2 + e * 65536, OFF_W2T + (size_t)e * 65536 * 2, 1024, 64, 1, 16);
  for (int e = 0; e < 2; e++) add(p.a2 + e * 65536, OFF_A2T + (size_t)e * 65536 * 2, 1024, 64, 1, 16);
  add(p.g2, OFF_G2T, 1024, 128, 2, 16);
  for (int b = 0; b < 2; b++)
    for (int h = 0; h < 8; h++) add(p.cache_v + (size_t)b * 262144 + h * 64, OFF_CVT + (size_t)(b * 8 + h) * 64 * 512 * 2, 512, 512, 8, 1);
  p.ntr = start;

  static int grid_blocks = 0;
  if (!grid_blocks) {
    int dev = 0, cus = 0, per_cu = 0;
    (void)hipGetDevice(&dev);
    (void)hipDeviceGetAttribute(&cus, hipDeviceAttributeMultiprocessorCount, dev);
    (void)hipOccupancyMaxActiveBlocksPerMultiprocessor(&per_cu, fwd_kernel, 256, 0);
    if (per_cu > 2) per_cu = 2;
    if (per_cu < 1) per_cu = 1;
    grid_blocks = cus * per_cu;
  }
#if FUSED
  p.phase_lo = 0; p.phase_hi = 14;
  void* args[] = {&p};
  (void)hipMemsetAsync((char*)d_ws + OFF_BAR, 0, 16384, stream);
  hipError_t e = hipLaunchCooperativeKernel((void*)fwd_kernel, dim3(grid_blocks), dim3(256), args, 0, stream);
  if (e != hipSuccess) fprintf(stderr, "cooperative launch failed: %s (grid %d)\n", hipGetErrorString(e), grid_blocks);
#else
#ifndef PROBE_SEQ
#define PROBE_SEQ 0,1,2,3,4,5,6,7,8,9,10,11,12,13,14
#endif
  const int seq[] = {PROBE_SEQ};
  for (int i = 0; i < (int)(sizeof(seq) / sizeof(int)); i++) {
    p.phase_lo = seq[i]; p.phase_hi = seq[i];
    fwd_kernel<<<grid_blocks, 256, 0, stream>>>(p);
  }
#endif
}
```

```cpp
#include <hip/hip_runtime.h>
#include <hip/hip_cooperative_groups.h>
#include <stdint.h>
#include <cstdio>
#include <cstring>
namespace cg = cooperative_groups;

#ifndef FUSED
#define FUSED 1
#endif

typedef unsigned short u16;
typedef __attribute__((ext_vector_type(8))) __bf16 b16x8;
typedef __attribute__((ext_vector_type(16))) float f32x16;
typedef __attribute__((ext_vector_type(4))) unsigned u32x4;
typedef __attribute__((ext_vector_type(2))) unsigned u32x2;
#define DEV __device__ __forceinline__

constexpr int T_CTX = 8192;
constexpr float ALPHA_DN = 1.41421356237f;
constexpr float LOG2E = 1.44269504089f;
constexpr size_t MiB = 1u << 20;
constexpr size_t OFF_MODS = 0, OFF_BAR = 512 * 1024, OFF_BSUM = 1 * MiB;
constexpr size_t OFF_FSMP = 2 * MiB, OFF_U = 66 * MiB, OFF_ABUF = 98 * MiB, OFF_Q = 114 * MiB, OFF_K = 130 * MiB;
constexpr size_t OFF_VTC = 146 * MiB, OFF_VTS = 154 * MiB, OFF_GBUF = 162 * MiB, OFF_BTC = 194 * MiB, OFF_BTS = 210 * MiB;
constexpr size_t OFF_WINT = 226 * MiB, OFF_WOUTT = 232 * MiB, OFF_MCAT = 234 * MiB, OFF_FCTX = 234 * MiB + 256 * 1024;
constexpr size_t OFF_CK = 234 * MiB + 512 * 1024, OFF_CVT = 235 * MiB + 512 * 1024;
constexpr size_t OFF_RKVZT = 237 * MiB, OFF_RWOUTT = 245 * MiB, OFF_W1T = 247 * MiB, OFF_A1T = OFF_W1T + 256 * 1024,
                 OFF_G1T = OFF_W1T + 512 * 1024, OFF_W2T = OFF_W1T + 768 * 1024, OFF_A2T = 248 * MiB,
                 OFF_G2T = 248 * MiB + 256 * 1024, OFF_HW = 248 * MiB + 512 * 1024;
constexpr size_t OFF_U1 = 2 * MiB, OFF_R = 34 * MiB, OFF_K2 = 66 * MiB, OFF_V2 = 98 * MiB, OFF_SZ = 130 * MiB,
                 OFF_YSUM = 162 * MiB, OFF_HA = 226 * MiB, OFF_HG = 230 * MiB;
constexpr size_t OFF_BFOLD = 98 * MiB;
constexpr size_t OFF_Y0B = 98 * MiB, OFF_Y1B = 34 * MiB;
constexpr size_t OFF_DX = 162 * MiB;
constexpr size_t OFF_SEGP = 2 * MiB, OFF_SEGQ = 6 * MiB, OFF_SEGZ = 14 * MiB;
constexpr size_t OUT_NK = 16777216, OUT_NV = 20971520, OUT_ST = 25165824;

constexpr int NTJ = 33;
struct TJob { const float* src; u16* dst; int lds, ldd, tk, tn, start, pad; };

struct Params {
  const float *x_prompt, *x_sample, *cache_k, *cache_v, *state_rwkv, *c, *c_ctx;
  const float *ada_w, *ada_b, *post_g, *post_b, *w_in, *w_fnet, *rpb, *w_out;
  const float *mu, *rkvz, *w0, *w1, *w2, *a0, *a1, *a2, *g1, *g2, *k_k, *k_a, *r_k, *lnx_g, *lnx_b, *rw_out;
  float* out; char* ws;
  int phase_lo, phase_hi, ntr, pad;
  TJob tj[NTJ];
};

typedef __attribute__((ext_vector_type(2))) __bf16 bf16x2_t;
typedef __attribute__((ext_vector_type(2))) float f32x2_t;
DEV unsigned pack2(float a, float b) {
  f32x2_t f = {a, b};
  bf16x2_t r = __builtin_convertvector(f, bf16x2_t);
  return *(unsigned*)&r;
}
DEV u16 f2bf(float f) { return (u16)(pack2(f, 0.f) & 0xffffu); }
DEV float bflo(unsigned w) { return __uint_as_float(w << 16); }
DEV float bfhi(unsigned w) { return __uint_as_float(w & 0xffff0000u); }
DEV float rcp_f(float x) { return __builtin_amdgcn_rcpf(x); }
DEV float sigm(float x) { return rcp_f(1.f + __expf(-x)); }
DEV float silu(float x) { return x * rcp_f(1.f + __expf(-x)); }
DEV float tanh_f(float x) { return 1.f - 2.f * rcp_f(__expf(2.f * x) + 1.f); }
DEV b16x8 ld16(const u16* p) { uint4 v = *(const uint4*)p; return *(b16x8*)&v; }
DEV b16x8 asb(uint4 v) { return *(b16x8*)&v; }
template <int CTRL> DEV float dpp_add(float x) {
  return x + __int_as_float(__builtin_amdgcn_update_dpp(0, __float_as_int(x), CTRL, 0xf, 0xf, true));
}
DEV float allsum8(float x) {
  x = dpp_add<0xB1>(x); x = dpp_add<0x4E>(x); x = dpp_add<0x141>(x);
  return x;
}
DEV float wave_sum(float x) {
  x = dpp_add<0xB1>(x); x = dpp_add<0x4E>(x); x = dpp_add<0x141>(x); x = dpp_add<0x140>(x);
  x += __shfl_xor(x, 16); x += __shfl_xor(x, 32);
  return x;
}
DEV float allsum16(float x) {
  x = dpp_add<0xB1>(x); x = dpp_add<0x4E>(x); x = dpp_add<0x124>(x); x = dpp_add<0x128>(x);
  return x;
}
DEV void lds_barrier() { asm volatile("s_waitcnt lgkmcnt(0)\n\ts_barrier" ::: "memory"); }
DEV int mv_of(int token) { return token < T_CTX ? 0 : 1 + ((token - T_CTX) >> 12); }

template <bool LERP, class EP>
DEV void gemm_tile(const u16* __restrict__ A, int lda, const float* __restrict__ mu, int m0,
                   const u16* __restrict__ B, int ldb, int K, EP ep, char* smem) {
  u16(*sA0)[72] = (u16(*)[72])smem;
  u16(*sB0)[72] = (u16(*)[72])(smem + 18432);
  u16(*sA1)[72] = (u16(*)[72])(smem + 36864);
  u16(*sB1)[72] = (u16(*)[72])(smem + 36864 + 18432);
  int tid = threadIdx.x;
  asm volatile("" : "+v"(tid));
  const int lane = tid & 63, wave = tid >> 6, wm = wave >> 1, wn = wave & 1;
  const int lr = tid >> 3, lk = (tid & 7) * 8;
  f32x16 acc[2][2];
#pragma unroll
  for (int i = 0; i < 2; i++)
#pragma unroll
    for (int j = 0; j < 2; j++)
#pragma unroll
      for (int r = 0; r < 16; r++) acc[i][j][r] = 0.f;
  u32x4 ra0[4], rb0[4], rp0[4], ra1[4], rb1[4], rp1[4];
  float4 mu00, mu01, mu10, mu11;
  const u16* DXp = nullptr;
  if constexpr (LERP) DXp = (const u16*)(A) + (OFF_DX - OFF_U1) / 2;
#define GLOAD(K0, RA, RB, RP, M0, M1)                                                     \
  {                                                                                       \
    _Pragma("unroll") for (int i = 0; i < 4; i++) {                                       \
      int r = lr + 32 * i;                                                                \
      if constexpr (LERP) {                                                               \
        RA[i] = *(const u32x4*)(A + (size_t)(m0 + r) * lda + (K0) + lk);                  \
        RP[i] = *(const u32x4*)(DXp + (size_t)(m0 + r) * lda + (K0) + lk);                \
      } else {                                                                            \
        RA[i] = *(const u32x4*)(A + (size_t)r * lda + (K0) + lk);                         \
      }                                                                                   \
      RB[i] = *(const u32x4*)(B + (size_t)r * ldb + (K0) + lk);                           \
    }                                                                                     \
    if constexpr (LERP) {                                                                 \
      M0 = *(const float4*)(mu + (K0) + lk);                                              \
      M1 = *(const float4*)(mu + (K0) + lk + 4);                                          \
    }                                                                                     \
  }
#define GSTORE(RA, RB, RP, M0, M1, sA, sB)                                                     \
  {                                                                                       \
    _Pragma("unroll") for (int i = 0; i < 4; i++) {                                       \
      int r = lr + 32 * i;                                                                \
      u32x4 av = RA[i];                                                                   \
      if constexpr (LERP) {                                                               \
        unsigned cu[4] = {RA[i].x, RA[i].y, RA[i].z, RA[i].w};                            \
        unsigned du[4] = {RP[i].x, RP[i].y, RP[i].z, RP[i].w};                            \
        float m[8] = {M0.x, M0.y, M0.z, M0.w, M1.x, M1.y, M1.z, M1.w};                    \
        unsigned o[4];                                                                    \
        _Pragma("unroll") for (int q = 0; q < 4; q++)                                     \
          o[q] = pack2(bflo(cu[q]) + bflo(du[q]) * m[2 * q], bfhi(cu[q]) + bfhi(du[q]) * m[2 * q + 1]); \
        av = u32x4{o[0], o[1], o[2], o[3]};                                               \
      }                                                                                   \
      *(u32x4*)&sA[r][lk] = av;                                                           \
      *(u32x4*)&sB[r][lk] = RB[i];                                                        \
    }                                                                                     \
  }
#define GCOMPUTE(sA, sB)                                                                  \
  {                                                                                       \
    _Pragma("unroll") for (int ks = 0; ks < 4; ks++) {                                    \
      b16x8 af[2], bf[2];                                                                 \
      _Pragma("unroll") for (int i = 0; i < 2; i++) {                                     \
        af[i] = *(const b16x8*)&sA[wm * 64 + i * 32 + (lane & 31)][ks * 16 + (lane >> 5) * 8]; \
        bf[i] = *(const b16x8*)&sB[wn * 64 + i * 32 + (lane & 31)][ks * 16 + (lane >> 5) * 8]; \
      }                                                                                   \
      _Pragma("unroll") for (int i = 0; i < 2; i++)                                       \
        _Pragma("unroll") for (int j = 0; j < 2; j++)                                     \
          acc[i][j] = __builtin_amdgcn_mfma_f32_32x32x16_bf16(af[i], bf[j], acc[i][j], 0, 0, 0); \
    }                                                                                     \
  }
  GLOAD(0, ra0, rb0, rp0, mu00, mu01);
  GLOAD(64, ra1, rb1, rp1, mu10, mu11);
  __syncthreads();
  GSTORE(ra0, rb0, rp0, mu00, mu01, sA0, sB0);
  if (128 < K) GLOAD(128, ra0, rb0, rp0, mu00, mu01);
  __syncthreads();
#pragma unroll 1
  for (int k0 = 0; k0 < K; k0 += 128) {
    __builtin_amdgcn_s_setprio(1);
    GCOMPUTE(sA0, sB0);
    __builtin_amdgcn_s_setprio(0);
    GSTORE(ra1, rb1, rp1, mu10, mu11, sA1, sB1);
    if (k0 + 192 < K) GLOAD(k0 + 192, ra1, rb1, rp1, mu10, mu11);
    __syncthreads();
    __builtin_amdgcn_s_setprio(1);
    GCOMPUTE(sA1, sB1);
    __builtin_amdgcn_s_setprio(0);
    if (k0 + 128 < K) {
      GSTORE(ra0, rb0, rp0, mu00, mu01, sA0, sB0);
      if (k0 + 256 < K) GLOAD(k0 + 256, ra0, rb0, rp0, mu00, mu01);
    }
    __syncthreads();
  }
#undef GLOAD
#undef GSTORE
#undef GCOMPUTE
  __syncthreads();
  int tide = tid;
  asm volatile("" : "+v"(tide));
  const int lane_e = tide & 63, wv_e = tide >> 6, wm_e = wv_e >> 1, wn_e = wv_e & 1;
  u16* stg = (u16*)smem + wv_e * (64 * 72);
#pragma unroll
  for (int i = 0; i < 2; i++)
#pragma unroll
    for (int j = 0; j < 2; j++)
#pragma unroll
      for (int q = 0; q < 4; q++) {
        const int r = i * 32 + q * 8 + (lane_e >> 5) * 4, c = j * 32 + (lane_e & 31);
        const float v0 = acc[i][j][q * 4 + 0], v1 = acc[i][j][q * 4 + 1], v2 = acc[i][j][q * 4 + 2], v3 = acc[i][j][q * 4 + 3];
        ep.direct(wm_e * 64 + r, wn_e * 64 + c, v0, v1, v2, v3);
        if constexpr (EP::TRANS) {
          *(uint2*)(stg + c * 72 + r) = make_uint2(pack2(ep.act(v0), ep.act(v1)), pack2(ep.act(v2), ep.act(v3)));
        } else {
          const unsigned p01 = pack2(ep.act(v0), ep.act(v1)), p23 = pack2(ep.act(v2), ep.act(v3));
          stg[(r + 0) * 72 + c] = (u16)(p01 & 0xffffu); stg[(r + 1) * 72 + c] = (u16)(p01 >> 16);
          stg[(r + 2) * 72 + c] = (u16)(p23 & 0xffffu); stg[(r + 3) * 72 + c] = (u16)(p23 >> 16);
        }
      }
#pragma unroll
  for (int n = 0; n < 8; n++) {
    const int id = lane_e + 64 * n, rr = id >> 3, cc = (id & 7) * 8;
    const u32x4 v = *(const u32x4*)(stg + rr * 72 + cc);
    if constexpr (EP::TRANS) ep.store(wn_e * 64 + rr, wm_e * 64 + cc, v);
    else ep.store(wm_e * 64 + rr, wn_e * 64 + cc, v);
  }
}

template <int ACT> struct EpStore {
  static constexpr bool TRANS = false;
  u16* dst; int ld; float scale;
  DEV float act(float x) const {
    if (ACT == 1) return silu(x);
    if (ACT == 2) return tanh_f(x);
    if (ACT == 3) return sigm(x);
    if (ACT == 4) return x * scale;
    return x;
  }
  DEV void direct(int, int, float, float, float, float) const {}
  DEV void store(int R, int C, u32x4 v) const { *(u32x4*)(dst + (size_t)R * ld + C) = v; }
};
struct EpNull {
  static constexpr bool TRANS = false;
  DEV float act(float x) const { return x; }
  DEV void direct(int, int, float, float, float, float) const {}
  DEV void store(int, int, u32x4) const {}
};
struct EpKeep {
  static constexpr bool TRANS = false;
  u16* dst; int ld; float* f32dst; int ldf;
  DEV float act(float x) const { return x; }
  DEV void direct(int r, int c, float v0, float v1, float v2, float v3) const {
    if (f32dst) {
      f32dst[(size_t)(r + 0) * ldf + c] = v0; f32dst[(size_t)(r + 1) * ldf + c] = v1;
      f32dst[(size_t)(r + 2) * ldf + c] = v2; f32dst[(size_t)(r + 3) * ldf + c] = v3;
    }
  }
  DEV void store(int R, int C, u32x4 v) const { *(u32x4*)(dst + (size_t)R * ld + C) = v; }
};
struct EpTrans {
  static constexpr bool TRANS = true;
  u16* dst; size_t ldt; float* f32dst; int ldf;
  DEV float act(float x) const { return x; }
  DEV void direct(int r, int c, float v0, float v1, float v2, float v3) const {
    if (f32dst) {
      f32dst[(size_t)(r + 0) * ldf + c] = v0; f32dst[(size_t)(r + 1) * ldf + c] = v1;
      f32dst[(size_t)(r + 2) * ldf + c] = v2; f32dst[(size_t)(r + 3) * ldf + c] = v3;
    }
  }
  DEV void store(int Rc, int Cr, u32x4 v) const { *(u32x4*)(dst + (size_t)Rc * ldt + Cr) = v; }
};
struct EpGate {
  static constexpr bool TRANS = false;
  u16* dst; const u16* gate; int ld;
  DEV float act(float x) const { return x; }
  DEV void direct(int, int, float, float, float, float) const {}
  DEV void store(int R, int C, u32x4 v) const {
    const size_t o = (size_t)R * ld + C;
    const u32x4 g = *(const u32x4*)(gate + o);
    u32x4 r;
    r.x = pack2(bflo(v.x) * bflo(g.x), bfhi(v.x) * bfhi(g.x)); r.y = pack2(bflo(v.y) * bflo(g.y), bfhi(v.y) * bfhi(g.y));
    r.z = pack2(bflo(v.z) * bflo(g.z), bfhi(v.z) * bfhi(g.z)); r.w = pack2(bflo(v.w) * bflo(g.w), bfhi(v.w) * bfhi(g.w));
    *(u32x4*)(dst + o) = r;
  }
};
struct EpRes {
  static constexpr bool TRANS = false;
  u16* dst; const float* xsrc; const float* gate;
  DEV float act(float x) const { return x; }
  DEV void direct(int, int, float, float, float, float) const {}
  DEV void store(int R, int C, u32x4 v) const {
    const size_t o = (size_t)R * 1024 + C;
    const float4 x0 = *(const float4*)(xsrc + o), x1 = *(const float4*)(xsrc + o + 4);
    const float4 g0 = *(const float4*)(gate + C), g1 = *(const float4*)(gate + C + 4);
    u32x4 r;
    r.x = pack2(ALPHA_DN * x0.x + (1.f + g0.x) * bflo(v.x), ALPHA_DN * x0.y + (1.f + g0.y) * bfhi(v.x));
    r.y = pack2(ALPHA_DN * x0.z + (1.f + g0.z) * bflo(v.y), ALPHA_DN * x0.w + (1.f + g0.w) * bfhi(v.y));
    r.z = pack2(ALPHA_DN * x1.x + (1.f + g1.x) * bflo(v.z), ALPHA_DN * x1.y + (1.f + g1.y) * bfhi(v.z));
    r.w = pack2(ALPHA_DN * x1.z + (1.f + g1.z) * bflo(v.w), ALPHA_DN * x1.w + (1.f + g1.w) * bfhi(v.w));
    *(u32x4*)(dst + o) = r;
  }
};

DEV void p0_prep(const Params& p, char* smem) {
  const int tid = threadIdx.x;
  const int njobs = 192 + p.ntr;
  for (int job = blockIdx.x; job < njobs; job += gridDim.x) {
    __syncthreads();
    if (job < 192) {
      float* sc = (float*)smem;
      float* red = sc + 3072;
      for (int i = tid; i < 3072; i += 256) {
        int m = i >> 10, k = i & 1023;
        float cv = m == 0 ? p.c_ctx[k] : p.c[(m - 1) * 1024 + k];
        sc[i] = silu(cv);
      }
      __syncthreads();
      int l = job / 96, col = (job % 96) * 32 + (tid & 31), ks = tid >> 5;
      const float* w = p.ada_w + (size_t)l * 1024 * 3072 + col;
      float a0 = 0, a1 = 0, a2 = 0;
#pragma unroll 8
      for (int k = ks * 128; k < ks * 128 + 128; k++) {
        float wv = w[(size_t)k * 3072];
        a0 += sc[k] * wv; a1 += sc[1024 + k] * wv; a2 += sc[2048 + k] * wv;
      }
      red[(ks * 32 + (tid & 31)) * 3 + 0] = a0; red[(ks * 32 + (tid & 31)) * 3 + 1] = a1; red[(ks * 32 + (tid & 31)) * 3 + 2] = a2;
      __syncthreads();
      if (tid < 96) {
        int cl = tid & 31, m = tid >> 5;
        float s = 0;
        for (int q = 0; q < 8; q++) s += red[(q * 32 + cl) * 3 + m];
        int cc = (job % 96) * 32 + cl;
        ((float*)(p.ws + OFF_MODS))[(l * 3 + m) * 3072 + cc] = s + p.ada_b[l * 3072 + cc];
      }
    } else {
      int tj = job - 192, e = 0;
      while (e + 1 < NTJ && p.tj[e + 1].start <= tj) e++;
      const TJob J = p.tj[e];
      int lt = tj - J.start, tkk = lt / J.tn, tnn = lt % J.tn;
      float(*tile)[65] = (float(*)[65])smem;
      const float* src = J.src + (size_t)(tkk * 64) * J.lds + tnn * 64;
#pragma unroll
      for (int i = 0; i < 4; i++) {
        int kk = (tid >> 4) + 16 * i, nn = (tid & 15) * 4;
        float4 v = *(const float4*)(src + (size_t)kk * J.lds + nn);
        tile[kk][nn] = v.x; tile[kk][nn + 1] = v.y; tile[kk][nn + 2] = v.z; tile[kk][nn + 3] = v.w;
      }
      __syncthreads();
      u16* dst = J.dst + (size_t)(tnn * 64) * J.ldd + tkk * 64;
#pragma unroll
      for (int i = 0; i < 2; i++) {
        int nn = (tid >> 3) + 32 * i, kk = (tid & 7) * 8;
        uint4 o;
        o.x = pack2(tile[kk][nn], tile[kk + 1][nn]); o.y = pack2(tile[kk + 2][nn], tile[kk + 3][nn]);
        o.z = pack2(tile[kk + 4][nn], tile[kk + 5][nn]); o.w = pack2(tile[kk + 6][nn], tile[kk + 7][nn]);
        *(uint4*)(dst + (size_t)nn * J.ldd + kk) = o;
      }
    }
  }
  const size_t gt = (size_t)blockIdx.x * 256 + tid, gs = (size_t)gridDim.x * 256;
  {
    u16* ck = (u16*)(p.ws + OFF_CK);
    for (size_t i = gt; i < 65536; i += gs) {
      float4 a = *(const float4*)(p.cache_k + i * 8), b = *(const float4*)(p.cache_k + i * 8 + 4);
      *(uint4*)(ck + i * 8) = make_uint4(pack2(a.x, a.y), pack2(a.z, a.w), pack2(b.x, b.y), pack2(b.z, b.w));
    }
  }
  {
    u16* fs = (u16*)(p.ws + OFF_FSMP);
    const float sc = 0.001381067932f;
    for (size_t i = gt; i < 2097152; i += gs) {
      int lp = (int)(i >> 9), j0 = (int)(i & 511) * 8;
      unsigned o[4];
#pragma unroll
      for (int q = 0; q < 4; q++) {
        float v[2];
#pragma unroll
        for (int z = 0; z < 2; z++) {
          int j = j0 + 2 * q + z;
          bool cs = j <= 2048;
          int ph = (lp * (cs ? j : j - 2048)) & 4095;
          float ang = (float)ph * (6.283185307179586f / 4096.f);
          v[z] = (cs ? __cosf(ang) : -__sinf(ang)) * sc;
        }
        o[q] = pack2(v[0], v[1]);
      }
      *(uint4*)(fs + i * 8) = make_uint4(o[0], o[1], o[2], o[3]);
    }
    u16* fc = (u16*)(p.ws + OFF_FCTX);
    const float sc2 = 0.005524271728f;
    for (size_t i = gt; i < 16384; i += gs) {
      int lp = (int)(i >> 6), j0 = (int)(i & 63) * 8;
      unsigned o[4];
#pragma unroll
      for (int q = 0; q < 4; q++) {
        float v[2];
#pragma unroll
        for (int z = 0; z < 2; z++) {
          int j = j0 + 2 * q + z;
          int ph = (lp * (j & 255)) & 255;
          float ang = (float)ph * (6.283185307179586f / 256.f);
          v[z] = (j < 256 ? __cosf(ang) : -__sinf(ang)) * sc2;
        }
        o[q] = pack2(v[0], v[1]);
      }
      *(uint4*)(fc + i * 8) = make_uint4(o[0], o[1], o[2], o[3]);
    }
  }
  {
    u16* mc = (u16*)(p.ws + OFF_MCAT);
    for (size_t i = gt; i < 131072; i += gs) {
      int c = (int)(i & 127), ep = (int)((i >> 7) & 255), g = (int)(i >> 15);
      const float* wf = p.w_fnet + (size_t)g * 16384 + (ep & 127);
      float s = 0;
      for (int cp = 0; cp < 128; cp++) {
        float ang = (float)((c * cp) & 127) * (6.283185307179586f / 128.f);
        float tw = ep < 128 ? __cosf(ang) : __sinf(ang);
        s += tw * wf[cp * 128];
      }
      mc[i] = f2bf(s);
    }
  }
}

DEV void ln_stats(const float4 (&x)[4], float& mean, float& rstd) {
  float s = 0;
#pragma unroll
  for (int i = 0; i < 4; i++) s += x[i].x + x[i].y + x[i].z + x[i].w;
  mean = wave_sum(s) * (1.f / 1024.f);
  float q = 0;
#pragma unroll
  for (int i = 0; i < 4; i++) {
    float a = x[i].x - mean, b = x[i].y - mean, c = x[i].z - mean, d = x[i].w - mean;
    q += a * a + b * b + c * c + d * d;
  }
  rstd = rsqrtf(wave_sum(q) * (1.f / 1024.f) + 1e-6f);
}

template <int MODE> DEV void ln_phase(const Params& p) {
  const int lane = threadIdx.x & 63;
  const int gw = blockIdx.x * 4 + (threadIdx.x >> 6), nw = gridDim.x * 4;
  const float* mods = (const float*)(p.ws + OFF_MODS);
  typedef __attribute__((ext_vector_type(4))) float f32x4v;
  f32x4v xn[4];
  u32x2 wn[4];
  auto fetch = [&](int row) {
    if (MODE == 0) {
      const float* src = row < T_CTX ? p.x_prompt + (size_t)row * 1024 : p.x_sample + (size_t)(row - T_CTX) * 1024;
#pragma unroll
      for (int i = 0; i < 4; i++) xn[i] = *(const f32x4v*)(src + lane * 4 + 256 * i);
    } else {
      const u16* sb = (const u16*)(p.ws + (MODE == 1 ? OFF_Y0B : OFF_Y1B)) + (size_t)row * 1024;
#pragma unroll
      for (int i = 0; i < 4; i++) wn[i] = *(const u32x2*)(sb + lane * 4 + 256 * i);
    }
  };
  if (gw < 16384) fetch(gw);
  for (int row = gw; row < 16384; row += nw) {
    float4 x[4];
#pragma unroll
    for (int i = 0; i < 4; i++) {
      if (MODE == 0) x[i] = make_float4(xn[i].x, xn[i].y, xn[i].z, xn[i].w);
      else x[i] = make_float4(bflo(wn[i].x), bfhi(wn[i].x), bflo(wn[i].y), bfhi(wn[i].y));
    }
    if (row + nw < 16384) fetch(row + nw);
    float mean, rstd;
    ln_stats(x, mean, rstd);
    if (MODE >= 1) {
      const float* g = p.post_g + (MODE == 1 ? 0 : 1024);
      const float* b = p.post_b + (MODE == 1 ? 0 : 1024);
      float* dst = p.out + (size_t)row * 1024;
#pragma unroll
      for (int i = 0; i < 4; i++) {
        float4 gv = *(const float4*)(g + lane * 4 + 256 * i), bv = *(const float4*)(b + lane * 4 + 256 * i);
        x[i].x = (x[i].x - mean) * rstd * gv.x + bv.x; x[i].y = (x[i].y - mean) * rstd * gv.y + bv.y;
        x[i].z = (x[i].z - mean) * rstd * gv.z + bv.z; x[i].w = (x[i].w - mean) * rstd * gv.w + bv.w;
        *(float4*)(dst + lane * 4 + 256 * i) = x[i];
      }
      if (MODE == 2) continue;
      ln_stats(x, mean, rstd);
    }
    const float* md = mods + ((MODE == 0 ? 0 : 3) + mv_of(row)) * 3072;
    u16* ud = (u16*)(p.ws + (MODE == 0 ? OFF_U : OFF_U1)) + (size_t)row * 1024;
#pragma unroll
    for (int i = 0; i < 4; i++) {
      int k = lane * 4 + 256 * i;
      float4 sh = *(const float4*)(md + k), sc = *(const float4*)(md + 1024 + k);
      float a = (x[i].x - mean) * rstd * (1.f + sc.x) + sh.x, b = (x[i].y - mean) * rstd * (1.f + sc.y) + sh.y;
      float c = (x[i].z - mean) * rstd * (1.f + sc.z) + sh.z, d = (x[i].w - mean) * rstd * (1.f + sc.w) + sh.w;
      *(uint2*)(ud + k) = make_uint2(pack2(a, b), pack2(c, d));
    }
  }
}

DEV void p2_gemm1(const Params& p, char* smem) {
  const u16* U = (const u16*)(p.ws + OFF_U);
  const u16* W = (const u16*)(p.ws + OFF_WINT);
  const int xcd = blockIdx.x & 7, jx = blockIdx.x >> 3, nbx = gridDim.x >> 3;
  for (int q = jx; q < 16 * 24; q += nbx) {
    int st = q >> 6, w = q & 63, sm = st / 3, sn = st % 3;
    int mt = xcd * 16 + sm * 8 + (w >> 3), nt = sn * 8 + (w & 7);
    int m0 = mt * 128, n0 = nt * 128, sec = nt >> 2, nc = (nt & 3) * 128;
    const u16* A = U + (size_t)m0 * 1024;
    const u16* B = W + (size_t)n0 * 1024;
    if (sec == 0) {
      gemm_tile<false>(A, 1024, nullptr, m0, B, 1024, 1024, EpStore<0>{(u16*)(p.ws + OFF_ABUF) + (size_t)m0 * 512 + nc, 512, 1.f}, smem);
    } else if (sec == 1 || sec == 5) {
      gemm_tile<false>(A, 1024, nullptr, m0, B, 1024, 1024,
                       EpStore<1>{(u16*)(p.ws + OFF_GBUF) + (size_t)m0 * 1024 + (sec == 5 ? 512 : 0) + nc, 1024, 1.f}, smem);
    } else if (sec == 2) {
      gemm_tile<false>(A, 1024, nullptr, m0, B, 1024, 1024, EpStore<4>{(u16*)(p.ws + OFF_Q) + (size_t)m0 * 512 + nc, 512, 0.125f * LOG2E}, smem);
    } else if (sec == 3) {
      float* f = m0 < T_CTX ? p.out + OUT_NK + (size_t)m0 * 512 + nc : nullptr;
      gemm_tile<false>(A, 1024, nullptr, m0, B, 1024, 1024, EpKeep{(u16*)(p.ws + OFF_K) + (size_t)m0 * 512 + nc, 512, f, 512}, smem);
    } else {
      float* f = m0 < T_CTX ? p.out + OUT_NV + (size_t)m0 * 512 + nc : nullptr;
      u16* d; size_t ldt;
      if (m0 < T_CTX) { int b = m0 >> 8, l = m0 & 255; ldt = 256; d = (u16*)(p.ws + OFF_VTC) + ((size_t)b * 512 + nc) * 256 + l; }
      else { int tt = m0 - T_CTX, b = tt >> 12, l = tt & 4095; ldt = 4096; d = (u16*)(p.ws + OFF_VTS) + ((size_t)b * 512 + nc) * 4096 + l; }
      gemm_tile<false>(A, 1024, nullptr, m0, B, 1024, 1024, EpTrans{d, ldt, f, 512}, smem);
    }
  }
}

struct AttnState { f32x16 o0, o1; float m, l; };

DEV void attn_tile(AttnState& st, const b16x8 (&qf)[4], const u16* kS, const u16* vS, int mode, int dr, int kc0, int c,
                   const float* rpbh, int qi, int hh) {
  f32x16 s;
#pragma unroll
  for (int r = 0; r < 16; r++) s[r] = 0.f;
#pragma unroll
  for (int ks = 0; ks < 4; ks++) s = __builtin_amdgcn_mfma_f32_32x32x16_bf16(*(const b16x8*)(kS + qi * 72 + ks * 16 + hh * 8), qf[ks], s, 0, 0, 0);
  if (mode) {
    int cs = min(max(c - 8, 0), 48);
#pragma unroll
    for (int r = 0; r < 16; r++) {
      int kc = kc0 + (r & 3) + 8 * (r >> 2) + 4 * hh;
      bool valid = (kc >= cs) && (kc < cs + 16);
      int dc = min(max(kc - c + 15, 0), 30);
      float bias = rpbh[dr * 31 + dc] * LOG2E;
      s[r] = valid ? s[r] + bias : -1e30f;
    }
  }
  float tm = s[0];
#pragma unroll
  for (int r = 1; r < 16; r++) tm = fmaxf(tm, s[r]);
  tm = fmaxf(tm, __shfl_xor(tm, 32));
  float mn = fmaxf(st.m, tm);
  float alpha = __builtin_amdgcn_exp2f(st.m - mn);
  st.m = mn;
  float ps = 0;
#pragma unroll
  for (int r = 0; r < 16; r++) { float e = __builtin_amdgcn_exp2f(s[r] - mn); ps += e; s[r] = e; }
  st.l = st.l * alpha + ps;
#pragma unroll
  for (int r = 0; r < 16; r++) { st.o0[r] *= alpha; st.o1[r] *= alpha; }
#pragma unroll
  for (int s2 = 0; s2 < 2; s2++) {
    u32x4 pw = {pack2(s[8 * s2 + 0], s[8 * s2 + 1]), pack2(s[8 * s2 + 2], s[8 * s2 + 3]),
                pack2(s[8 * s2 + 4], s[8 * s2 + 5]), pack2(s[8 * s2 + 6], s[8 * s2 + 7])};
    b16x8 pfr = *(b16x8*)&pw;
#pragma unroll
    for (int dt = 0; dt < 2; dt++) {
      const u16* vr = vS + (dt * 32 + qi) * 40 + 16 * s2 + 4 * hh;
      const uint2 lo = *(const uint2*)vr, hi = *(const uint2*)(vr + 8);
      u32x4 vw = {lo.x, lo.y, hi.x, hi.y};
      b16x8 vf = *(b16x8*)&vw;
      if (dt == 0) st.o0 = __builtin_amdgcn_mfma_f32_32x32x16_bf16(vf, pfr, st.o0, 0, 0, 0);
      else st.o1 = __builtin_amdgcn_mfma_f32_32x32x16_bf16(vf, pfr, st.o1, 0, 0, 0);
    }
  }
}

DEV void attn_unit(const Params& p, int u, int lane, char* smem) {
  const u16* Qb = (const u16*)(p.ws + OFF_Q);
  const u16* Kb = (const u16*)(p.ws + OFF_K);
  const int qi = lane & 31, hh = lane >> 5;
  u16* kS = (u16*)smem + (threadIdx.x >> 6) * 4864;
  u16* vS = kS + 32 * 72;
  bool smp = u < 2048;
  int b, h, qg, tq0, r = 0, c0 = 0;
  if (smp) { b = u >> 10; h = (u >> 7) & 7; qg = u & 127; tq0 = T_CTX + b * 4096 + qg * 32; r = qg >> 1; c0 = (qg & 1) * 32; }
  else { int v = u - 2048; b = v >> 6; h = (v >> 3) & 7; qg = v & 7; tq0 = b * 256 + qg * 32; }
  b16x8 qf[4];
#pragma unroll
  for (int s = 0; s < 4; s++) qf[s] = ld16(Qb + (size_t)(tq0 + qi) * 512 + h * 64 + s * 16 + hh * 8);
  AttnState st;
#pragma unroll
  for (int i = 0; i < 16; i++) { st.o0[i] = 0.f; st.o1[i] = 0.f; }
  st.m = -INFINITY; st.l = 0.f;
  const float* rpbh = p.rpb + h * 465;
  const int rs = min(max(r - 4, 0), 56);
  const u16* ck = (const u16*)(p.ws + OFF_CK) + (size_t)b * 512 * 512 + h * 64;
  const u16* cvt = (const u16*)(p.ws + OFF_CVT) + (size_t)(b * 8 + h) * 64 * 512;
  const u16* kls = Kb + (size_t)(T_CTX + b * 4096) * 512 + h * 64;
  const u16* vls = (const u16*)(p.ws + OFF_VTS) + (size_t)(b * 8 + h) * 64 * 4096;
  const u16* klc = Kb + (size_t)(b * 256) * 512 + h * 64;
  const u16* vlc = (const u16*)(p.ws + OFF_VTC) + (size_t)(b * 8 + h) * 64 * 256;
  const int ntile = smp ? 32 : 8;
  u32x4 kr[4], vr[4];
  auto issue = [&](int tt) {
    int ll = lane;
    asm volatile("" : "+v"(ll));
    const u16 *kp, *vp; int ldv;
    if (!smp) { kp = klc + (size_t)tt * 32 * 512; vp = vlc + tt * 32; ldv = 256; }
    else if (tt < 16) { kp = ck + (size_t)tt * 32 * 512; vp = cvt + tt * 32; ldv = 512; }
    else { int kt = tt - 16, krow = rs + (kt >> 1), kc0 = (kt & 1) * 32; kp = kls + (size_t)(krow * 64 + kc0) * 512; vp = vls + krow * 64 + kc0; ldv = 4096; }
#pragma unroll
    for (int n = 0; n < 4; n++) {
      const int id = ll + 64 * n;
      kr[n] = *(const u32x4*)(kp + (size_t)(id >> 3) * 512 + (id & 7) * 8);
      vr[n] = *(const u32x4*)(vp + (size_t)(id >> 2) * ldv + (id & 3) * 8);
    }
  };
  issue(0);
#pragma unroll 1
  for (int tt = 0; tt < ntile; tt++) {
    {
      int ll = lane;
      asm volatile("" : "+v"(ll));
#pragma unroll
      for (int n = 0; n < 4; n++) {
        const int id = ll + 64 * n;
        *(u32x4*)(kS + (id >> 3) * 72 + (id & 7) * 8) = kr[n];
        *(u32x4*)(vS + (id >> 2) * 40 + (id & 3) * 8) = vr[n];
      }
    }
    if (tt + 1 < ntile) issue(tt + 1);
    const bool loc = smp && tt >= 16;
    const int kt = tt - 16;
    attn_tile(st, qf, kS, vS, loc ? 1 : 0, loc ? rs + (kt >> 1) - r + 7 : 0, loc ? (kt & 1) * 32 : 0, c0 + qi, rpbh, qi, hh);
  }
  float lt = st.l + __shfl_xor(st.l, 32);
  float inv = 1.f / lt;
  const size_t rowo = (size_t)(tq0 + qi) * 1024 + 512 + h * 64;
  const u16* gb = (const u16*)(p.ws + OFF_GBUF) + rowo;
  u16* cat = (u16*)(p.ws + OFF_U) + rowo;
#pragma unroll
  for (int dt = 0; dt < 2; dt++)
#pragma unroll
    for (int q = 0; q < 4; q++) {
      int d = dt * 32 + q * 8 + hh * 4;
      uint2 g = *(const uint2*)(gb + d);
      float v0 = (dt ? st.o1[q * 4 + 0] : st.o0[q * 4 + 0]) * inv * bflo(g.x);
      float v1 = (dt ? st.o1[q * 4 + 1] : st.o0[q * 4 + 1]) * inv * bfhi(g.x);
      float v2 = (dt ? st.o1[q * 4 + 2] : st.o0[q * 4 + 2]) * inv * bflo(g.y);
      float v3 = (dt ? st.o1[q * 4 + 3] : st.o0[q * 4 + 3]) * inv * bfhi(g.y);
      *(uint2*)(cat + d) = make_uint2(pack2(v0, v1), pack2(v2, v3));
    }
}

DEV void p3_mix(const Params& p, char* smem) {
  for (int t = blockIdx.x; t < 2048; t += gridDim.x) {
    if (t < 1024) {
      __syncthreads();
      attn_unit(p, t * 4 + (threadIdx.x >> 6), threadIdx.x & 63, smem);
    } else {
      int q = t - 1024, mt = q >> 3, g = (q >> 1) & 3, nh = q & 1, m0 = mt * 128;
      const u16* A = (const u16*)(p.ws + OFF_ABUF) + (size_t)m0 * 512 + g * 128;
      const u16* B = (const u16*)(p.ws + OFF_MCAT) + (size_t)(g * 256 + nh * 128) * 128;
      u16* d; size_t ldt;
      if (m0 < T_CTX) { int b = m0 >> 8, l = m0 & 255; ldt = 512; d = (u16*)(p.ws + OFF_BTC) + ((size_t)b * 512 + g * 128) * 512 + nh * 256 + l; }
      else { int tt = m0 - T_CTX, b = tt >> 12, l = tt & 4095; ldt = 8192; d = (u16*)(p.ws + OFF_BTS) + ((size_t)b * 512 + g * 128) * 8192 + nh * 4096 + l; }
      gemm_tile<false>(A, 512, nullptr, m0, B, 128, 128, EpTrans{d, ldt, nullptr, 0}, smem);
    }
  }
}

DEV void p3b_fold(const Params& p) {
  const u16* bt = (const u16*)(p.ws + OFF_BTS);
  u16* bf = (u16*)(p.ws + OFF_BFOLD);
  const size_t gt = (size_t)blockIdx.x * 256 + threadIdx.x, gs = (size_t)gridDim.x * 256;
  for (size_t i = gt; i < 4194304; i += gs) {
    const int jj = (int)(i & 4095);
    const u16* row = bt + (i >> 12) * 8192;
    float v;
    if (jj <= 2048) {
      v = __uint_as_float((unsigned)row[jj] << 16);
      if (jj >= 1 && jj <= 2047) v += __uint_as_float((unsigned)row[4096 - jj] << 16);
    } else {
      const int j = jj - 2048;
      v = __uint_as_float((unsigned)row[4096 + j] << 16) - __uint_as_float((unsigned)row[8192 - j] << 16);
    }
    bf[i] = f2bf(v);
  }
}

DEV void p4_fnet(const Params& p, char* smem) {
  for (int t = blockIdx.x; t < 512; t += gridDim.x) {
    if (t < 256) {
      int b = t >> 7, mt = (t >> 2) & 31, nt = t & 3;
      int tok0 = T_CTX + b * 4096 + mt * 128;
      const u16* A = (const u16*)(p.ws + OFF_FSMP) + (size_t)(mt * 128) * 4096;
      const u16* B = (const u16*)(p.ws + OFF_BFOLD) + ((size_t)b * 512 + nt * 128) * 4096;
      size_t o = (size_t)tok0 * 1024 + nt * 128;
      gemm_tile<false>(A, 4096, nullptr, 0, B, 4096, 4096, EpGate{(u16*)(p.ws + OFF_U) + o, (const u16*)(p.ws + OFF_GBUF) + o, 1024}, smem);
    } else {
      int q = t - 256, b = q >> 3, mt = (q >> 2) & 1, nt = q & 3;
      int tok0 = b * 256 + mt * 128;
      const u16* A = (const u16*)(p.ws + OFF_FCTX) + (size_t)(mt * 128) * 512;
      const u16* B = (const u16*)(p.ws + OFF_BTC) + ((size_t)b * 512 + nt * 128) * 512;
      size_t o = (size_t)tok0 * 1024 + nt * 128;
      gemm_tile<false>(A, 512, nullptr, 0, B, 512, 512, EpGate{(u16*)(p.ws + OFF_U) + o, (const u16*)(p.ws + OFF_GBUF) + o, 1024}, smem);
    }
  }
}

template <int LAYER> DEV void p_outproj(const Params& p, char* smem) {
  const u16* Aall = (const u16*)(p.ws + (LAYER == 0 ? OFF_U : OFF_U1));
  const u16* W = (const u16*)(p.ws + (LAYER == 0 ? OFF_WOUTT : OFF_RWOUTT));
  const float* mods = (const float*)(p.ws + OFF_MODS);
  for (int t = blockIdx.x; t < 1024; t += gridDim.x) {
    int mt = t >> 3, nt = t & 7, m0 = mt * 128, n0 = nt * 128;
    const float* xs;
    if (LAYER == 0) xs = (m0 < T_CTX ? p.x_prompt + (size_t)m0 * 1024 : p.x_sample + (size_t)(m0 - T_CTX) * 1024) + n0;
    else xs = p.out + (size_t)m0 * 1024 + n0;
    const float* gate = mods + (LAYER * 3 + mv_of(m0)) * 3072 + 2048 + n0;
    gemm_tile<false>(Aall + (size_t)m0 * 1024, 1024, nullptr, m0, W + (size_t)n0 * 1024, 1024, 1024,
                     EpRes{(u16*)(p.ws + (LAYER == 0 ? OFF_Y0B : OFF_Y1B)) + (size_t)m0 * 1024 + n0, xs, gate}, smem);
  }
}

DEV void p6b_dx(const Params& p) {
  const int lane = threadIdx.x & 63;
  const int gw = blockIdx.x * 4 + (threadIdx.x >> 6), nw = gridDim.x * 4;
  const u16* U = (const u16*)(p.ws + OFF_U1);
  u16* DX = (u16*)(p.ws + OFF_DX);
  for (int row = gw; row < 16384; row += nw) {
    const int l = row < T_CTX ? (row & 255) : ((row - T_CTX) & 4095);
    const int len = row < T_CTX ? 256 : 4096;
    const float pf = l > 0 ? 1.f : 0.f, nf = l + 1 < len ? 1.f : 0.f;
    const u16* uc = U + (size_t)row * 1024 + lane * 16;
    const u16* up = l > 0 ? uc - 1024 : uc;
    const u16* un = l + 1 < len ? uc + 1024 : uc;
#pragma unroll
    for (int hlf = 0; hlf < 2; hlf++) {
      uint4 c = *(const uint4*)(uc + 8 * hlf), a = *(const uint4*)(up + 8 * hlf), n = *(const uint4*)(un + 8 * hlf);
      const unsigned cu[4] = {c.x, c.y, c.z, c.w}, au[4] = {a.x, a.y, a.z, a.w}, nu[4] = {n.x, n.y, n.z, n.w};
      unsigned o[4];
#pragma unroll
      for (int q = 0; q < 4; q++)
        o[q] = pack2(0.5f * (bflo(au[q]) * pf + bflo(nu[q]) * nf) - bflo(cu[q]), 0.5f * (bfhi(au[q]) * pf + bfhi(nu[q]) * nf) - bfhi(cu[q]));
      *(uint4*)(DX + (size_t)row * 1024 + lane * 16 + 8 * hlf) = make_uint4(o[0], o[1], o[2], o[3]);
    }
  }
}

DEV void p7_rwkv_proj(const Params& p, char* smem) {
  const u16* U1 = (const u16*)(p.ws + OFF_U1);
  const int xcd = blockIdx.x & 7, jx = blockIdx.x >> 3, nbx = gridDim.x >> 3;
  for (int q = jx; q < 16 * 35; q += nbx) {
    int mt, nt;
    if (q < 512) { int st = q >> 6, w = q & 63; mt = xcd * 16 + (st >> 2) * 8 + (w >> 3); nt = (st & 3) * 8 + (w & 7); }
    else { int w = q - 512; mt = xcd * 16 + w / 3; nt = 32 + w % 3; }
    const int m0 = mt * 128;
    if (nt < 32) {
      int which = nt >> 3, n0 = (nt & 7) * 128;
      const u16* B = (const u16*)(p.ws + OFF_RKVZT) + (size_t)which * 1048576 + (size_t)n0 * 1024;
      if (which == 3) {
        gemm_tile<false>(U1 + (size_t)m0 * 1024, 1024, nullptr, m0, B, 1024, 1024,
                         EpStore<1>{(u16*)(p.ws + OFF_SZ) + (size_t)m0 * 1024 + n0, 1024, 1.f}, smem);
      } else {
        size_t off = which == 0 ? OFF_R : (which == 1 ? OFF_K2 : OFF_V2);
        const float* mu = p.mu + (which == 0 ? 0 : (which == 1 ? 2 : 3)) * 1024;
        gemm_tile<true>(U1, 1024, mu, m0, B, 1024, 1024, EpStore<0>{(u16*)(p.ws + off) + (size_t)m0 * 1024 + n0, 1024, 1.f}, smem);
      }
    } else {
      int w = nt - 32;
      if (w == 0)
        gemm_tile<true>(U1, 1024, p.mu + 1 * 1024, m0, (const u16*)(p.ws + OFF_W1T), 1024, 1024, EpStore<2>{(u16*)(p.ws + OFF_HW) + (size_t)m0 * 128, 128, 1.f}, smem);
      else if (w == 1)
        gemm_tile<true>(U1, 1024, p.mu + 4 * 1024, m0, (const u16*)(p.ws + OFF_A1T), 1024, 1024, EpStore<0>{(u16*)(p.ws + OFF_HA) + (size_t)m0 * 128, 128, 1.f}, smem);
      else
        gemm_tile<true>(U1, 1024, p.mu + 5 * 1024, m0, (const u16*)(p.ws + OFF_G1T), 1024, 1024, EpStore<3>{(u16*)(p.ws + OFF_HG) + (size_t)m0 * 128, 128, 1.f}, smem);
    }
  }
}

DEV b16x8 lds_perm(const u16* M, int ld, int row, int s, int hh) {
  const u16* q = M + row * ld + 16 * s + 4 * hh;
  uint2 lo = *(const uint2*)q, hi = *(const uint2*)(q + 8);
  u32x4 v = {lo.x, lo.y, hi.x, hi.y};
  return *(b16x8*)&v;
}
DEV b16x8 lds_norm(const u16* M, int ld, int row, int s, int hh) { return *(const b16x8*)(M + row * ld + 16 * s + 8 * hh); }
template <int OFF> DEV b16x8 pack8(const f32x16& a) {
  u32x4 v = {pack2(a[OFF], a[OFF + 1]), pack2(a[OFF + 2], a[OFF + 3]), pack2(a[OFF + 4], a[OFF + 5]), pack2(a[OFF + 6], a[OFF + 7])};
  return *(b16x8*)&v;
}
#define MFMA32(a, b, c) __builtin_amdgcn_mfma_f32_32x32x16_bf16(a, b, c, 0, 0, 0)

DEV int swz_idx(int row, int col) { return row * 40 + ((row >> 5) & 1) * 32 + ((((col >> 3) ^ (row >> 3)) & 3) << 3) + (col & 7); }
DEV b16x8 swz_norm(const u16* M, int row, int s, int hh) { return *(const b16x8*)(M + swz_idx(row, 16 * s + 8 * hh)); }
DEV b16x8 swz_perm(const u16* M, int row, int s, int hh) {
  uint2 lo = *(const uint2*)(M + swz_idx(row, 16 * s) + 4 * hh), hi = *(const uint2*)(M + swz_idx(row, 16 * s + 8) + 4 * hh);
  u32x4 v = {lo.x, lo.y, hi.x, hi.y};
  return *(b16x8*)&v;
}
struct ScanJob {
  int e, b, hd, tb, L, step0, nch, pq;
  int ncomb, seq;
  const float* zin;
  float* zout;
  u16* pout;
  float* qout;
};
DEV void scan_job(const Params& p, const ScanJob& J, char* smem) {
  float* sCum = (float*)smem;
  float* sAa = (float*)(smem + 8320);
  float* sNN = (float*)(smem + 8320);
  float* sT11 = (float*)(smem + 12544);
  float* sT22 = (float*)(smem + 13632);
  float* sWm = (float*)(smem + 14720);
  u16* AT = (u16*)(smem + 16640);
  u16* RT = (u16*)(smem + 21248);
  u16* BTl = (u16*)(smem + 25856);
  u16* KTl = (u16*)(smem + 30464);
  u16* BH = (u16*)(smem + 35072);
  u16* KH = (u16*)(smem + 40256);
  u16* VT = (u16*)(smem + 45440);
  u16* MkaT = (u16*)(smem + 50624);
  u16* MbrT = (u16*)(smem + 53184);
  u16* MkrT = (u16*)(smem + 55744);
  u16* TT = (u16*)(smem + 58304);
  float* gC = (float*)(smem + 60864);
  const int tid = threadIdx.x, wave = __builtin_amdgcn_readfirstlane(threadIdx.x >> 6);
  float* sKc = (float*)(smem + 61120);
  const int e = J.e, hd = J.hd, tb = J.tb, L = J.L, step0 = J.step0;
  const bool pq = J.pq != 0;
  const bool chainw = pq || wave < 2;
  const bool useV = pq ? (wave >= 2) : true;
  const int rb = wave & 1;
  const u16* HW = (const u16*)(p.ws + OFF_HW);
  const u16* HA = (const u16*)(p.ws + OFF_HA);
  const u16* Rb = (const u16*)(p.ws + OFF_R);
  const u16* Kb = (const u16*)(p.ws + OFF_K2);
  const u16* Vb = (const u16*)(p.ws + OFF_V2);
  float* Ysum = (float*)(p.ws + OFF_YSUM);
  float* Bsum = (float*)(p.ws + OFF_BSUM);
  const int arr = wave >> 1, ct = wave & 1;
  const u16* Xb = (arr ? HA : HW) + e * 64;
  b16x8 wf[4];
  {
    const int qi = tid & 31, hh = (tid >> 5) & 1;
    const u16* Wt = (const u16*)(p.ws + (arr ? OFF_A2T : OFF_W2T)) + (size_t)e * 65536 + (size_t)(hd * 64 + ct * 32 + qi) * 64 + hh * 8;
#pragma unroll
    for (int ks = 0; ks < 4; ks++) wf[ks] = ld16(Wt + ks * 16);
  }
  const float bias0 = (arr ? p.a0 : p.w0)[e * 1024 + hd * 64 + ct * 32 + (tid & 31)];
  if (tid < 64) { sKc[tid] = p.k_k[hd * 64 + tid]; sKc[64 + tid] = p.k_a[hd * 64 + tid]; sKc[128 + tid] = p.r_k[hd * 64 + tid]; }
  f32x16 z0, z1;
#pragma unroll
  for (int q = 0; q < 4; q++) {
    const int qi = tid & 31, hh = (tid >> 5) & 1;
    float4 v0 = make_float4(0, 0, 0, 0), v1 = v0;
    if (pq) {
      if (wave < 2) {
#pragma unroll
        for (int i = 0; i < 4; i++) {
          const int k = 8 * q + 4 * hh + i, col = rb * 32 + qi;
          ((float*)&v0)[i] = (k == col) ? 1.f : 0.f;
          ((float*)&v1)[i] = (k + 32 == col) ? 1.f : 0.f;
        }
      }
    } else if (J.zin && wave < 2) {
      const float* sp = J.zin + (size_t)(wave * 32 + qi) * 64 + 8 * q + 4 * hh;
      v0 = *(const float4*)sp; v1 = *(const float4*)(sp + 32);
    }
    z0[4 * q] = v0.x; z0[4 * q + 1] = v0.y; z0[4 * q + 2] = v0.z; z0[4 * q + 3] = v0.w;
    z1[4 * q] = v1.x; z1[4 * q + 1] = v1.y; z1[4 * q + 2] = v1.z; z1[4 * q + 3] = v1.w;
  }
  if (!pq && wave < 2) {
    const int qi = tid & 31, hh = (tid >> 5) & 1;
#pragma unroll 1
    for (int g = 0; g < J.ncomb; g++) {
      const u16* P = (const u16*)(p.ws + OFF_SEGP) + (size_t)(J.seq * 7 + g) * 4096;
      const float* Q = (const float*)(p.ws + OFF_SEGQ) + (size_t)(J.seq * 7 + g) * 4096;
      b16x8 zb[4] = {pack8<0>(z0), pack8<8>(z0), pack8<0>(z1), pack8<8>(z1)};
      f32x16 n0, n1;
#pragma unroll
      for (int q = 0; q < 4; q++) {
        const float* sp = Q + (size_t)(wave * 32 + qi) * 64 + 8 * q + 4 * hh;
        float4 v0 = *(const float4*)sp, v1 = *(const float4*)(sp + 32);
        n0[4 * q] = v0.x; n0[4 * q + 1] = v0.y; n0[4 * q + 2] = v0.z; n0[4 * q + 3] = v0.w;
        n1[4 * q] = v1.x; n1[4 * q + 1] = v1.y; n1[4 * q + 2] = v1.z; n1[4 * q + 3] = v1.w;
      }
#pragma unroll
      for (int s2 = 0; s2 < 4; s2++) {
        const u16* r0 = P + (size_t)qi * 64 + 16 * s2 + 4 * hh;
        const u16* r1 = P + (size_t)(32 + qi) * 64 + 16 * s2 + 4 * hh;
        uint2 a = *(const uint2*)r0, c = *(const uint2*)(r0 + 8), d = *(const uint2*)r1, f = *(const uint2*)(r1 + 8);
        u32x4 fa = {a.x, a.y, c.x, c.y}, fb = {d.x, d.y, f.x, f.y};
        n0 = MFMA32(*(b16x8*)&fa, zb[s2], n0);
        n1 = MFMA32(*(b16x8*)&fb, zb[s2], n1);
      }
      z0 = n0; z1 = n1;
    }
  }
  const int nch = J.nch;
  b16x8 xf[4];
  u32x4 kq, rq, vq;
  int tokC;
  {
    const int qi = tid & 31, hh = (tid >> 5) & 1, ci_ = tid >> 3, chg = hd * 64 + (tid & 7) * 8;
    const int tok0 = tb + (e ? L - step0 - 32 : step0);
    const int tokA = tok0 + (e ? 31 - qi : qi);
#pragma unroll
    for (int ks = 0; ks < 4; ks++) xf[ks] = ld16(Xb + (size_t)tokA * 128 + hh * 8 + ks * 16);
    tokC = tok0 + (e ? 31 - ci_ : ci_);
    kq = *(const u32x4*)(Kb + (size_t)tokC * 1024 + chg);
    rq = *(const u32x4*)(Rb + (size_t)tokC * 1024 + chg);
    vq = *(const u32x4*)(Vb + (size_t)tokC * 1024 + chg);
  }
#pragma unroll 1
  for (int ci = 0; ci < nch; ci++) {
    const int tok0 = tb + (e ? L - step0 - 32 * (ci + 1) : step0 + 32 * ci);
    const int tokn0 = tb + (e ? L - step0 - 32 * (ci + 2) : step0 + 32 * (ci + 1));
    const bool more = ci + 1 < nch;
    int tl = tid;
    asm volatile("" : "+v"(tl));
    const int lane = tl & 63, qi = lane & 31, hh = lane >> 5, ci_ = tl >> 3, cb = (tl & 7) * 8, chg = hd * 64 + cb;
    {
      f32x16 acc;
#pragma unroll
      for (int r = 0; r < 16; r++) acc[r] = 0.f;
#pragma unroll
      for (int ks = 0; ks < 4; ks++) acc = MFMA32(xf[ks], wf[ks], acc);
      if (more) {
        const int tokA = tokn0 + (e ? 31 - qi : qi);
#pragma unroll
        for (int ks = 0; ks < 4; ks++) xf[ks] = ld16(Xb + (size_t)tokA * 128 + hh * 8 + ks * 16);
      }
      const int ch = ct * 32 + qi;
      if (arr == 0) {
        float lw[16], gs[4], og[4];
#pragma unroll
        for (int r = 0; r < 16; r++) lw[r] = -0.606531f * sigm(acc[r] + bias0);
#pragma unroll
        for (int q = 0; q < 4; q++) { gs[q] = (lw[4 * q] + lw[4 * q + 1]) + (lw[4 * q + 2] + lw[4 * q + 3]); og[q] = __shfl_xor(gs[q], 32); }
        float pre = 0.f;
#pragma unroll
        for (int q = 0; q < 4; q++) {
          float run = pre + (hh ? og[q] : 0.f);
#pragma unroll
          for (int i = 0; i < 4; i++) { run += lw[4 * q + i]; sCum[(8 * q + 4 * hh + i) * 65 + ch] = run; }
          pre += gs[q] + og[q];
        }
      } else {
#pragma unroll
        for (int r = 0; r < 16; r++) {
          int row = (r & 3) + 8 * (r >> 2) + 4 * hh;
          sAa[row * 65 + ch] = sigm(acc[r] + bias0);
        }
      }
    }
    lds_barrier();
    {
      const int i = ci_;
      const unsigned ku[4] = {kq.x, kq.y, kq.z, kq.w}, ru[4] = {rq.x, rq.y, rq.z, rq.w}, vu[4] = {vq.x, vq.y, vq.z, vq.w};
      float k[8], r[8], kkr[8];
#pragma unroll
      for (int q = 0; q < 4; q++) {
        k[2 * q] = bflo(ku[q]); k[2 * q + 1] = bfhi(ku[q]);
        r[2 * q] = bflo(ru[q]); r[2 * q + 1] = bfhi(ru[q]);
      }
      float kkc[8], kac[8], rkc[8];
#pragma unroll
      for (int j = 0; j < 8; j++) { kkc[j] = sKc[cb + j]; kac[j] = sKc[64 + cb + j]; rkc[j] = sKc[128 + cb + j]; }
      float ss = 0;
#pragma unroll
      for (int j = 0; j < 8; j++) { kkr[j] = k[j] * kkc[j]; ss += kkr[j] * kkr[j]; }
      ss = allsum8(ss);
      const float inv = rsqrtf(ss + 1e-12f);
      float bon = 0;
      float oa[8], orr[8], ob[8], ok[8];
#pragma unroll
      for (int j = 0; j < 8; j++) {
        const float a = sAa[i * 65 + cb + j];
        const float cm = sCum[i * 65 + cb + j];
        const float cp = i > 0 ? sCum[(i - 1) * 65 + cb + j] : 0.f;
        const float cl = sCum[31 * 65 + cb + j];
        const float kd = k[j] * (1.f + (a - 1.f) * kac[j]);
        const float kk = kkr[j] * inv;
        const float bb = kk * a;
        bon += r[j] * kd * rkc[j];
        const float em = __expf(-cm), eC = __expf(cl - cm);
        oa[j] = -kk * __expf(cp);
        orr[j] = pq ? 0.f : r[j] * __expf(cm);
        ob[j] = bb * em;
        ok[j] = kd * em;
        BH[swz_idx(cb + j, i)] = f2bf(bb * eC);
        KH[swz_idx(cb + j, i)] = f2bf(kd * eC);
        if (i == 31) gC[cb + j] = __expf(cl);
      }
#pragma unroll
      for (int q = 0; q < 4; q++) {
        VT[swz_idx(cb + 2 * q, i)] = (u16)(vu[q] & 0xffffu);
        VT[swz_idx(cb + 2 * q + 1, i)] = (u16)(vu[q] >> 16);
      }
      *(u32x4*)(AT + i * 72 + cb) = u32x4{pack2(oa[0], oa[1]), pack2(oa[2], oa[3]), pack2(oa[4], oa[5]), pack2(oa[6], oa[7])};
      if (!pq) *(u32x4*)(RT + i * 72 + cb) = u32x4{pack2(orr[0], orr[1]), pack2(orr[2], orr[3]), pack2(orr[4], orr[5]), pack2(orr[6], orr[7])};
      *(u32x4*)(BTl + i * 72 + cb) = u32x4{pack2(ob[0], ob[1]), pack2(ob[2], ob[3]), pack2(ob[4], ob[5]), pack2(ob[6], ob[7])};
      *(u32x4*)(KTl + i * 72 + cb) = u32x4{pack2(ok[0], ok[1]), pack2(ok[2], ok[3]), pack2(ok[4], ok[5]), pack2(ok[6], ok[7])};
      bon = allsum8(bon);
      if (!pq && (tl & 7) == 0) atomicAdd(Bsum + (size_t)tokC * 16 + hd, 0.5f * bon);
      if (more) {
        tokC = tokn0 + (e ? 31 - ci_ : ci_);
        kq = *(const u32x4*)(Kb + (size_t)tokC * 1024 + chg);
        rq = *(const u32x4*)(Rb + (size_t)tokC * 1024 + chg);
        vq = *(const u32x4*)(Vb + (size_t)tokC * 1024 + chg);
      }
    }
    lds_barrier();
    if (!(pq && wave >= 2)) {
      const u16* Am = (wave < 2) ? AT : RT;
      const u16* Bm = (wave & 1) ? KTl : BTl;
      f32x16 acc;
#pragma unroll
      for (int r = 0; r < 16; r++) acc[r] = 0.f;
#pragma unroll
      for (int s = 0; s < 4; s++) acc = MFMA32(lds_norm(Am, 72, qi, s, hh), lds_norm(Bm, 72, qi, s, hh), acc);
      u16* dst = wave == 1 ? MkaT : (wave == 2 ? MbrT : MkrT);
#pragma unroll
      for (int r = 0; r < 16; r++) {
        const int tt = (r & 3) + 8 * (r >> 2) + 4 * hh, j = qi;
        const bool keep = (wave < 2) ? (j < tt) : (j <= tt);
        const float val = keep ? acc[r] : 0.f;
        if (wave == 0) sNN[j * 33 + tt] = val;
        else dst[tt * 40 + j] = f2bf(val);
      }
    }
    if (tl < 32) {
      const int i = tl & 15, base = (tl >> 4) * 16;
      float Tr[16];
#pragma unroll
      for (int q = 0; q < 16; q++) Tr[q] = (q == i) ? 1.f : 0.f;
#pragma unroll
      for (int q = 1; q < 16; q++) {
        float s0 = 0.f, s1 = 0.f, s2 = 0.f, s3 = 0.f;
#pragma unroll
        for (int j = 0; j < q; j++) {
          const float pr = Tr[j] * sNN[(base + j) * 33 + base + q];
          if ((j & 3) == 0) s0 += pr; else if ((j & 3) == 1) s1 += pr; else if ((j & 3) == 2) s2 += pr; else s3 += pr;
        }
        if (q > i) Tr[q] = (s0 + s1) + (s2 + s3);
      }
      float* sT = (tl >> 4) ? sT22 : sT11;
#pragma unroll
      for (int q = 0; q < 16; q++) { sT[i * 17 + q] = Tr[q]; TT[(base + q) * 40 + base + i] = f2bf(Tr[q]); }
    }
    lds_barrier();
    {
      const int i = tl >> 4, q = tl & 15;
      float s = 0.f;
#pragma unroll
      for (int j = 0; j < 16; j++) s += sT11[i * 17 + j] * sNN[j * 33 + 16 + q];
      sWm[i * 17 + q] = s;
      TT[i * 40 + 16 + q] = 0;
    }
    lds_barrier();
    {
      const int i = tl >> 4, q = tl & 15;
      float s = 0.f;
#pragma unroll
      for (int j = 0; j < 16; j++) s += sWm[i * 17 + j] * sT22[j * 17 + q];
      TT[(16 + q) * 40 + i] = f2bf(s);
    }
    lds_barrier();
    if (chainw) {
      const int vrow = rb * 32 + qi;
      b16x8 zb0 = pack8<0>(z0), zb1 = pack8<8>(z0), zb2 = pack8<0>(z1), zb3 = pack8<8>(z1);
      b16x8 vt0 = swz_norm(VT, vrow, 0, hh), vt1 = swz_norm(VT, vrow, 1, hh);
      f32x16 x;
#pragma unroll
      for (int r = 0; r < 16; r++) x[r] = 0.f;
      x = MFMA32(lds_perm(AT, 72, qi, 0, hh), zb0, x);
      x = MFMA32(lds_perm(AT, 72, qi, 1, hh), zb1, x);
      x = MFMA32(lds_perm(AT, 72, qi, 2, hh), zb2, x);
      x = MFMA32(lds_perm(AT, 72, qi, 3, hh), zb3, x);
      if (useV) {
        x = MFMA32(lds_norm(MkaT, 40, qi, 0, hh), vt0, x);
        x = MFMA32(lds_norm(MkaT, 40, qi, 1, hh), vt1, x);
      }
      f32x16 y;
#pragma unroll
      for (int r = 0; r < 16; r++) y[r] = 0.f;
      if (!pq) {
        y = MFMA32(lds_perm(RT, 72, qi, 0, hh), zb0, y);
        y = MFMA32(lds_perm(RT, 72, qi, 1, hh), zb1, y);
        y = MFMA32(lds_perm(RT, 72, qi, 2, hh), zb2, y);
        y = MFMA32(lds_perm(RT, 72, qi, 3, hh), zb3, y);
        y = MFMA32(lds_norm(MkrT, 40, qi, 0, hh), vt0, y);
        y = MFMA32(lds_norm(MkrT, 40, qi, 1, hh), vt1, y);
      }
#pragma unroll
      for (int q = 0; q < 4; q++) {
        float4 g0 = *(const float4*)(gC + 8 * q + 4 * hh), g1 = *(const float4*)(gC + 32 + 8 * q + 4 * hh);
        z0[4 * q] *= g0.x; z0[4 * q + 1] *= g0.y; z0[4 * q + 2] *= g0.z; z0[4 * q + 3] *= g0.w;
        z1[4 * q] *= g1.x; z1[4 * q + 1] *= g1.y; z1[4 * q + 2] *= g1.z; z1[4 * q + 3] *= g1.w;
      }
      if (useV) {
        z0 = MFMA32(swz_norm(KH, qi, 0, hh), vt0, z0);
        z0 = MFMA32(swz_norm(KH, qi, 1, hh), vt1, z0);
        z1 = MFMA32(swz_norm(KH, 32 + qi, 0, hh), vt0, z1);
        z1 = MFMA32(swz_norm(KH, 32 + qi, 1, hh), vt1, z1);
      }
      b16x8 xb0 = pack8<0>(x), xb1 = pack8<8>(x);
      f32x16 u;
#pragma unroll
      for (int r = 0; r < 16; r++) u[r] = 0.f;
      u = MFMA32(lds_perm(TT, 40, qi, 0, hh), xb0, u);
      u = MFMA32(lds_perm(TT, 40, qi, 1, hh), xb1, u);
      b16x8 ub0 = pack8<0>(u), ub1 = pack8<8>(u);
      z0 = MFMA32(swz_perm(BH, qi, 0, hh), ub0, z0);
      z0 = MFMA32(swz_perm(BH, qi, 1, hh), ub1, z0);
      z1 = MFMA32(swz_perm(BH, 32 + qi, 0, hh), ub0, z1);
      z1 = MFMA32(swz_perm(BH, 32 + qi, 1, hh), ub1, z1);
      if (!pq) {
        y = MFMA32(lds_perm(MbrT, 40, qi, 0, hh), ub0, y);
        y = MFMA32(lds_perm(MbrT, 40, qi, 1, hh), ub1, y);
#pragma unroll
        for (int r = 0; r < 16; r++) {
          const int st = (r & 3) + 8 * (r >> 2) + 4 * hh;
          const int tok = tok0 + (e ? 31 - st : st);
          atomicAdd(Ysum + (size_t)tok * 1024 + hd * 64 + vrow, y[r]);
        }
      }
    }
  }
  {
    const int qi = tid & 31, hh = (tid >> 5) & 1;
    if (pq) {
      if (wave < 2) {
#pragma unroll
        for (int r = 0; r < 16; r++) {
          const int k = (r & 3) + 8 * (r >> 2) + 4 * hh;
          J.pout[k * 64 + rb * 32 + qi] = f2bf(z0[r]);
          J.pout[(k + 32) * 64 + rb * 32 + qi] = f2bf(z1[r]);
        }
      } else {
#pragma unroll
        for (int q = 0; q < 4; q++) {
          float* sp = J.qout + (size_t)(rb * 32 + qi) * 64 + 8 * q + 4 * hh;
          *(float4*)sp = make_float4(z0[4 * q], z0[4 * q + 1], z0[4 * q + 2], z0[4 * q + 3]);
          *(float4*)(sp + 32) = make_float4(z1[4 * q], z1[4 * q + 1], z1[4 * q + 2], z1[4 * q + 3]);
        }
      }
    } else if (J.zout && wave < 2) {
#pragma unroll
      for (int q = 0; q < 4; q++) {
        float* sp = J.zout + (size_t)(wave * 32 + qi) * 64 + 8 * q + 4 * hh;
        *(float4*)sp = make_float4(z0[4 * q], z0[4 * q + 1], z0[4 * q + 2], z0[4 * q + 3]);
        *(float4*)(sp + 32) = make_float4(z1[4 * q], z1[4 * q + 1], z1[4 * q + 2], z1[4 * q + 3]);
      }
    }
  }
  __syncthreads();
}

DEV void scan_combine(const Params& p, int seq) {
  const int tid = threadIdx.x, wave = tid >> 6, qi = tid & 31, hh = (tid >> 5) & 1;
  if (wave >= 2) return;
  const int e = seq >> 5, b = (seq >> 4) & 1, hd = seq & 15;
  const float* zin = p.state_rwkv + ((size_t)(b * 2 + e) * 16 + hd) * 4096;
  f32x16 z0, z1;
#pragma unroll
  for (int q = 0; q < 4; q++) {
    const float* sp = zin + (size_t)(wave * 32 + qi) * 64 + 8 * q + 4 * hh;
    float4 v0 = *(const float4*)sp, v1 = *(const float4*)(sp + 32);
    z0[4 * q] = v0.x; z0[4 * q + 1] = v0.y; z0[4 * q + 2] = v0.z; z0[4 * q + 3] = v0.w;
    z1[4 * q] = v1.x; z1[4 * q + 1] = v1.y; z1[4 * q + 2] = v1.z; z1[4 * q + 3] = v1.w;
  }
#pragma unroll 1
  for (int g = 0; g < 7; g++) {
    const u16* P = (const u16*)(p.ws + OFF_SEGP) + (size_t)(seq * 7 + g) * 4096;
    const float* Q = (const float*)(p.ws + OFF_SEGQ) + (size_t)(seq * 7 + g) * 4096;
    b16x8 zb[4] = {pack8<0>(z0), pack8<8>(z0), pack8<0>(z1), pack8<8>(z1)};
    f32x16 n0, n1;
#pragma unroll
    for (int q = 0; q < 4; q++) {
      const float* sp = Q + (size_t)(wave * 32 + qi) * 64 + 8 * q + 4 * hh;
      float4 v0 = *(const float4*)sp, v1 = *(const float4*)(sp + 32);
      n0[4 * q] = v0.x; n0[4 * q + 1] = v0.y; n0[4 * q + 2] = v0.z; n0[4 * q + 3] = v0.w;
      n1[4 * q] = v1.x; n1[4 * q + 1] = v1.y; n1[4 * q + 2] = v1.z; n1[4 * q + 3] = v1.w;
    }
#pragma unroll
    for (int s = 0; s < 4; s++) {
      const u16* r0 = P + (size_t)qi * 64 + 16 * s + 4 * hh;
      const u16* r1 = P + (size_t)(32 + qi) * 64 + 16 * s + 4 * hh;
      uint2 a = *(const uint2*)r0, c = *(const uint2*)(r0 + 8), d = *(const uint2*)r1, f = *(const uint2*)(r1 + 8);
      u32x4 fa = {a.x, a.y, c.x, c.y}, fb = {d.x, d.y, f.x, f.y};
      n0 = MFMA32(*(b16x8*)&fa, zb[s], n0);
      n1 = MFMA32(*(b16x8*)&fb, zb[s], n1);
    }
    z0 = n0; z1 = n1;
    float* zs = (float*)(p.ws + OFF_SEGZ) + (size_t)(seq * 7 + g) * 4096;
#pragma unroll
    for (int q = 0; q < 4; q++) {
      float* sp = zs + (size_t)(wave * 32 + qi) * 64 + 8 * q + 4 * hh;
      *(float4*)sp = make_float4(z0[4 * q], z0[4 * q + 1], z0[4 * q + 2], z0[4 * q + 3]);
      *(float4*)(sp + 32) = make_float4(z1[4 * q], z1[4 * q + 1], z1[4 * q + 2], z1[4 * q + 3]);
    }
  }
}

DEV ScanJob ctx_job(const Params& p, int v) {
  ScanJob J;
  J.e = v >> 9; J.b = (v >> 4) & 31; J.hd = v & 15; J.tb = J.b * 256; J.L = 256; J.step0 = 0; J.nch = 8; J.pq = 0;
  J.zin = nullptr; J.zout = p.out + OUT_ST + ((size_t)(J.b * 2 + J.e) * 16 + J.hd) * 4096; J.pout = nullptr; J.qout = nullptr;
  J.ncomb = 0; J.seq = 0;
  return J;
}
DEV ScanJob smp_job(const Params& p, int seq, int g, int pq) {
  ScanJob J;
  J.e = seq >> 5; J.b = (seq >> 4) & 1; J.hd = seq & 15; J.tb = T_CTX + J.b * 4096; J.L = 4096; J.step0 = g * 512; J.nch = 16; J.pq = pq;
  J.zin = p.state_rwkv + ((size_t)(J.b * 2 + J.e) * 16 + J.hd) * 4096;
  J.ncomb = pq ? 0 : g; J.seq = seq;
  J.zout = nullptr;
  J.pout = (u16*)(p.ws + OFF_SEGP) + (size_t)(seq * 7 + g) * 4096;
  J.qout = (float*)(p.ws + OFF_SEGQ) + (size_t)(seq * 7 + g) * 4096;
  return J;
}

DEV void p8a_scan(const Params& p, char* smem) {
  if (blockIdx.x < 448) {
    for (int j = blockIdx.x; j < 448; j += 448) scan_job(p, smp_job(p, j / 7, j % 7, 1), smem);
  } else {
    {
      float4* ys = (float4*)(p.ws + OFF_YSUM);
      float4* bs = (float4*)(p.ws + OFF_BSUM);
      const size_t gt = (size_t)(blockIdx.x - 448) * 256 + threadIdx.x, gs = (size_t)(gridDim.x - 448) * 256;
      for (size_t i = gt; i < 4194304; i += gs) ys[i] = make_float4(0, 0, 0, 0);
      for (size_t i = gt; i < 65536; i += gs) bs[i] = make_float4(0, 0, 0, 0);
    }
    for (int q = blockIdx.x - 448; q < 1024; q += gridDim.x - 448) {
      int mt = q >> 3, nt = q & 7, m0 = mt * 128, n0 = nt * 128;
      u16* sz = (u16*)(p.ws + OFF_SZ) + (size_t)m0 * 1024 + n0;
      gemm_tile<false>((const u16*)(p.ws + OFF_HG) + (size_t)m0 * 128, 128, nullptr, m0, (const u16*)(p.ws + OFF_G2T) + (size_t)n0 * 128, 128, 128,
                       EpGate{sz, sz, 1024}, smem);
    }
  }
}
DEV void p8b_scan(const Params& p, char* smem) {
  if (blockIdx.x < 64) scan_combine(p, blockIdx.x);
}
DEV void p8c_scan(const Params& p, char* smem) {
  for (int j = blockIdx.x; j < 512 + 1024; j += gridDim.x) {
    if (j < 512) scan_job(p, smp_job(p, j >> 3, j & 7, 0), smem);
    else scan_job(p, ctx_job(p, j - 512), smem);
  }
}

DEV void p9_post(const Params& p) {
  const int lane = threadIdx.x & 63;
  const int gw = blockIdx.x * 4 + (threadIdx.x >> 6), nw = gridDim.x * 4;
  const float* Ysum = (const float*)(p.ws + OFF_YSUM);
  const float* Bsum = (const float*)(p.ws + OFF_BSUM);
  for (int row = gw; row < 16384; row += nw) {
    const size_t o = (size_t)row * 1024 + lane * 16;
    float y[16];
#pragma unroll
    for (int i = 0; i < 4; i++) { float4 v = *(const float4*)(Ysum + o + 4 * i); y[4 * i] = v.x; y[4 * i + 1] = v.y; y[4 * i + 2] = v.z; y[4 * i + 3] = v.w; }
    float s = 0;
#pragma unroll
    for (int i = 0; i < 16; i++) s += y[i];
    s += __shfl_xor(s, 1); s += __shfl_xor(s, 2);
    float mean = s * (1.f / 64.f), q = 0;
#pragma unroll
    for (int i = 0; i < 16; i++) { float d = y[i] - mean; q += d * d; }
    q += __shfl_xor(q, 1); q += __shfl_xor(q, 2);
    float rstd = rsqrtf(q * (1.f / 64.f) + 64e-5f);
    float bon = Bsum[(size_t)row * 16 + (lane >> 2)];
    u16* O = (u16*)(p.ws + OFF_U1) + o;
    const u16* V = (const u16*)(p.ws + OFF_V2) + o;
    const u16* Z = (const u16*)(p.ws + OFF_SZ) + o;
#pragma unroll
    for (int hlf = 0; hlf < 2; hlf++) {
      uint4 vq = *(const uint4*)(V + 8 * hlf), zq = *(const uint4*)(Z + 8 * hlf);
      const unsigned vu[4] = {vq.x, vq.y, vq.z, vq.w}, zu[4] = {zq.x, zq.y, zq.z, zq.w};
      unsigned ow[4];
#pragma unroll
      for (int w = 0; w < 4; w++) {
        int c = lane * 16 + hlf * 8 + 2 * w;
        float y0 = (y[hlf * 8 + 2 * w] - mean) * rstd * p.lnx_g[c] + p.lnx_b[c] + bon * bflo(vu[w]);
        float y1 = (y[hlf * 8 + 2 * w + 1] - mean) * rstd * p.lnx_g[c + 1] + p.lnx_b[c + 1] + bon * bfhi(vu[w]);
        ow[w] = pack2(y0 * bflo(zu[w]), y1 * bfhi(zu[w]));
      }
      *(uint4*)(O + 8 * hlf) = make_uint4(ow[0], ow[1], ow[2], ow[3]);
    }
  }
}


#define XB_TMO 128
#define XB_XCNT(j) (256 + 64 * (j))
#define XB_XSUB(j) (1280 + 64 * (j))
#define XB_XGEN(j) (2304 + 64 * (j))
#define XB_TOP 3328
#define XB_TOPGEN 3392
#define XCD_BAR_WORDS 3456
#define XB_SPIN_CAP (1u << 22)
#define LAS __attribute__((address_space(3)))
DEV unsigned xb_ld(unsigned* p) { return __hip_atomic_load(p, __ATOMIC_RELAXED, __HIP_MEMORY_SCOPE_AGENT); }
DEV unsigned xb_add(unsigned* p, unsigned v) { return __hip_atomic_fetch_add(p, v, __ATOMIC_RELAXED, __HIP_MEMORY_SCOPE_AGENT); }
DEV unsigned xb_xcc_id() { return (unsigned)__builtin_amdgcn_s_getreg((3 << 11) | 20) & 0xFu; }
#define XB_SPIN(cond, bar) do { unsigned _sp = 0; while (cond) { __builtin_amdgcn_s_sleep(4); \
    if ((++_sp & 255u) == 0u) { if (xb_ld(&(bar)[XB_TMO])) break; if (_sp > XB_SPIN_CAP) { atomicAdd(&(bar)[XB_TMO], 1u); break; } } } } while (0)
struct XcdBarrier { unsigned* bar; unsigned x; volatile LAS unsigned* st; };
DEV XcdBarrier xcd_barrier_post(unsigned* bar, volatile LAS unsigned* st) {
  XcdBarrier b; b.bar = bar; b.x = xb_xcc_id(); b.st = st;
  if (threadIdx.x == 0) (void)xb_add(&bar[XB_XCNT(b.x)], 1u);
  return b;
}
DEV void xcd_barrier_complete(unsigned* bar, unsigned x, unsigned& nloc, unsigned& nx) {
  const unsigned G = gridDim.x * gridDim.y * gridDim.z;
  unsigned sum, cnt, mine, sp = 0u;
  for (;;) {
    sum = 0u; cnt = 0u; mine = 0u;
#pragma unroll
    for (unsigned j = 0; j < 16; ++j) { const unsigned c = xb_ld(&bar[XB_XCNT(j)]); sum += c; cnt += (c > 0u) ? 1u : 0u; mine = (j == x) ? c : mine; }
    if (sum == G) break;
    __builtin_amdgcn_s_sleep(1);
    if ((++sp & 255u) == 0u) { if (xb_ld(&bar[XB_TMO])) break; if (sp > XB_SPIN_CAP) { atomicAdd(&bar[XB_TMO], 1u); break; } }
  }
  nloc = mine > 0u ? mine : 1u; nx = cnt > 0u ? cnt : 1u;
}
DEV void xcd_barrier(const XcdBarrier& b) {
  asm volatile("s_waitcnt vmcnt(0)" ::: "memory");
  __syncthreads();
  if (threadIdx.x == 0) {
    unsigned* bar = b.bar;
    __builtin_amdgcn_s_waitcnt(0);
    unsigned nloc = b.st[0], nx = b.st[1];
    if (nloc == 0u) { xcd_barrier_complete(bar, b.x, nloc, nx); b.st[0] = nloc; b.st[1] = nx; }
    const unsigned old = xb_add(&bar[XB_XSUB(b.x)], 1u);
    const unsigned gen = old / nloc;
    if (old + 1u == (gen + 1u) * nloc) {
      __builtin_amdgcn_fence(__ATOMIC_RELEASE, "agent");
      asm volatile("s_waitcnt vmcnt(0)" ::: "memory");
      const unsigned og = xb_add(&bar[XB_TOP], 1u);
      const unsigned tg = og / nx;
      if (og + 1u == (tg + 1u) * nx) xb_add(&bar[XB_TOPGEN], 1u);
      else XB_SPIN(xb_ld(&bar[XB_TOPGEN]) == tg, bar);
      __builtin_amdgcn_fence(__ATOMIC_ACQUIRE, "agent");
      xb_add(&bar[XB_XGEN(b.x)], 1u);
      asm volatile("s_waitcnt vmcnt(0)" ::: "memory");
    } else {
      XB_SPIN(xb_ld(&bar[XB_XGEN(b.x)]) == gen, bar);
      __builtin_amdgcn_fence(__ATOMIC_ACQUIRE, "agent");
      asm volatile("s_waitcnt vmcnt(0)" ::: "memory");
    }
  }
  __syncthreads();
}

__global__ void __launch_bounds__(256, 2) fwd_kernel(Params p) {
  __shared__ __attribute__((aligned(16))) char smem[73728];
#if FUSED
  __shared__ unsigned xb_st[4];
  if (threadIdx.x < 4) xb_st[threadIdx.x] = 0u;
  __syncthreads();
  const XcdBarrier xb = xcd_barrier_post((unsigned*)(p.ws + OFF_BAR), (volatile LAS unsigned*)xb_st);
  if (p.phase_hi > 1000) cg::this_grid().sync();
#define SYNC() xcd_barrier(xb)
#else
#define SYNC()
#endif
#define PH(n, call) if (p.phase_lo <= n && n <= p.phase_hi) { call; if (n < p.phase_hi) { SYNC(); } }
  PH(0, p0_prep(p, smem))
  PH(1, ln_phase<0>(p))
  PH(2, p2_gemm1(p, smem))
  PH(3, p3_mix(p, smem))
  PH(4, p3b_fold(p))
  PH(5, p4_fnet(p, smem))
  PH(6, p_outproj<0>(p, smem))
  PH(7, ln_phase<1>(p))
  PH(8, p6b_dx(p))
  PH(9, p7_rwkv_proj(p, smem))
  PH(10, p8a_scan(p, smem))
  PH(11, p8c_scan(p, smem))
  PH(12, p9_post(p))
  PH(13, p_outproj<1>(p, smem))
  PH(14, ln_phase<2>(p))
}

extern "C" void kernel_launch(void* const* d_in, const int* in_sizes, int n_in, void* d_out, int out_size, void* d_ws,
                              size_t ws_size, hipStream_t stream) {
  Params p;
  memset(&p, 0, sizeof(p));
  const float* const* in = (const float* const*)d_in;
  p.x_prompt = in[0]; p.x_sample = in[1]; p.cache_k = in[2]; p.cache_v = in[3]; p.state_rwkv = in[4]; p.c = in[5]; p.c_ctx = in[6];
  p.ada_w = in[7]; p.ada_b = in[8]; p.post_g = in[9]; p.post_b = in[10]; p.w_in = in[11]; p.w_fnet = in[12]; p.rpb = in[13]; p.w_out = in[14];
  p.mu = in[15]; p.rkvz = in[16]; p.w0 = in[17]; p.w1 = in[18]; p.w2 = in[19]; p.a0 = in[20]; p.a1 = in[21]; p.a2 = in[22];
  p.g1 = in[23]; p.g2 = in[24]; p.k_k = in[25]; p.k_a = in[26]; p.r_k = in[27]; p.lnx_g = in[28]; p.lnx_b = in[29]; p.rw_out = in[30];
  p.out = (float*)d_out; p.ws = (char*)d_ws;
  char* ws = (char*)d_ws;
  int n = 0, start = 0;
  auto add = [&](const float* src, size_t dstoff, int lds, int ldd, int tk, int tn) {
    p.tj[n].src = src; p.tj[n].dst = (u16*)(ws + dstoff); p.tj[n].lds = lds; p.tj[n].ldd = ldd; p.tj[n].tk = tk; p.tj[n].tn = tn;
    p.tj[n].start = start; p.tj[n].pad = 0; start += tk * tn; n++;
  };
  add(p.w_in, OFF_WINT, 3072, 1024, 16, 48);
  add(p.w_out, OFF_WOUTT, 1024, 1024, 16, 16);
  for (int i = 0; i < 4; i++) add(p.rkvz + (size_t)i * 1048576, OFF_RKVZT + (size_t)i * 2097152, 1024, 1024, 16, 16);
  add(p.rw_out, OFF_RWOUTT, 1024, 1024, 16, 16);
  for (int e = 0; e < 2; e++) add(p.w1 + e * 65536, OFF_W1T + (size_t)e * 64 * 1024 * 2, 64, 1024, 16, 1);
  for (int e = 0; e < 2; e++) add(p.a1 + e * 65536, OFF_A1T + (size_t)e * 64 * 1024 * 2, 64, 1024, 16, 1);
  add(p.g1, OFF_G1T, 128, 1024, 16, 2);
  for (int e = 0; e < 2; e++) add(p.w2 + e * 65536, OFF_W2T + (size_t)e * 65536 * 2, 1024, 64, 1, 16);
  for (int e = 0; e < 2; e++) add(p.a2 + e * 65536, OFF_A2T + (size_t)e * 65536 * 2, 1024, 64, 1, 16);
  add(p.g2, OFF_G2T, 1024, 128, 2, 16);
  for (int b = 0; b < 2; b++)
    for (int h = 0; h < 8; h++) add(p.cache_v + (size_t)b * 262144 + h * 64, OFF_CVT + (size_t)(b * 8 + h) * 64 * 512 * 2, 512, 512, 8, 1);
  p.ntr = start;

  static int grid_blocks = 0;
  if (!grid_blocks) {
    int dev = 0, cus = 0, per_cu = 0;
    (void)hipGetDevice(&dev);
    (void)hipDeviceGetAttribute(&cus, hipDeviceAttributeMultiprocessorCount, dev);
    (void)hipOccupancyMaxActiveBlocksPerMultiprocessor(&per_cu, fwd_kernel, 256, 0);
    if (per_cu > 2) per_cu = 2;
    if (per_cu < 1) per_cu = 1;
    grid_blocks = cus * per_cu;
  }
#if FUSED
  p.phase_lo = 0; p.phase_hi = 14;
  void* args[] = {&p};
  (void)hipMemsetAsync((char*)d_ws + OFF_BAR, 0, 16384, stream);
  hipError_t e = hipLaunchCooperativeKernel((void*)fwd_kernel, dim3(grid_blocks), dim3(256), args, 0, stream);
  if (e != hipSuccess) fprintf(stderr, "cooperative launch failed: %s (grid %d)\n", hipGetErrorString(e), grid_blocks);
#else
#ifndef PROBE_SEQ
#define PROBE_SEQ 0,1,2,3,4,5,6,7,8,9,10,11,12,13,14
#endif
  const int seq[] = {PROBE_SEQ};
  for (int i = 0; i < (int)(sizeof(seq) / sizeof(int)); i++) {
    p.phase_lo = seq[i]; p.phase_hi = seq[i];
    fwd_kernel<<<grid_blocks, 256, 0, stream>>>(p);
  }
#endif
}
```

```cpp
#include <hip/hip_runtime.h>
#include <hip/hip_cooperative_groups.h>
#include <stdint.h>
#include <cstdio>
#include <cstring>
namespace cg = cooperative_groups;

#ifndef FUSED
#define FUSED 1
#endif

typedef unsigned short u16;
typedef __attribute__((ext_vector_type(8))) __bf16 b16x8;
typedef __attribute__((ext_vector_type(16))) float f32x16;
typedef __attribute__((ext_vector_type(4))) unsigned u32x4;
typedef __attribute__((ext_vector_type(2))) unsigned u32x2;
#define DEV __device__ __forceinline__

constexpr int T_CTX = 8192;
constexpr float ALPHA_DN = 1.41421356237f;
constexpr float LOG2E = 1.44269504089f;
constexpr size_t MiB = 1u << 20;
constexpr size_t OFF_MODS = 0, OFF_BAR = 512 * 1024, OFF_BSUM = 1 * MiB;
constexpr size_t OFF_FSMP = 2 * MiB, OFF_U = 66 * MiB, OFF_ABUF = 98 * MiB, OFF_Q = 114 * MiB, OFF_K = 130 * MiB;
constexpr size_t OFF_VTC = 146 * MiB, OFF_VTS = 154 * MiB, OFF_GBUF = 162 * MiB, OFF_BTC = 194 * MiB, OFF_BTS = 210 * MiB;
constexpr size_t OFF_WINT = 226 * MiB, OFF_WOUTT = 232 * MiB, OFF_MCAT = 234 * MiB, OFF_FCTX = 234 * MiB + 256 * 1024;
constexpr size_t OFF_CK = 234 * MiB + 512 * 1024, OFF_CVT = 235 * MiB + 512 * 1024;
constexpr size_t OFF_RKVZT = 237 * MiB, OFF_RWOUTT = 245 * MiB, OFF_W1T = 247 * MiB, OFF_A1T = OFF_W1T + 256 * 1024,
                 OFF_G1T = OFF_W1T + 512 * 1024, OFF_W2T = OFF_W1T + 768 * 1024, OFF_A2T = 248 * MiB,
                 OFF_G2T = 248 * MiB + 256 * 1024, OFF_HW = 248 * MiB + 512 * 1024;
constexpr size_t OFF_U1 = 2 * MiB, OFF_R = 34 * MiB, OFF_K2 = 66 * MiB, OFF_V2 = 98 * MiB, OFF_SZ = 130 * MiB,
                 OFF_YSUM = 162 * MiB, OFF_HA = 226 * MiB, OFF_HG = 230 * MiB;
constexpr size_t OFF_BFOLD = 98 * MiB;
constexpr size_t OFF_Y0B = 98 * MiB, OFF_Y1B = 34 * MiB;
constexpr size_t OFF_DX = 162 * MiB;
constexpr size_t OFF_SEGP = 2 * MiB, OFF_SEGQ = 6 * MiB, OFF_SEGZ = 14 * MiB;
constexpr size_t OUT_NK = 16777216, OUT_NV = 20971520, OUT_ST = 25165824;

constexpr int NTJ = 33;
struct TJob { const float* src; u16* dst; int lds, ldd, tk, tn, start, pad; };

struct Params {
  const float *x_prompt, *x_sample, *cache_k, *cache_v, *state_rwkv, *c, *c_ctx;
  const float *ada_w, *ada_b, *post_g, *post_b, *w_in, *w_fnet, *rpb, *w_out;
  const float *mu, *rkvz, *w0, *w1, *w2, *a0, *a1, *a2, *g1, *g2, *k_k, *k_a, *r_k, *lnx_g, *lnx_b, *rw_out;
  float* out; char* ws;
  int phase_lo, phase_hi, ntr, pad;
  TJob tj[NTJ];
};

typedef __attribute__((ext_vector_type(2))) __bf16 bf16x2_t;
typedef __attribute__((ext_vector_type(2))) float f32x2_t;
DEV unsigned pack2(float a, float b) {
  f32x2_t f = {a, b};
  bf16x2_t r = __builtin_convertvector(f, bf16x2_t);
  return *(unsigned*)&r;
}
DEV u16 f2bf(float f) { return (u16)(pack2(f, 0.f) & 0xffffu); }
DEV float bflo(unsigned w) { return __uint_as_float(w << 16); }
DEV float bfhi(unsigned w) { return __uint_as_float(w & 0xffff0000u); }
DEV float rcp_f(float x) { return __builtin_amdgcn_rcpf(x); }
DEV float sigm(float x) { return rcp_f(1.f + __expf(-x)); }
DEV float silu(float x) { return x * rcp_f(1.f + __expf(-x)); }
DEV float tanh_f(float x) { return 1.f - 2.f * rcp_f(__expf(2.f * x) + 1.f); }
DEV b16x8 ld16(const u16* p) { uint4 v = *(const uint4*)p; return *(b16x8*)&v; }
DEV b16x8 asb(uint4 v) { return *(b16x8*)&v; }
template <int CTRL> DEV float dpp_add(float x) {
  return x + __int_as_float(__builtin_amdgcn_update_dpp(0, __float_as_int(x), CTRL, 0xf, 0xf, true));
}
DEV float allsum8(float x) {
  x = dpp_add<0xB1>(x); x = dpp_add<0x4E>(x); x = dpp_add<0x141>(x);
  return x;
}
DEV float wave_sum(float x) {
  x = dpp_add<0xB1>(x); x = dpp_add<0x4E>(x); x = dpp_add<0x141>(x); x = dpp_add<0x140>(x);
  x += __shfl_xor(x, 16); x += __shfl_xor(x, 32);
  return x;
}
DEV float allsum16(float x) {
  x = dpp_add<0xB1>(x); x = dpp_add<0x4E>(x); x = dpp_add<0x124>(x); x = dpp_add<0x128>(x);
  return x;
}
DEV void lds_barrier() { asm volatile("s_waitcnt lgkmcnt(0)\n\ts_barrier" ::: "memory"); }
DEV int mv_of(int token) { return token < T_CTX ? 0 : 1 + ((token - T_CTX) >> 12); }

template <bool LERP, class EP>
DEV void gemm_tile(const u16* __restrict__ A, int lda, const float* __restrict__ mu, int m0,
                   const u16* __restrict__ B, int ldb, int K, EP ep, char* smem) {
  u16(*sA0)[72] = (u16(*)[72])smem;
  u16(*sB0)[72] = (u16(*)[72])(smem + 18432);
  u16(*sA1)[72] = (u16(*)[72])(smem + 36864);
  u16(*sB1)[72] = (u16(*)[72])(smem + 36864 + 18432);
  int tid = threadIdx.x;
  asm volatile("" : "+v"(tid));
  const int lane = tid & 63, wave = tid >> 6, wm = wave >> 1, wn = wave & 1;
  const int lr = tid >> 3, lk = (tid & 7) * 8;
  f32x16 acc[2][2];
#pragma unroll
  for (int i = 0; i < 2; i++)
#pragma unroll
    for (int j = 0; j < 2; j++)
#pragma unroll
      for (int r = 0; r < 16; r++) acc[i][j][r] = 0.f;
  u32x4 ra0[4], rb0[4], rp0[4], ra1[4], rb1[4], rp1[4];
  float4 mu00, mu01, mu10, mu11;
  const u16* DXp = nullptr;
  if constexpr (LERP) DXp = (const u16*)(A) + (OFF_DX - OFF_U1) / 2;
#define GLOAD(K0, RA, RB, RP, M0, M1)                                                     \
  {                                                                                       \
    _Pragma("unroll") for (int i = 0; i < 4; i++) {                                       \
      int r = lr + 32 * i;                                                                \
      if constexpr (LERP) {                                                               \
        RA[i] = *(const u32x4*)(A + (size_t)(m0 + r) * lda + (K0) + lk);                  \
        RP[i] = *(const u32x4*)(DXp + (size_t)(m0 + r) * lda + (K0) + lk);                \
      } else {                                                                            \
        RA[i] = *(const u32x4*)(A + (size_t)r * lda + (K0) + lk);                         \
      }                                                                                   \
      RB[i] = *(const u32x4*)(B + (size_t)r * ldb + (K0) + lk);                           \
    }                                                                                     \
    if constexpr (LERP) {                                                                 \
      M0 = *(const float4*)(mu + (K0) + lk);                                              \
      M1 = *(const float4*)(mu + (K0) + lk + 4);                                          \
    }                                                                                     \
  }
#define GSTORE(RA, RB, RP, M0, M1, sA, sB)                                                     \
  {                                                                                       \
    _Pragma("unroll") for (int i = 0; i < 4; i++) {                                       \
      int r = lr + 32 * i;                                                                \
      u32x4 av = RA[i];                                                                   \
      if constexpr (LERP) {                                                               \
        unsigned cu[4] = {RA[i].x, RA[i].y, RA[i].z, RA[i].w};                            \
        unsigned du[4] = {RP[i].x, RP[i].y, RP[i].z, RP[i].w};                            \
        float m[8] = {M0.x, M0.y, M0.z, M0.w, M1.x, M1.y, M1.z, M1.w};                    \
        unsigned o[4];                                                                    \
        _Pragma("unroll") for (int q = 0; q < 4; q++)                                     \
          o[q] = pack2(bflo(cu[q]) + bflo(du[q]) * m[2 * q], bfhi(cu[q]) + bfhi(du[q]) * m[2 * q + 1]); \
        av = u32x4{o[0], o[1], o[2], o[3]};                                               \
      }                                                                                   \
      *(u32x4*)&sA[r][lk] = av;                                                           \
      *(u32x4*)&sB[r][lk] = RB[i];                                                        \
    }                                                                                     \
  }
#define GCOMPUTE(sA, sB)                                                                  \
  {                                                                                       \
    _Pragma("unroll") for (int ks = 0; ks < 4; ks++) {                                    \
      b16x8 af[2], bf[2];                                                                 \
      _Pragma("unroll") for (int i = 0; i < 2; i++) {                                     \
        af[i] = *(const b16x8*)&sA[wm * 64 + i * 32 + (lane & 31)][ks * 16 + (lane >> 5) * 8]; \
        bf[i] = *(const b16x8*)&sB[wn * 64 + i * 32 + (lane & 31)][ks * 16 + (lane >> 5) * 8]; \
      }                                                                                   \
      _Pragma("unroll") for (int i = 0; i < 2; i++)                                       \
        _Pragma("unroll") for (int j = 0; j < 2; j++)                                     \
          acc[i][j] = __builtin_amdgcn_mfma_f32_32x32x16_bf16(af[i], bf[j], acc[i][j], 0, 0, 0); \
    }                                                                                     \
  }
#define GPIPE()                                                                           \
  {                                                                                       \
    __builtin_amdgcn_sched_group_barrier(0x100, 4, 0);                                    \
    _Pragma("unroll") for (int pi = 0; pi < 16; pi++) {                                   \
      __builtin_amdgcn_sched_group_barrier(0x008, 1, 0);                                  \
      __builtin_amdgcn_sched_group_barrier(0x100, 1, 0);                                  \
      __builtin_amdgcn_sched_group_barrier(0x002, 7, 0);                                  \
      __builtin_amdgcn_sched_group_barrier(0x200, 1, 0);                                  \
    }                                                                                     \
  }
  GLOAD(0, ra0, rb0, rp0, mu00, mu01);
  GLOAD(64, ra1, rb1, rp1, mu10, mu11);
  __syncthreads();
  GSTORE(ra0, rb0, rp0, mu00, mu01, sA0, sB0);
  if (128 < K) GLOAD(128, ra0, rb0, rp0, mu00, mu01);
  __syncthreads();
#pragma unroll 1
  for (int k0 = 0; k0 < K; k0 += 128) {
    GCOMPUTE(sA0, sB0);
    GSTORE(ra1, rb1, rp1, mu10, mu11, sA1, sB1);
    GPIPE();
    if (k0 + 192 < K) GLOAD(k0 + 192, ra1, rb1, rp1, mu10, mu11);
    __syncthreads();
    __builtin_amdgcn_s_setprio(1);
    GCOMPUTE(sA1, sB1);
    __builtin_amdgcn_s_setprio(0);
    if (k0 + 128 < K) {
      GSTORE(ra0, rb0, rp0, mu00, mu01, sA0, sB0);
      if (k0 + 256 < K) GLOAD(k0 + 256, ra0, rb0, rp0, mu00, mu01);
    }
    __syncthreads();
  }
#undef GLOAD
#undef GSTORE
#undef GCOMPUTE
#undef GPIPE
  __syncthreads();
  int tide = tid;
  asm volatile("" : "+v"(tide));
  const int lane_e = tide & 63, wv_e = tide >> 6, wm_e = wv_e >> 1, wn_e = wv_e & 1;
  u16* stg = (u16*)smem + wv_e * (64 * 72);
#pragma unroll
  for (int i = 0; i < 2; i++)
#pragma unroll
    for (int j = 0; j < 2; j++)
#pragma unroll
      for (int q = 0; q < 4; q++) {
        const int r = i * 32 + q * 8 + (lane_e >> 5) * 4, c = j * 32 + (lane_e & 31);
        const float v0 = acc[i][j][q * 4 + 0], v1 = acc[i][j][q * 4 + 1], v2 = acc[i][j][q * 4 + 2], v3 = acc[i][j][q * 4 + 3];
        ep.direct(wm_e * 64 + r, wn_e * 64 + c, v0, v1, v2, v3);
        if constexpr (EP::TRANS) {
          *(uint2*)(stg + c * 72 + r) = make_uint2(pack2(ep.act(v0), ep.act(v1)), pack2(ep.act(v2), ep.act(v3)));
        } else {
          const unsigned p01 = pack2(ep.act(v0), ep.act(v1)), p23 = pack2(ep.act(v2), ep.act(v3));
          stg[(r + 0) * 72 + c] = (u16)(p01 & 0xffffu); stg[(r + 1) * 72 + c] = (u16)(p01 >> 16);
          stg[(r + 2) * 72 + c] = (u16)(p23 & 0xffffu); stg[(r + 3) * 72 + c] = (u16)(p23 >> 16);
        }
      }
#pragma unroll
  for (int n = 0; n < 8; n++) {
    const int id = lane_e + 64 * n, rr = id >> 3, cc = (id & 7) * 8;
    const u32x4 v = *(const u32x4*)(stg + rr * 72 + cc);
    if constexpr (EP::TRANS) ep.store(wn_e * 64 + rr, wm_e * 64 + cc, v);
    else ep.store(wm_e * 64 + rr, wn_e * 64 + cc, v);
  }
}

template <int ACT> struct EpStore {
  static constexpr bool TRANS = false;
  u16* dst; int ld; float scale;
  DEV float act(float x) const {
    if (ACT == 1) return silu(x);
    if (ACT == 2) return tanh_f(x);
    if (ACT == 3) return sigm(x);
    if (ACT == 4) return x * scale;
    return x;
  }
  DEV void direct(int, int, float, float, float, float) const {}
  DEV void store(int R, int C, u32x4 v) const { *(u32x4*)(dst + (size_t)R * ld + C) = v; }
};
struct EpNull {
  static constexpr bool TRANS = false;
  DEV float act(float x) const { return x; }
  DEV void direct(int, int, float, float, float, float) const {}
  DEV void store(int, int, u32x4) const {}
};
struct EpKeep {
  static constexpr bool TRANS = false;
  u16* dst; int ld; float* f32dst; int ldf;
  DEV float act(float x) const { return x; }
  DEV void direct(int r, int c, float v0, float v1, float v2, float v3) const {
    if (f32dst) {
      f32dst[(size_t)(r + 0) * ldf + c] = v0; f32dst[(size_t)(r + 1) * ldf + c] = v1;
      f32dst[(size_t)(r + 2) * ldf + c] = v2; f32dst[(size_t)(r + 3) * ldf + c] = v3;
    }
  }
  DEV void store(int R, int C, u32x4 v) const { *(u32x4*)(dst + (size_t)R * ld + C) = v; }
};
struct EpTrans {
  static constexpr bool TRANS = true;
  u16* dst; size_t ldt; float* f32dst; int ldf;
  DEV float act(float x) const { return x; }
  DEV void direct(int r, int c, float v0, float v1, float v2, float v3) const {
    if (f32dst) {
      f32dst[(size_t)(r + 0) * ldf + c] = v0; f32dst[(size_t)(r + 1) * ldf + c] = v1;
      f32dst[(size_t)(r + 2) * ldf + c] = v2; f32dst[(size_t)(r + 3) * ldf + c] = v3;
    }
  }
  DEV void store(int Rc, int Cr, u32x4 v) const { *(u32x4*)(dst + (size_t)Rc * ldt + Cr) = v; }
};
struct EpGate {
  static constexpr bool TRANS = false;
  u16* dst; const u16* gate; int ld;
  DEV float act(float x) const { return x; }
  DEV void direct(int, int, float, float, float, float) const {}
  DEV void store(int R, int C, u32x4 v) const {
    const size_t o = (size_t)R * ld + C;
    const u32x4 g = *(const u32x4*)(gate + o);
    u32x4 r;
    r.x = pack2(bflo(v.x) * bflo(g.x), bfhi(v.x) * bfhi(g.x)); r.y = pack2(bflo(v.y) * bflo(g.y), bfhi(v.y) * bfhi(g.y));
    r.z = pack2(bflo(v.z) * bflo(g.z), bfhi(v.z) * bfhi(g.z)); r.w = pack2(bflo(v.w) * bflo(g.w), bfhi(v.w) * bfhi(g.w));
    *(u32x4*)(dst + o) = r;
  }
};
struct EpRes {
  static constexpr bool TRANS = false;
  u16* dst; const float* xsrc; const float* gate;
  DEV float act(float x) const { return x; }
  DEV void direct(int, int, float, float, float, float) const {}
  DEV void store(int R, int C, u32x4 v) const {
    const size_t o = (size_t)R * 1024 + C;
    const float4 x0 = *(const float4*)(xsrc + o), x1 = *(const float4*)(xsrc + o + 4);
    const float4 g0 = *(const float4*)(gate + C), g1 = *(const float4*)(gate + C + 4);
    u32x4 r;
    r.x = pack2(ALPHA_DN * x0.x + (1.f + g0.x) * bflo(v.x), ALPHA_DN * x0.y + (1.f + g0.y) * bfhi(v.x));
    r.y = pack2(ALPHA_DN * x0.z + (1.f + g0.z) * bflo(v.y), ALPHA_DN * x0.w + (1.f + g0.w) * bfhi(v.y));
    r.z = pack2(ALPHA_DN * x1.x + (1.f + g1.x) * bflo(v.z), ALPHA_DN * x1.y + (1.f + g1.y) * bfhi(v.z));
    r.w = pack2(ALPHA_DN * x1.z + (1.f + g1.z) * bflo(v.w), ALPHA_DN * x1.w + (1.f + g1.w) * bfhi(v.w));
    *(u32x4*)(dst + o) = r;
  }
};

DEV void p0_prep(const Params& p, char* smem) {
  const int tid = threadIdx.x;
  const int njobs = 192 + p.ntr;
  for (int job = blockIdx.x; job < njobs; job += gridDim.x) {
    __syncthreads();
    if (job < 192) {
      float* sc = (float*)smem;
      float* red = sc + 3072;
      for (int i = tid; i < 3072; i += 256) {
        int m = i >> 10, k = i & 1023;
        float cv = m == 0 ? p.c_ctx[k] : p.c[(m - 1) * 1024 + k];
        sc[i] = silu(cv);
      }
      __syncthreads();
      int l = job / 96, col = (job % 96) * 32 + (tid & 31), ks = tid >> 5;
      const float* w = p.ada_w + (size_t)l * 1024 * 3072 + col;
      float a0 = 0, a1 = 0, a2 = 0;
#pragma unroll 8
      for (int k = ks * 128; k < ks * 128 + 128; k++) {
        float wv = w[(size_t)k * 3072];
        a0 += sc[k] * wv; a1 += sc[1024 + k] * wv; a2 += sc[2048 + k] * wv;
      }
      red[(ks * 32 + (tid & 31)) * 3 + 0] = a0; red[(ks * 32 + (tid & 31)) * 3 + 1] = a1; red[(ks * 32 + (tid & 31)) * 3 + 2] = a2;
      __syncthreads();
      if (tid < 96) {
        int cl = tid & 31, m = tid >> 5;
        float s = 0;
        for (int q = 0; q < 8; q++) s += red[(q * 32 + cl) * 3 + m];
        int cc = (job % 96) * 32 + cl;
        ((float*)(p.ws + OFF_MODS))[(l * 3 + m) * 3072 + cc] = s + p.ada_b[l * 3072 + cc];
      }
    } else {
      int tj = job - 192, e = 0;
      while (e + 1 < NTJ && p.tj[e + 1].start <= tj) e++;
      const TJob J = p.tj[e];
      int lt = tj - J.start, tkk = lt / J.tn, tnn = lt % J.tn;
      float(*tile)[65] = (float(*)[65])smem;
      const float* src = J.src + (size_t)(tkk * 64) * J.lds + tnn * 64;
#pragma unroll
      for (int i = 0; i < 4; i++) {
        int kk = (tid >> 4) + 16 * i, nn = (tid & 15) * 4;
        float4 v = *(const float4*)(src + (size_t)kk * J.lds + nn);
        tile[kk][nn] = v.x; tile[kk][nn + 1] = v.y; tile[kk][nn + 2] = v.z; tile[kk][nn + 3] = v.w;
      }
      __syncthreads();
      u16* dst = J.dst + (size_t)(tnn * 64) * J.ldd + tkk * 64;
#pragma unroll
      for (int i = 0; i < 2; i++) {
        int nn = (tid >> 3) + 32 * i, kk = (tid & 7) * 8;
        uint4 o;
        o.x = pack2(tile[kk][nn], tile[kk + 1][nn]); o.y = pack2(tile[kk + 2][nn], tile[kk + 3][nn]);
        o.z = pack2(tile[kk + 4][nn], tile[kk + 5][nn]); o.w = pack2(tile[kk + 6][nn], tile[kk + 7][nn]);
        *(uint4*)(dst + (size_t)nn * J.ldd + kk) = o;
      }
    }
  }
  const size_t gt = (size_t)blockIdx.x * 256 + tid, gs = (size_t)gridDim.x * 256;
  {
    u16* ck = (u16*)(p.ws + OFF_CK);
    for (size_t i = gt; i < 65536; i += gs) {
      float4 a = *(const float4*)(p.cache_k + i * 8), b = *(const float4*)(p.cache_k + i * 8 + 4);
      *(uint4*)(ck + i * 8) = make_uint4(pack2(a.x, a.y), pack2(a.z, a.w), pack2(b.x, b.y), pack2(b.z, b.w));
    }
  }
  {
    u16* fs = (u16*)(p.ws + OFF_FSMP);
    const float sc = 0.001381067932f;
    for (size_t i = gt; i < 2097152; i += gs) {
      int lp = (int)(i >> 9), j0 = (int)(i & 511) * 8;
      unsigned o[4];
#pragma unroll
      for (int q = 0; q < 4; q++) {
        float v[2];
#pragma unroll
        for (int z = 0; z < 2; z++) {
          int j = j0 + 2 * q + z;
          bool cs = j <= 2048;
          int ph = (lp * (cs ? j : j - 2048)) & 4095;
          float ang = (float)ph * (6.283185307179586f / 4096.f);
          v[z] = (cs ? __cosf(ang) : -__sinf(ang)) * sc;
        }
        o[q] = pack2(v[0], v[1]);
      }
      *(uint4*)(fs + i * 8) = make_uint4(o[0], o[1], o[2], o[3]);
    }
    u16* fc = (u16*)(p.ws + OFF_FCTX);
    const float sc2 = 0.005524271728f;
    for (size_t i = gt; i < 16384; i += gs) {
      int lp = (int)(i >> 6), j0 = (int)(i & 63) * 8;
      unsigned o[4];
#pragma unroll
      for (int q = 0; q < 4; q++) {
        float v[2];
#pragma unroll
        for (int z = 0; z < 2; z++) {
          int j = j0 + 2 * q + z;
          int ph = (lp * (j & 255)) & 255;
          float ang = (float)ph * (6.283185307179586f / 256.f);
          v[z] = (j < 256 ? __cosf(ang) : -__sinf(ang)) * sc2;
        }
        o[q] = pack2(v[0], v[1]);
      }
      *(uint4*)(fc + i * 8) = make_uint4(o[0], o[1], o[2], o[3]);
    }
  }
  {
    u16* mc = (u16*)(p.ws + OFF_MCAT);
    for (size_t i = gt; i < 131072; i += gs) {
      int c = (int)(i & 127), ep = (int)((i >> 7) & 255), g = (int)(i >> 15);
      const float* wf = p.w_fnet + (size_t)g * 16384 + (ep & 127);
      float s = 0;
      for (int cp = 0; cp < 128; cp++) {
        float ang = (float)((c * cp) & 127) * (6.283185307179586f / 128.f);
        float tw = ep < 128 ? __cosf(ang) : __sinf(ang);
        s += tw * wf[cp * 128];
      }
      mc[i] = f2bf(s);
    }
  }
}

DEV void ln_stats(const float4 (&x)[4], float& mean, float& rstd) {
  float s = 0;
#pragma unroll
  for (int i = 0; i < 4; i++) s += x[i].x + x[i].y + x[i].z + x[i].w;
  mean = wave_sum(s) * (1.f / 1024.f);
  float q = 0;
#pragma unroll
  for (int i = 0; i < 4; i++) {
    float a = x[i].x - mean, b = x[i].y - mean, c = x[i].z - mean, d = x[i].w - mean;
    q += a * a + b * b + c * c + d * d;
  }
  rstd = rsqrtf(wave_sum(q) * (1.f / 1024.f) + 1e-6f);
}

template <int MODE> DEV void ln_phase(const Params& p) {
  const int lane = threadIdx.x & 63;
  const int gw = blockIdx.x * 4 + (threadIdx.x >> 6), nw = gridDim.x * 4;
  const float* mods = (const float*)(p.ws + OFF_MODS);
  typedef __attribute__((ext_vector_type(4))) float f32x4v;
  f32x4v xn[4];
  u32x2 wn[4];
  auto fetch = [&](int row) {
    if (MODE == 0) {
      const float* src = row < T_CTX ? p.x_prompt + (size_t)row * 1024 : p.x_sample + (size_t)(row - T_CTX) * 1024;
#pragma unroll
      for (int i = 0; i < 4; i++) xn[i] = *(const f32x4v*)(src + lane * 4 + 256 * i);
    } else {
      const u16* sb = (const u16*)(p.ws + (MODE == 1 ? OFF_Y0B : OFF_Y1B)) + (size_t)row * 1024;
#pragma unroll
      for (int i = 0; i < 4; i++) wn[i] = *(const u32x2*)(sb + lane * 4 + 256 * i);
    }
  };
  if (gw < 16384) fetch(gw);
  for (int row = gw; row < 16384; row += nw) {
    float4 x[4];
#pragma unroll
    for (int i = 0; i < 4; i++) {
      if (MODE == 0) x[i] = make_float4(xn[i].x, xn[i].y, xn[i].z, xn[i].w);
      else x[i] = make_float4(bflo(wn[i].x), bfhi(wn[i].x), bflo(wn[i].y), bfhi(wn[i].y));
    }
    if (row + nw < 16384) fetch(row + nw);
    float mean, rstd;
    ln_stats(x, mean, rstd);
    if (MODE >= 1) {
      const float* g = p.post_g + (MODE == 1 ? 0 : 1024);
      const float* b = p.post_b + (MODE == 1 ? 0 : 1024);
      float* dst = p.out + (size_t)row * 1024;
#pragma unroll
      for (int i = 0; i < 4; i++) {
        float4 gv = *(const float4*)(g + lane * 4 + 256 * i), bv = *(const float4*)(b + lane * 4 + 256 * i);
        x[i].x = (x[i].x - mean) * rstd * gv.x + bv.x; x[i].y = (x[i].y - mean) * rstd * gv.y + bv.y;
        x[i].z = (x[i].z - mean) * rstd * gv.z + bv.z; x[i].w = (x[i].w - mean) * rstd * gv.w + bv.w;
        *(float4*)(dst + lane * 4 + 256 * i) = x[i];
      }
      if (MODE == 2) continue;
      ln_stats(x, mean, rstd);
    }
    const float* md = mods + ((MODE == 0 ? 0 : 3) + mv_of(row)) * 3072;
    u16* ud = (u16*)(p.ws + (MODE == 0 ? OFF_U : OFF_U1)) + (size_t)row * 1024;
#pragma unroll
    for (int i = 0; i < 4; i++) {
      int k = lane * 4 + 256 * i;
      float4 sh = *(const float4*)(md + k), sc = *(const float4*)(md + 1024 + k);
      float a = (x[i].x - mean) * rstd * (1.f + sc.x) + sh.x, b = (x[i].y - mean) * rstd * (1.f + sc.y) + sh.y;
      float c = (x[i].z - mean) * rstd * (1.f + sc.z) + sh.z, d = (x[i].w - mean) * rstd * (1.f + sc.w) + sh.w;
      *(uint2*)(ud + k) = make_uint2(pack2(a, b), pack2(c, d));
    }
  }
}

DEV void p2_gemm1(const Params& p, char* smem) {
  const u16* U = (const u16*)(p.ws + OFF_U);
  const u16* W = (const u16*)(p.ws + OFF_WINT);
  const int xcd = blockIdx.x & 7, jx = blockIdx.x >> 3, nbx = gridDim.x >> 3;
  for (int q = jx; q < 16 * 24; q += nbx) {
    int st = q >> 6, w = q & 63, sm = st / 3, sn = st % 3;
    int mt = xcd * 16 + sm * 8 + (w >> 3), nt = sn * 8 + (w & 7);
    int m0 = mt * 128, n0 = nt * 128, sec = nt >> 2, nc = (nt & 3) * 128;
    const u16* A = U + (size_t)m0 * 1024;
    const u16* B = W + (size_t)n0 * 1024;
    if (sec == 0) {
      gemm_tile<false>(A, 1024, nullptr, m0, B, 1024, 1024, EpStore<0>{(u16*)(p.ws + OFF_ABUF) + (size_t)m0 * 512 + nc, 512, 1.f}, smem);
    } else if (sec == 1 || sec == 5) {
      gemm_tile<false>(A, 1024, nullptr, m0, B, 1024, 1024,
                       EpStore<1>{(u16*)(p.ws + OFF_GBUF) + (size_t)m0 * 1024 + (sec == 5 ? 512 : 0) + nc, 1024, 1.f}, smem);
    } else if (sec == 2) {
      gemm_tile<false>(A, 1024, nullptr, m0, B, 1024, 1024, EpStore<4>{(u16*)(p.ws + OFF_Q) + (size_t)m0 * 512 + nc, 512, 0.125f * LOG2E}, smem);
    } else if (sec == 3) {
      float* f = m0 < T_CTX ? p.out + OUT_NK + (size_t)m0 * 512 + nc : nullptr;
      gemm_tile<false>(A, 1024, nullptr, m0, B, 1024, 1024, EpKeep{(u16*)(p.ws + OFF_K) + (size_t)m0 * 512 + nc, 512, f, 512}, smem);
    } else {
      float* f = m0 < T_CTX ? p.out + OUT_NV + (size_t)m0 * 512 + nc : nullptr;
      u16* d; size_t ldt;
      if (m0 < T_CTX) { int b = m0 >> 8, l = m0 & 255; ldt = 256; d = (u16*)(p.ws + OFF_VTC) + ((size_t)b * 512 + nc) * 256 + l; }
      else { int tt = m0 - T_CTX, b = tt >> 12, l = tt & 4095; ldt = 4096; d = (u16*)(p.ws + OFF_VTS) + ((size_t)b * 512 + nc) * 4096 + l; }
      gemm_tile<false>(A, 1024, nullptr, m0, B, 1024, 1024, EpTrans{d, ldt, f, 512}, smem);
    }
  }
}

struct AttnState { f32x16 o0, o1; float m, l; };

DEV void attn_tile(AttnState& st, const b16x8 (&qf)[4], const u16* kS, const u16* vS, int mode, int dr, int kc0, int c,
                   const float* rpbh, int qi, int hh) {
  f32x16 s;
#pragma unroll
  for (int r = 0; r < 16; r++) s[r] = 0.f;
#pragma unroll
  for (int ks = 0; ks < 4; ks++) s = __builtin_amdgcn_mfma_f32_32x32x16_bf16(*(const b16x8*)(kS + qi * 72 + ks * 16 + hh * 8), qf[ks], s, 0, 0, 0);
  if (mode) {
    int cs = min(max(c - 8, 0), 48);
#pragma unroll
    for (int r = 0; r < 16; r++) {
      int kc = kc0 + (r & 3) + 8 * (r >> 2) + 4 * hh;
      bool valid = (kc >= cs) && (kc < cs + 16);
      int dc = min(max(kc - c + 15, 0), 30);
      float bias = rpbh[dr * 31 + dc] * LOG2E;
      s[r] = valid ? s[r] + bias : -1e30f;
    }
  }
  float tm = s[0];
#pragma unroll
  for (int r = 1; r < 16; r++) tm = fmaxf(tm, s[r]);
  tm = fmaxf(tm, __shfl_xor(tm, 32));
  float mn = fmaxf(st.m, tm);
  float alpha = __builtin_amdgcn_exp2f(st.m - mn);
  st.m = mn;
  float ps = 0;
#pragma unroll
  for (int r = 0; r < 16; r++) { float e = __builtin_amdgcn_exp2f(s[r] - mn); ps += e; s[r] = e; }
  st.l = st.l * alpha + ps;
#pragma unroll
  for (int r = 0; r < 16; r++) { st.o0[r] *= alpha; st.o1[r] *= alpha; }
#pragma unroll
  for (int s2 = 0; s2 < 2; s2++) {
    u32x4 pw = {pack2(s[8 * s2 + 0], s[8 * s2 + 1]), pack2(s[8 * s2 + 2], s[8 * s2 + 3]),
                pack2(s[8 * s2 + 4], s[8 * s2 + 5]), pack2(s[8 * s2 + 6], s[8 * s2 + 7])};
    b16x8 pfr = *(b16x8*)&pw;
#pragma unroll
    for (int dt = 0; dt < 2; dt++) {
      const u16* vr = vS + (dt * 32 + qi) * 40 + 16 * s2 + 4 * hh;
      const uint2 lo = *(const uint2*)vr, hi = *(const uint2*)(vr + 8);
      u32x4 vw = {lo.x, lo.y, hi.x, hi.y};
      b16x8 vf = *(b16x8*)&vw;
      if (dt == 0) st.o0 = __builtin_amdgcn_mfma_f32_32x32x16_bf16(vf, pfr, st.o0, 0, 0, 0);
      else st.o1 = __builtin_amdgcn_mfma_f32_32x32x16_bf16(vf, pfr, st.o1, 0, 0, 0);
    }
  }
}

DEV void attn_unit(const Params& p, int u, int lane, char* smem) {
  const u16* Qb = (const u16*)(p.ws + OFF_Q);
  const u16* Kb = (const u16*)(p.ws + OFF_K);
  const int qi = lane & 31, hh = lane >> 5;
  u16* kS = (u16*)smem + (threadIdx.x >> 6) * 4864;
  u16* vS = kS + 32 * 72;
  bool smp = u < 2048;
  int b, h, qg, tq0, r = 0, c0 = 0;
  if (smp) { b = u >> 10; h = (u >> 7) & 7; qg = u & 127; tq0 = T_CTX + b * 4096 + qg * 32; r = qg >> 1; c0 = (qg & 1) * 32; }
  else { int v = u - 2048; b = v >> 6; h = (v >> 3) & 7; qg = v & 7; tq0 = b * 256 + qg * 32; }
  b16x8 qf[4];
#pragma unroll
  for (int s = 0; s < 4; s++) qf[s] = ld16(Qb + (size_t)(tq0 + qi) * 512 + h * 64 + s * 16 + hh * 8);
  AttnState st;
#pragma unroll
  for (int i = 0; i < 16; i++) { st.o0[i] = 0.f; st.o1[i] = 0.f; }
  st.m = -INFINITY; st.l = 0.f;
  const float* rpbh = p.rpb + h * 465;
  const int rs = min(max(r - 4, 0), 56);
  const u16* ck = (const u16*)(p.ws + OFF_CK) + (size_t)b * 512 * 512 + h * 64;
  const u16* cvt = (const u16*)(p.ws + OFF_CVT) + (size_t)(b * 8 + h) * 64 * 512;
  const u16* kls = Kb + (size_t)(T_CTX + b * 4096) * 512 + h * 64;
  const u16* vls = (const u16*)(p.ws + OFF_VTS) + (size_t)(b * 8 + h) * 64 * 4096;
  const u16* klc = Kb + (size_t)(b * 256) * 512 + h * 64;
  const u16* vlc = (const u16*)(p.ws + OFF_VTC) + (size_t)(b * 8 + h) * 64 * 256;
  const int ntile = smp ? 32 : 8;
  u32x4 kr[4], vr[4];
  auto issue = [&](int tt) {
    int ll = lane;
    asm volatile("" : "+v"(ll));
    const u16 *kp, *vp; int ldv;
    if (!smp) { kp = klc + (size_t)tt * 32 * 512; vp = vlc + tt * 32; ldv = 256; }
    else if (tt < 16) { kp = ck + (size_t)tt * 32 * 512; vp = cvt + tt * 32; ldv = 512; }
    else { int kt = tt - 16, krow = rs + (kt >> 1), kc0 = (kt & 1) * 32; kp = kls + (size_t)(krow * 64 + kc0) * 512; vp = vls + krow * 64 + kc0; ldv = 4096; }
#pragma unroll
    for (int n = 0; n < 4; n++) {
      const int id = ll + 64 * n;
      kr[n] = *(const u32x4*)(kp + (size_t)(id >> 3) * 512 + (id & 7) * 8);
      vr[n] = *(const u32x4*)(vp + (size_t)(id >> 2) * ldv + (id & 3) * 8);
    }
  };
  issue(0);
#pragma unroll 1
  for (int tt = 0; tt < ntile; tt++) {
    {
      int ll = lane;
      asm volatile("" : "+v"(ll));
#pragma unroll
      for (int n = 0; n < 4; n++) {
        const int id = ll + 64 * n;
        *(u32x4*)(kS + (id >> 3) * 72 + (id & 7) * 8) = kr[n];
        *(u32x4*)(vS + (id >> 2) * 40 + (id & 3) * 8) = vr[n];
      }
    }
    if (tt + 1 < ntile) issue(tt + 1);
    const bool loc = smp && tt >= 16;
    const int kt = tt - 16;
    attn_tile(st, qf, kS, vS, loc ? 1 : 0, loc ? rs + (kt >> 1) - r + 7 : 0, loc ? (kt & 1) * 32 : 0, c0 + qi, rpbh, qi, hh);
  }
  float lt = st.l + __shfl_xor(st.l, 32);
  float inv = 1.f / lt;
  const size_t rowo = (size_t)(tq0 + qi) * 1024 + 512 + h * 64;
  const u16* gb = (const u16*)(p.ws + OFF_GBUF) + rowo;
  u16* cat = (u16*)(p.ws + OFF_U) + rowo;
#pragma unroll
  for (int dt = 0; dt < 2; dt++)
#pragma unroll
    for (int q = 0; q < 4; q++) {
      int d = dt * 32 + q * 8 + hh * 4;
      uint2 g = *(const uint2*)(gb + d);
      float v0 = (dt ? st.o1[q * 4 + 0] : st.o0[q * 4 + 0]) * inv * bflo(g.x);
      float v1 = (dt ? st.o1[q * 4 + 1] : st.o0[q * 4 + 1]) * inv * bfhi(g.x);
      float v2 = (dt ? st.o1[q * 4 + 2] : st.o0[q * 4 + 2]) * inv * bflo(g.y);
      float v3 = (dt ? st.o1[q * 4 + 3] : st.o0[q * 4 + 3]) * inv * bfhi(g.y);
      *(uint2*)(cat + d) = make_uint2(pack2(v0, v1), pack2(v2, v3));
    }
}

DEV void p3_mix(const Params& p, char* smem) {
  for (int t = blockIdx.x; t < 2048; t += gridDim.x) {
    if (t < 1024) {
      __syncthreads();
      attn_unit(p, t * 4 + (threadIdx.x >> 6), threadIdx.x & 63, smem);
    } else {
      int q = t - 1024, mt = q >> 3, g = (q >> 1) & 3, nh = q & 1, m0 = mt * 128;
      const u16* A = (const u16*)(p.ws + OFF_ABUF) + (size_t)m0 * 512 + g * 128;
      const u16* B = (const u16*)(p.ws + OFF_MCAT) + (size_t)(g * 256 + nh * 128) * 128;
      u16* d; size_t ldt;
      if (m0 < T_CTX) { int b = m0 >> 8, l = m0 & 255; ldt = 512; d = (u16*)(p.ws + OFF_BTC) + ((size_t)b * 512 + g * 128) * 512 + nh * 256 + l; }
      else { int tt = m0 - T_CTX, b = tt >> 12, l = tt & 4095; ldt = 8192; d = (u16*)(p.ws + OFF_BTS) + ((size_t)b * 512 + g * 128) * 8192 + nh * 4096 + l; }
      gemm_tile<false>(A, 512, nullptr, m0, B, 128, 128, EpTrans{d, ldt, nullptr, 0}, smem);
    }
  }
}

DEV void p3b_fold(const Params& p) {
  const u16* bt = (const u16*)(p.ws + OFF_BTS);
  u16* bf = (u16*)(p.ws + OFF_BFOLD);
  const size_t gt = (size_t)blockIdx.x * 256 + threadIdx.x, gs = (size_t)gridDim.x * 256;
  for (size_t i = gt; i < 4194304; i += gs) {
    const int jj = (int)(i & 4095);
    const u16* row = bt + (i >> 12) * 8192;
    float v;
    if (jj <= 2048) {
      v = __uint_as_float((unsigned)row[jj] << 16);
      if (jj >= 1 && jj <= 2047) v += __uint_as_float((unsigned)row[4096 - jj] << 16);
    } else {
      const int j = jj - 2048;
      v = __uint_as_float((unsigned)row[4096 + j] << 16) - __uint_as_float((unsigned)row[8192 - j] << 16);
    }
    bf[i] = f2bf(v);
  }
}

DEV void p4_fnet(const Params& p, char* smem) {
  for (int t = blockIdx.x; t < 512; t += gridDim.x) {
    if (t < 256) {
      int b = t >> 7, mt = (t >> 2) & 31, nt = t & 3;
      int tok0 = T_CTX + b * 4096 + mt * 128;
      const u16* A = (const u16*)(p.ws + OFF_FSMP) + (size_t)(mt * 128) * 4096;
      const u16* B = (const u16*)(p.ws + OFF_BFOLD) + ((size_t)b * 512 + nt * 128) * 4096;
      size_t o = (size_t)tok0 * 1024 + nt * 128;
      gemm_tile<false>(A, 4096, nullptr, 0, B, 4096, 4096, EpGate{(u16*)(p.ws + OFF_U) + o, (const u16*)(p.ws + OFF_GBUF) + o, 1024}, smem);
    } else {
      int q = t - 256, b = q >> 3, mt = (q >> 2) & 1, nt = q & 3;
      int tok0 = b * 256 + mt * 128;
      const u16* A = (const u16*)(p.ws + OFF_FCTX) + (size_t)(mt * 128) * 512;
      const u16* B = (const u16*)(p.ws + OFF_BTC) + ((size_t)b * 512 + nt * 128) * 512;
      size_t o = (size_t)tok0 * 1024 + nt * 128;
      gemm_tile<false>(A, 512, nullptr, 0, B, 512, 512, EpGate{(u16*)(p.ws + OFF_U) + o, (const u16*)(p.ws + OFF_GBUF) + o, 1024}, smem);
    }
  }
}

template <int LAYER> DEV void p_outproj(const Params& p, char* smem) {
  const u16* Aall = (const u16*)(p.ws + (LAYER == 0 ? OFF_U : OFF_U1));
  const u16* W = (const u16*)(p.ws + (LAYER == 0 ? OFF_WOUTT : OFF_RWOUTT));
  const float* mods = (const float*)(p.ws + OFF_MODS);
  for (int t = blockIdx.x; t < 1024; t += gridDim.x) {
    int mt = t >> 3, nt = t & 7, m0 = mt * 128, n0 = nt * 128;
    const float* xs;
    if (LAYER == 0) xs = (m0 < T_CTX ? p.x_prompt + (size_t)m0 * 1024 : p.x_sample + (size_t)(m0 - T_CTX) * 1024) + n0;
    else xs = p.out + (size_t)m0 * 1024 + n0;
    const float* gate = mods + (LAYER * 3 + mv_of(m0)) * 3072 + 2048 + n0;
    gemm_tile<false>(Aall + (size_t)m0 * 1024, 1024, nullptr, m0, W + (size_t)n0 * 1024, 1024, 1024,
                     EpRes{(u16*)(p.ws + (LAYER == 0 ? OFF_Y0B : OFF_Y1B)) + (size_t)m0 * 1024 + n0, xs, gate}, smem);
  }
}

DEV void p6b_dx(const Params& p) {
  const int lane = threadIdx.x & 63;
  const int gw = blockIdx.x * 4 + (threadIdx.x >> 6), nw = gridDim.x * 4;
  const u16* U = (const u16*)(p.ws + OFF_U1);
  u16* DX = (u16*)(p.ws + OFF_DX);
  for (int row = gw; row < 16384; row += nw) {
    const int l = row < T_CTX ? (row & 255) : ((row - T_CTX) & 4095);
    const int len = row < T_CTX ? 256 : 4096;
    const float pf = l > 0 ? 1.f : 0.f, nf = l + 1 < len ? 1.f : 0.f;
    const u16* uc = U + (size_t)row * 1024 + lane * 16;
    const u16* up = l > 0 ? uc - 1024 : uc;
    const u16* un = l + 1 < len ? uc + 1024 : uc;
#pragma unroll
    for (int hlf = 0; hlf < 2; hlf++) {
      uint4 c = *(const uint4*)(uc + 8 * hlf), a = *(const uint4*)(up + 8 * hlf), n = *(const uint4*)(un + 8 * hlf);
      const unsigned cu[4] = {c.x, c.y, c.z, c.w}, au[4] = {a.x, a.y, a.z, a.w}, nu[4] = {n.x, n.y, n.z, n.w};
      unsigned o[4];
#pragma unroll
      for (int q = 0; q < 4; q++)
        o[q] = pack2(0.5f * (bflo(au[q]) * pf + bflo(nu[q]) * nf) - bflo(cu[q]), 0.5f * (bfhi(au[q]) * pf + bfhi(nu[q]) * nf) - bfhi(cu[q]));
      *(uint4*)(DX + (size_t)row * 1024 + lane * 16 + 8 * hlf) = make_uint4(o[0], o[1], o[2], o[3]);
    }
  }
}

DEV void p7_rwkv_proj(const Params& p, char* smem) {
  const u16* U1 = (const u16*)(p.ws + OFF_U1);
  const int xcd = blockIdx.x & 7, jx = blockIdx.x >> 3, nbx = gridDim.x >> 3;
  for (int q = jx; q < 16 * 35; q += nbx) {
    int mt, nt;
    if (q < 512) { int st = q >> 6, w = q & 63; mt = xcd * 16 + (st >> 2) * 8 + (w >> 3); nt = (st & 3) * 8 + (w & 7); }
    else { int w = q - 512; mt = xcd * 16 + w / 3; nt = 32 + w % 3; }
    const int m0 = mt * 128;
    if (nt < 32) {
      int which = nt >> 3, n0 = (nt & 7) * 128;
      const u16* B = (const u16*)(p.ws + OFF_RKVZT) + (size_t)which * 1048576 + (size_t)n0 * 1024;
      if (which == 3) {
        gemm_tile<false>(U1 + (size_t)m0 * 1024, 1024, nullptr, m0, B, 1024, 1024,
                         EpStore<1>{(u16*)(p.ws + OFF_SZ) + (size_t)m0 * 1024 + n0, 1024, 1.f}, smem);
      } else {
        size_t off = which == 0 ? OFF_R : (which == 1 ? OFF_K2 : OFF_V2);
        const float* mu = p.mu + (which == 0 ? 0 : (which == 1 ? 2 : 3)) * 1024;
        gemm_tile<true>(U1, 1024, mu, m0, B, 1024, 1024, EpStore<0>{(u16*)(p.ws + off) + (size_t)m0 * 1024 + n0, 1024, 1.f}, smem);
      }
    } else {
      int w = nt - 32;
      if (w == 0)
        gemm_tile<true>(U1, 1024, p.mu + 1 * 1024, m0, (const u16*)(p.ws + OFF_W1T), 1024, 1024, EpStore<2>{(u16*)(p.ws + OFF_HW) + (size_t)m0 * 128, 128, 1.f}, smem);
      else if (w == 1)
        gemm_tile<true>(U1, 1024, p.mu + 4 * 1024, m0, (const u16*)(p.ws + OFF_A1T), 1024, 1024, EpStore<0>{(u16*)(p.ws + OFF_HA) + (size_t)m0 * 128, 128, 1.f}, smem);
      else
        gemm_tile<true>(U1, 1024, p.mu + 5 * 1024, m0, (const u16*)(p.ws + OFF_G1T), 1024, 1024, EpStore<3>{(u16*)(p.ws + OFF_HG) + (size_t)m0 * 128, 128, 1.f}, smem);
    }
  }
}

DEV b16x8 lds_perm(const u16* M, int ld, int row, int s, int hh) {
  const u16* q = M + row * ld + 16 * s + 4 * hh;
  uint2 lo = *(const uint2*)q, hi = *(const uint2*)(q + 8);
  u32x4 v = {lo.x, lo.y, hi.x, hi.y};
  return *(b16x8*)&v;
}
DEV b16x8 lds_norm(const u16* M, int ld, int row, int s, int hh) { return *(const b16x8*)(M + row * ld + 16 * s + 8 * hh); }
template <int OFF> DEV b16x8 pack8(const f32x16& a) {
  u32x4 v = {pack2(a[OFF], a[OFF + 1]), pack2(a[OFF + 2], a[OFF + 3]), pack2(a[OFF + 4], a[OFF + 5]), pack2(a[OFF + 6], a[OFF + 7])};
  return *(b16x8*)&v;
}
#define MFMA32(a, b, c) __builtin_amdgcn_mfma_f32_32x32x16_bf16(a, b, c, 0, 0, 0)

DEV int swz_idx(int row, int col) { return row * 40 + ((row >> 5) & 1) * 32 + ((((col >> 3) ^ (row >> 3)) & 3) << 3) + (col & 7); }
DEV b16x8 swz_norm(const u16* M, int row, int s, int hh) { return *(const b16x8*)(M + swz_idx(row, 16 * s + 8 * hh)); }
DEV b16x8 swz_perm(const u16* M, int row, int s, int hh) {
  uint2 lo = *(const uint2*)(M + swz_idx(row, 16 * s) + 4 * hh), hi = *(const uint2*)(M + swz_idx(row, 16 * s + 8) + 4 * hh);
  u32x4 v = {lo.x, lo.y, hi.x, hi.y};
  return *(b16x8*)&v;
}
struct ScanJob {
  int e, b, hd, tb, L, step0, nch, pq;
  int ncomb, seq;
  const float* zin;
  float* zout;
  u16* pout;
  float* qout;
};
DEV void scan_job(const Params& p, const ScanJob& J, char* smem) {
  float* sCum = (float*)smem;
  float* sAa = (float*)(smem + 8320);
  float* sNN = (float*)(smem + 8320);
  float* sT11 = (float*)(smem + 12544);
  float* sT22 = (float*)(smem + 13632);
  float* sWm = (float*)(smem + 14720);
  u16* AT = (u16*)(smem + 16640);
  u16* RT = (u16*)(smem + 21248);
  u16* BTl = (u16*)(smem + 25856);
  u16* KTl = (u16*)(smem + 30464);
  u16* BH = (u16*)(smem + 35072);
  u16* KH = (u16*)(smem + 40256);
  u16* VT = (u16*)(smem + 45440);
  u16* MkaT = (u16*)(smem + 50624);
  u16* MbrT = (u16*)(smem + 53184);
  u16* MkrT = (u16*)(smem + 55744);
  u16* TT = (u16*)(smem + 58304);
  float* gC = (float*)(smem + 60864);
  const int tid = threadIdx.x, wave = __builtin_amdgcn_readfirstlane(threadIdx.x >> 6);
  float* sKc = (float*)(smem + 61120);
  const int e = J.e, hd = J.hd, tb = J.tb, L = J.L, step0 = J.step0;
  const bool pq = J.pq != 0;
  const bool chainw = pq || wave < 2;
  const bool useV = pq ? (wave >= 2) : true;
  const int rb = wave & 1;
  const u16* HW = (const u16*)(p.ws + OFF_HW);
  const u16* HA = (const u16*)(p.ws + OFF_HA);
  const u16* Rb = (const u16*)(p.ws + OFF_R);
  const u16* Kb = (const u16*)(p.ws + OFF_K2);
  const u16* Vb = (const u16*)(p.ws + OFF_V2);
  float* Ysum = (float*)(p.ws + OFF_YSUM);
  float* Bsum = (float*)(p.ws + OFF_BSUM);
  const int arr = wave >> 1, ct = wave & 1;
  const u16* Xb = (arr ? HA : HW) + e * 64;
  b16x8 wf[4];
  {
    const int qi = tid & 31, hh = (tid >> 5) & 1;
    const u16* Wt = (const u16*)(p.ws + (arr ? OFF_A2T : OFF_W2T)) + (size_t)e * 65536 + (size_t)(hd * 64 + ct * 32 + qi) * 64 + hh * 8;
#pragma unroll
    for (int ks = 0; ks < 4; ks++) wf[ks] = ld16(Wt + ks * 16);
  }
  const float bias0 = (arr ? p.a0 : p.w0)[e * 1024 + hd * 64 + ct * 32 + (tid & 31)];
  if (tid < 64) { sKc[tid] = p.k_k[hd * 64 + tid]; sKc[64 + tid] = p.k_a[hd * 64 + tid]; sKc[128 + tid] = p.r_k[hd * 64 + tid]; }
  f32x16 z0, z1;
#pragma unroll
  for (int q = 0; q < 4; q++) {
    const int qi = tid & 31, hh = (tid >> 5) & 1;
    float4 v0 = make_float4(0, 0, 0, 0), v1 = v0;
    if (pq) {
      if (wave < 2) {
#pragma unroll
        for (int i = 0; i < 4; i++) {
          const int k = 8 * q + 4 * hh + i, col = rb * 32 + qi;
          ((float*)&v0)[i] = (k == col) ? 1.f : 0.f;
          ((float*)&v1)[i] = (k + 32 == col) ? 1.f : 0.f;
        }
      }
    } else if (J.zin && wave < 2) {
      const float* sp = J.zin + (size_t)(wave * 32 + qi) * 64 + 8 * q + 4 * hh;
      v0 = *(const float4*)sp; v1 = *(const float4*)(sp + 32);
    }
    z0[4 * q] = v0.x; z0[4 * q + 1] = v0.y; z0[4 * q + 2] = v0.z; z0[4 * q + 3] = v0.w;
    z1[4 * q] = v1.x; z1[4 * q + 1] = v1.y; z1[4 * q + 2] = v1.z; z1[4 * q + 3] = v1.w;
  }
  if (!pq && wave < 2) {
    const int qi = tid & 31, hh = (tid >> 5) & 1;
#pragma unroll 1
    for (int g = 0; g < J.ncomb; g++) {
      const u16* P = (const u16*)(p.ws + OFF_SEGP) + (size_t)(J.seq * 7 + g) * 4096;
      const float* Q = (const float*)(p.ws + OFF_SEGQ) + (size_t)(J.seq * 7 + g) * 4096;
      b16x8 zb[4] = {pack8<0>(z0), pack8<8>(z0), pack8<0>(z1), pack8<8>(z1)};
      f32x16 n0, n1;
#pragma unroll
      for (int q = 0; q < 4; q++) {
        const float* sp = Q + (size_t)(wave * 32 + qi) * 64 + 8 * q + 4 * hh;
        float4 v0 = *(const float4*)sp, v1 = *(const float4*)(sp + 32);
        n0[4 * q] = v0.x; n0[4 * q + 1] = v0.y; n0[4 * q + 2] = v0.z; n0[4 * q + 3] = v0.w;
        n1[4 * q] = v1.x; n1[4 * q + 1] = v1.y; n1[4 * q + 2] = v1.z; n1[4 * q + 3] = v1.w;
      }
#pragma unroll
      for (int s2 = 0; s2 < 4; s2++) {
        const u16* r0 = P + (size_t)qi * 64 + 16 * s2 + 4 * hh;
        const u16* r1 = P + (size_t)(32 + qi) * 64 + 16 * s2 + 4 * hh;
        uint2 a = *(const uint2*)r0, c = *(const uint2*)(r0 + 8), d = *(const uint2*)r1, f = *(const uint2*)(r1 + 8);
        u32x4 fa = {a.x, a.y, c.x, c.y}, fb = {d.x, d.y, f.x, f.y};
        n0 = MFMA32(*(b16x8*)&fa, zb[s2], n0);
        n1 = MFMA32(*(b16x8*)&fb, zb[s2], n1);
      }
      z0 = n0; z1 = n1;
    }
  }
  const int nch = J.nch;
  b16x8 xf[4];
  u32x4 kq, rq, vq;
  int tokC;
  {
    const int qi = tid & 31, hh = (tid >> 5) & 1, ci_ = tid >> 3, chg = hd * 64 + (tid & 7) * 8;
    const int tok0 = tb + (e ? L - step0 - 32 : step0);
    const int tokA = tok0 + (e ? 31 - qi : qi);
#pragma unroll
    for (int ks = 0; ks < 4; ks++) xf[ks] = ld16(Xb + (size_t)tokA * 128 + hh * 8 + ks * 16);
    tokC = tok0 + (e ? 31 - ci_ : ci_);
    kq = *(const u32x4*)(Kb + (size_t)tokC * 1024 + chg);
    rq = *(const u32x4*)(Rb + (size_t)tokC * 1024 + chg);
    vq = *(const u32x4*)(Vb + (size_t)tokC * 1024 + chg);
  }
#pragma unroll 1
  for (int ci = 0; ci < nch; ci++) {
    const int tok0 = tb + (e ? L - step0 - 32 * (ci + 1) : step0 + 32 * ci);
    const int tokn0 = tb + (e ? L - step0 - 32 * (ci + 2) : step0 + 32 * (ci + 1));
    const bool more = ci + 1 < nch;
    int tl = tid;
    asm volatile("" : "+v"(tl));
    const int lane = tl & 63, qi = lane & 31, hh = lane >> 5, ci_ = tl >> 3, cb = (tl & 7) * 8, chg = hd * 64 + cb;
    {
      f32x16 acc;
#pragma unroll
      for (int r = 0; r < 16; r++) acc[r] = 0.f;
#pragma unroll
      for (int ks = 0; ks < 4; ks++) acc = MFMA32(xf[ks], wf[ks], acc);
      if (more) {
        const int tokA = tokn0 + (e ? 31 - qi : qi);
#pragma unroll
        for (int ks = 0; ks < 4; ks++) xf[ks] = ld16(Xb + (size_t)tokA * 128 + hh * 8 + ks * 16);
      }
      const int ch = ct * 32 + qi;
      if (arr == 0) {
        float lw[16], gs[4], og[4];
#pragma unroll
        for (int r = 0; r < 16; r++) lw[r] = -0.606531f * sigm(acc[r] + bias0);
#pragma unroll
        for (int q = 0; q < 4; q++) { gs[q] = (lw[4 * q] + lw[4 * q + 1]) + (lw[4 * q + 2] + lw[4 * q + 3]); og[q] = __shfl_xor(gs[q], 32); }
        float pre = 0.f;
#pragma unroll
        for (int q = 0; q < 4; q++) {
          float run = pre + (hh ? og[q] : 0.f);
#pragma unroll
          for (int i = 0; i < 4; i++) { run += lw[4 * q + i]; sCum[(8 * q + 4 * hh + i) * 65 + ch] = run; }
          pre += gs[q] + og[q];
        }
      } else {
#pragma unroll
        for (int r = 0; r < 16; r++) {
          int row = (r & 3) + 8 * (r >> 2) + 4 * hh;
          sAa[row * 65 + ch] = sigm(acc[r] + bias0);
        }
      }
    }
    lds_barrier();
    {
      const int i = ci_;
      const unsigned ku[4] = {kq.x, kq.y, kq.z, kq.w}, ru[4] = {rq.x, rq.y, rq.z, rq.w}, vu[4] = {vq.x, vq.y, vq.z, vq.w};
      float k[8], r[8], kkr[8];
#pragma unroll
      for (int q = 0; q < 4; q++) {
        k[2 * q] = bflo(ku[q]); k[2 * q + 1] = bfhi(ku[q]);
        r[2 * q] = bflo(ru[q]); r[2 * q + 1] = bfhi(ru[q]);
      }
      float kkc[8], kac[8], rkc[8];
#pragma unroll
      for (int j = 0; j < 8; j++) { kkc[j] = sKc[cb + j]; kac[j] = sKc[64 + cb + j]; rkc[j] = sKc[128 + cb + j]; }
      float ss = 0;
#pragma unroll
      for (int j = 0; j < 8; j++) { kkr[j] = k[j] * kkc[j]; ss += kkr[j] * kkr[j]; }
      ss = allsum8(ss);
      const float inv = rsqrtf(ss + 1e-12f);
      float bon = 0;
      float oa[8], orr[8], ob[8], ok[8];
#pragma unroll
      for (int j = 0; j < 8; j++) {
        const float a = sAa[i * 65 + cb + j];
        const float cm = sCum[i * 65 + cb + j];
        const float cp = i > 0 ? sCum[(i - 1) * 65 + cb + j] : 0.f;
        const float cl = sCum[31 * 65 + cb + j];
        const float kd = k[j] * (1.f + (a - 1.f) * kac[j]);
        const float kk = kkr[j] * inv;
        const float bb = kk * a;
        bon += r[j] * kd * rkc[j];
        const float em = __expf(-cm), eC = __expf(cl - cm);
        oa[j] = -kk * __expf(cp);
        orr[j] = pq ? 0.f : r[j] * __expf(cm);
        ob[j] = bb * em;
        ok[j] = kd * em;
        BH[swz_idx(cb + j, i)] = f2bf(bb * eC);
        KH[swz_idx(cb + j, i)] = f2bf(kd * eC);
        if (i == 31) gC[cb + j] = __expf(cl);
      }
#pragma unroll
      for (int q = 0; q < 4; q++) {
        VT[swz_idx(cb + 2 * q, i)] = (u16)(vu[q] & 0xffffu);
        VT[swz_idx(cb + 2 * q + 1, i)] = (u16)(vu[q] >> 16);
      }
      *(u32x4*)(AT + i * 72 + cb) = u32x4{pack2(oa[0], oa[1]), pack2(oa[2], oa[3]), pack2(oa[4], oa[5]), pack2(oa[6], oa[7])};
      if (!pq) *(u32x4*)(RT + i * 72 + cb) = u32x4{pack2(orr[0], orr[1]), pack2(orr[2], orr[3]), pack2(orr[4], orr[5]), pack2(orr[6], orr[7])};
      *(u32x4*)(BTl + i * 72 + cb) = u32x4{pack2(ob[0], ob[1]), pack2(ob[2], ob[3]), pack2(ob[4], ob[5]), pack2(ob[6], ob[7])};
      *(u32x4*)(KTl + i * 72 + cb) = u32x4{pack2(ok[0], ok[1]), pack2(ok[2], ok[3]), pack2(ok[4], ok[5]), pack2(ok[6], ok[7])};
      bon = allsum8(bon);
      if (!pq && (tl & 7) == 0) atomicAdd(Bsum + (size_t)tokC * 16 + hd, 0.5f * bon);
      if (more) {
        tokC = tokn0 + (e ? 31 - ci_ : ci_);
        kq = *(const u32x4*)(Kb + (size_t)tokC * 1024 + chg);
        rq = *(const u32x4*)(Rb + (size_t)tokC * 1024 + chg);
        vq = *(const u32x4*)(Vb + (size_t)tokC * 1024 + chg);
      }
    }
    lds_barrier();
    if (!(pq && wave >= 2)) {
      const u16* Am = (wave < 2) ? AT : RT;
      const u16* Bm = (wave & 1) ? KTl : BTl;
      f32x16 acc;
#pragma unroll
      for (int r = 0; r < 16; r++) acc[r] = 0.f;
#pragma unroll
      for (int s = 0; s < 4; s++) acc = MFMA32(lds_norm(Am, 72, qi, s, hh), lds_norm(Bm, 72, qi, s, hh), acc);
      u16* dst = wave == 1 ? MkaT : (wave == 2 ? MbrT : MkrT);
#pragma unroll
      for (int r = 0; r < 16; r++) {
        const int tt = (r & 3) + 8 * (r >> 2) + 4 * hh, j = qi;
        const bool keep = (wave < 2) ? (j < tt) : (j <= tt);
        const float val = keep ? acc[r] : 0.f;
        if (wave == 0) sNN[j * 33 + tt] = val;
        else dst[tt * 40 + j] = f2bf(val);
      }
    }
    if (tl < 32) {
      const int i = tl & 15, base = (tl >> 4) * 16;
      float Tr[16];
#pragma unroll
      for (int q = 0; q < 16; q++) Tr[q] = (q == i) ? 1.f : 0.f;
#pragma unroll
      for (int q = 1; q < 16; q++) {
        float s0 = 0.f, s1 = 0.f, s2 = 0.f, s3 = 0.f;
#pragma unroll
        for (int j = 0; j < q; j++) {
          const float pr = Tr[j] * sNN[(base + j) * 33 + base + q];
          if ((j & 3) == 0) s0 += pr; else if ((j & 3) == 1) s1 += pr; else if ((j & 3) == 2) s2 += pr; else s3 += pr;
        }
        if (q > i) Tr[q] = (s0 + s1) + (s2 + s3);
      }
      float* sT = (tl >> 4) ? sT22 : sT11;
#pragma unroll
      for (int q = 0; q < 16; q++) { sT[i * 17 + q] = Tr[q]; TT[(base + q) * 40 + base + i] = f2bf(Tr[q]); }
    }
    lds_barrier();
    {
      const int i = tl >> 4, q = tl & 15;
      float s = 0.f;
#pragma unroll
      for (int j = 0; j < 16; j++) s += sT11[i * 17 + j] * sNN[j * 33 + 16 + q];
      sWm[i * 17 + q] = s;
      TT[i * 40 + 16 + q] = 0;
    }
    lds_barrier();
    {
      const int i = tl >> 4, q = tl & 15;
      float s = 0.f;
#pragma unroll
      for (int j = 0; j < 16; j++) s += sWm[i * 17 + j] * sT22[j * 17 + q];
      TT[(16 + q) * 40 + i] = f2bf(s);
    }
    lds_barrier();
    if (chainw) {
      const int vrow = rb * 32 + qi;
      b16x8 zb0 = pack8<0>(z0), zb1 = pack8<8>(z0), zb2 = pack8<0>(z1), zb3 = pack8<8>(z1);
      b16x8 vt0 = swz_norm(VT, vrow, 0, hh), vt1 = swz_norm(VT, vrow, 1, hh);
      f32x16 x;
#pragma unroll
      for (int r = 0; r < 16; r++) x[r] = 0.f;
      x = MFMA32(lds_perm(AT, 72, qi, 0, hh), zb0, x);
      x = MFMA32(lds_perm(AT, 72, qi, 1, hh), zb1, x);
      x = MFMA32(lds_perm(AT, 72, qi, 2, hh), zb2, x);
      x = MFMA32(lds_perm(AT, 72, qi, 3, hh), zb3, x);
      if (useV) {
        x = MFMA32(lds_norm(MkaT, 40, qi, 0, hh), vt0, x);
        x = MFMA32(lds_norm(MkaT, 40, qi, 1, hh), vt1, x);
      }
      f32x16 y;
#pragma unroll
      for (int r = 0; r < 16; r++) y[r] = 0.f;
      if (!pq) {
        y = MFMA32(lds_perm(RT, 72, qi, 0, hh), zb0, y);
        y = MFMA32(lds_perm(RT, 72, qi, 1, hh), zb1, y);
        y = MFMA32(lds_perm(RT, 72, qi, 2, hh), zb2, y);
        y = MFMA32(lds_perm(RT, 72, qi, 3, hh), zb3, y);
        y = MFMA32(lds_norm(MkrT, 40, qi, 0, hh), vt0, y);
        y = MFMA32(lds_norm(MkrT, 40, qi, 1, hh), vt1, y);
      }
#pragma unroll
      for (int q = 0; q < 4; q++) {
        float4 g0 = *(const float4*)(gC + 8 * q + 4 * hh), g1 = *(const float4*)(gC + 32 + 8 * q + 4 * hh);
        z0[4 * q] *= g0.x; z0[4 * q + 1] *= g0.y; z0[4 * q + 2] *= g0.z; z0[4 * q + 3] *= g0.w;
        z1[4 * q] *= g1.x; z1[4 * q + 1] *= g1.y; z1[4 * q + 2] *= g1.z; z1[4 * q + 3] *= g1.w;
      }
      if (useV) {
        z0 = MFMA32(swz_norm(KH, qi, 0, hh), vt0, z0);
        z0 = MFMA32(swz_norm(KH, qi, 1, hh), vt1, z0);
        z1 = MFMA32(swz_norm(KH, 32 + qi, 0, hh), vt0, z1);
        z1 = MFMA32(swz_norm(KH, 32 + qi, 1, hh), vt1, z1);
      }
      b16x8 xb0 = pack8<0>(x), xb1 = pack8<8>(x);
      f32x16 u;
#pragma unroll
      for (int r = 0; r < 16; r++) u[r] = 0.f;
      u = MFMA32(lds_perm(TT, 40, qi, 0, hh), xb0, u);
      u = MFMA32(lds_perm(TT, 40, qi, 1, hh), xb1, u);
      b16x8 ub0 = pack8<0>(u), ub1 = pack8<8>(u);
      z0 = MFMA32(swz_perm(BH, qi, 0, hh), ub0, z0);
      z0 = MFMA32(swz_perm(BH, qi, 1, hh), ub1, z0);
      z1 = MFMA32(swz_perm(BH, 32 + qi, 0, hh), ub0, z1);
      z1 = MFMA32(swz_perm(BH, 32 + qi, 1, hh), ub1, z1);
      if (!pq) {
        y = MFMA32(lds_perm(MbrT, 40, qi, 0, hh), ub0, y);
        y = MFMA32(lds_perm(MbrT, 40, qi, 1, hh), ub1, y);
#pragma unroll
        for (int r = 0; r < 16; r++) {
          const int st = (r & 3) + 8 * (r >> 2) + 4 * hh;
          const int tok = tok0 + (e ? 31 - st : st);
          atomicAdd(Ysum + (size_t)tok * 1024 + hd * 64 + vrow, y[r]);
        }
      }
    }
  }
  {
    const int qi = tid & 31, hh = (tid >> 5) & 1;
    if (pq) {
      if (wave < 2) {
#pragma unroll
        for (int r = 0; r < 16; r++) {
          const int k = (r & 3) + 8 * (r >> 2) + 4 * hh;
          J.pout[k * 64 + rb * 32 + qi] = f2bf(z0[r]);
          J.pout[(k + 32) * 64 + rb * 32 + qi] = f2bf(z1[r]);
        }
      } else {
#pragma unroll
        for (int q = 0; q < 4; q++) {
          float* sp = J.qout + (size_t)(rb * 32 + qi) * 64 + 8 * q + 4 * hh;
          *(float4*)sp = make_float4(z0[4 * q], z0[4 * q + 1], z0[4 * q + 2], z0[4 * q + 3]);
          *(float4*)(sp + 32) = make_float4(z1[4 * q], z1[4 * q + 1], z1[4 * q + 2], z1[4 * q + 3]);
        }
      }
    } else if (J.zout && wave < 2) {
#pragma unroll
      for (int q = 0; q < 4; q++) {
        float* sp = J.zout + (size_t)(wave * 32 + qi) * 64 + 8 * q + 4 * hh;
        *(float4*)sp = make_float4(z0[4 * q], z0[4 * q + 1], z0[4 * q + 2], z0[4 * q + 3]);
        *(float4*)(sp + 32) = make_float4(z1[4 * q], z1[4 * q + 1], z1[4 * q + 2], z1[4 * q + 3]);
      }
    }
  }
  __syncthreads();
}

DEV void scan_combine(const Params& p, int seq) {
  const int tid = threadIdx.x, wave = tid >> 6, qi = tid & 31, hh = (tid >> 5) & 1;
  if (wave >= 2) return;
  const int e = seq >> 5, b = (seq >> 4) & 1, hd = seq & 15;
  const float* zin = p.state_rwkv + ((size_t)(b * 2 + e) * 16 + hd) * 4096;
  f32x16 z0, z1;
#pragma unroll
  for (int q = 0; q < 4; q++) {
    const float* sp = zin + (size_t)(wave * 32 + qi) * 64 + 8 * q + 4 * hh;
    float4 v0 = *(const float4*)sp, v1 = *(const float4*)(sp + 32);
    z0[4 * q] = v0.x; z0[4 * q + 1] = v0.y; z0[4 * q + 2] = v0.z; z0[4 * q + 3] = v0.w;
    z1[4 * q] = v1.x; z1[4 * q + 1] = v1.y; z1[4 * q + 2] = v1.z; z1[4 * q + 3] = v1.w;
  }
#pragma unroll 1
  for (int g = 0; g < 7; g++) {
    const u16* P = (const u16*)(p.ws + OFF_SEGP) + (size_t)(seq * 7 + g) * 4096;
    const float* Q = (const float*)(p.ws + OFF_SEGQ) + (size_t)(seq * 7 + g) * 4096;
    b16x8 zb[4] = {pack8<0>(z0), pack8<8>(z0), pack8<0>(z1), pack8<8>(z1)};
    f32x16 n0, n1;
#pragma unroll
    for (int q = 0; q < 4; q++) {
      const float* sp = Q + (size_t)(wave * 32 + qi) * 64 + 8 * q + 4 * hh;
      float4 v0 = *(const float4*)sp, v1 = *(const float4*)(sp + 32);
      n0[4 * q] = v0.x; n0[4 * q + 1] = v0.y; n0[4 * q + 2] = v0.z; n0[4 * q + 3] = v0.w;
      n1[4 * q] = v1.x; n1[4 * q + 1] = v1.y; n1[4 * q + 2] = v1.z; n1[4 * q + 3] = v1.w;
    }
#pragma unroll
    for (int s = 0; s < 4; s++) {
      const u16* r0 = P + (size_t)qi * 64 + 16 * s + 4 * hh;
      const u16* r1 = P + (size_t)(32 + qi) * 64 + 16 * s + 4 * hh;
      uint2 a = *(const uint2*)r0, c = *(const uint2*)(r0 + 8), d = *(const uint2*)r1, f = *(const uint2*)(r1 + 8);
      u32x4 fa = {a.x, a.y, c.x, c.y}, fb = {d.x, d.y, f.x, f.y};
      n0 = MFMA32(*(b16x8*)&fa, zb[s], n0);
      n1 = MFMA32(*(b16x8*)&fb, zb[s], n1);
    }
    z0 = n0; z1 = n1;
    float* zs = (float*)(p.ws + OFF_SEGZ) + (size_t)(seq * 7 + g) * 4096;
#pragma unroll
    for (int q = 0; q < 4; q++) {
      float* sp = zs + (size_t)(wave * 32 + qi) * 64 + 8 * q + 4 * hh;
      *(float4*)sp = make_float4(z0[4 * q], z0[4 * q + 1], z0[4 * q + 2], z0[4 * q + 3]);
      *(float4*)(sp + 32) = make_float4(z1[4 * q], z1[4 * q + 1], z1[4 * q + 2], z1[4 * q + 3]);
    }
  }
}

DEV ScanJob ctx_job(const Params& p, int v) {
  ScanJob J;
  J.e = v >> 9; J.b = (v >> 4) & 31; J.hd = v & 15; J.tb = J.b * 256; J.L = 256; J.step0 = 0; J.nch = 8; J.pq = 0;
  J.zin = nullptr; J.zout = p.out + OUT_ST + ((size_t)(J.b * 2 + J.e) * 16 + J.hd) * 4096; J.pout = nullptr; J.qout = nullptr;
  J.ncomb = 0; J.seq = 0;
  return J;
}
DEV ScanJob smp_job(const Params& p, int seq, int g, int pq) {
  ScanJob J;
  J.e = seq >> 5; J.b = (seq >> 4) & 1; J.hd = seq & 15; J.tb = T_CTX + J.b * 4096; J.L = 4096; J.step0 = g * 512; J.nch = 16; J.pq = pq;
  J.zin = p.state_rwkv + ((size_t)(J.b * 2 + J.e) * 16 + J.hd) * 4096;
  J.ncomb = pq ? 0 : g; J.seq = seq;
  J.zout = nullptr;
  J.pout = (u16*)(p.ws + OFF_SEGP) + (size_t)(seq * 7 + g) * 4096;
  J.qout = (float*)(p.ws + OFF_SEGQ) + (size_t)(seq * 7 + g) * 4096;
  return J;
}

DEV void p8a_scan(const Params& p, char* smem) {
  if (blockIdx.x < 448) {
    for (int j = blockIdx.x; j < 448; j += 448) scan_job(p, smp_job(p, j / 7, j % 7, 1), smem);
  } else {
    {
      float4* ys = (float4*)(p.ws + OFF_YSUM);
      float4* bs = (float4*)(p.ws + OFF_BSUM);
      const size_t gt = (size_t)(blockIdx.x - 448) * 256 + threadIdx.x, gs = (size_t)(gridDim.x - 448) * 256;
      for (size_t i = gt; i < 4194304; i += gs) ys[i] = make_float4(0, 0, 0, 0);
      for (size_t i = gt; i < 65536; i += gs) bs[i] = make_float4(0, 0, 0, 0);
    }
    for (int q = blockIdx.x - 448; q < 1024; q += gridDim.x - 448) {
      int mt = q >> 3, nt = q & 7, m0 = mt * 128, n0 = nt * 128;
      u16* sz = (u16*)(p.ws + OFF_SZ) + (size_t)m0 * 1024 + n0;
      gemm_tile<false>((const u16*)(p.ws + OFF_HG) + (size_t)m0 * 128, 128, nullptr, m0, (const u16*)(p.ws + OFF_G2T) + (size_t)n0 * 128, 128, 128,
                       EpGate{sz, sz, 1024}, smem);
    }
  }
}
DEV void p8b_scan(const Params& p, char* smem) {
  if (blockIdx.x < 64) scan_combine(p, blockIdx.x);
}
DEV void p8c_scan(const Params& p, char* smem) {
  for (int j = blockIdx.x; j < 512 + 1024; j += gridDim.x) {
    if (j < 512) scan_job(p, smp_job(p, j >> 3, j & 7, 0), smem);
    else scan_job(p, ctx_job(p, j - 512), smem);
  }
}

DEV void p9_post(const Params& p) {
  const int lane = threadIdx.x & 63;
  const int gw = blockIdx.x * 4 + (threadIdx.x >> 6), nw = gridDim.x * 4;
  const float* Ysum = (const float*)(p.ws + OFF_YSUM);
  const float* Bsum = (const float*)(p.ws + OFF_BSUM);
  for (int row = gw; row < 16384; row += nw) {
    const size_t o = (size_t)row * 1024 + lane * 16;
    float y[16];
#pragma unroll
    for (int i = 0; i < 4; i++) { float4 v = *(const float4*)(Ysum + o + 4 * i); y[4 * i] = v.x; y[4 * i + 1] = v.y; y[4 * i + 2] = v.z; y[4 * i + 3] = v.w; }
    float s = 0;
#pragma unroll
    for (int i = 0; i < 16; i++) s += y[i];
    s += __shfl_xor(s, 1); s += __shfl_xor(s, 2);
    float mean = s * (1.f / 64.f), q = 0;
#pragma unroll
    for (int i = 0; i < 16; i++) { float d = y[i] - mean; q += d * d; }
    q += __shfl_xor(q, 1); q += __shfl_xor(q, 2);
    float rstd = rsqrtf(q * (1.f / 64.f) + 64e-5f);
    float bon = Bsum[(size_t)row * 16 + (lane >> 2)];
    u16* O = (u16*)(p.ws + OFF_U1) + o;
    const u16* V = (const u16*)(p.ws + OFF_V2) + o;
    const u16* Z = (const u16*)(p.ws + OFF_SZ) + o;
#pragma unroll
    for (int hlf = 0; hlf < 2; hlf++) {
      uint4 vq = *(const uint4*)(V + 8 * hlf), zq = *(const uint4*)(Z + 8 * hlf);
      const unsigned vu[4] = {vq.x, vq.y, vq.z, vq.w}, zu[4] = {zq.x, zq.y, zq.z, zq.w};
      unsigned ow[4];
#pragma unroll
      for (int w = 0; w < 4; w++) {
        int c = lane * 16 + hlf * 8 + 2 * w;
        float y0 = (y[hlf * 8 + 2 * w] - mean) * rstd * p.lnx_g[c] + p.lnx_b[c] + bon * bflo(vu[w]);
        float y1 = (y[hlf * 8 + 2 * w + 1] - mean) * rstd * p.lnx_g[c + 1] + p.lnx_b[c + 1] + bon * bfhi(vu[w]);
        ow[w] = pack2(y0 * bflo(zu[w]), y1 * bfhi(zu[w]));
      }
      *(uint4*)(O + 8 * hlf) = make_uint4(ow[0], ow[1], ow[2], ow[3]);
    }
  }
}


#define XB_TMO 128
#define XB_XCNT(j) (256 + 64 * (j))
#define XB_XSUB(j) (1280 + 64 * (j))
#define XB_XGEN(j) (2304 + 64 * (j))
#define XB_TOP 3328
#define XB_TOPGEN 3392
#define XCD_BAR_WORDS 3456
#define XB_SPIN_CAP (1u << 22)
#define LAS __attribute__((address_space(3)))
DEV unsigned xb_ld(unsigned* p) { return __hip_atomic_load(p, __ATOMIC_RELAXED, __HIP_MEMORY_SCOPE_AGENT); }
DEV unsigned xb_add(unsigned* p, unsigned v) { return __hip_atomic_fetch_add(p, v, __ATOMIC_RELAXED, __HIP_MEMORY_SCOPE_AGENT); }
DEV unsigned xb_xcc_id() { return (unsigned)__builtin_amdgcn_s_getreg((3 << 11) | 20) & 0xFu; }
#define XB_SPIN(cond, bar) do { unsigned _sp = 0; while (cond) { __builtin_amdgcn_s_sleep(4); \
    if ((++_sp & 255u) == 0u) { if (xb_ld(&(bar)[XB_TMO])) break; if (_sp > XB_SPIN_CAP) { atomicAdd(&(bar)[XB_TMO], 1u); break; } } } } while (0)
struct XcdBarrier { unsigned* bar; unsigned x; volatile LAS unsigned* st; };
DEV XcdBarrier xcd_barrier_post(unsigned* bar, volatile LAS unsigned* st) {
  XcdBarrier b; b.bar = bar; b.x = xb_xcc_id(); b.st = st;
  if (threadIdx.x == 0) (void)xb_add(&bar[XB_XCNT(b.x)], 1u);
  return b;
}
DEV void xcd_barrier_complete(unsigned* bar, unsigned x, unsigned& nloc, unsigned& nx) {
  const unsigned G = gridDim.x * gridDim.y * gridDim.z;
  unsigned sum, cnt, mine, sp = 0u;
  for (;;) {
    sum = 0u; cnt = 0u; mine = 0u;
#pragma unroll
    for (unsigned j = 0; j < 16; ++j) { const unsigned c = xb_ld(&bar[XB_XCNT(j)]); sum += c; cnt += (c > 0u) ? 1u : 0u; mine = (j == x) ? c : mine; }
    if (sum == G) break;
    __builtin_amdgcn_s_sleep(1);
    if ((++sp & 255u) == 0u) { if (xb_ld(&bar[XB_TMO])) break; if (sp > XB_SPIN_CAP) { atomicAdd(&bar[XB_TMO], 1u); break; } }
  }
  nloc = mine > 0u ? mine : 1u; nx = cnt > 0u ? cnt : 1u;
}
DEV void xcd_barrier(const XcdBarrier& b) {
  asm volatile("s_waitcnt vmcnt(0)" ::: "memory");
  __syncthreads();
  if (threadIdx.x == 0) {
    unsigned* bar = b.bar;
    __builtin_amdgcn_s_waitcnt(0);
    unsigned nloc = b.st[0], nx = b.st[1];
    if (nloc == 0u) { xcd_barrier_complete(bar, b.x, nloc, nx); b.st[0] = nloc; b.st[1] = nx; }
    const unsigned old = xb_add(&bar[XB_XSUB(b.x)], 1u);
    const unsigned gen = old / nloc;
    if (old + 1u == (gen + 1u) * nloc) {
      __builtin_amdgcn_fence(__ATOMIC_RELEASE, "agent");
      asm volatile("s_waitcnt vmcnt(0)" ::: "memory");
      const unsigned og = xb_add(&bar[XB_TOP], 1u);
      const unsigned tg = og / nx;
      if (og + 1u == (tg + 1u) * nx) xb_add(&bar[XB_TOPGEN], 1u);
      else XB_SPIN(xb_ld(&bar[XB_TOPGEN]) == tg, bar);
      __builtin_amdgcn_fence(__ATOMIC_ACQUIRE, "agent");
      xb_add(&bar[XB_XGEN(b.x)], 1u);
      asm volatile("s_waitcnt vmcnt(0)" ::: "memory");
    } else {
      XB_SPIN(xb_ld(&bar[XB_XGEN(b.x)]) == gen, bar);
      __builtin_amdgcn_fence(__ATOMIC_ACQUIRE, "agent");
      asm volatile("s_waitcnt vmcnt(0)" ::: "memory");
    }
  }
  __syncthreads();
}

__global__ void __launch_bounds__(256, 2) fwd_kernel(Params p) {
  __shared__ __attribute__((aligned(16))) char smem[73728];
#if FUSED
  __shared__ unsigned xb_st[4];
  if (threadIdx.x < 4) xb_st[threadIdx.x] = 0u;
  __syncthreads();
  const XcdBarrier xb = xcd_barrier_post((unsigned*)(p.ws + OFF_BAR), (volatile LAS unsigned*)xb_st);
  if (p.phase_hi > 1000) cg::this_grid().sync();
#define SYNC() xcd_barrier(xb)
#else
#define SYNC()
#endif
#define PH(n, call) if (p.phase_lo <= n && n <= p.phase_hi) { call; if (n < p.phase_hi) { SYNC(); } }
  PH(0, p0_prep(p, smem))
  PH(1, ln_phase<0>(p))
  PH(2, p2_gemm1(p, smem))
  PH(3, p3_mix(p, smem))
  PH(4, p3b_fold(p))
  PH(5, p4_fnet(p, smem))
  PH(6, p_outproj<0>(p, smem))
  PH(7, ln_phase<1>(p))
  PH(8, p6b_dx(p))
  PH(9, p7_rwkv_proj(p, smem))
  PH(10, p8a_scan(p, smem))
  PH(11, p8c_scan(p, smem))
  PH(12, p9_post(p))
  PH(13, p_outproj<1>(p, smem))
  PH(14, ln_phase<2>(p))
}

extern "C" void kernel_launch(void* const* d_in, const int* in_sizes, int n_in, void* d_out, int out_size, void* d_ws,
                              size_t ws_size, hipStream_t stream) {
  Params p;
  memset(&p, 0, sizeof(p));
  const float* const* in = (const float* const*)d_in;
  p.x_prompt = in[0]; p.x_sample = in[1]; p.cache_k = in[2]; p.cache_v = in[3]; p.state_rwkv = in[4]; p.c = in[5]; p.c_ctx = in[6];
  p.ada_w = in[7]; p.ada_b = in[8]; p.post_g = in[9]; p.post_b = in[10]; p.w_in = in[11]; p.w_fnet = in[12]; p.rpb = in[13]; p.w_out = in[14];
  p.mu = in[15]; p.rkvz = in[16]; p.w0 = in[17]; p.w1 = in[18]; p.w2 = in[19]; p.a0 = in[20]; p.a1 = in[21]; p.a2 = in[22];
  p.g1 = in[23]; p.g2 = in[24]; p.k_k = in[25]; p.k_a = in[26]; p.r_k = in[27]; p.lnx_g = in[28]; p.lnx_b = in[29]; p.rw_out = in[30];
  p.out = (float*)d_out; p.ws = (char*)d_ws;
  char* ws = (char*)d_ws;
  int n = 0, start = 0;
  auto add = [&](const float* src, size_t dstoff, int lds, int ldd, int tk, int tn) {
    p.tj[n].src = src; p.tj[n].dst = (u16*)(ws + dstoff); p.tj[n].lds = lds; p.tj[n].ldd = ldd; p.tj[n].tk = tk; p.tj[n].tn = tn;
    p.tj[n].start = start; p.tj[n].pad = 0; start += tk * tn; n++;
  };
  add(p.w_in, OFF_WINT, 3072, 1024, 16, 48);
  add(p.w_out, OFF_WOUTT, 1024, 1024, 16, 16);
  for (int i = 0; i < 4; i++) add(p.rkvz + (size_t)i * 1048576, OFF_RKVZT + (size_t)i * 2097152, 1024, 1024, 16, 16);
  add(p.rw_out, OFF_RWOUTT, 1024, 1024, 16, 16);
  for (int e = 0; e < 2; e++) add(p.w1 + e * 65536, OFF_W1T + (size_t)e * 64 * 1024 * 2, 64, 1024, 16, 1);
  for (int e = 0; e < 2; e++) add(p.a1 + e * 65536, OFF_A1T + (size_t)e * 64 * 1024 * 2, 64, 1024, 16, 1);
  add(p.g1, OFF_G1T, 128, 1024, 16, 2);
  for (int e = 0; e < 2; e++) add(p.w2 + e * 65536, OFF_W2T + (size_t)e * 65536 * 2, 1024, 64, 1, 16);
  for (int e = 0; e < 2; e++) add(p.a2 + e * 65536, OFF_A2T + (size_t)e * 65536 * 2, 1024, 64, 1, 16);
  add(p.g2, OFF_G2T, 1024, 128, 2, 16);
  for (int b = 0; b < 2; b++)
    for (int h = 0; h < 8; h++) add(p.cache_v + (size_t)b * 262144 + h * 64, OFF_CVT + (size_t)(b * 8 + h) * 64 * 512 * 2, 512, 512, 8, 1);
  p.ntr = start;

  static int grid_blocks = 0;
  if (!grid_blocks) {
    int dev = 0, cus = 0, per_cu = 0;
    (void)hipGetDevice(&dev);
    (void)hipDeviceGetAttribute(&cus, hipDeviceAttributeMultiprocessorCount, dev);
    (void)hipOccupancyMaxActiveBlocksPerMultiprocessor(&per_cu, fwd_kernel, 256, 0);
    if (per_cu > 2) per_cu = 2;
    if (per_cu < 1) per_cu = 1;
    grid_blocks = cus * per_cu;
  }
#if FUSED
  p.phase_lo = 0; p.phase_hi = 14;
  void* args[] = {&p};
  (void)hipMemsetAsync((char*)d_ws + OFF_BAR, 0, 16384, stream);
  hipError_t e = hipLaunchCooperativeKernel((void*)fwd_kernel, dim3(grid_blocks), dim3(256), args, 0, stream);
  if (e != hipSuccess) fprintf(stderr, "cooperative launch failed: %s (grid %d)\n", hipGetErrorString(e), grid_blocks);
#else
#ifndef PROBE_SEQ
#define PROBE_SEQ 0,1,2,3,4,5,6,7,8,9,10,11,12,13,14
#endif
  const int seq[] = {PROBE_SEQ};
  for (int i = 0; i < (int)(sizeof(seq) / sizeof(int)); i++) {
    p.phase_lo = seq[i]; p.phase_hi = seq[i];
    fwd_kernel<<<grid_blocks, 256, 0, stream>>>(p);
  }
#endif
}
```

```cpp
#include <hip/hip_runtime.h>
#include <hip/hip_cooperative_groups.h>
#include <stdint.h>
#include <cstdio>
#include <cstring>
namespace cg = cooperative_groups;

#ifndef FUSED
#define FUSED 1
#endif

typedef unsigned short u16;
typedef __attribute__((ext_vector_type(8))) __bf16 b16x8;
typedef __attribute__((ext_vector_type(16))) float f32x16;
typedef __attribute__((ext_vector_type(4))) unsigned u32x4;
typedef __attribute__((ext_vector_type(2))) unsigned u32x2;
#define DEV __device__ __forceinline__

constexpr int T_CTX = 8192;
constexpr float ALPHA_DN = 1.41421356237f;
constexpr float LOG2E = 1.44269504089f;
constexpr size_t MiB = 1u << 20;
constexpr size_t OFF_MODS = 0, OFF_BAR = 512 * 1024, OFF_BSUM = 1 * MiB;
constexpr size_t OFF_FSMP = 2 * MiB, OFF_U = 66 * MiB, OFF_ABUF = 98 * MiB, OFF_Q = 114 * MiB, OFF_K = 130 * MiB;
constexpr size_t OFF_VTC = 146 * MiB, OFF_VTS = 154 * MiB, OFF_GBUF = 162 * MiB, OFF_BTC = 194 * MiB, OFF_BTS = 210 * MiB;
constexpr size_t OFF_WINT = 226 * MiB, OFF_WOUTT = 232 * MiB, OFF_MCAT = 234 * MiB, OFF_FCTX = 234 * MiB + 256 * 1024;
constexpr size_t OFF_CK = 234 * MiB + 512 * 1024, OFF_CVT = 235 * MiB + 512 * 1024;
constexpr size_t OFF_RKVZT = 237 * MiB, OFF_RWOUTT = 245 * MiB, OFF_W1T = 247 * MiB, OFF_A1T = OFF_W1T + 256 * 1024,
                 OFF_G1T = OFF_W1T + 512 * 1024, OFF_W2T = OFF_W1T + 768 * 1024, OFF_A2T = 248 * MiB,
                 OFF_G2T = 248 * MiB + 256 * 1024, OFF_HW = 248 * MiB + 512 * 1024;
constexpr size_t OFF_U1 = 2 * MiB, OFF_R = 34 * MiB, OFF_K2 = 66 * MiB, OFF_V2 = 98 * MiB, OFF_SZ = 130 * MiB,
                 OFF_YSUM = 162 * MiB, OFF_HA = 226 * MiB, OFF_HG = 230 * MiB;
constexpr size_t OFF_BFOLD = 98 * MiB;
constexpr size_t OFF_Y0B = 98 * MiB, OFF_Y1B = 34 * MiB;
constexpr size_t OFF_DX = 162 * MiB;
constexpr size_t OFF_SEGP = 2 * MiB, OFF_SEGQ = 6 * MiB, OFF_SEGZ = 14 * MiB;
constexpr size_t OUT_NK = 16777216, OUT_NV = 20971520, OUT_ST = 25165824;

constexpr int NTJ = 33;
struct TJob { const float* src; u16* dst; int lds, ldd, tk, tn, start, pad; };

struct Params {
  const float *x_prompt, *x_sample, *cache_k, *cache_v, *state_rwkv, *c, *c_ctx;
  const float *ada_w, *ada_b, *post_g, *post_b, *w_in, *w_fnet, *rpb, *w_out;
  const float *mu, *rkvz, *w0, *w1, *w2, *a0, *a1, *a2, *g1, *g2, *k_k, *k_a, *r_k, *lnx_g, *lnx_b, *rw_out;
  float* out; char* ws;
  int phase_lo, phase_hi, ntr, pad;
  TJob tj[NTJ];
};

typedef __attribute__((ext_vector_type(2))) __bf16 bf16x2_t;
typedef __attribute__((ext_vector_type(2))) float f32x2_t;
DEV unsigned pack2(float a, float b) {
  f32x2_t f = {a, b};
  bf16x2_t r = __builtin_convertvector(f, bf16x2_t);
  return *(unsigned*)&r;
}
DEV u16 f2bf(float f) { return (u16)(pack2(f, 0.f) & 0xffffu); }
DEV float bflo(unsigned w) { return __uint_as_float(w << 16); }
DEV float bfhi(unsigned w) { return __uint_as_float(w & 0xffff0000u); }
DEV float rcp_f(float x) { return __builtin_amdgcn_rcpf(x); }
DEV float sigm(float x) { return rcp_f(1.f + __expf(-x)); }
DEV float silu(float x) { return x * rcp_f(1.f + __expf(-x)); }
DEV float tanh_f(float x) { return 1.f - 2.f * rcp_f(__expf(2.f * x) + 1.f); }
DEV b16x8 ld16(const u16* p) { uint4 v = *(const uint4*)p; return *(b16x8*)&v; }
DEV b16x8 asb(uint4 v) { return *(b16x8*)&v; }
template <int CTRL> DEV float dpp_add(float x) {
  return x + __int_as_float(__builtin_amdgcn_update_dpp(0, __float_as_int(x), CTRL, 0xf, 0xf, true));
}
DEV float allsum8(float x) {
  x = dpp_add<0xB1>(x); x = dpp_add<0x4E>(x); x = dpp_add<0x141>(x);
  return x;
}
DEV float wave_sum(float x) {
  x = dpp_add<0xB1>(x); x = dpp_add<0x4E>(x); x = dpp_add<0x141>(x); x = dpp_add<0x140>(x);
  x += __shfl_xor(x, 16); x += __shfl_xor(x, 32);
  return x;
}
DEV float allsum16(float x) {
  x = dpp_add<0xB1>(x); x = dpp_add<0x4E>(x); x = dpp_add<0x124>(x); x = dpp_add<0x128>(x);
  return x;
}
DEV void lds_barrier() { asm volatile("s_waitcnt lgkmcnt(0)\n\ts_barrier" ::: "memory"); }
DEV int mv_of(int token) { return token < T_CTX ? 0 : 1 + ((token - T_CTX) >> 12); }

template <bool LERP, class EP>
DEV void gemm_tile(const u16* __restrict__ A, int lda, const float* __restrict__ mu, int m0,
                   const u16* __restrict__ B, int ldb, int K, EP ep, char* smem) {
  u16(*sA0)[72] = (u16(*)[72])smem;
  u16(*sB0)[72] = (u16(*)[72])(smem + 18432);
  u16(*sA1)[72] = (u16(*)[72])(smem + 36864);
  u16(*sB1)[72] = (u16(*)[72])(smem + 36864 + 18432);
  int tid = threadIdx.x;
  asm volatile("" : "+v"(tid));
  const int lane = tid & 63, wave = tid >> 6, wm = wave >> 1, wn = wave & 1;
  const int lr = tid >> 3, lk = (tid & 7) * 8;
  f32x16 acc[2][2];
#pragma unroll
  for (int i = 0; i < 2; i++)
#pragma unroll
    for (int j = 0; j < 2; j++)
#pragma unroll
      for (int r = 0; r < 16; r++) acc[i][j][r] = 0.f;
  u32x4 ra0[4], rb0[4], rp0[4], ra1[4], rb1[4], rp1[4];
  float4 mu00, mu01, mu10, mu11;
  const u16* DXp = nullptr;
  if constexpr (LERP) DXp = (const u16*)(A) + (OFF_DX - OFF_U1) / 2;
#define GLOAD(K0, RA, RB, RP, M0, M1)                                                     \
  {                                                                                       \
    _Pragma("unroll") for (int i = 0; i < 4; i++) {                                       \
      int r = lr + 32 * i;                                                                \
      if constexpr (LERP) {                                                               \
        RA[i] = *(const u32x4*)(A + (size_t)(m0 + r) * lda + (K0) + lk);                  \
        RP[i] = *(const u32x4*)(DXp + (size_t)(m0 + r) * lda + (K0) + lk);                \
      } else {                                                                            \
        RA[i] = *(const u32x4*)(A + (size_t)r * lda + (K0) + lk);                         \
      }                                                                                   \
      RB[i] = *(const u32x4*)(B + (size_t)r * ldb + (K0) + lk);                           \
    }                                                                                     \
    if constexpr (LERP) {                                                                 \
      M0 = *(const float4*)(mu + (K0) + lk);                                              \
      M1 = *(const float4*)(mu + (K0) + lk + 4);                                          \
    }                                                                                     \
  }
#define GSTORE(RA, RB, RP, M0, M1, sA, sB)                                                     \
  {                                                                                       \
    _Pragma("unroll") for (int i = 0; i < 4; i++) {                                       \
      int r = lr + 32 * i;                                                                \
      u32x4 av = RA[i];                                                                   \
      if constexpr (LERP) {                                                               \
        unsigned cu[4] = {RA[i].x, RA[i].y, RA[i].z, RA[i].w};                            \
        unsigned du[4] = {RP[i].x, RP[i].y, RP[i].z, RP[i].w};                            \
        float m[8] = {M0.x, M0.y, M0.z, M0.w, M1.x, M1.y, M1.z, M1.w};                    \
        unsigned o[4];                                                                    \
        _Pragma("unroll") for (int q = 0; q < 4; q++)                                     \
          o[q] = pack2(bflo(cu[q]) + bflo(du[q]) * m[2 * q], bfhi(cu[q]) + bfhi(du[q]) * m[2 * q + 1]); \
        av = u32x4{o[0], o[1], o[2], o[3]};                                               \
      }                                                                                   \
      *(u32x4*)&sA[r][lk] = av;                                                           \
      *(u32x4*)&sB[r][lk] = RB[i];                                                        \
    }                                                                                     \
  }
#define GCOMPUTE(sA, sB)                                                                  \
  {                                                                                       \
    _Pragma("unroll") for (int ks = 0; ks < 4; ks++) {                                    \
      b16x8 af[2], bf[2];                                                                 \
      _Pragma("unroll") for (int i = 0; i < 2; i++) {                                     \
        af[i] = *(const b16x8*)&sA[wm * 64 + i * 32 + (lane & 31)][ks * 16 + (lane >> 5) * 8]; \
        bf[i] = *(const b16x8*)&sB[wn * 64 + i * 32 + (lane & 31)][ks * 16 + (lane >> 5) * 8]; \
      }                                                                                   \
      _Pragma("unroll") for (int i = 0; i < 2; i++)                                       \
        _Pragma("unroll") for (int j = 0; j < 2; j++)                                     \
          acc[i][j] = __builtin_amdgcn_mfma_f32_32x32x16_bf16(af[i], bf[j], acc[i][j], 0, 0, 0); \
    }                                                                                     \
  }
#define GPIPE()                                                                           \
  {                                                                                       \
    __builtin_amdgcn_sched_group_barrier(0x100, 4, 0);                                    \
    _Pragma("unroll") for (int pi = 0; pi < 16; pi++) {                                   \
      __builtin_amdgcn_sched_group_barrier(0x008, 1, 0);                                  \
      __builtin_amdgcn_sched_group_barrier(0x100, 1, 0);                                  \
      __builtin_amdgcn_sched_group_barrier(0x002, 7, 0);                                  \
      __builtin_amdgcn_sched_group_barrier(0x200, 1, 0);                                  \
    }                                                                                     \
  }
  GLOAD(0, ra0, rb0, rp0, mu00, mu01);
  GLOAD(64, ra1, rb1, rp1, mu10, mu11);
  __syncthreads();
  GSTORE(ra0, rb0, rp0, mu00, mu01, sA0, sB0);
  if (128 < K) GLOAD(128, ra0, rb0, rp0, mu00, mu01);
  __syncthreads();
#pragma unroll 1
  for (int k0 = 0; k0 < K; k0 += 128) {
    __builtin_amdgcn_s_setprio(1);
    GCOMPUTE(sA0, sB0);
    GSTORE(ra1, rb1, rp1, mu10, mu11, sA1, sB1);
    GPIPE();
    __builtin_amdgcn_s_setprio(0);
    if (k0 + 192 < K) GLOAD(k0 + 192, ra1, rb1, rp1, mu10, mu11);
    __syncthreads();
    __builtin_amdgcn_s_setprio(1);
    GCOMPUTE(sA1, sB1);
    __builtin_amdgcn_s_setprio(0);
    if (k0 + 128 < K) {
      GSTORE(ra0, rb0, rp0, mu00, mu01, sA0, sB0);
      if (k0 + 256 < K) GLOAD(k0 + 256, ra0, rb0, rp0, mu00, mu01);
    }
    __syncthreads();
  }
#undef GLOAD
#undef GSTORE
#undef GCOMPUTE
#undef GPIPE
  __syncthreads();
  int tide = tid;
  asm volatile("" : "+v"(tide));
  const int lane_e = tide & 63, wv_e = tide >> 6, wm_e = wv_e >> 1, wn_e = wv_e & 1;
  u16* stg = (u16*)smem + wv_e * (64 * 72);
#pragma unroll
  for (int i = 0; i < 2; i++)
#pragma unroll
    for (int j = 0; j < 2; j++)
#pragma unroll
      for (int q = 0; q < 4; q++) {
        const int r = i * 32 + q * 8 + (lane_e >> 5) * 4, c = j * 32 + (lane_e & 31);
        const float v0 = acc[i][j][q * 4 + 0], v1 = acc[i][j][q * 4 + 1], v2 = acc[i][j][q * 4 + 2], v3 = acc[i][j][q * 4 + 3];
        ep.direct(wm_e * 64 + r, wn_e * 64 + c, v0, v1, v2, v3);
        if constexpr (EP::TRANS) {
          *(uint2*)(stg + c * 72 + r) = make_uint2(pack2(ep.act(v0), ep.act(v1)), pack2(ep.act(v2), ep.act(v3)));
        } else {
          const unsigned p01 = pack2(ep.act(v0), ep.act(v1)), p23 = pack2(ep.act(v2), ep.act(v3));
          stg[(r + 0) * 72 + c] = (u16)(p01 & 0xffffu); stg[(r + 1) * 72 + c] = (u16)(p01 >> 16);
          stg[(r + 2) * 72 + c] = (u16)(p23 & 0xffffu); stg[(r + 3) * 72 + c] = (u16)(p23 >> 16);
        }
      }
#pragma unroll
  for (int n = 0; n < 8; n++) {
    const int id = lane_e + 64 * n, rr = id >> 3, cc = (id & 7) * 8;
    const u32x4 v = *(const u32x4*)(stg + rr * 72 + cc);
    if constexpr (EP::TRANS) ep.store(wn_e * 64 + rr, wm_e * 64 + cc, v);
    else ep.store(wm_e * 64 + rr, wn_e * 64 + cc, v);
  }
}

template <int ACT> struct EpStore {
  static constexpr bool TRANS = false;
  u16* dst; int ld; float scale;
  DEV float act(float x) const {
    if (ACT == 1) return silu(x);
    if (ACT == 2) return tanh_f(x);
    if (ACT == 3) return sigm(x);
    if (ACT == 4) return x * scale;
    return x;
  }
  DEV void direct(int, int, float, float, float, float) const {}
  DEV void store(int R, int C, u32x4 v) const { *(u32x4*)(dst + (size_t)R * ld + C) = v; }
};
struct EpNull {
  static constexpr bool TRANS = false;
  DEV float act(float x) const { return x; }
  DEV void direct(int, int, float, float, float, float) const {}
  DEV void store(int, int, u32x4) const {}
};
struct EpKeep {
  static constexpr bool TRANS = false;
  u16* dst; int ld; float* f32dst; int ldf;
  DEV float act(float x) const { return x; }
  DEV void direct(int r, int c, float v0, float v1, float v2, float v3) const {
    if (f32dst) {
      f32dst[(size_t)(r + 0) * ldf + c] = v0; f32dst[(size_t)(r + 1) * ldf + c] = v1;
      f32dst[(size_t)(r + 2) * ldf + c] = v2; f32dst[(size_t)(r + 3) * ldf + c] = v3;
    }
  }
  DEV void store(int R, int C, u32x4 v) const { *(u32x4*)(dst + (size_t)R * ld + C) = v; }
};
struct EpTrans {
  static constexpr bool TRANS = true;
  u16* dst; size_t ldt; float* f32dst; int ldf;
  DEV float act(float x) const { return x; }
  DEV void direct(int r, int c, float v0, float v1, float v2, float v3) const {
    if (f32dst) {
      f32dst[(size_t)(r + 0) * ldf + c] = v0; f32dst[(size_t)(r + 1) * ldf + c] = v1;
      f32dst[(size_t)(r + 2) * ldf + c] = v2; f32dst[(size_t)(r + 3) * ldf + c] = v3;
    }
  }
  DEV void store(int Rc, int Cr, u32x4 v) const { *(u32x4*)(dst + (size_t)Rc * ldt + Cr) = v; }
};
struct EpGate {
  static constexpr bool TRANS = false;
  u16* dst; const u16* gate; int ld;
  DEV float act(float x) const { return x; }
  DEV void direct(int, int, float, float, float, float) const {}
  DEV void store(int R, int C, u32x4 v) const {
    const size_t o = (size_t)R * ld + C;
    const u32x4 g = *(const u32x4*)(gate + o);
    u32x4 r;
    r.x = pack2(bflo(v.x) * bflo(g.x), bfhi(v.x) * bfhi(g.x)); r.y = pack2(bflo(v.y) * bflo(g.y), bfhi(v.y) * bfhi(g.y));
    r.z = pack2(bflo(v.z) * bflo(g.z), bfhi(v.z) * bfhi(g.z)); r.w = pack2(bflo(v.w) * bflo(g.w), bfhi(v.w) * bfhi(g.w));
    *(u32x4*)(dst + o) = r;
  }
};
struct EpRes {
  static constexpr bool TRANS = false;
  u16* dst; const float* xsrc; const float* gate;
  DEV float act(float x) const { return x; }
  DEV void direct(int, int, float, float, float, float) const {}
  DEV void store(int R, int C, u32x4 v) const {
    const size_t o = (size_t)R * 1024 + C;
    const float4 x0 = *(const float4*)(xsrc + o), x1 = *(const float4*)(xsrc + o + 4);
    const float4 g0 = *(const float4*)(gate + C), g1 = *(const float4*)(gate + C + 4);
    u32x4 r;
    r.x = pack2(ALPHA_DN * x0.x + (1.f + g0.x) * bflo(v.x), ALPHA_DN * x0.y + (1.f + g0.y) * bfhi(v.x));
    r.y = pack2(ALPHA_DN * x0.z + (1.f + g0.z) * bflo(v.y), ALPHA_DN * x0.w + (1.f + g0.w) * bfhi(v.y));
    r.z = pack2(ALPHA_DN * x1.x + (1.f + g1.x) * bflo(v.z), ALPHA_DN * x1.y + (1.f + g1.y) * bfhi(v.z));
    r.w = pack2(ALPHA_DN * x1.z + (1.f + g1.z) * bflo(v.w), ALPHA_DN * x1.w + (1.f + g1.w) * bfhi(v.w));
    *(u32x4*)(dst + o) = r;
  }
};

DEV void p0_prep(const Params& p, char* smem) {
  const int tid = threadIdx.x;
  const int njobs = 192 + p.ntr;
  for (int job = blockIdx.x; job < njobs; job += gridDim.x) {
    __syncthreads();
    if (job < 192) {
      float* sc = (float*)smem;
      float* red = sc + 3072;
      for (int i = tid; i < 3072; i += 256) {
        int m = i >> 10, k = i & 1023;
        float cv = m == 0 ? p.c_ctx[k] : p.c[(m - 1) * 1024 + k];
        sc[i] = silu(cv);
      }
      __syncthreads();
      int l = job / 96, col = (job % 96) * 32 + (tid & 31), ks = tid >> 5;
      const float* w = p.ada_w + (size_t)l * 1024 * 3072 + col;
      float a0 = 0, a1 = 0, a2 = 0;
#pragma unroll 8
      for (int k = ks * 128; k < ks * 128 + 128; k++) {
        float wv = w[(size_t)k * 3072];
        a0 += sc[k] * wv; a1 += sc[1024 + k] * wv; a2 += sc[2048 + k] * wv;
      }
      red[(ks * 32 + (tid & 31)) * 3 + 0] = a0; red[(ks * 32 + (tid & 31)) * 3 + 1] = a1; red[(ks * 32 + (tid & 31)) * 3 + 2] = a2;
      __syncthreads();
      if (tid < 96) {
        int cl = tid & 31, m = tid >> 5;
        float s = 0;
        for (int q = 0; q < 8; q++) s += red[(q * 32 + cl) * 3 + m];
        int cc = (job % 96) * 32 + cl;
        ((float*)(p.ws + OFF_MODS))[(l * 3 + m) * 3072 + cc] = s + p.ada_b[l * 3072 + cc];
      }
    } else {
      int tj = job - 192, e = 0;
      while (e + 1 < NTJ && p.tj[e + 1].start <= tj) e++;
      const TJob J = p.tj[e];
      int lt = tj - J.start, tkk = lt / J.tn, tnn = lt % J.tn;
      float(*tile)[65] = (float(*)[65])smem;
      const float* src = J.src + (size_t)(tkk * 64) * J.lds + tnn * 64;
#pragma unroll
      for (int i = 0; i < 4; i++) {
        int kk = (tid >> 4) + 16 * i, nn = (tid & 15) * 4;
        float4 v = *(const float4*)(src + (size_t)kk * J.lds + nn);
        tile[kk][nn] = v.x; tile[kk][nn + 1] = v.y; tile[kk][nn + 2] = v.z; tile[kk][nn + 3] = v.w;
      }
      __syncthreads();
      u16* dst = J.dst + (size_t)(tnn * 64) * J.ldd + tkk * 64;
#pragma unroll
      for (int i = 0; i < 2; i++) {
        int nn = (tid >> 3) + 32 * i, kk = (tid & 7) * 8;
        uint4 o;
        o.x = pack2(tile[kk][nn], tile[kk + 1][nn]); o.y = pack2(tile[kk + 2][nn], tile[kk + 3][nn]);
        o.z = pack2(tile[kk + 4][nn], tile[kk + 5][nn]); o.w = pack2(tile[kk + 6][nn], tile[kk + 7][nn]);
        *(uint4*)(dst + (size_t)nn * J.ldd + kk) = o;
      }
    }
  }
  const size_t gt = (size_t)blockIdx.x * 256 + tid, gs = (size_t)gridDim.x * 256;
  {
    u16* ck = (u16*)(p.ws + OFF_CK);
    for (size_t i = gt; i < 65536; i += gs) {
      float4 a = *(const float4*)(p.cache_k + i * 8), b = *(const float4*)(p.cache_k + i * 8 + 4);
      *(uint4*)(ck + i * 8) = make_uint4(pack2(a.x, a.y), pack2(a.z, a.w), pack2(b.x, b.y), pack2(b.z, b.w));
    }
  }
  {
    u16* fs = (u16*)(p.ws + OFF_FSMP);
    const float sc = 0.001381067932f;
    for (size_t i = gt; i < 2097152; i += gs) {
      int lp = (int)(i >> 9), j0 = (int)(i & 511) * 8;
      unsigned o[4];
#pragma unroll
      for (int q = 0; q < 4; q++) {
        float v[2];
#pragma unroll
        for (int z = 0; z < 2; z++) {
          int j = j0 + 2 * q + z;
          bool cs = j <= 2048;
          int ph = (lp * (cs ? j : j - 2048)) & 4095;
          float ang = (float)ph * (6.283185307179586f / 4096.f);
          v[z] = (cs ? __cosf(ang) : -__sinf(ang)) * sc;
        }
        o[q] = pack2(v[0], v[1]);
      }
      *(uint4*)(fs + i * 8) = make_uint4(o[0], o[1], o[2], o[3]);
    }
    u16* fc = (u16*)(p.ws + OFF_FCTX);
    const float sc2 = 0.005524271728f;
    for (size_t i = gt; i < 16384; i += gs) {
      int lp = (int)(i >> 6), j0 = (int)(i & 63) * 8;
      unsigned o[4];
#pragma unroll
      for (int q = 0; q < 4; q++) {
        float v[2];
#pragma unroll
        for (int z = 0; z < 2; z++) {
          int j = j0 + 2 * q + z;
          int ph = (lp * (j & 255)) & 255;
          float ang = (float)ph * (6.283185307179586f / 256.f);
          v[z] = (j < 256 ? __cosf(ang) : -__sinf(ang)) * sc2;
        }
        o[q] = pack2(v[0], v[1]);
      }
      *(uint4*)(fc + i * 8) = make_uint4(o[0], o[1], o[2], o[3]);
    }
  }
  {
    u16* mc = (u16*)(p.ws + OFF_MCAT);
    for (size_t i = gt; i < 131072; i += gs) {
      int c = (int)(i & 127), ep = (int)((i >> 7) & 255), g = (int)(i >> 15);
      const float* wf = p.w_fnet + (size_t)g * 16384 + (ep & 127);
      float s = 0;
      for (int cp = 0; cp < 128; cp++) {
        float ang = (float)((c * cp) & 127) * (6.283185307179586f / 128.f);
        float tw = ep < 128 ? __cosf(ang) : __sinf(ang);
        s += tw * wf[cp * 128];
      }
      mc[i] = f2bf(s);
    }
  }
}

DEV void ln_stats(const float4 (&x)[4], float& mean, float& rstd) {
  float s = 0;
#pragma unroll
  for (int i = 0; i < 4; i++) s += x[i].x + x[i].y + x[i].z + x[i].w;
  mean = wave_sum(s) * (1.f / 1024.f);
  float q = 0;
#pragma unroll
  for (int i = 0; i < 4; i++) {
    float a = x[i].x - mean, b = x[i].y - mean, c = x[i].z - mean, d = x[i].w - mean;
    q += a * a + b * b + c * c + d * d;
  }
  rstd = rsqrtf(wave_sum(q) * (1.f / 1024.f) + 1e-6f);
}

template <int MODE> DEV void ln_phase(const Params& p) {
  const int lane = threadIdx.x & 63;
  const int gw = blockIdx.x * 4 + (threadIdx.x >> 6), nw = gridDim.x * 4;
  const float* mods = (const float*)(p.ws + OFF_MODS);
  typedef __attribute__((ext_vector_type(4))) float f32x4v;
  f32x4v xn[4];
  u32x2 wn[4];
  auto fetch = [&](int row) {
    if (MODE == 0) {
      const float* src = row < T_CTX ? p.x_prompt + (size_t)row * 1024 : p.x_sample + (size_t)(row - T_CTX) * 1024;
#pragma unroll
      for (int i = 0; i < 4; i++) xn[i] = *(const f32x4v*)(src + lane * 4 + 256 * i);
    } else {
      const u16* sb = (const u16*)(p.ws + (MODE == 1 ? OFF_Y0B : OFF_Y1B)) + (size_t)row * 1024;
#pragma unroll
      for (int i = 0; i < 4; i++) wn[i] = *(const u32x2*)(sb + lane * 4 + 256 * i);
    }
  };
  if (gw < 16384) fetch(gw);
  for (int row = gw; row < 16384; row += nw) {
    float4 x[4];
#pragma unroll
    for (int i = 0; i < 4; i++) {
      if (MODE == 0) x[i] = make_float4(xn[i].x, xn[i].y, xn[i].z, xn[i].w);
      else x[i] = make_float4(bflo(wn[i].x), bfhi(wn[i].x), bflo(wn[i].y), bfhi(wn[i].y));
    }
    if (row + nw < 16384) fetch(row + nw);
    float mean, rstd;
    ln_stats(x, mean, rstd);
    if (MODE >= 1) {
      const float* g = p.post_g + (MODE == 1 ? 0 : 1024);
      const float* b = p.post_b + (MODE == 1 ? 0 : 1024);
      float* dst = p.out + (size_t)row * 1024;
#pragma unroll
      for (int i = 0; i < 4; i++) {
        float4 gv = *(const float4*)(g + lane * 4 + 256 * i), bv = *(const float4*)(b + lane * 4 + 256 * i);
        x[i].x = (x[i].x - mean) * rstd * gv.x + bv.x; x[i].y = (x[i].y - mean) * rstd * gv.y + bv.y;
        x[i].z = (x[i].z - mean) * rstd * gv.z + bv.z; x[i].w = (x[i].w - mean) * rstd * gv.w + bv.w;
        *(float4*)(dst + lane * 4 + 256 * i) = x[i];
      }
      if (MODE == 2) continue;
      ln_stats(x, mean, rstd);
    }
    const float* md = mods + ((MODE == 0 ? 0 : 3) + mv_of(row)) * 3072;
    u16* ud = (u16*)(p.ws + (MODE == 0 ? OFF_U : OFF_U1)) + (size_t)row * 1024;
#pragma unroll
    for (int i = 0; i < 4; i++) {
      int k = lane * 4 + 256 * i;
      float4 sh = *(const float4*)(md + k), sc = *(const float4*)(md + 1024 + k);
      float a = (x[i].x - mean) * rstd * (1.f + sc.x) + sh.x, b = (x[i].y - mean) * rstd * (1.f + sc.y) + sh.y;
      float c = (x[i].z - mean) * rstd * (1.f + sc.z) + sh.z, d = (x[i].w - mean) * rstd * (1.f + sc.w) + sh.w;
      *(uint2*)(ud + k) = make_uint2(pack2(a, b), pack2(c, d));
    }
  }
}

DEV void p2_gemm1(const Params& p, char* smem) {
  const u16* U = (const u16*)(p.ws + OFF_U);
  const u16* W = (const u16*)(p.ws + OFF_WINT);
  const int xcd = blockIdx.x & 7, jx = blockIdx.x >> 3, nbx = gridDim.x >> 3;
  for (int q = jx; q < 16 * 24; q += nbx) {
    int st = q >> 6, w = q & 63, sm = st / 3, sn = st % 3;
    int mt = xcd * 16 + sm * 8 + (w >> 3), nt = sn * 8 + (w & 7);
    int m0 = mt * 128, n0 = nt * 128, sec = nt >> 2, nc = (nt & 3) * 128;
    const u16* A = U + (size_t)m0 * 1024;
    const u16* B = W + (size_t)n0 * 1024;
    if (sec == 0) {
      gemm_tile<false>(A, 1024, nullptr, m0, B, 1024, 1024, EpStore<0>{(u16*)(p.ws + OFF_ABUF) + (size_t)m0 * 512 + nc, 512, 1.f}, smem);
    } else if (sec == 1 || sec == 5) {
      gemm_tile<false>(A, 1024, nullptr, m0, B, 1024, 1024,
                       EpStore<1>{(u16*)(p.ws + OFF_GBUF) + (size_t)m0 * 1024 + (sec == 5 ? 512 : 0) + nc, 1024, 1.f}, smem);
    } else if (sec == 2) {
      gemm_tile<false>(A, 1024, nullptr, m0, B, 1024, 1024, EpStore<4>{(u16*)(p.ws + OFF_Q) + (size_t)m0 * 512 + nc, 512, 0.125f * LOG2E}, smem);
    } else if (sec == 3) {
      float* f = m0 < T_CTX ? p.out + OUT_NK + (size_t)m0 * 512 + nc : nullptr;
      gemm_tile<false>(A, 1024, nullptr, m0, B, 1024, 1024, EpKeep{(u16*)(p.ws + OFF_K) + (size_t)m0 * 512 + nc, 512, f, 512}, smem);
    } else {
      float* f = m0 < T_CTX ? p.out + OUT_NV + (size_t)m0 * 512 + nc : nullptr;
      u16* d; size_t ldt;
      if (m0 < T_CTX) { int b = m0 >> 8, l = m0 & 255; ldt = 256; d = (u16*)(p.ws + OFF_VTC) + ((size_t)b * 512 + nc) * 256 + l; }
      else { int tt = m0 - T_CTX, b = tt >> 12, l = tt & 4095; ldt = 4096; d = (u16*)(p.ws + OFF_VTS) + ((size_t)b * 512 + nc) * 4096 + l; }
      gemm_tile<false>(A, 1024, nullptr, m0, B, 1024, 1024, EpTrans{d, ldt, f, 512}, smem);
    }
  }
}

struct AttnState { f32x16 o0, o1; float m, l; };

DEV void attn_tile(AttnState& st, const b16x8 (&qf)[4], const u16* kS, const u16* vS, int mode, int dr, int kc0, int c,
                   const float* rpbh, int qi, int hh) {
  f32x16 s;
#pragma unroll
  for (int r = 0; r < 16; r++) s[r] = 0.f;
#pragma unroll
  for (int ks = 0; ks < 4; ks++) s = __builtin_amdgcn_mfma_f32_32x32x16_bf16(*(const b16x8*)(kS + qi * 72 + ks * 16 + hh * 8), qf[ks], s, 0, 0, 0);
  if (mode) {
    int cs = min(max(c - 8, 0), 48);
#pragma unroll
    for (int r = 0; r < 16; r++) {
      int kc = kc0 + (r & 3) + 8 * (r >> 2) + 4 * hh;
      bool valid = (kc >= cs) && (kc < cs + 16);
      int dc = min(max(kc - c + 15, 0), 30);
      float bias = rpbh[dr * 31 + dc] * LOG2E;
      s[r] = valid ? s[r] + bias : -1e30f;
    }
  }
  float tm = s[0];
#pragma unroll
  for (int r = 1; r < 16; r++) tm = fmaxf(tm, s[r]);
  tm = fmaxf(tm, __shfl_xor(tm, 32));
  float mn = fmaxf(st.m, tm);
  float alpha = __builtin_amdgcn_exp2f(st.m - mn);
  st.m = mn;
  float ps = 0;
#pragma unroll
  for (int r = 0; r < 16; r++) { float e = __builtin_amdgcn_exp2f(s[r] - mn); ps += e; s[r] = e; }
  st.l = st.l * alpha + ps;
#pragma unroll
  for (int r = 0; r < 16; r++) { st.o0[r] *= alpha; st.o1[r] *= alpha; }
#pragma unroll
  for (int s2 = 0; s2 < 2; s2++) {
    u32x4 pw = {pack2(s[8 * s2 + 0], s[8 * s2 + 1]), pack2(s[8 * s2 + 2], s[8 * s2 + 3]),
                pack2(s[8 * s2 + 4], s[8 * s2 + 5]), pack2(s[8 * s2 + 6], s[8 * s2 + 7])};
    b16x8 pfr = *(b16x8*)&pw;
#pragma unroll
    for (int dt = 0; dt < 2; dt++) {
      const u16* vr = vS + (dt * 32 + qi) * 40 + 16 * s2 + 4 * hh;
      const uint2 lo = *(const uint2*)vr, hi = *(const uint2*)(vr + 8);
      u32x4 vw = {lo.x, lo.y, hi.x, hi.y};
      b16x8 vf = *(b16x8*)&vw;
      if (dt == 0) st.o0 = __builtin_amdgcn_mfma_f32_32x32x16_bf16(vf, pfr, st.o0, 0, 0, 0);
      else st.o1 = __builtin_amdgcn_mfma_f32_32x32x16_bf16(vf, pfr, st.o1, 0, 0, 0);
    }
  }
}

DEV void attn_unit(const Params& p, int u, int lane, char* smem) {
  const u16* Qb = (const u16*)(p.ws + OFF_Q);
  const u16* Kb = (const u16*)(p.ws + OFF_K);
  const int qi = lane & 31, hh = lane >> 5;
  u16* kS = (u16*)smem + (threadIdx.x >> 6) * 4864;
  u16* vS = kS + 32 * 72;
  bool smp = u < 2048;
  int b, h, qg, tq0, r = 0, c0 = 0;
  if (smp) { b = u >> 10; h = (u >> 7) & 7; qg = u & 127; tq0 = T_CTX + b * 4096 + qg * 32; r = qg >> 1; c0 = (qg & 1) * 32; }
  else { int v = u - 2048; b = v >> 6; h = (v >> 3) & 7; qg = v & 7; tq0 = b * 256 + qg * 32; }
  b16x8 qf[4];
#pragma unroll
  for (int s = 0; s < 4; s++) qf[s] = ld16(Qb + (size_t)(tq0 + qi) * 512 + h * 64 + s * 16 + hh * 8);
  AttnState st;
#pragma unroll
  for (int i = 0; i < 16; i++) { st.o0[i] = 0.f; st.o1[i] = 0.f; }
  st.m = -INFINITY; st.l = 0.f;
  const float* rpbh = p.rpb + h * 465;
  const int rs = min(max(r - 4, 0), 56);
  const u16* ck = (const u16*)(p.ws + OFF_CK) + (size_t)b * 512 * 512 + h * 64;
  const u16* cvt = (const u16*)(p.ws + OFF_CVT) + (size_t)(b * 8 + h) * 64 * 512;
  const u16* kls = Kb + (size_t)(T_CTX + b * 4096) * 512 + h * 64;
  const u16* vls = (const u16*)(p.ws + OFF_VTS) + (size_t)(b * 8 + h) * 64 * 4096;
  const u16* klc = Kb + (size_t)(b * 256) * 512 + h * 64;
  const u16* vlc = (const u16*)(p.ws + OFF_VTC) + (size_t)(b * 8 + h) * 64 * 256;
  const int ntile = smp ? 32 : 8;
  u32x4 kr[4], vr[4];
  auto issue = [&](int tt) {
    int ll = lane;
    asm volatile("" : "+v"(ll));
    const u16 *kp, *vp; int ldv;
    if (!smp) { kp = klc + (size_t)tt * 32 * 512; vp = vlc + tt * 32; ldv = 256; }
    else if (tt < 16) { kp = ck + (size_t)tt * 32 * 512; vp = cvt + tt * 32; ldv = 512; }
    else { int kt = tt - 16, krow = rs + (kt >> 1), kc0 = (kt & 1) * 32; kp = kls + (size_t)(krow * 64 + kc0) * 512; vp = vls + krow * 64 + kc0; ldv = 4096; }
#pragma unroll
    for (int n = 0; n < 4; n++) {
      const int id = ll + 64 * n;
      kr[n] = *(const u32x4*)(kp + (size_t)(id >> 3) * 512 + (id & 7) * 8);
      vr[n] = *(const u32x4*)(vp + (size_t)(id >> 2) * ldv + (id & 3) * 8);
    }
  };
  issue(0);
#pragma unroll 1
  for (int tt = 0; tt < ntile; tt++) {
    {
      int ll = lane;
      asm volatile("" : "+v"(ll));
#pragma unroll
      for (int n = 0; n < 4; n++) {
        const int id = ll + 64 * n;
        *(u32x4*)(kS + (id >> 3) * 72 + (id & 7) * 8) = kr[n];
        *(u32x4*)(vS + (id >> 2) * 40 + (id & 3) * 8) = vr[n];
      }
    }
    if (tt + 1 < ntile) issue(tt + 1);
    const bool loc = smp && tt >= 16;
    const int kt = tt - 16;
    attn_tile(st, qf, kS, vS, loc ? 1 : 0, loc ? rs + (kt >> 1) - r + 7 : 0, loc ? (kt & 1) * 32 : 0, c0 + qi, rpbh, qi, hh);
  }
  float lt = st.l + __shfl_xor(st.l, 32);
  float inv = 1.f / lt;
  const size_t rowo = (size_t)(tq0 + qi) * 1024 + 512 + h * 64;
  const u16* gb = (const u16*)(p.ws + OFF_GBUF) + rowo;
  u16* cat = (u16*)(p.ws + OFF_U) + rowo;
#pragma unroll
  for (int dt = 0; dt < 2; dt++)
#pragma unroll
    for (int q = 0; q < 4; q++) {
      int d = dt * 32 + q * 8 + hh * 4;
      uint2 g = *(const uint2*)(gb + d);
      float v0 = (dt ? st.o1[q * 4 + 0] : st.o0[q * 4 + 0]) * inv * bflo(g.x);
      float v1 = (dt ? st.o1[q * 4 + 1] : st.o0[q * 4 + 1]) * inv * bfhi(g.x);
      float v2 = (dt ? st.o1[q * 4 + 2] : st.o0[q * 4 + 2]) * inv * bflo(g.y);
      float v3 = (dt ? st.o1[q * 4 + 3] : st.o0[q * 4 + 3]) * inv * bfhi(g.y);
      *(uint2*)(cat + d) = make_uint2(pack2(v0, v1), pack2(v2, v3));
    }
}

DEV void p3_mix(const Params& p, char* smem) {
  for (int t = blockIdx.x; t < 2048; t += gridDim.x) {
    if (t < 1024) {
      __syncthreads();
      attn_unit(p, t * 4 + (threadIdx.x >> 6), threadIdx.x & 63, smem);
    } else {
      int q = t - 1024, mt = q >> 3, g = (q >> 1) & 3, nh = q & 1, m0 = mt * 128;
      const u16* A = (const u16*)(p.ws + OFF_ABUF) + (size_t)m0 * 512 + g * 128;
      const u16* B = (const u16*)(p.ws + OFF_MCAT) + (size_t)(g * 256 + nh * 128) * 128;
      u16* d; size_t ldt;
      if (m0 < T_CTX) { int b = m0 >> 8, l = m0 & 255; ldt = 512; d = (u16*)(p.ws + OFF_BTC) + ((size_t)b * 512 + g * 128) * 512 + nh * 256 + l; }
      else { int tt = m0 - T_CTX, b = tt >> 12, l = tt & 4095; ldt = 8192; d = (u16*)(p.ws + OFF_BTS) + ((size_t)b * 512 + g * 128) * 8192 + nh * 4096 + l; }
      gemm_tile<false>(A, 512, nullptr, m0, B, 128, 128, EpTrans{d, ldt, nullptr, 0}, smem);
    }
  }
}

DEV void p3b_fold(const Params& p) {
  const u16* bt = (const u16*)(p.ws + OFF_BTS);
  u16* bf = (u16*)(p.ws + OFF_BFOLD);
  const size_t gt = (size_t)blockIdx.x * 256 + threadIdx.x, gs = (size_t)gridDim.x * 256;
  for (size_t i = gt; i < 4194304; i += gs) {
    const int jj = (int)(i & 4095);
    const u16* row = bt + (i >> 12) * 8192;
    float v;
    if (jj <= 2048) {
      v = __uint_as_float((unsigned)row[jj] << 16);
      if (jj >= 1 && jj <= 2047) v += __uint_as_float((unsigned)row[4096 - jj] << 16);
    } else {
      const int j = jj - 2048;
      v = __uint_as_float((unsigned)row[4096 + j] << 16) - __uint_as_float((unsigned)row[8192 - j] << 16);
    }
    bf[i] = f2bf(v);
  }
}

DEV void p4_fnet(const Params& p, char* smem) {
  for (int t = blockIdx.x; t < 512; t += gridDim.x) {
    if (t < 256) {
      int b = t >> 7, mt = (t >> 2) & 31, nt = t & 3;
      int tok0 = T_CTX + b * 4096 + mt * 128;
      const u16* A = (const u16*)(p.ws + OFF_FSMP) + (size_t)(mt * 128) * 4096;
      const u16* B = (const u16*)(p.ws + OFF_BFOLD) + ((size_t)b * 512 + nt * 128) * 4096;
      size_t o = (size_t)tok0 * 1024 + nt * 128;
      gemm_tile<false>(A, 4096, nullptr, 0, B, 4096, 4096, EpGate{(u16*)(p.ws + OFF_U) + o, (const u16*)(p.ws + OFF_GBUF) + o, 1024}, smem);
    } else {
      int q = t - 256, b = q >> 3, mt = (q >> 2) & 1, nt = q & 3;
      int tok0 = b * 256 + mt * 128;
      const u16* A = (const u16*)(p.ws + OFF_FCTX) + (size_t)(mt * 128) * 512;
      const u16* B = (const u16*)(p.ws + OFF_BTC) + ((size_t)b * 512 + nt * 128) * 512;
      size_t o = (size_t)tok0 * 1024 + nt * 128;
      gemm_tile<false>(A, 512, nullptr, 0, B, 512, 512, EpGate{(u16*)(p.ws + OFF_U) + o, (const u16*)(p.ws + OFF_GBUF) + o, 1024}, smem);
    }
  }
}

template <int LAYER> DEV void p_outproj(const Params& p, char* smem) {
  const u16* Aall = (const u16*)(p.ws + (LAYER == 0 ? OFF_U : OFF_U1));
  const u16* W = (const u16*)(p.ws + (LAYER == 0 ? OFF_WOUTT : OFF_RWOUTT));
  const float* mods = (const float*)(p.ws + OFF_MODS);
  for (int t = blockIdx.x; t < 1024; t += gridDim.x) {
    int mt = t >> 3, nt = t & 7, m0 = mt * 128, n0 = nt * 128;
    const float* xs;
    if (LAYER == 0) xs = (m0 < T_CTX ? p.x_prompt + (size_t)m0 * 1024 : p.x_sample + (size_t)(m0 - T_CTX) * 1024) + n0;
    else xs = p.out + (size_t)m0 * 1024 + n0;
    const float* gate = mods + (LAYER * 3 + mv_of(m0)) * 3072 + 2048 + n0;
    gemm_tile<false>(Aall + (size_t)m0 * 1024, 1024, nullptr, m0, W + (size_t)n0 * 1024, 1024, 1024,
                     EpRes{(u16*)(p.ws + (LAYER == 0 ? OFF_Y0B : OFF_Y1B)) + (size_t)m0 * 1024 + n0, xs, gate}, smem);
  }
}

DEV void p6b_dx(const Params& p) {
  const int lane = threadIdx.x & 63;
  const int gw = blockIdx.x * 4 + (threadIdx.x >> 6), nw = gridDim.x * 4;
  const u16* U = (const u16*)(p.ws + OFF_U1);
  u16* DX = (u16*)(p.ws + OFF_DX);
  for (int row = gw; row < 16384; row += nw) {
    const int l = row < T_CTX ? (row & 255) : ((row - T_CTX) & 4095);
    const int len = row < T_CTX ? 256 : 4096;
    const float pf = l > 0 ? 1.f : 0.f, nf = l + 1 < len ? 1.f : 0.f;
    const u16* uc = U + (size_t)row * 1024 + lane * 16;
    const u16* up = l > 0 ? uc - 1024 : uc;
    const u16* un = l + 1 < len ? uc + 1024 : uc;
#pragma unroll
    for (int hlf = 0; hlf < 2; hlf++) {
      uint4 c = *(const uint4*)(uc + 8 * hlf), a = *(const uint4*)(up + 8 * hlf), n = *(const uint4*)(un + 8 * hlf);
      const unsigned cu[4] = {c.x, c.y, c.z, c.w}, au[4] = {a.x, a.y, a.z, a.w}, nu[4] = {n.x, n.y, n.z, n.w};
      unsigned o[4];
#pragma unroll
      for (int q = 0; q < 4; q++)
        o[q] = pack2(0.5f * (bflo(au[q]) * pf + bflo(nu[q]) * nf) - bflo(cu[q]), 0.5f * (bfhi(au[q]) * pf + bfhi(nu[q]) * nf) - bfhi(cu[q]));
      *(uint4*)(DX + (size_t)row * 1024 + lane * 16 + 8 * hlf) = make_uint4(o[0], o[1], o[2], o[3]);
    }
  }
}

DEV void p7_rwkv_proj(const Params& p, char* smem) {
  const u16* U1 = (const u16*)(p.ws + OFF_U1);
  const int xcd = blockIdx.x & 7, jx = blockIdx.x >> 3, nbx = gridDim.x >> 3;
  for (int q = jx; q < 16 * 35; q += nbx) {
    int mt, nt;
    if (q < 512) { int st = q >> 6, w = q & 63; mt = xcd * 16 + (st >> 2) * 8 + (w >> 3); nt = (st & 3) * 8 + (w & 7); }
    else { int w = q - 512; mt = xcd * 16 + w / 3; nt = 32 + w % 3; }
    const int m0 = mt * 128;
    if (nt < 32) {
      int which = nt >> 3, n0 = (nt & 7) * 128;
      const u16* B = (const u16*)(p.ws + OFF_RKVZT) + (size_t)which * 1048576 + (size_t)n0 * 1024;
      if (which == 3) {
        gemm_tile<false>(U1 + (size_t)m0 * 1024, 1024, nullptr, m0, B, 1024, 1024,
                         EpStore<1>{(u16*)(p.ws + OFF_SZ) + (size_t)m0 * 1024 + n0, 1024, 1.f}, smem);
      } else {
        size_t off = which == 0 ? OFF_R : (which == 1 ? OFF_K2 : OFF_V2);
        const float* mu = p.mu + (which == 0 ? 0 : (which == 1 ? 2 : 3)) * 1024;
        gemm_tile<true>(U1, 1024, mu, m0, B, 1024, 1024, EpStore<0>{(u16*)(p.ws + off) + (size_t)m0 * 1024 + n0, 1024, 1.f}, smem);
      }
    } else {
      int w = nt - 32;
      if (w == 0)
        gemm_tile<true>(U1, 1024, p.mu + 1 * 1024, m0, (const u16*)(p.ws + OFF_W1T), 1024, 1024, EpStore<2>{(u16*)(p.ws + OFF_HW) + (size_t)m0 * 128, 128, 1.f}, smem);
      else if (w == 1)
        gemm_tile<true>(U1, 1024, p.mu + 4 * 1024, m0, (const u16*)(p.ws + OFF_A1T), 1024, 1024, EpStore<0>{(u16*)(p.ws + OFF_HA) + (size_t)m0 * 128, 128, 1.f}, smem);
      else
        gemm_tile<true>(U1, 1024, p.mu + 5 * 1024, m0, (const u16*)(p.ws + OFF_G1T), 1024, 1024, EpStore<3>{(u16*)(p.ws + OFF_HG) + (size_t)m0 * 128, 128, 1.f}, smem);
    }
  }
}

DEV b16x8 lds_perm(const u16* M, int ld, int row, int s, int hh) {
  const u16* q = M + row * ld + 16 * s + 4 * hh;
  uint2 lo = *(const uint2*)q, hi = *(const uint2*)(q + 8);
  u32x4 v = {lo.x, lo.y, hi.x, hi.y};
  return *(b16x8*)&v;
}
DEV b16x8 lds_norm(const u16* M, int ld, int row, int s, int hh) { return *(const b16x8*)(M + row * ld + 16 * s + 8 * hh); }
template <int OFF> DEV b16x8 pack8(const f32x16& a) {
  u32x4 v = {pack2(a[OFF], a[OFF + 1]), pack2(a[OFF + 2], a[OFF + 3]), pack2(a[OFF + 4], a[OFF + 5]), pack2(a[OFF + 6], a[OFF + 7])};
  return *(b16x8*)&v;
}
#define MFMA32(a, b, c) __builtin_amdgcn_mfma_f32_32x32x16_bf16(a, b, c, 0, 0, 0)

DEV int swz_idx(int row, int col) { return row * 40 + ((row >> 5) & 1) * 32 + ((((col >> 3) ^ (row >> 3)) & 3) << 3) + (col & 7); }
DEV b16x8 swz_norm(const u16* M, int row, int s, int hh) { return *(const b16x8*)(M + swz_idx(row, 16 * s + 8 * hh)); }
DEV b16x8 swz_perm(const u16* M, int row, int s, int hh) {
  uint2 lo = *(const uint2*)(M + swz_idx(row, 16 * s) + 4 * hh), hi = *(const uint2*)(M + swz_idx(row, 16 * s + 8) + 4 * hh);
  u32x4 v = {lo.x, lo.y, hi.x, hi.y};
  return *(b16x8*)&v;
}
struct ScanJob {
  int e, b, hd, tb, L, step0, nch, pq;
  int ncomb, seq;
  const float* zin;
  float* zout;
  u16* pout;
  float* qout;
};
DEV void scan_job(const Params& p, const ScanJob& J, char* smem) {
  float* sCum = (float*)smem;
  float* sAa = (float*)(smem + 8320);
  float* sNN = (float*)(smem + 8320);
  float* sT11 = (float*)(smem + 12544);
  float* sT22 = (float*)(smem + 13632);
  float* sWm = (float*)(smem + 14720);
  u16* AT = (u16*)(smem + 16640);
  u16* RT = (u16*)(smem + 21248);
  u16* BTl = (u16*)(smem + 25856);
  u16* KTl = (u16*)(smem + 30464);
  u16* BH = (u16*)(smem + 35072);
  u16* KH = (u16*)(smem + 40256);
  u16* VT = (u16*)(smem + 45440);
  u16* MkaT = (u16*)(smem + 50624);
  u16* MbrT = (u16*)(smem + 53184);
  u16* MkrT = (u16*)(smem + 55744);
  u16* TT = (u16*)(smem + 58304);
  float* gC = (float*)(smem + 60864);
  const int tid = threadIdx.x, wave = __builtin_amdgcn_readfirstlane(threadIdx.x >> 6);
  float* sKc = (float*)(smem + 61120);
  const int e = J.e, hd = J.hd, tb = J.tb, L = J.L, step0 = J.step0;
  const bool pq = J.pq != 0;
  const bool chainw = pq || wave < 2;
  const bool useV = pq ? (wave >= 2) : true;
  const int rb = wave & 1;
  const u16* HW = (const u16*)(p.ws + OFF_HW);
  const u16* HA = (const u16*)(p.ws + OFF_HA);
  const u16* Rb = (const u16*)(p.ws + OFF_R);
  const u16* Kb = (const u16*)(p.ws + OFF_K2);
  const u16* Vb = (const u16*)(p.ws + OFF_V2);
  float* Ysum = (float*)(p.ws + OFF_YSUM);
  float* Bsum = (float*)(p.ws + OFF_BSUM);
  const int arr = wave >> 1, ct = wave & 1;
  const u16* Xb = (arr ? HA : HW) + e * 64;
  b16x8 wf[4];
  {
    const int qi = tid & 31, hh = (tid >> 5) & 1;
    const u16* Wt = (const u16*)(p.ws + (arr ? OFF_A2T : OFF_W2T)) + (size_t)e * 65536 + (size_t)(hd * 64 + ct * 32 + qi) * 64 + hh * 8;
#pragma unroll
    for (int ks = 0; ks < 4; ks++) wf[ks] = ld16(Wt + ks * 16);
  }
  const float bias0 = (arr ? p.a0 : p.w0)[e * 1024 + hd * 64 + ct * 32 + (tid & 31)];
  if (tid < 64) { sKc[tid] = p.k_k[hd * 64 + tid]; sKc[64 + tid] = p.k_a[hd * 64 + tid]; sKc[128 + tid] = p.r_k[hd * 64 + tid]; }
  f32x16 z0, z1;
#pragma unroll
  for (int q = 0; q < 4; q++) {
    const int qi = tid & 31, hh = (tid >> 5) & 1;
    float4 v0 = make_float4(0, 0, 0, 0), v1 = v0;
    if (pq) {
      if (wave < 2) {
#pragma unroll
        for (int i = 0; i < 4; i++) {
          const int k = 8 * q + 4 * hh + i, col = rb * 32 + qi;
          ((float*)&v0)[i] = (k == col) ? 1.f : 0.f;
          ((float*)&v1)[i] = (k + 32 == col) ? 1.f : 0.f;
        }
      }
    } else if (J.zin && wave < 2) {
      const float* sp = J.zin + (size_t)(wave * 32 + qi) * 64 + 8 * q + 4 * hh;
      v0 = *(const float4*)sp; v1 = *(const float4*)(sp + 32);
    }
    z0[4 * q] = v0.x; z0[4 * q + 1] = v0.y; z0[4 * q + 2] = v0.z; z0[4 * q + 3] = v0.w;
    z1[4 * q] = v1.x; z1[4 * q + 1] = v1.y; z1[4 * q + 2] = v1.z; z1[4 * q + 3] = v1.w;
  }
  if (!pq && wave < 2) {
    const int qi = tid & 31, hh = (tid >> 5) & 1;
#pragma unroll 1
    for (int g = 0; g < J.ncomb; g++) {
      const u16* P = (const u16*)(p.ws + OFF_SEGP) + (size_t)(J.seq * 7 + g) * 4096;
      const float* Q = (const float*)(p.ws + OFF_SEGQ) + (size_t)(J.seq * 7 + g) * 4096;
      b16x8 zb[4] = {pack8<0>(z0), pack8<8>(z0), pack8<0>(z1), pack8<8>(z1)};
      f32x16 n0, n1;
#pragma unroll
      for (int q = 0; q < 4; q++) {
        const float* sp = Q + (size_t)(wave * 32 + qi) * 64 + 8 * q + 4 * hh;
        float4 v0 = *(const float4*)sp, v1 = *(const float4*)(sp + 32);
        n0[4 * q] = v0.x; n0[4 * q + 1] = v0.y; n0[4 * q + 2] = v0.z; n0[4 * q + 3] = v0.w;
        n1[4 * q] = v1.x; n1[4 * q + 1] = v1.y; n1[4 * q + 2] = v1.z; n1[4 * q + 3] = v1.w;
      }
#pragma unroll
      for (int s2 = 0; s2 < 4; s2++) {
        const u16* r0 = P + (size_t)qi * 64 + 16 * s2 + 4 * hh;
        const u16* r1 = P + (size_t)(32 + qi) * 64 + 16 * s2 + 4 * hh;
        uint2 a = *(const uint2*)r0, c = *(const uint2*)(r0 + 8), d = *(const uint2*)r1, f = *(const uint2*)(r1 + 8);
        u32x4 fa = {a.x, a.y, c.x, c.y}, fb = {d.x, d.y, f.x, f.y};
        n0 = MFMA32(*(b16x8*)&fa, zb[s2], n0);
        n1 = MFMA32(*(b16x8*)&fb, zb[s2], n1);
      }
      z0 = n0; z1 = n1;
    }
  }
  const int nch = J.nch;
  b16x8 xf[4];
  u32x4 kq, rq, vq;
  int tokC;
  {
    const int qi = tid & 31, hh = (tid >> 5) & 1, ci_ = tid >> 3, chg = hd * 64 + (tid & 7) * 8;
    const int tok0 = tb + (e ? L - step0 - 32 : step0);
    const int tokA = tok0 + (e ? 31 - qi : qi);
#pragma unroll
    for (int ks = 0; ks < 4; ks++) xf[ks] = ld16(Xb + (size_t)tokA * 128 + hh * 8 + ks * 16);
    tokC = tok0 + (e ? 31 - ci_ : ci_);
    kq = *(const u32x4*)(Kb + (size_t)tokC * 1024 + chg);
    rq = *(const u32x4*)(Rb + (size_t)tokC * 1024 + chg);
    vq = *(const u32x4*)(Vb + (size_t)tokC * 1024 + chg);
  }
#pragma unroll 1
  for (int ci = 0; ci < nch; ci++) {
    const int tok0 = tb + (e ? L - step0 - 32 * (ci + 1) : step0 + 32 * ci);
    const int tokn0 = tb + (e ? L - step0 - 32 * (ci + 2) : step0 + 32 * (ci + 1));
    const bool more = ci + 1 < nch;
    int tl = tid;
    asm volatile("" : "+v"(tl));
    const int lane = tl & 63, qi = lane & 31, hh = lane >> 5, ci_ = tl >> 3, cb = (tl & 7) * 8, chg = hd * 64 + cb;
    {
      f32x16 acc;
#pragma unroll
      for (int r = 0; r < 16; r++) acc[r] = 0.f;
#pragma unroll
      for (int ks = 0; ks < 4; ks++) acc = MFMA32(xf[ks], wf[ks], acc);
      if (more) {
        const int tokA = tokn0 + (e ? 31 - qi : qi);
#pragma unroll
        for (int ks = 0; ks < 4; ks++) xf[ks] = ld16(Xb + (size_t)tokA * 128 + hh * 8 + ks * 16);
      }
      const int ch = ct * 32 + qi;
      if (arr == 0) {
        float lw[16], gs[4], og[4];
#pragma unroll
        for (int r = 0; r < 16; r++) lw[r] = -0.606531f * sigm(acc[r] + bias0);
#pragma unroll
        for (int q = 0; q < 4; q++) { gs[q] = (lw[4 * q] + lw[4 * q + 1]) + (lw[4 * q + 2] + lw[4 * q + 3]); og[q] = __shfl_xor(gs[q], 32); }
        float pre = 0.f;
#pragma unroll
        for (int q = 0; q < 4; q++) {
          float run = pre + (hh ? og[q] : 0.f);
#pragma unroll
          for (int i = 0; i < 4; i++) { run += lw[4 * q + i]; sCum[(8 * q + 4 * hh + i) * 65 + ch] = run; }
          pre += gs[q] + og[q];
        }
      } else {
#pragma unroll
        for (int r = 0; r < 16; r++) {
          int row = (r & 3) + 8 * (r >> 2) + 4 * hh;
          sAa[row * 65 + ch] = sigm(acc[r] + bias0);
        }
      }
    }
    lds_barrier();
    {
      const int i = ci_;
      const unsigned ku[4] = {kq.x, kq.y, kq.z, kq.w}, ru[4] = {rq.x, rq.y, rq.z, rq.w}, vu[4] = {vq.x, vq.y, vq.z, vq.w};
      float k[8], r[8], kkr[8];
#pragma unroll
      for (int q = 0; q < 4; q++) {
        k[2 * q] = bflo(ku[q]); k[2 * q + 1] = bfhi(ku[q]);
        r[2 * q] = bflo(ru[q]); r[2 * q + 1] = bfhi(ru[q]);
      }
      float kkc[8], kac[8], rkc[8];
#pragma unroll
      for (int j = 0; j < 8; j++) { kkc[j] = sKc[cb + j]; kac[j] = sKc[64 + cb + j]; rkc[j] = sKc[128 + cb + j]; }
      float ss = 0;
#pragma unroll
      for (int j = 0; j < 8; j++) { kkr[j] = k[j] * kkc[j]; ss += kkr[j] * kkr[j]; }
      ss = allsum8(ss);
      const float inv = rsqrtf(ss + 1e-12f);
      float bon = 0;
      float oa[8], orr[8], ob[8], ok[8];
#pragma unroll
      for (int j = 0; j < 8; j++) {
        const float a = sAa[i * 65 + cb + j];
        const float cm = sCum[i * 65 + cb + j];
        const float cp = i > 0 ? sCum[(i - 1) * 65 + cb + j] : 0.f;
        const float cl = sCum[31 * 65 + cb + j];
        const float kd = k[j] * (1.f + (a - 1.f) * kac[j]);
        const float kk = kkr[j] * inv;
        const float bb = kk * a;
        bon += r[j] * kd * rkc[j];
        const float em = __expf(-cm), eC = __expf(cl - cm);
        oa[j] = -kk * __expf(cp);
        orr[j] = pq ? 0.f : r[j] * __expf(cm);
        ob[j] = bb * em;
        ok[j] = kd * em;
        BH[swz_idx(cb + j, i)] = f2bf(bb * eC);
        KH[swz_idx(cb + j, i)] = f2bf(kd * eC);
        if (i == 31) gC[cb + j] = __expf(cl);
      }
#pragma unroll
      for (int q = 0; q < 4; q++) {
        VT[swz_idx(cb + 2 * q, i)] = (u16)(vu[q] & 0xffffu);
        VT[swz_idx(cb + 2 * q + 1, i)] = (u16)(vu[q] >> 16);
      }
      *(u32x4*)(AT + i * 72 + cb) = u32x4{pack2(oa[0], oa[1]), pack2(oa[2], oa[3]), pack2(oa[4], oa[5]), pack2(oa[6], oa[7])};
      if (!pq) *(u32x4*)(RT + i * 72 + cb) = u32x4{pack2(orr[0], orr[1]), pack2(orr[2], orr[3]), pack2(orr[4], orr[5]), pack2(orr[6], orr[7])};
      *(u32x4*)(BTl + i * 72 + cb) = u32x4{pack2(ob[0], ob[1]), pack2(ob[2], ob[3]), pack2(ob[4], ob[5]), pack2(ob[6], ob[7])};
      *(u32x4*)(KTl + i * 72 + cb) = u32x4{pack2(ok[0], ok[1]), pack2(ok[2], ok[3]), pack2(ok[4], ok[5]), pack2(ok[6], ok[7])};
      bon = allsum8(bon);
      if (!pq && (tl & 7) == 0) atomicAdd(Bsum + (size_t)tokC * 16 + hd, 0.5f * bon);
      if (more) {
        tokC = tokn0 + (e ? 31 - ci_ : ci_);
        kq = *(const u32x4*)(Kb + (size_t)tokC * 1024 + chg);
        rq = *(const u32x4*)(Rb + (size_t)tokC * 1024 + chg);
        vq = *(const u32x4*)(Vb + (size_t)tokC * 1024 + chg);
      }
    }
    lds_barrier();
    if (!(pq && wave >= 2)) {
      const u16* Am = (wave < 2) ? AT : RT;
      const u16* Bm = (wave & 1) ? KTl : BTl;
      f32x16 acc;
#pragma unroll
      for (int r = 0; r < 16; r++) acc[r] = 0.f;
#pragma unroll
      for (int s = 0; s < 4; s++) acc = MFMA32(lds_norm(Am, 72, qi, s, hh), lds_norm(Bm, 72, qi, s, hh), acc);
      u16* dst = wave == 1 ? MkaT : (wave == 2 ? MbrT : MkrT);
#pragma unroll
      for (int r = 0; r < 16; r++) {
        const int tt = (r & 3) + 8 * (r >> 2) + 4 * hh, j = qi;
        const bool keep = (wave < 2) ? (j < tt) : (j <= tt);
        const float val = keep ? acc[r] : 0.f;
        if (wave == 0) sNN[j * 33 + tt] = val;
        else dst[tt * 40 + j] = f2bf(val);
      }
    }
    if (tl < 32) {
      const int i = tl & 15, base = (tl >> 4) * 16;
      float Tr[16];
#pragma unroll
      for (int q = 0; q < 16; q++) Tr[q] = (q == i) ? 1.f : 0.f;
#pragma unroll
      for (int q = 1; q < 16; q++) {
        float s0 = 0.f, s1 = 0.f, s2 = 0.f, s3 = 0.f;
#pragma unroll
        for (int j = 0; j < q; j++) {
          const float pr = Tr[j] * sNN[(base + j) * 33 + base + q];
          if ((j & 3) == 0) s0 += pr; else if ((j & 3) == 1) s1 += pr; else if ((j & 3) == 2) s2 += pr; else s3 += pr;
        }
        if (q > i) Tr[q] = (s0 + s1) + (s2 + s3);
      }
      float* sT = (tl >> 4) ? sT22 : sT11;
#pragma unroll
      for (int q = 0; q < 16; q++) { sT[i * 17 + q] = Tr[q]; TT[(base + q) * 40 + base + i] = f2bf(Tr[q]); }
    }
    lds_barrier();
    {
      const int i = tl >> 4, q = tl & 15;
      float s = 0.f;
#pragma unroll
      for (int j = 0; j < 16; j++) s += sT11[i * 17 + j] * sNN[j * 33 + 16 + q];
      sWm[i * 17 + q] = s;
      TT[i * 40 + 16 + q] = 0;
    }
    lds_barrier();
    {
      const int i = tl >> 4, q = tl & 15;
      float s = 0.f;
#pragma unroll
      for (int j = 0; j < 16; j++) s += sWm[i * 17 + j] * sT22[j * 17 + q];
      TT[(16 + q) * 40 + i] = f2bf(s);
    }
    lds_barrier();
    if (chainw) {
      const int vrow = rb * 32 + qi;
      b16x8 zb0 = pack8<0>(z0), zb1 = pack8<8>(z0), zb2 = pack8<0>(z1), zb3 = pack8<8>(z1);
      b16x8 vt0 = swz_norm(VT, vrow, 0, hh), vt1 = swz_norm(VT, vrow, 1, hh);
      f32x16 x;
#pragma unroll
      for (int r = 0; r < 16; r++) x[r] = 0.f;
      x = MFMA32(lds_perm(AT, 72, qi, 0, hh), zb0, x);
      x = MFMA32(lds_perm(AT, 72, qi, 1, hh), zb1, x);
      x = MFMA32(lds_perm(AT, 72, qi, 2, hh), zb2, x);
      x = MFMA32(lds_perm(AT, 72, qi, 3, hh), zb3, x);
      if (useV) {
        x = MFMA32(lds_norm(MkaT, 40, qi, 0, hh), vt0, x);
        x = MFMA32(lds_norm(MkaT, 40, qi, 1, hh), vt1, x);
      }
      f32x16 y;
#pragma unroll
      for (int r = 0; r < 16; r++) y[r] = 0.f;
      if (!pq) {
        y = MFMA32(lds_perm(RT, 72, qi, 0, hh), zb0, y);
        y = MFMA32(lds_perm(RT, 72, qi, 1, hh), zb1, y);
        y = MFMA32(lds_perm(RT, 72, qi, 2, hh), zb2, y);
        y = MFMA32(lds_perm(RT, 72, qi, 3, hh), zb3, y);
        y = MFMA32(lds_norm(MkrT, 40, qi, 0, hh), vt0, y);
        y = MFMA32(lds_norm(MkrT, 40, qi, 1, hh), vt1, y);
      }
#pragma unroll
      for (int q = 0; q < 4; q++) {
        float4 g0 = *(const float4*)(gC + 8 * q + 4 * hh), g1 = *(const float4*)(gC + 32 + 8 * q + 4 * hh);
        z0[4 * q] *= g0.x; z0[4 * q + 1] *= g0.y; z0[4 * q + 2] *= g0.z; z0[4 * q + 3] *= g0.w;
        z1[4 * q] *= g1.x; z1[4 * q + 1] *= g1.y; z1[4 * q + 2] *= g1.z; z1[4 * q + 3] *= g1.w;
      }
      if (useV) {
        z0 = MFMA32(swz_norm(KH, qi, 0, hh), vt0, z0);
        z0 = MFMA32(swz_norm(KH, qi, 1, hh), vt1, z0);
        z1 = MFMA32(swz_norm(KH, 32 + qi, 0, hh), vt0, z1);
        z1 = MFMA32(swz_norm(KH, 32 + qi, 1, hh), vt1, z1);
      }
      b16x8 xb0 = pack8<0>(x), xb1 = pack8<8>(x);
      f32x16 u;
#pragma unroll
      for (int r = 0; r < 16; r++) u[r] = 0.f;
      u = MFMA32(lds_perm(TT, 40, qi, 0, hh), xb0, u);
      u = MFMA32(lds_perm(TT, 40, qi, 1, hh), xb1, u);
      b16x8 ub0 = pack8<0>(u), ub1 = pack8<8>(u);
      z0 = MFMA32(swz_perm(BH, qi, 0, hh), ub0, z0);
      z0 = MFMA32(swz_perm(BH, qi, 1, hh), ub1, z0);
      z1 = MFMA32(swz_perm(BH, 32 + qi, 0, hh), ub0, z1);
      z1 = MFMA32(swz_perm(BH, 32 + qi, 1, hh), ub1, z1);
      if (!pq) {
        y = MFMA32(lds_perm(MbrT, 40, qi, 0, hh), ub0, y);
        y = MFMA32(lds_perm(MbrT, 40, qi, 1, hh), ub1, y);
#pragma unroll
        for (int r = 0; r < 16; r++) {
          const int st = (r & 3) + 8 * (r >> 2) + 4 * hh;
          const int tok = tok0 + (e ? 31 - st : st);
          atomicAdd(Ysum + (size_t)tok * 1024 + hd * 64 + vrow, y[r]);
        }
      }
    }
  }
  {
    const int qi = tid & 31, hh = (tid >> 5) & 1;
    if (pq) {
      if (wave < 2) {
#pragma unroll
        for (int r = 0; r < 16; r++) {
          const int k = (r & 3) + 8 * (r >> 2) + 4 * hh;
          J.pout[k * 64 + rb * 32 + qi] = f2bf(z0[r]);
          J.pout[(k + 32) * 64 + rb * 32 + qi] = f2bf(z1[r]);
        }
      } else {
#pragma unroll
        for (int q = 0; q < 4; q++) {
          float* sp = J.qout + (size_t)(rb * 32 + qi) * 64 + 8 * q + 4 * hh;
          *(float4*)sp = make_float4(z0[4 * q], z0[4 * q + 1], z0[4 * q + 2], z0[4 * q + 3]);
          *(float4*)(sp + 32) = make_float4(z1[4 * q], z1[4 * q + 1], z1[4 * q + 2], z1[4 * q + 3]);
        }
      }
    } else if (J.zout && wave < 2) {
#pragma unroll
      for (int q = 0; q < 4; q++) {
        float* sp = J.zout + (size_t)(wave * 32 + qi) * 64 + 8 * q + 4 * hh;
        *(float4*)sp = make_float4(z0[4 * q], z0[4 * q + 1], z0[4 * q + 2], z0[4 * q + 3]);
        *(float4*)(sp + 32) = make_float4(z1[4 * q], z1[4 * q + 1], z1[4 * q + 2], z1[4 * q + 3]);
      }
    }
  }
  __syncthreads();
}

DEV void scan_combine(const Params& p, int seq) {
  const int tid = threadIdx.x, wave = tid >> 6, qi = tid & 31, hh = (tid >> 5) & 1;
  if (wave >= 2) return;
  const int e = seq >> 5, b = (seq >> 4) & 1, hd = seq & 15;
  const float* zin = p.state_rwkv + ((size_t)(b * 2 + e) * 16 + hd) * 4096;
  f32x16 z0, z1;
#pragma unroll
  for (int q = 0; q < 4; q++) {
    const float* sp = zin + (size_t)(wave * 32 + qi) * 64 + 8 * q + 4 * hh;
    float4 v0 = *(const float4*)sp, v1 = *(const float4*)(sp + 32);
    z0[4 * q] = v0.x; z0[4 * q + 1] = v0.y; z0[4 * q + 2] = v0.z; z0[4 * q + 3] = v0.w;
    z1[4 * q] = v1.x; z1[4 * q + 1] = v1.y; z1[4 * q + 2] = v1.z; z1[4 * q + 3] = v1.w;
  }
#pragma unroll 1
  for (int g = 0; g < 7; g++) {
    const u16* P = (const u16*)(p.ws + OFF_SEGP) + (size_t)(seq * 7 + g) * 4096;
    const float* Q = (const float*)(p.ws + OFF_SEGQ) + (size_t)(seq * 7 + g) * 4096;
    b16x8 zb[4] = {pack8<0>(z0), pack8<8>(z0), pack8<0>(z1), pack8<8>(z1)};
    f32x16 n0, n1;
#pragma unroll
    for (int q = 0; q < 4; q++) {
      const float* sp = Q + (size_t)(wave * 32 + qi) * 64 + 8 * q + 4 * hh;
      float4 v0 = *(const float4*)sp, v1 = *(const float4*)(sp + 32);
      n0[4 * q] = v0.x; n0[4 * q + 1] = v0.y; n0[4 * q + 2] = v0.z; n0[4 * q + 3] = v0.w;
      n1[4 * q] = v1.x; n1[4 * q + 1] = v1.y; n1[4 * q + 2] = v1.z; n1[4 * q + 3] = v1.w;
    }
#pragma unroll
    for (int s = 0; s < 4; s++) {
      const u16* r0 = P + (size_t)qi * 64 + 16 * s + 4 * hh;
      const u16* r1 = P + (size_t)(32 + qi) * 64 + 16 * s + 4 * hh;
      uint2 a = *(const uint2*)r0, c = *(const uint2*)(r0 + 8), d = *(const uint2*)r1, f = *(const uint2*)(r1 + 8);
      u32x4 fa = {a.x, a.y, c.x, c.y}, fb = {d.x, d.y, f.x, f.y};
      n0 = MFMA32(*(b16x8*)&fa, zb[s], n0);
      n1 = MFMA32(*(b16x8*)&fb, zb[s], n1);
    }
    z0 = n0; z1 = n1;
    float* zs = (float*)(p.ws + OFF_SEGZ) + (size_t)(seq * 7 + g) * 4096;
#pragma unroll
    for (int q = 0; q < 4; q++) {
      float* sp = zs + (size_t)(wave * 32 + qi) * 64 + 8 * q + 4 * hh;
      *(float4*)sp = make_float4(z0[4 * q], z0[4 * q + 1], z0[4 * q + 2], z0[4 * q + 3]);
      *(float4*)(sp + 32) = make_float4(z1[4 * q], z1[4 * q + 1], z1[4 * q + 2], z1[4 * q + 3]);
    }
  }
}

DEV ScanJob ctx_job(const Params& p, int v) {
  ScanJob J;
  J.e = v >> 9; J.b = (v >> 4) & 31; J.hd = v & 15; J.tb = J.b * 256; J.L = 256; J.step0 = 0; J.nch = 8; J.pq = 0;
  J.zin = nullptr; J.zout = p.out + OUT_ST + ((size_t)(J.b * 2 + J.e) * 16 + J.hd) * 4096; J.pout = nullptr; J.qout = nullptr;
  J.ncomb = 0; J.seq = 0;
  return J;
}
DEV ScanJob smp_job(const Params& p, int seq, int g, int pq) {
  ScanJob J;
  J.e = seq >> 5; J.b = (seq >> 4) & 1; J.hd = seq & 15; J.tb = T_CTX + J.b * 4096; J.L = 4096; J.step0 = g * 512; J.nch = 16; J.pq = pq;
  J.zin = p.state_rwkv + ((size_t)(J.b * 2 + J.e) * 16 + J.hd) * 4096;
  J.ncomb = pq ? 0 : g; J.seq = seq;
  J.zout = nullptr;
  J.pout = (u16*)(p.ws + OFF_SEGP) + (size_t)(seq * 7 + g) * 4096;
  J.qout = (float*)(p.ws + OFF_SEGQ) + (size_t)(seq * 7 + g) * 4096;
  return J;
}

DEV void p8a_scan(const Params& p, char* smem) {
  if (blockIdx.x < 448) {
    for (int j = blockIdx.x; j < 448; j += 448) scan_job(p, smp_job(p, j / 7, j % 7, 1), smem);
  } else {
    {
      float4* ys = (float4*)(p.ws + OFF_YSUM);
      float4* bs = (float4*)(p.ws + OFF_BSUM);
      const size_t gt = (size_t)(blockIdx.x - 448) * 256 + threadIdx.x, gs = (size_t)(gridDim.x - 448) * 256;
      for (size_t i = gt; i < 4194304; i += gs) ys[i] = make_float4(0, 0, 0, 0);
      for (size_t i = gt; i < 65536; i += gs) bs[i] = make_float4(0, 0, 0, 0);
    }
    for (int q = blockIdx.x - 448; q < 1024; q += gridDim.x - 448) {
      int mt = q >> 3, nt = q & 7, m0 = mt * 128, n0 = nt * 128;
      u16* sz = (u16*)(p.ws + OFF_SZ) + (size_t)m0 * 1024 + n0;
      gemm_tile<false>((const u16*)(p.ws + OFF_HG) + (size_t)m0 * 128, 128, nullptr, m0, (const u16*)(p.ws + OFF_G2T) + (size_t)n0 * 128, 128, 128,
                       EpGate{sz, sz, 1024}, smem);
    }
  }
}
DEV void p8b_scan(const Params& p, char* smem) {
  if (blockIdx.x < 64) scan_combine(p, blockIdx.x);
}
DEV void p8c_scan(const Params& p, char* smem) {
  for (int j = blockIdx.x; j < 512 + 1024; j += gridDim.x) {
    if (j < 512) scan_job(p, smp_job(p, j >> 3, j & 7, 0), smem);
    else scan_job(p, ctx_job(p, j - 512), smem);
  }
}

DEV void p9_post(const Params& p) {
  const int lane = threadIdx.x & 63;
  const int gw = blockIdx.x * 4 + (threadIdx.x >> 6), nw = gridDim.x * 4;
  const float* Ysum = (const float*)(p.ws + OFF_YSUM);
  const float* Bsum = (const float*)(p.ws + OFF_BSUM);
  for (int row = gw; row < 16384; row += nw) {
    const size_t o = (size_t)row * 1024 + lane * 16;
    float y[16];
#pragma unroll
    for (int i = 0; i < 4; i++) { float4 v = *(const float4*)(Ysum + o + 4 * i); y[4 * i] = v.x; y[4 * i + 1] = v.y; y[4 * i + 2] = v.z; y[4 * i + 3] = v.w; }
    float s = 0;
#pragma unroll
    for (int i = 0; i < 16; i++) s += y[i];
    s += __shfl_xor(s, 1); s += __shfl_xor(s, 2);
    float mean = s * (1.f / 64.f), q = 0;
#pragma unroll
    for (int i = 0; i < 16; i++) { float d = y[i] - mean; q += d * d; }
    q += __shfl_xor(q, 1); q += __shfl_xor(q, 2);
    float rstd = rsqrtf(q * (1.f / 64.f) + 64e-5f);
    float bon = Bsum[(size_t)row * 16 + (lane >> 2)];
    u16* O = (u16*)(p.ws + OFF_U1) + o;
    const u16* V = (const u16*)(p.ws + OFF_V2) + o;
    const u16* Z = (const u16*)(p.ws + OFF_SZ) + o;
#pragma unroll
    for (int hlf = 0; hlf < 2; hlf++) {
      uint4 vq = *(const uint4*)(V + 8 * hlf), zq = *(const uint4*)(Z + 8 * hlf);
      const unsigned vu[4] = {vq.x, vq.y, vq.z, vq.w}, zu[4] = {zq.x, zq.y, zq.z, zq.w};
      unsigned ow[4];
#pragma unroll
      for (int w = 0; w < 4; w++) {
        int c = lane * 16 + hlf * 8 + 2 * w;
        float y0 = (y[hlf * 8 + 2 * w] - mean) * rstd * p.lnx_g[c] + p.lnx_b[c] + bon * bflo(vu[w]);
        float y1 = (y[hlf * 8 + 2 * w + 1] - mean) * rstd * p.lnx_g[c + 1] + p.lnx_b[c + 1] + bon * bfhi(vu[w]);
        ow[w] = pack2(y0 * bflo(zu[w]), y1 * bfhi(zu[w]));
      }
      *(uint4*)(O + 8 * hlf) = make_uint4(ow[0], ow[1], ow[2], ow[3]);
    }
  }
}


#define XB_TMO 128
#define XB_XCNT(j) (256 + 64 * (j))
#define XB_XSUB(j) (1280 + 64 * (j))
#define XB_XGEN(j) (2304 + 64 * (j))
#define XB_TOP 3328
#define XB_TOPGEN 3392
#define XCD_BAR_WORDS 3456
#define XB_SPIN_CAP (1u << 22)
#define LAS __attribute__((address_space(3)))
DEV unsigned xb_ld(unsigned* p) { return __hip_atomic_load(p, __ATOMIC_RELAXED, __HIP_MEMORY_SCOPE_AGENT); }
DEV unsigned xb_add(unsigned* p, unsigned v) { return __hip_atomic_fetch_add(p, v, __ATOMIC_RELAXED, __HIP_MEMORY_SCOPE_AGENT); }
DEV unsigned xb_xcc_id() { return (unsigned)__builtin_amdgcn_s_getreg((3 << 11) | 20) & 0xFu; }
#define XB_SPIN(cond, bar) do { unsigned _sp = 0; while (cond) { __builtin_amdgcn_s_sleep(4); \
    if ((++_sp & 255u) == 0u) { if (xb_ld(&(bar)[XB_TMO])) break; if (_sp > XB_SPIN_CAP) { atomicAdd(&(bar)[XB_TMO], 1u); break; } } } } while (0)
struct XcdBarrier { unsigned* bar; unsigned x; volatile LAS unsigned* st; };
DEV XcdBarrier xcd_barrier_post(unsigned* bar, volatile LAS unsigned* st) {
  XcdBarrier b; b.bar = bar; b.x = xb_xcc_id(); b.st = st;
  if (threadIdx.x == 0) (void)xb_add(&bar[XB_XCNT(b.x)], 1u);
  return b;
}
DEV void xcd_barrier_complete(unsigned* bar, unsigned x, unsigned& nloc, unsigned& nx) {
  const unsigned G = gridDim.x * gridDim.y * gridDim.z;
  unsigned sum, cnt, mine, sp = 0u;
  for (;;) {
    sum = 0u; cnt = 0u; mine = 0u;
#pragma unroll
    for (unsigned j = 0; j < 16; ++j) { const unsigned c = xb_ld(&bar[XB_XCNT(j)]); sum += c; cnt += (c > 0u) ? 1u : 0u; mine = (j == x) ? c : mine; }
    if (sum == G) break;
    __builtin_amdgcn_s_sleep(1);
    if ((++sp & 255u) == 0u) { if (xb_ld(&bar[XB_TMO])) break; if (sp > XB_SPIN_CAP) { atomicAdd(&bar[XB_TMO], 1u); break; } }
  }
  nloc = mine > 0u ? mine : 1u; nx = cnt > 0u ? cnt : 1u;
}
DEV void xcd_barrier(const XcdBarrier& b) {
  asm volatile("s_waitcnt vmcnt(0)" ::: "memory");
  __syncthreads();
  if (threadIdx.x == 0) {
    unsigned* bar = b.bar;
    __builtin_amdgcn_s_waitcnt(0);
    unsigned nloc = b.st[0], nx = b.st[1];
    if (nloc == 0u) { xcd_barrier_complete(bar, b.x, nloc, nx); b.st[0] = nloc; b.st[1] = nx; }
    const unsigned old = xb_add(&bar[XB_XSUB(b.x)], 1u);
    const unsigned gen = old / nloc;
    if (old + 1u == (gen + 1u) * nloc) {
      __builtin_amdgcn_fence(__ATOMIC_RELEASE, "agent");
      asm volatile("s_waitcnt vmcnt(0)" ::: "memory");
      const unsigned og = xb_add(&bar[XB_TOP], 1u);
      const unsigned tg = og / nx;
      if (og + 1u == (tg + 1u) * nx) xb_add(&bar[XB_TOPGEN], 1u);
      else XB_SPIN(xb_ld(&bar[XB_TOPGEN]) == tg, bar);
      __builtin_amdgcn_fence(__ATOMIC_ACQUIRE, "agent");
      xb_add(&bar[XB_XGEN(b.x)], 1u);
      asm volatile("s_waitcnt vmcnt(0)" ::: "memory");
    } else {
      XB_SPIN(xb_ld(&bar[XB_XGEN(b.x)]) == gen, bar);
      __builtin_amdgcn_fence(__ATOMIC_ACQUIRE, "agent");
      asm volatile("s_waitcnt vmcnt(0)" ::: "memory");
    }
  }
  __syncthreads();
}

__global__ void __launch_bounds__(256, 2) fwd_kernel(Params p) {
  __shared__ __attribute__((aligned(16))) char smem[73728];
#if FUSED
  __shared__ unsigned xb_st[4];
  if (threadIdx.x < 4) xb_st[threadIdx.x] = 0u;
  __syncthreads();
  const XcdBarrier xb = xcd_barrier_post((unsigned*)(p.ws + OFF_BAR), (volatile LAS unsigned*)xb_st);
  if (p.phase_hi > 1000) cg::this_grid().sync();
#define SYNC() xcd_barrier(xb)
#else
#define SYNC()
#endif
#define PH(n, call) if (p.phase_lo <= n && n <= p.phase_hi) { call; if (n < p.phase_hi) { SYNC(); } }
  PH(0, p0_prep(p, smem))
  PH(1, ln_phase<0>(p))
  PH(2, p2_gemm1(p, smem))
  PH(3, p3_mix(p, smem))
  PH(4, p3b_fold(p))
  PH(5, p4_fnet(p, smem))
  PH(6, p_outproj<0>(p, smem))
  PH(7, ln_phase<1>(p))
  PH(8, p6b_dx(p))
  PH(9, p7_rwkv_proj(p, smem))
  PH(10, p8a_scan(p, smem))
  PH(11, p8c_scan(p, smem))
  PH(12, p9_post(p))
  PH(13, p_outproj<1>(p, smem))
  PH(14, ln_phase<2>(p))
}

extern "C" void kernel_launch(void* const* d_in, const int* in_sizes, int n_in, void* d_out, int out_size, void* d_ws,
                              size_t ws_size, hipStream_t stream) {
  Params p;
  memset(&p, 0, sizeof(p));
  const float* const* in = (const float* const*)d_in;
  p.x_prompt = in[0]; p.x_sample = in[1]; p.cache_k = in[2]; p.cache_v = in[3]; p.state_rwkv = in[4]; p.c = in[5]; p.c_ctx = in[6];
  p.ada_w = in[7]; p.ada_b = in[8]; p.post_g = in[9]; p.post_b = in[10]; p.w_in = in[11]; p.w_fnet = in[12]; p.rpb = in[13]; p.w_out = in[14];
  p.mu = in[15]; p.rkvz = in[16]; p.w0 = in[17]; p.w1 = in[18]; p.w2 = in[19]; p.a0 = in[20]; p.a1 = in[21]; p.a2 = in[22];
  p.g1 = in[23]; p.g2 = in[24]; p.k_k = in[25]; p.k_a = in[26]; p.r_k = in[27]; p.lnx_g = in[28]; p.lnx_b = in[29]; p.rw_out = in[30];
  p.out = (float*)d_out; p.ws = (char*)d_ws;
  char* ws = (char*)d_ws;
  int n = 0, start = 0;
  auto add = [&](const float* src, size_t dstoff, int lds, int ldd, int tk, int tn) {
    p.tj[n].src = src; p.tj[n].dst = (u16*)(ws + dstoff); p.tj[n].lds = lds; p.tj[n].ldd = ldd; p.tj[n].tk = tk; p.tj[n].tn = tn;
    p.tj[n].start = start; p.tj[n].pad = 0; start += tk * tn; n++;
  };
  add(p.w_in, OFF_WINT, 3072, 1024, 16, 48);
  add(p.w_out, OFF_WOUTT, 1024, 1024, 16, 16);
  for (int i = 0; i < 4; i++) add(p.rkvz + (size_t)i * 1048576, OFF_RKVZT + (size_t)i * 2097152, 1024, 1024, 16, 16);
  add(p.rw_out, OFF_RWOUTT, 1024, 1024, 16, 16);
  for (int e = 0; e < 2; e++) add(p.w1 + e * 65536, OFF_W1T + (size_t)e * 64 * 1024 * 2, 64, 1024, 16, 1);
  for (int e = 0; e < 2; e++) add(p.a1 + e * 65536, OFF_A1T + (size_t)e * 64 * 1024 * 2, 64, 1024, 16, 1);
  add(p.g1, OFF_G1T, 128, 1024, 16, 2);
  for (int e = 0; e < 2; e++) add(p.w2 + e * 65536, OFF_W2T + (size_t)e * 65536 * 2, 1024, 64, 1, 16);
  for (int e = 0; e < 2; e++) add(p.a2 + e * 65536, OFF_A2T + (size_t)e * 65536 * 2, 1024, 64, 1, 16);
  add(p.g2, OFF_G2T, 1024, 128, 2, 16);
  for (int b = 0; b < 2; b++)
    for (int h = 0; h < 8; h++) add(p.cache_v + (size_t)b * 262144 + h * 64, OFF_CVT + (size_t)(b * 8 + h) * 64 * 512 * 2, 512, 512, 8, 1);
  p.ntr = start;

  static int grid_blocks = 0;
  if (!grid_blocks) {
    int dev = 0, cus = 0, per_cu = 0;
    (void)hipGetDevice(&dev);
    (void)hipDeviceGetAttribute(&cus, hipDeviceAttributeMultiprocessorCount, dev);
    (void)hipOccupancyMaxActiveBlocksPerMultiprocessor(&per_cu, fwd_kernel, 256, 0);
    if (per_cu > 2) per_cu = 2;
    if (per_cu < 1) per_cu = 1;
    grid_blocks = cus * per_cu;
  }
#if FUSED
  p.phase_lo = 0; p.phase_hi = 14;
  void* args[] = {&p};
  (void)hipMemsetAsync((char*)d_ws + OFF_BAR, 0, 16384, stream);
  hipError_t e = hipLaunchCooperativeKernel((void*)fwd_kernel, dim3(grid_blocks), dim3(256), args, 0, stream);
  if (e != hipSuccess) fprintf(stderr, "cooperative launch failed: %s (grid %d)\n", hipGetErrorString(e), grid_blocks);
#else
#ifndef PROBE_SEQ
#define PROBE_SEQ 0,1,2,3,4,5,6,7,8,9,10,11,12,13,14
#endif
  const int seq[] = {PROBE_SEQ};
  for (int i = 0; i < (int)(sizeof(seq) / sizeof(int)); i++) {
    p.phase_lo = seq[i]; p.phase_hi = seq[i];
    fwd_kernel<<<grid_blocks, 256, 0, stream>>>(p);
  }
#endif
}
```

```cpp
#include <hip/hip_runtime.h>
#include <hip/hip_cooperative_groups.h>
#include <stdint.h>
#include <cstdio>
#include <cstring>
namespace cg = cooperative_groups;

#ifndef FUSED
#define FUSED 1
#endif

typedef unsigned short u16;
typedef __attribute__((ext_vector_type(8))) __bf16 b16x8;
typedef __attribute__((ext_vector_type(16))) float f32x16;
typedef __attribute__((ext_vector_type(4))) unsigned u32x4;
typedef __attribute__((ext_vector_type(2))) unsigned u32x2;
#define DEV __device__ __forceinline__

constexpr int T_CTX = 8192;
constexpr float ALPHA_DN = 1.41421356237f;
constexpr float LOG2E = 1.44269504089f;
constexpr size_t MiB = 1u << 20;
constexpr size_t OFF_MODS = 0, OFF_BAR = 512 * 1024, OFF_BSUM = 1 * MiB;
constexpr size_t OFF_FSMP = 2 * MiB, OFF_U = 66 * MiB, OFF_ABUF = 98 * MiB, OFF_Q = 114 * MiB, OFF_K = 130 * MiB;
constexpr size_t OFF_VTC = 146 * MiB, OFF_VTS = 154 * MiB, OFF_GBUF = 162 * MiB, OFF_BTC = 194 * MiB, OFF_BTS = 210 * MiB;
constexpr size_t OFF_WINT = 226 * MiB, OFF_WOUTT = 232 * MiB, OFF_MCAT = 234 * MiB, OFF_FCTX = 234 * MiB + 256 * 1024;
constexpr size_t OFF_CK = 234 * MiB + 512 * 1024, OFF_CVT = 235 * MiB + 512 * 1024;
constexpr size_t OFF_RKVZT = 237 * MiB, OFF_RWOUTT = 245 * MiB, OFF_W1T = 247 * MiB, OFF_A1T = OFF_W1T + 256 * 1024,
                 OFF_G1T = OFF_W1T + 512 * 1024, OFF_W2T = OFF_W1T + 768 * 1024, OFF_A2T = 248 * MiB,
                 OFF_G2T = 248 * MiB + 256 * 1024, OFF_HW = 248 * MiB + 512 * 1024;
constexpr size_t OFF_U1 = 2 * MiB, OFF_R = 34 * MiB, OFF_K2 = 66 * MiB, OFF_V2 = 98 * MiB, OFF_SZ = 130 * MiB,
                 OFF_YSUM = 162 * MiB, OFF_HA = 226 * MiB, OFF_HG = 230 * MiB;
constexpr size_t OFF_BFOLD = 98 * MiB;
constexpr size_t OFF_Y0B = 98 * MiB, OFF_Y1B = 34 * MiB;
constexpr size_t OFF_DX = 162 * MiB;
constexpr size_t OFF_SEGP = 2 * MiB, OFF_SEGQ = 6 * MiB, OFF_SEGZ = 14 * MiB;
constexpr size_t OUT_NK = 16777216, OUT_NV = 20971520, OUT_ST = 25165824;

constexpr int NTJ = 33;
struct TJob { const float* src; u16* dst; int lds, ldd, tk, tn, start, pad; };

struct Params {
  const float *x_prompt, *x_sample, *cache_k, *cache_v, *state_rwkv, *c, *c_ctx;
  const float *ada_w, *ada_b, *post_g, *post_b, *w_in, *w_fnet, *rpb, *w_out;
  const float *mu, *rkvz, *w0, *w1, *w2, *a0, *a1, *a2, *g1, *g2, *k_k, *k_a, *r_k, *lnx_g, *lnx_b, *rw_out;
  float* out; char* ws;
  int phase_lo, phase_hi, ntr, pad;
  TJob tj[NTJ];
};

typedef __attribute__((ext_vector_type(2))) __bf16 bf16x2_t;
typedef __attribute__((ext_vector_type(2))) float f32x2_t;
DEV unsigned pack2(float a, float b) {
  f32x2_t f = {a, b};
  bf16x2_t r = __builtin_convertvector(f, bf16x2_t);
  return *(unsigned*)&r;
}
DEV u16 f2bf(float f) { return (u16)(pack2(f, 0.f) & 0xffffu); }
DEV float bflo(unsigned w) { return __uint_as_float(w << 16); }
DEV float bfhi(unsigned w) { return __uint_as_float(w & 0xffff0000u); }
DEV float rcp_f(float x) { return __builtin_amdgcn_rcpf(x); }
DEV float sigm(float x) { return rcp_f(1.f + __expf(-x)); }
DEV float silu(float x) { return x * rcp_f(1.f + __expf(-x)); }
DEV float tanh_f(float x) { return 1.f - 2.f * rcp_f(__expf(2.f * x) + 1.f); }
DEV b16x8 ld16(const u16* p) { uint4 v = *(const uint4*)p; return *(b16x8*)&v; }
DEV b16x8 asb(uint4 v) { return *(b16x8*)&v; }
template <int CTRL> DEV float dpp_add(float x) {
  return x + __int_as_float(__builtin_amdgcn_update_dpp(0, __float_as_int(x), CTRL, 0xf, 0xf, true));
}
DEV float allsum8(float x) {
  x = dpp_add<0xB1>(x); x = dpp_add<0x4E>(x); x = dpp_add<0x141>(x);
  return x;
}
DEV float wave_sum(float x) {
  x = dpp_add<0xB1>(x); x = dpp_add<0x4E>(x); x = dpp_add<0x141>(x); x = dpp_add<0x140>(x);
  x += __shfl_xor(x, 16); x += __shfl_xor(x, 32);
  return x;
}
DEV float allsum16(float x) {
  x = dpp_add<0xB1>(x); x = dpp_add<0x4E>(x); x = dpp_add<0x124>(x); x = dpp_add<0x128>(x);
  return x;
}
DEV void lds_barrier() { asm volatile("s_waitcnt lgkmcnt(0)\n\ts_barrier" ::: "memory"); }
DEV int mv_of(int token) { return token < T_CTX ? 0 : 1 + ((token - T_CTX) >> 12); }

template <bool LERP, class EP>
DEV void gemm_tile(const u16* __restrict__ A, int lda, const float* __restrict__ mu, int m0,
                   const u16* __restrict__ B, int ldb, int K, EP ep, char* smem) {
  u16(*sA0)[72] = (u16(*)[72])smem;
  u16(*sB0)[72] = (u16(*)[72])(smem + 18432);
  u16(*sA1)[72] = (u16(*)[72])(smem + 36864);
  u16(*sB1)[72] = (u16(*)[72])(smem + 36864 + 18432);
  int tid = threadIdx.x;
  asm volatile("" : "+v"(tid));
  const int lane = tid & 63, wave = tid >> 6, wm = wave >> 1, wn = wave & 1;
  const int lr = tid >> 3, lk = (tid & 7) * 8;
  f32x16 acc[2][2];
#pragma unroll
  for (int i = 0; i < 2; i++)
#pragma unroll
    for (int j = 0; j < 2; j++)
#pragma unroll
      for (int r = 0; r < 16; r++) acc[i][j][r] = 0.f;
  u32x4 ra0[4], rb0[4], rp0[4], ra1[4], rb1[4], rp1[4];
  float4 mu00, mu01, mu10, mu11;
  const u16* DXp = nullptr;
  if constexpr (LERP) DXp = (const u16*)(A) + (OFF_DX - OFF_U1) / 2;
#define GLOAD(K0, RA, RB, RP, M0, M1)                                                     \
  {                                                                                       \
    _Pragma("unroll") for (int i = 0; i < 4; i++) {                                       \
      int r = lr + 32 * i;                                                                \
      if constexpr (LERP) {                                                               \
        RA[i] = *(const u32x4*)(A + (size_t)(m0 + r) * lda + (K0) + lk);                  \
        RP[i] = *(const u32x4*)(DXp + (size_t)(m0 + r) * lda + (K0) + lk);                \
      } else {                                                                            \
        RA[i] = *(const u32x4*)(A + (size_t)r * lda + (K0) + lk);                         \
      }                                                                                   \
      RB[i] = *(const u32x4*)(B + (size_t)r * ldb + (K0) + lk);                           \
    }                                                                                     \
    if constexpr (LERP) {                                                                 \
      M0 = *(const float4*)(mu + (K0) + lk);                                              \
      M1 = *(const float4*)(mu + (K0) + lk + 4);                                          \
    }                                                                                     \
  }
#define GSTORE(RA, RB, RP, M0, M1, sA, sB)                                                     \
  {                                                                                       \
    _Pragma("unroll") for (int i = 0; i < 4; i++) {                                       \
      int r = lr + 32 * i;                                                                \
      u32x4 av = RA[i];                                                                   \
      if constexpr (LERP) {                                                               \
        unsigned cu[4] = {RA[i].x, RA[i].y, RA[i].z, RA[i].w};                            \
        unsigned du[4] = {RP[i].x, RP[i].y, RP[i].z, RP[i].w};                            \
        float m[8] = {M0.x, M0.y, M0.z, M0.w, M1.x, M1.y, M1.z, M1.w};                    \
        unsigned o[4];                                                                    \
        _Pragma("unroll") for (int q = 0; q < 4; q++)                                     \
          o[q] = pack2(bflo(cu[q]) + bflo(du[q]) * m[2 * q], bfhi(cu[q]) + bfhi(du[q]) * m[2 * q + 1]); \
        av = u32x4{o[0], o[1], o[2], o[3]};                                               \
      }                                                                                   \
      *(u32x4*)&sA[r][lk] = av;                                                           \
      *(u32x4*)&sB[r][lk] = RB[i];                                                        \
    }                                                                                     \
  }
#define GCOMPUTE(sA, sB)                                                                  \
  {                                                                                       \
    _Pragma("unroll") for (int ks = 0; ks < 4; ks++) {                                    \
      b16x8 af[2], bf[2];                                                                 \
      _Pragma("unroll") for (int i = 0; i < 2; i++) {                                     \
        af[i] = *(const b16x8*)&sA[wm * 64 + i * 32 + (lane & 31)][ks * 16 + (lane >> 5) * 8]; \
        bf[i] = *(const b16x8*)&sB[wn * 64 + i * 32 + (lane & 31)][ks * 16 + (lane >> 5) * 8]; \
      }                                                                                   \
      _Pragma("unroll") for (int i = 0; i < 2; i++)                                       \
        _Pragma("unroll") for (int j = 0; j < 2; j++)                                     \
          acc[i][j] = __builtin_amdgcn_mfma_f32_32x32x16_bf16(af[i], bf[j], acc[i][j], 0, 0, 0); \
    }                                                                                     \
  }
#define GPIPE()                                                                           \
  {                                                                                       \
    __builtin_amdgcn_sched_group_barrier(0x100, 4, 0);                                    \
    _Pragma("unroll") for (int pi = 0; pi < 16; pi++) {                                   \
      __builtin_amdgcn_sched_group_barrier(0x008, 1, 0);                                  \
      __builtin_amdgcn_sched_group_barrier(0x100, 1, 0);                                  \
      __builtin_amdgcn_sched_group_barrier(0x002, 7, 0);                                  \
      __builtin_amdgcn_sched_group_barrier(0x200, 1, 0);                                  \
    }                                                                                     \
  }
  GLOAD(0, ra0, rb0, rp0, mu00, mu01);
  GLOAD(64, ra1, rb1, rp1, mu10, mu11);
  __syncthreads();
  GSTORE(ra0, rb0, rp0, mu00, mu01, sA0, sB0);
  if (128 < K) GLOAD(128, ra0, rb0, rp0, mu00, mu01);
  __syncthreads();
#pragma unroll 1
  for (int k0 = 0; k0 < K; k0 += 128) {
    __builtin_amdgcn_s_setprio(1);
    GCOMPUTE(sA0, sB0);
    GSTORE(ra1, rb1, rp1, mu10, mu11, sA1, sB1);
    {
      const int kn = k0 + 192 < K ? k0 + 192 : K - 64;
      GLOAD(kn, ra1, rb1, rp1, mu10, mu11);
    }
    GPIPE();
    __builtin_amdgcn_s_setprio(0);
    __syncthreads();
    __builtin_amdgcn_s_setprio(1);
    GCOMPUTE(sA1, sB1);
    __builtin_amdgcn_s_setprio(0);
    if (k0 + 128 < K) {
      GSTORE(ra0, rb0, rp0, mu00, mu01, sA0, sB0);
      if (k0 + 256 < K) GLOAD(k0 + 256, ra0, rb0, rp0, mu00, mu01);
    }
    __syncthreads();
  }
#undef GLOAD
#undef GSTORE
#undef GCOMPUTE
#undef GPIPE
  __syncthreads();
  int tide = tid;
  asm volatile("" : "+v"(tide));
  const int lane_e = tide & 63, wv_e = tide >> 6, wm_e = wv_e >> 1, wn_e = wv_e & 1;
  u16* stg = (u16*)smem + wv_e * (64 * 72);
#pragma unroll
  for (int i = 0; i < 2; i++)
#pragma unroll
    for (int j = 0; j < 2; j++)
#pragma unroll
      for (int q = 0; q < 4; q++) {
        const int r = i * 32 + q * 8 + (lane_e >> 5) * 4, c = j * 32 + (lane_e & 31);
        const float v0 = acc[i][j][q * 4 + 0], v1 = acc[i][j][q * 4 + 1], v2 = acc[i][j][q * 4 + 2], v3 = acc[i][j][q * 4 + 3];
        ep.direct(wm_e * 64 + r, wn_e * 64 + c, v0, v1, v2, v3);
        if constexpr (EP::TRANS) {
          *(uint2*)(stg + c * 72 + r) = make_uint2(pack2(ep.act(v0), ep.act(v1)), pack2(ep.act(v2), ep.act(v3)));
        } else {
          const unsigned p01 = pack2(ep.act(v0), ep.act(v1)), p23 = pack2(ep.act(v2), ep.act(v3));
          stg[(r + 0) * 72 + c] = (u16)(p01 & 0xffffu); stg[(r + 1) * 72 + c] = (u16)(p01 >> 16);
          stg[(r + 2) * 72 + c] = (u16)(p23 & 0xffffu); stg[(r + 3) * 72 + c] = (u16)(p23 >> 16);
        }
      }
#pragma unroll
  for (int n = 0; n < 8; n++) {
    const int id = lane_e + 64 * n, rr = id >> 3, cc = (id & 7) * 8;
    const u32x4 v = *(const u32x4*)(stg + rr * 72 + cc);
    if constexpr (EP::TRANS) ep.store(wn_e * 64 + rr, wm_e * 64 + cc, v);
    else ep.store(wm_e * 64 + rr, wn_e * 64 + cc, v);
  }
}

template <int ACT> struct EpStore {
  static constexpr bool TRANS = false;
  u16* dst; int ld; float scale;
  DEV float act(float x) const {
    if (ACT == 1) return silu(x);
    if (ACT == 2) return tanh_f(x);
    if (ACT == 3) return sigm(x);
    if (ACT == 4) return x * scale;
    return x;
  }
  DEV void direct(int, int, float, float, float, float) const {}
  DEV void store(int R, int C, u32x4 v) const { *(u32x4*)(dst + (size_t)R * ld + C) = v; }
};
struct EpNull {
  static constexpr bool TRANS = false;
  DEV float act(float x) const { return x; }
  DEV void direct(int, int, float, float, float, float) const {}
  DEV void store(int, int, u32x4) const {}
};
struct EpKeep {
  static constexpr bool TRANS = false;
  u16* dst; int ld; float* f32dst; int ldf;
  DEV float act(float x) const { return x; }
  DEV void direct(int r, int c, float v0, float v1, float v2, float v3) const {
    if (f32dst) {
      f32dst[(size_t)(r + 0) * ldf + c] = v0; f32dst[(size_t)(r + 1) * ldf + c] = v1;
      f32dst[(size_t)(r + 2) * ldf + c] = v2; f32dst[(size_t)(r + 3) * ldf + c] = v3;
    }
  }
  DEV void store(int R, int C, u32x4 v) const { *(u32x4*)(dst + (size_t)R * ld + C) = v; }
};
struct EpTrans {
  static constexpr bool TRANS = true;
  u16* dst; size_t ldt; float* f32dst; int ldf;
  DEV float act(float x) const { return x; }
  DEV void direct(int r, int c, float v0, float v1, float v2, float v3) const {
    if (f32dst) {
      f32dst[(size_t)(r + 0) * ldf + c] = v0; f32dst[(size_t)(r + 1) * ldf + c] = v1;
      f32dst[(size_t)(r + 2) * ldf + c] = v2; f32dst[(size_t)(r + 3) * ldf + c] = v3;
    }
  }
  DEV void store(int Rc, int Cr, u32x4 v) const { *(u32x4*)(dst + (size_t)Rc * ldt + Cr) = v; }
};
struct EpGate {
  static constexpr bool TRANS = false;
  u16* dst; const u16* gate; int ld;
  DEV float act(float x) const { return x; }
  DEV void direct(int, int, float, float, float, float) const {}
  DEV void store(int R, int C, u32x4 v) const {
    const size_t o = (size_t)R * ld + C;
    const u32x4 g = *(const u32x4*)(gate + o);
    u32x4 r;
    r.x = pack2(bflo(v.x) * bflo(g.x), bfhi(v.x) * bfhi(g.x)); r.y = pack2(bflo(v.y) * bflo(g.y), bfhi(v.y) * bfhi(g.y));
    r.z = pack2(bflo(v.z) * bflo(g.z), bfhi(v.z) * bfhi(g.z)); r.w = pack2(bflo(v.w) * bflo(g.w), bfhi(v.w) * bfhi(g.w));
    *(u32x4*)(dst + o) = r;
  }
};
struct EpRes {
  static constexpr bool TRANS = false;
  u16* dst; const float* xsrc; const float* gate;
  DEV float act(float x) const { return x; }
  DEV void direct(int, int, float, float, float, float) const {}
  DEV void store(int R, int C, u32x4 v) const {
    const size_t o = (size_t)R * 1024 + C;
    const float4 x0 = *(const float4*)(xsrc + o), x1 = *(const float4*)(xsrc + o + 4);
    const float4 g0 = *(const float4*)(gate + C), g1 = *(const float4*)(gate + C + 4);
    u32x4 r;
    r.x = pack2(ALPHA_DN * x0.x + (1.f + g0.x) * bflo(v.x), ALPHA_DN * x0.y + (1.f + g0.y) * bfhi(v.x));
    r.y = pack2(ALPHA_DN * x0.z + (1.f + g0.z) * bflo(v.y), ALPHA_DN * x0.w + (1.f + g0.w) * bfhi(v.y));
    r.z = pack2(ALPHA_DN * x1.x + (1.f + g1.x) * bflo(v.z), ALPHA_DN * x1.y + (1.f + g1.y) * bfhi(v.z));
    r.w = pack2(ALPHA_DN * x1.z + (1.f + g1.z) * bflo(v.w), ALPHA_DN * x1.w + (1.f + g1.w) * bfhi(v.w));
    *(u32x4*)(dst + o) = r;
  }
};

DEV void p0_prep(const Params& p, char* smem) {
  const int tid = threadIdx.x;
  const int njobs = 192 + p.ntr;
  for (int job = blockIdx.x; job < njobs; job += gridDim.x) {
    __syncthreads();
    if (job < 192) {
      float* sc = (float*)smem;
      float* red = sc + 3072;
      for (int i = tid; i < 3072; i += 256) {
        int m = i >> 10, k = i & 1023;
        float cv = m == 0 ? p.c_ctx[k] : p.c[(m - 1) * 1024 + k];
        sc[i] = silu(cv);
      }
      __syncthreads();
      int l = job / 96, col = (job % 96) * 32 + (tid & 31), ks = tid >> 5;
      const float* w = p.ada_w + (size_t)l * 1024 * 3072 + col;
      float a0 = 0, a1 = 0, a2 = 0;
#pragma unroll 8
      for (int k = ks * 128; k < ks * 128 + 128; k++) {
        float wv = w[(size_t)k * 3072];
        a0 += sc[k] * wv; a1 += sc[1024 + k] * wv; a2 += sc[2048 + k] * wv;
      }
      red[(ks * 32 + (tid & 31)) * 3 + 0] = a0; red[(ks * 32 + (tid & 31)) * 3 + 1] = a1; red[(ks * 32 + (tid & 31)) * 3 + 2] = a2;
      __syncthreads();
      if (tid < 96) {
        int cl = tid & 31, m = tid >> 5;
        float s = 0;
        for (int q = 0; q < 8; q++) s += red[(q * 32 + cl) * 3 + m];
        int cc = (job % 96) * 32 + cl;
        ((float*)(p.ws + OFF_MODS))[(l * 3 + m) * 3072 + cc] = s + p.ada_b[l * 3072 + cc];
      }
    } else {
      int tj = job - 192, e = 0;
      while (e + 1 < NTJ && p.tj[e + 1].start <= tj) e++;
      const TJob J = p.tj[e];
      int lt = tj - J.start, tkk = lt / J.tn, tnn = lt % J.tn;
      float(*tile)[65] = (float(*)[65])smem;
      const float* src = J.src + (size_t)(tkk * 64) * J.lds + tnn * 64;
#pragma unroll
      for (int i = 0; i < 4; i++) {
        int kk = (tid >> 4) + 16 * i, nn = (tid & 15) * 4;
        float4 v = *(const float4*)(src + (size_t)kk * J.lds + nn);
        tile[kk][nn] = v.x; tile[kk][nn + 1] = v.y; tile[kk][nn + 2] = v.z; tile[kk][nn + 3] = v.w;
      }
      __syncthreads();
      u16* dst = J.dst + (size_t)(tnn * 64) * J.ldd + tkk * 64;
#pragma unroll
      for (int i = 0; i < 2; i++) {
        int nn = (tid >> 3) + 32 * i, kk = (tid & 7) * 8;
        uint4 o;
        o.x = pack2(tile[kk][nn], tile[kk + 1][nn]); o.y = pack2(tile[kk + 2][nn], tile[kk + 3][nn]);
        o.z = pack2(tile[kk + 4][nn], tile[kk + 5][nn]); o.w = pack2(tile[kk + 6][nn], tile[kk + 7][nn]);
        *(uint4*)(dst + (size_t)nn * J.ldd + kk) = o;
      }
    }
  }
  const size_t gt = (size_t)blockIdx.x * 256 + tid, gs = (size_t)gridDim.x * 256;
  {
    u16* ck = (u16*)(p.ws + OFF_CK);
    for (size_t i = gt; i < 65536; i += gs) {
      float4 a = *(const float4*)(p.cache_k + i * 8), b = *(const float4*)(p.cache_k + i * 8 + 4);
      *(uint4*)(ck + i * 8) = make_uint4(pack2(a.x, a.y), pack2(a.z, a.w), pack2(b.x, b.y), pack2(b.z, b.w));
    }
  }
  {
    u16* fs = (u16*)(p.ws + OFF_FSMP);
    const float sc = 0.001381067932f;
    for (size_t i = gt; i < 2097152; i += gs) {
      int lp = (int)(i >> 9), j0 = (int)(i & 511) * 8;
      unsigned o[4];
#pragma unroll
      for (int q = 0; q < 4; q++) {
        float v[2];
#pragma unroll
        for (int z = 0; z < 2; z++) {
          int j = j0 + 2 * q + z;
          bool cs = j <= 2048;
          int ph = (lp * (cs ? j : j - 2048)) & 4095;
          float ang = (float)ph * (6.283185307179586f / 4096.f);
          v[z] = (cs ? __cosf(ang) : -__sinf(ang)) * sc;
        }
        o[q] = pack2(v[0], v[1]);
      }
      *(uint4*)(fs + i * 8) = make_uint4(o[0], o[1], o[2], o[3]);
    }
    u16* fc = (u16*)(p.ws + OFF_FCTX);
    const float sc2 = 0.005524271728f;
    for (size_t i = gt; i < 16384; i += gs) {
      int lp = (int)(i >> 6), j0 = (int)(i & 63) * 8;
      unsigned o[4];
#pragma unroll
      for (int q = 0; q < 4; q++) {
        float v[2];
#pragma unroll
        for (int z = 0; z < 2; z++) {
          int j = j0 + 2 * q + z;
          int ph = (lp * (j & 255)) & 255;
          float ang = (float)ph * (6.283185307179586f / 256.f);
          v[z] = (j < 256 ? __cosf(ang) : -__sinf(ang)) * sc2;
        }
        o[q] = pack2(v[0], v[1]);
      }
      *(uint4*)(fc + i * 8) = make_uint4(o[0], o[1], o[2], o[3]);
    }
  }
  {
    u16* mc = (u16*)(p.ws + OFF_MCAT);
    for (size_t i = gt; i < 131072; i += gs) {
      int c = (int)(i & 127), ep = (int)((i >> 7) & 255), g = (int)(i >> 15);
      const float* wf = p.w_fnet + (size_t)g * 16384 + (ep & 127);
      float s = 0;
      for (int cp = 0; cp < 128; cp++) {
        float ang = (float)((c * cp) & 127) * (6.283185307179586f / 128.f);
        float tw = ep < 128 ? __cosf(ang) : __sinf(ang);
        s += tw * wf[cp * 128];
      }
      mc[i] = f2bf(s);
    }
  }
}

DEV void ln_stats(const float4 (&x)[4], float& mean, float& rstd) {
  float s = 0;
#pragma unroll
  for (int i = 0; i < 4; i++) s += x[i].x + x[i].y + x[i].z + x[i].w;
  mean = wave_sum(s) * (1.f / 1024.f);
  float q = 0;
#pragma unroll
  for (int i = 0; i < 4; i++) {
    float a = x[i].x - mean, b = x[i].y - mean, c = x[i].z - mean, d = x[i].w - mean;
    q += a * a + b * b + c * c + d * d;
  }
  rstd = rsqrtf(wave_sum(q) * (1.f / 1024.f) + 1e-6f);
}

template <int MODE> DEV void ln_phase(const Params& p) {
  const int lane = threadIdx.x & 63;
  const int gw = blockIdx.x * 4 + (threadIdx.x >> 6), nw = gridDim.x * 4;
  const float* mods = (const float*)(p.ws + OFF_MODS);
  typedef __attribute__((ext_vector_type(4))) float f32x4v;
  f32x4v xn[4];
  u32x2 wn[4];
  auto fetch = [&](int row) {
    if (MODE == 0) {
      const float* src = row < T_CTX ? p.x_prompt + (size_t)row * 1024 : p.x_sample + (size_t)(row - T_CTX) * 1024;
#pragma unroll
      for (int i = 0; i < 4; i++) xn[i] = *(const f32x4v*)(src + lane * 4 + 256 * i);
    } else {
      const u16* sb = (const u16*)(p.ws + (MODE == 1 ? OFF_Y0B : OFF_Y1B)) + (size_t)row * 1024;
#pragma unroll
      for (int i = 0; i < 4; i++) wn[i] = *(const u32x2*)(sb + lane * 4 + 256 * i);
    }
  };
  if (gw < 16384) fetch(gw);
  for (int row = gw; row < 16384; row += nw) {
    float4 x[4];
#pragma unroll
    for (int i = 0; i < 4; i++) {
      if (MODE == 0) x[i] = make_float4(xn[i].x, xn[i].y, xn[i].z, xn[i].w);
      else x[i] = make_float4(bflo(wn[i].x), bfhi(wn[i].x), bflo(wn[i].y), bfhi(wn[i].y));
    }
    if (row + nw < 16384) fetch(row + nw);
    float mean, rstd;
    ln_stats(x, mean, rstd);
    if (MODE >= 1) {
      const float* g = p.post_g + (MODE == 1 ? 0 : 1024);
      const float* b = p.post_b + (MODE == 1 ? 0 : 1024);
      float* dst = p.out + (size_t)row * 1024;
#pragma unroll
      for (int i = 0; i < 4; i++) {
        float4 gv = *(const float4*)(g + lane * 4 + 256 * i), bv = *(const float4*)(b + lane * 4 + 256 * i);
        x[i].x = (x[i].x - mean) * rstd * gv.x + bv.x; x[i].y = (x[i].y - mean) * rstd * gv.y + bv.y;
        x[i].z = (x[i].z - mean) * rstd * gv.z + bv.z; x[i].w = (x[i].w - mean) * rstd * gv.w + bv.w;
        *(float4*)(dst + lane * 4 + 256 * i) = x[i];
      }
      if (MODE == 2) continue;
      ln_stats(x, mean, rstd);
    }
    const float* md = mods + ((MODE == 0 ? 0 : 3) + mv_of(row)) * 3072;
    u16* ud = (u16*)(p.ws + (MODE == 0 ? OFF_U : OFF_U1)) + (size_t)row * 1024;
#pragma unroll
    for (int i = 0; i < 4; i++) {
      int k = lane * 4 + 256 * i;
      float4 sh = *(const float4*)(md + k), sc = *(const float4*)(md + 1024 + k);
      float a = (x[i].x - mean) * rstd * (1.f + sc.x) + sh.x, b = (x[i].y - mean) * rstd * (1.f + sc.y) + sh.y;
      float c = (x[i].z - mean) * rstd * (1.f + sc.z) + sh.z, d = (x[i].w - mean) * rstd * (1.f + sc.w) + sh.w;
      *(uint2*)(ud + k) = make_uint2(pack2(a, b), pack2(c, d));
    }
  }
}

DEV void p2_gemm1(const Params& p, char* smem) {
  const u16* U = (const u16*)(p.ws + OFF_U);
  const u16* W = (const u16*)(p.ws + OFF_WINT);
  const int xcd = blockIdx.x & 7, jx = blockIdx.x >> 3, nbx = gridDim.x >> 3;
  for (int q = jx; q < 16 * 24; q += nbx) {
    int st = q >> 6, w = q & 63, sm = st / 3, sn = st % 3;
    int mt = xcd * 16 + sm * 8 + (w >> 3), nt = sn * 8 + (w & 7);
    int m0 = mt * 128, n0 = nt * 128, sec = nt >> 2, nc = (nt & 3) * 128;
    const u16* A = U + (size_t)m0 * 1024;
    const u16* B = W + (size_t)n0 * 1024;
    if (sec == 0) {
      gemm_tile<false>(A, 1024, nullptr, m0, B, 1024, 1024, EpStore<0>{(u16*)(p.ws + OFF_ABUF) + (size_t)m0 * 512 + nc, 512, 1.f}, smem);
    } else if (sec == 1 || sec == 5) {
      gemm_tile<false>(A, 1024, nullptr, m0, B, 1024, 1024,
                       EpStore<1>{(u16*)(p.ws + OFF_GBUF) + (size_t)m0 * 1024 + (sec == 5 ? 512 : 0) + nc, 1024, 1.f}, smem);
    } else if (sec == 2) {
      gemm_tile<false>(A, 1024, nullptr, m0, B, 1024, 1024, EpStore<4>{(u16*)(p.ws + OFF_Q) + (size_t)m0 * 512 + nc, 512, 0.125f * LOG2E}, smem);
    } else if (sec == 3) {
      float* f = m0 < T_CTX ? p.out + OUT_NK + (size_t)m0 * 512 + nc : nullptr;
      gemm_tile<false>(A, 1024, nullptr, m0, B, 1024, 1024, EpKeep{(u16*)(p.ws + OFF_K) + (size_t)m0 * 512 + nc, 512, f, 512}, smem);
    } else {
      float* f = m0 < T_CTX ? p.out + OUT_NV + (size_t)m0 * 512 + nc : nullptr;
      u16* d; size_t ldt;
      if (m0 < T_CTX) { int b = m0 >> 8, l = m0 & 255; ldt = 256; d = (u16*)(p.ws + OFF_VTC) + ((size_t)b * 512 + nc) * 256 + l; }
      else { int tt = m0 - T_CTX, b = tt >> 12, l = tt & 4095; ldt = 4096; d = (u16*)(p.ws + OFF_VTS) + ((size_t)b * 512 + nc) * 4096 + l; }
      gemm_tile<false>(A, 1024, nullptr, m0, B, 1024, 1024, EpTrans{d, ldt, f, 512}, smem);
    }
  }
}

struct AttnState { f32x16 o0, o1; float m, l; };

DEV void attn_tile(AttnState& st, const b16x8 (&qf)[4], const u16* kS, const u16* vS, int mode, int dr, int kc0, int c,
                   const float* rpbh, int qi, int hh) {
  f32x16 s;
#pragma unroll
  for (int r = 0; r < 16; r++) s[r] = 0.f;
#pragma unroll
  for (int ks = 0; ks < 4; ks++) s = __builtin_amdgcn_mfma_f32_32x32x16_bf16(*(const b16x8*)(kS + qi * 72 + ks * 16 + hh * 8), qf[ks], s, 0, 0, 0);
  if (mode) {
    int cs = min(max(c - 8, 0), 48);
#pragma unroll
    for (int r = 0; r < 16; r++) {
      int kc = kc0 + (r & 3) + 8 * (r >> 2) + 4 * hh;
      bool valid = (kc >= cs) && (kc < cs + 16);
      int dc = min(max(kc - c + 15, 0), 30);
      float bias = rpbh[dr * 31 + dc] * LOG2E;
      s[r] = valid ? s[r] + bias : -1e30f;
    }
  }
  float tm = s[0];
#pragma unroll
  for (int r = 1; r < 16; r++) tm = fmaxf(tm, s[r]);
  tm = fmaxf(tm, __shfl_xor(tm, 32));
  float mn = fmaxf(st.m, tm);
  float alpha = __builtin_amdgcn_exp2f(st.m - mn);
  st.m = mn;
  float ps = 0;
#pragma unroll
  for (int r = 0; r < 16; r++) { float e = __builtin_amdgcn_exp2f(s[r] - mn); ps += e; s[r] = e; }
  st.l = st.l * alpha + ps;
#pragma unroll
  for (int r = 0; r < 16; r++) { st.o0[r] *= alpha; st.o1[r] *= alpha; }
#pragma unroll
  for (int s2 = 0; s2 < 2; s2++) {
    u32x4 pw = {pack2(s[8 * s2 + 0], s[8 * s2 + 1]), pack2(s[8 * s2 + 2], s[8 * s2 + 3]),
                pack2(s[8 * s2 + 4], s[8 * s2 + 5]), pack2(s[8 * s2 + 6], s[8 * s2 + 7])};
    b16x8 pfr = *(b16x8*)&pw;
#pragma unroll
    for (int dt = 0; dt < 2; dt++) {
      const u16* vr = vS + (dt * 32 + qi) * 40 + 16 * s2 + 4 * hh;
      const uint2 lo = *(const uint2*)vr, hi = *(const uint2*)(vr + 8);
      u32x4 vw = {lo.x, lo.y, hi.x, hi.y};
      b16x8 vf = *(b16x8*)&vw;
      if (dt == 0) st.o0 = __builtin_amdgcn_mfma_f32_32x32x16_bf16(vf, pfr, st.o0, 0, 0, 0);
      else st.o1 = __builtin_amdgcn_mfma_f32_32x32x16_bf16(vf, pfr, st.o1, 0, 0, 0);
    }
  }
}

DEV void attn_unit(const Params& p, int u, int lane, char* smem) {
  const u16* Qb = (const u16*)(p.ws + OFF_Q);
  const u16* Kb = (const u16*)(p.ws + OFF_K);
  const int qi = lane & 31, hh = lane >> 5;
  u16* kS = (u16*)smem + (threadIdx.x >> 6) * 4864;
  u16* vS = kS + 32 * 72;
  bool smp = u < 2048;
  int b, h, qg, tq0, r = 0, c0 = 0;
  if (smp) { b = u >> 10; h = (u >> 7) & 7; qg = u & 127; tq0 = T_CTX + b * 4096 + qg * 32; r = qg >> 1; c0 = (qg & 1) * 32; }
  else { int v = u - 2048; b = v >> 6; h = (v >> 3) & 7; qg = v & 7; tq0 = b * 256 + qg * 32; }
  b16x8 qf[4];
#pragma unroll
  for (int s = 0; s < 4; s++) qf[s] = ld16(Qb + (size_t)(tq0 + qi) * 512 + h * 64 + s * 16 + hh * 8);
  AttnState st;
#pragma unroll
  for (int i = 0; i < 16; i++) { st.o0[i] = 0.f; st.o1[i] = 0.f; }
  st.m = -INFINITY; st.l = 0.f;
  const float* rpbh = p.rpb + h * 465;
  const int rs = min(max(r - 4, 0), 56);
  const u16* ck = (const u16*)(p.ws + OFF_CK) + (size_t)b * 512 * 512 + h * 64;
  const u16* cvt = (const u16*)(p.ws + OFF_CVT) + (size_t)(b * 8 + h) * 64 * 512;
  const u16* kls = Kb + (size_t)(T_CTX + b * 4096) * 512 + h * 64;
  const u16* vls = (const u16*)(p.ws + OFF_VTS) + (size_t)(b * 8 + h) * 64 * 4096;
  const u16* klc = Kb + (size_t)(b * 256) * 512 + h * 64;
  const u16* vlc = (const u16*)(p.ws + OFF_VTC) + (size_t)(b * 8 + h) * 64 * 256;
  const int ntile = smp ? 32 : 8;
  u32x4 kr[4], vr[4];
  auto issue = [&](int tt) {
    int ll = lane;
    asm volatile("" : "+v"(ll));
    const u16 *kp, *vp; int ldv;
    if (!smp) { kp = klc + (size_t)tt * 32 * 512; vp = vlc + tt * 32; ldv = 256; }
    else if (tt < 16) { kp = ck + (size_t)tt * 32 * 512; vp = cvt + tt * 32; ldv = 512; }
    else { int kt = tt - 16, krow = rs + (kt >> 1), kc0 = (kt & 1) * 32; kp = kls + (size_t)(krow * 64 + kc0) * 512; vp = vls + krow * 64 + kc0; ldv = 4096; }
#pragma unroll
    for (int n = 0; n < 4; n++) {
      const int id = ll + 64 * n;
      kr[n] = *(const u32x4*)(kp + (size_t)(id >> 3) * 512 + (id & 7) * 8);
      vr[n] = *(const u32x4*)(vp + (size_t)(id >> 2) * ldv + (id & 3) * 8);
    }
  };
  issue(0);
#pragma unroll 1
  for (int tt = 0; tt < ntile; tt++) {
    {
      int ll = lane;
      asm volatile("" : "+v"(ll));
#pragma unroll
      for (int n = 0; n < 4; n++) {
        const int id = ll + 64 * n;
        *(u32x4*)(kS + (id >> 3) * 72 + (id & 7) * 8) = kr[n];
        *(u32x4*)(vS + (id >> 2) * 40 + (id & 3) * 8) = vr[n];
      }
    }
    if (tt + 1 < ntile) issue(tt + 1);
    const bool loc = smp && tt >= 16;
    const int kt = tt - 16;
    attn_tile(st, qf, kS, vS, loc ? 1 : 0, loc ? rs + (kt >> 1) - r + 7 : 0, loc ? (kt & 1) * 32 : 0, c0 + qi, rpbh, qi, hh);
  }
  float lt = st.l + __shfl_xor(st.l, 32);
  float inv = 1.f / lt;
  const size_t rowo = (size_t)(tq0 + qi) * 1024 + 512 + h * 64;
  const u16* gb = (const u16*)(p.ws + OFF_GBUF) + rowo;
  u16* cat = (u16*)(p.ws + OFF_U) + rowo;
#pragma unroll
  for (int dt = 0; dt < 2; dt++)
#pragma unroll
    for (int q = 0; q < 4; q++) {
      int d = dt * 32 + q * 8 + hh * 4;
      uint2 g = *(const uint2*)(gb + d);
      float v0 = (dt ? st.o1[q * 4 + 0] : st.o0[q * 4 + 0]) * inv * bflo(g.x);
      float v1 = (dt ? st.o1[q * 4 + 1] : st.o0[q * 4 + 1]) * inv * bfhi(g.x);
      float v2 = (dt ? st.o1[q * 4 + 2] : st.o0[q * 4 + 2]) * inv * bflo(g.y);
      float v3 = (dt ? st.o1[q * 4 + 3] : st.o0[q * 4 + 3]) * inv * bfhi(g.y);
      *(uint2*)(cat + d) = make_uint2(pack2(v0, v1), pack2(v2, v3));
    }
}

DEV void p3_mix(const Params& p, char* smem) {
  for (int t = blockIdx.x; t < 2048; t += gridDim.x) {
    if (t < 1024) {
      __syncthreads();
      attn_unit(p, t * 4 + (threadIdx.x >> 6), threadIdx.x & 63, smem);
    } else {
      int q = t - 1024, mt = q >> 3, g = (q >> 1) & 3, nh = q & 1, m0 = mt * 128;
      const u16* A = (const u16*)(p.ws + OFF_ABUF) + (size_t)m0 * 512 + g * 128;
      const u16* B = (const u16*)(p.ws + OFF_MCAT) + (size_t)(g * 256 + nh * 128) * 128;
      u16* d; size_t ldt;
      if (m0 < T_CTX) { int b = m0 >> 8, l = m0 & 255; ldt = 512; d = (u16*)(p.ws + OFF_BTC) + ((size_t)b * 512 + g * 128) * 512 + nh * 256 + l; }
      else { int tt = m0 - T_CTX, b = tt >> 12, l = tt & 4095; ldt = 8192; d = (u16*)(p.ws + OFF_BTS) + ((size_t)b * 512 + g * 128) * 8192 + nh * 4096 + l; }
      gemm_tile<false>(A, 512, nullptr, m0, B, 128, 128, EpTrans{d, ldt, nullptr, 0}, smem);
    }
  }
}

DEV void p3b_fold(const Params& p) {
  const u16* bt = (const u16*)(p.ws + OFF_BTS);
  u16* bf = (u16*)(p.ws + OFF_BFOLD);
  const size_t gt = (size_t)blockIdx.x * 256 + threadIdx.x, gs = (size_t)gridDim.x * 256;
  for (size_t i = gt; i < 4194304; i += gs) {
    const int jj = (int)(i & 4095);
    const u16* row = bt + (i >> 12) * 8192;
    float v;
    if (jj <= 2048) {
      v = __uint_as_float((unsigned)row[jj] << 16);
      if (jj >= 1 && jj <= 2047) v += __uint_as_float((unsigned)row[4096 - jj] << 16);
    } else {
      const int j = jj - 2048;
      v = __uint_as_float((unsigned)row[4096 + j] << 16) - __uint_as_float((unsigned)row[8192 - j] << 16);
    }
    bf[i] = f2bf(v);
  }
}

DEV void p4_fnet(const Params& p, char* smem) {
  for (int t = blockIdx.x; t < 512; t += gridDim.x) {
    if (t < 256) {
      int b = t >> 7, mt = (t >> 2) & 31, nt = t & 3;
      int tok0 = T_CTX + b * 4096 + mt * 128;
      const u16* A = (const u16*)(p.ws + OFF_FSMP) + (size_t)(mt * 128) * 4096;
      const u16* B = (const u16*)(p.ws + OFF_BFOLD) + ((size_t)b * 512 + nt * 128) * 4096;
      size_t o = (size_t)tok0 * 1024 + nt * 128;
      gemm_tile<false>(A, 4096, nullptr, 0, B, 4096, 4096, EpGate{(u16*)(p.ws + OFF_U) + o, (const u16*)(p.ws + OFF_GBUF) + o, 1024}, smem);
    } else {
      int q = t - 256, b = q >> 3, mt = (q >> 2) & 1, nt = q & 3;
      int tok0 = b * 256 + mt * 128;
      const u16* A = (const u16*)(p.ws + OFF_FCTX) + (size_t)(mt * 128) * 512;
      const u16* B = (const u16*)(p.ws + OFF_BTC) + ((size_t)b * 512 + nt * 128) * 512;
      size_t o = (size_t)tok0 * 1024 + nt * 128;
      gemm_tile<false>(A, 512, nullptr, 0, B, 512, 512, EpGate{(u16*)(p.ws + OFF_U) + o, (const u16*)(p.ws + OFF_GBUF) + o, 1024}, smem);
    }
  }
}

template <int LAYER> DEV void p_outproj(const Params& p, char* smem) {
  const u16* Aall = (const u16*)(p.ws + (LAYER == 0 ? OFF_U : OFF_U1));
  const u16* W = (const u16*)(p.ws + (LAYER == 0 ? OFF_WOUTT : OFF_RWOUTT));
  const float* mods = (const float*)(p.ws + OFF_MODS);
  for (int t = blockIdx.x; t < 1024; t += gridDim.x) {
    int mt = t >> 3, nt = t & 7, m0 = mt * 128, n0 = nt * 128;
    const float* xs;
    if (LAYER == 0) xs = (m0 < T_CTX ? p.x_prompt + (size_t)m0 * 1024 : p.x_sample + (size_t)(m0 - T_CTX) * 1024) + n0;
    else xs = p.out + (size_t)m0 * 1024 + n0;
    const float* gate = mods + (LAYER * 3 + mv_of(m0)) * 3072 + 2048 + n0;
    gemm_tile<false>(Aall + (size_t)m0 * 1024, 1024, nullptr, m0, W + (size_t)n0 * 1024, 1024, 1024,
                     EpRes{(u16*)(p.ws + (LAYER == 0 ? OFF_Y0B : OFF_Y1B)) + (size_t)m0 * 1024 + n0, xs, gate}, smem);
  }
}

DEV void p6b_dx(const Params& p) {
  const int lane = threadIdx.x & 63;
  const int gw = blockIdx.x * 4 + (threadIdx.x >> 6), nw = gridDim.x * 4;
  const u16* U = (const u16*)(p.ws + OFF_U1);
  u16* DX = (u16*)(p.ws + OFF_DX);
  for (int row = gw; row < 16384; row += nw) {
    const int l = row < T_CTX ? (row & 255) : ((row - T_CTX) & 4095);
    const int len = row < T_CTX ? 256 : 4096;
    const float pf = l > 0 ? 1.f : 0.f, nf = l + 1 < len ? 1.f : 0.f;
    const u16* uc = U + (size_t)row * 1024 + lane * 16;
    const u16* up = l > 0 ? uc - 1024 : uc;
    const u16* un = l + 1 < len ? uc + 1024 : uc;
#pragma unroll
    for (int hlf = 0; hlf < 2; hlf++) {
      uint4 c = *(const uint4*)(uc + 8 * hlf), a = *(const uint4*)(up + 8 * hlf), n = *(const uint4*)(un + 8 * hlf);
      const unsigned cu[4] = {c.x, c.y, c.z, c.w}, au[4] = {a.x, a.y, a.z, a.w}, nu[4] = {n.x, n.y, n.z, n.w};
      unsigned o[4];
#pragma unroll
      for (int q = 0; q < 4; q++)
        o[q] = pack2(0.5f * (bflo(au[q]) * pf + bflo(nu[q]) * nf) - bflo(cu[q]), 0.5f * (bfhi(au[q]) * pf + bfhi(nu[q]) * nf) - bfhi(cu[q]));
      *(uint4*)(DX + (size_t)row * 1024 + lane * 16 + 8 * hlf) = make_uint4(o[0], o[1], o[2], o[3]);
    }
  }
}

DEV void p7_rwkv_proj(const Params& p, char* smem) {
  const u16* U1 = (const u16*)(p.ws + OFF_U1);
  const int xcd = blockIdx.x & 7, jx = blockIdx.x >> 3, nbx = gridDim.x >> 3;
  for (int q = jx; q < 16 * 35; q += nbx) {
    int mt, nt;
    if (q < 512) { int st = q >> 6, w = q & 63; mt = xcd * 16 + (st >> 2) * 8 + (w >> 3); nt = (st & 3) * 8 + (w & 7); }
    else { int w = q - 512; mt = xcd * 16 + w / 3; nt = 32 + w % 3; }
    const int m0 = mt * 128;
    if (nt < 32) {
      int which = nt >> 3, n0 = (nt & 7) * 128;
      const u16* B = (const u16*)(p.ws + OFF_RKVZT) + (size_t)which * 1048576 + (size_t)n0 * 1024;
      if (which == 3) {
        gemm_tile<false>(U1 + (size_t)m0 * 1024, 1024, nullptr, m0, B, 1024, 1024,
                         EpStore<1>{(u16*)(p.ws + OFF_SZ) + (size_t)m0 * 1024 + n0, 1024, 1.f}, smem);
      } else {
        size_t off = which == 0 ? OFF_R : (which == 1 ? OFF_K2 : OFF_V2);
        const float* mu = p.mu + (which == 0 ? 0 : (which == 1 ? 2 : 3)) * 1024;
        gemm_tile<true>(U1, 1024, mu, m0, B, 1024, 1024, EpStore<0>{(u16*)(p.ws + off) + (size_t)m0 * 1024 + n0, 1024, 1.f}, smem);
      }
    } else {
      int w = nt - 32;
      if (w == 0)
        gemm_tile<true>(U1, 1024, p.mu + 1 * 1024, m0, (const u16*)(p.ws + OFF_W1T), 1024, 1024, EpStore<2>{(u16*)(p.ws + OFF_HW) + (size_t)m0 * 128, 128, 1.f}, smem);
      else if (w == 1)
        gemm_tile<true>(U1, 1024, p.mu + 4 * 1024, m0, (const u16*)(p.ws + OFF_A1T), 1024, 1024, EpStore<0>{(u16*)(p.ws + OFF_HA) + (size_t)m0 * 128, 128, 1.f}, smem);
      else
        gemm_tile<true>(U1, 1024, p.mu + 5 * 1024, m0, (const u16*)(p.ws + OFF_G1T), 1024, 1024, EpStore<3>{(u16*)(p.ws + OFF_HG) + (size_t)m0 * 128, 128, 1.f}, smem);
    }
  }
}

DEV b16x8 lds_perm(const u16* M, int ld, int row, int s, int hh) {
  const u16* q = M + row * ld + 16 * s + 4 * hh;
  uint2 lo = *(const uint2*)q, hi = *(const uint2*)(q + 8);
  u32x4 v = {lo.x, lo.y, hi.x, hi.y};
  return *(b16x8*)&v;
}
DEV b16x8 lds_norm(const u16* M, int ld, int row, int s, int hh) { return *(const b16x8*)(M + row * ld + 16 * s + 8 * hh); }
template <int OFF> DEV b16x8 pack8(const f32x16& a) {
  u32x4 v = {pack2(a[OFF], a[OFF + 1]), pack2(a[OFF + 2], a[OFF + 3]), pack2(a[OFF + 4], a[OFF + 5]), pack2(a[OFF + 6], a[OFF + 7])};
  return *(b16x8*)&v;
}
#define MFMA32(a, b, c) __builtin_amdgcn_mfma_f32_32x32x16_bf16(a, b, c, 0, 0, 0)

DEV int swz_idx(int row, int col) { return row * 40 + ((row >> 5) & 1) * 32 + ((((col >> 3) ^ (row >> 3)) & 3) << 3) + (col & 7); }
DEV b16x8 swz_norm(const u16* M, int row, int s, int hh) { return *(const b16x8*)(M + swz_idx(row, 16 * s + 8 * hh)); }
DEV b16x8 swz_perm(const u16* M, int row, int s, int hh) {
  uint2 lo = *(const uint2*)(M + swz_idx(row, 16 * s) + 4 * hh), hi = *(const uint2*)(M + swz_idx(row, 16 * s + 8) + 4 * hh);
  u32x4 v = {lo.x, lo.y, hi.x, hi.y};
  return *(b16x8*)&v;
}
struct ScanJob {
  int e, b, hd, tb, L, step0, nch, pq;
  int ncomb, seq;
  const float* zin;
  float* zout;
  u16* pout;
  float* qout;
};
DEV void scan_job(const Params& p, const ScanJob& J, char* smem) {
  float* sCum = (float*)smem;
  float* sAa = (float*)(smem + 8320);
  float* sNN = (float*)(smem + 8320);
  float* sT11 = (float*)(smem + 12544);
  float* sT22 = (float*)(smem + 13632);
  float* sWm = (float*)(smem + 14720);
  u16* AT = (u16*)(smem + 16640);
  u16* RT = (u16*)(smem + 21248);
  u16* BTl = (u16*)(smem + 25856);
  u16* KTl = (u16*)(smem + 30464);
  u16* BH = (u16*)(smem + 35072);
  u16* KH = (u16*)(smem + 40256);
  u16* VT = (u16*)(smem + 45440);
  u16* MkaT = (u16*)(smem + 50624);
  u16* MbrT = (u16*)(smem + 53184);
  u16* MkrT = (u16*)(smem + 55744);
  u16* TT = (u16*)(smem + 58304);
  float* gC = (float*)(smem + 60864);
  const int tid = threadIdx.x, wave = __builtin_amdgcn_readfirstlane(threadIdx.x >> 6);
  float* sKc = (float*)(smem + 61120);
  const int e = J.e, hd = J.hd, tb = J.tb, L = J.L, step0 = J.step0;
  const bool pq = J.pq != 0;
  const bool chainw = pq || wave < 2;
  const bool useV = pq ? (wave >= 2) : true;
  const int rb = wave & 1;
  const u16* HW = (const u16*)(p.ws + OFF_HW);
  const u16* HA = (const u16*)(p.ws + OFF_HA);
  const u16* Rb = (const u16*)(p.ws + OFF_R);
  const u16* Kb = (const u16*)(p.ws + OFF_K2);
  const u16* Vb = (const u16*)(p.ws + OFF_V2);
  float* Ysum = (float*)(p.ws + OFF_YSUM);
  float* Bsum = (float*)(p.ws + OFF_BSUM);
  const int arr = wave >> 1, ct = wave & 1;
  const u16* Xb = (arr ? HA : HW) + e * 64;
  b16x8 wf[4];
  {
    const int qi = tid & 31, hh = (tid >> 5) & 1;
    const u16* Wt = (const u16*)(p.ws + (arr ? OFF_A2T : OFF_W2T)) + (size_t)e * 65536 + (size_t)(hd * 64 + ct * 32 + qi) * 64 + hh * 8;
#pragma unroll
    for (int ks = 0; ks < 4; ks++) wf[ks] = ld16(Wt + ks * 16);
  }
  const float bias0 = (arr ? p.a0 : p.w0)[e * 1024 + hd * 64 + ct * 32 + (tid & 31)];
  if (tid < 64) { sKc[tid] = p.k_k[hd * 64 + tid]; sKc[64 + tid] = p.k_a[hd * 64 + tid]; sKc[128 + tid] = p.r_k[hd * 64 + tid]; }
  f32x16 z0, z1;
#pragma unroll
  for (int q = 0; q < 4; q++) {
    const int qi = tid & 31, hh = (tid >> 5) & 1;
    float4 v0 = make_float4(0, 0, 0, 0), v1 = v0;
    if (pq) {
      if (wave < 2) {
#pragma unroll
        for (int i = 0; i < 4; i++) {
          const int k = 8 * q + 4 * hh + i, col = rb * 32 + qi;
          ((float*)&v0)[i] = (k == col) ? 1.f : 0.f;
          ((float*)&v1)[i] = (k + 32 == col) ? 1.f : 0.f;
        }
      }
    } else if (J.zin && wave < 2) {
      const float* sp = J.zin + (size_t)(wave * 32 + qi) * 64 + 8 * q + 4 * hh;
      v0 = *(const float4*)sp; v1 = *(const float4*)(sp + 32);
    }
    z0[4 * q] = v0.x; z0[4 * q + 1] = v0.y; z0[4 * q + 2] = v0.z; z0[4 * q + 3] = v0.w;
    z1[4 * q] = v1.x; z1[4 * q + 1] = v1.y; z1[4 * q + 2] = v1.z; z1[4 * q + 3] = v1.w;
  }
  if (!pq && wave < 2) {
    const int qi = tid & 31, hh = (tid >> 5) & 1;
#pragma unroll 1
    for (int g = 0; g < J.ncomb; g++) {
      const u16* P = (const u16*)(p.ws + OFF_SEGP) + (size_t)(J.seq * 7 + g) * 4096;
      const float* Q = (const float*)(p.ws + OFF_SEGQ) + (size_t)(J.seq * 7 + g) * 4096;
      b16x8 zb[4] = {pack8<0>(z0), pack8<8>(z0), pack8<0>(z1), pack8<8>(z1)};
      f32x16 n0, n1;
#pragma unroll
      for (int q = 0; q < 4; q++) {
        const float* sp = Q + (size_t)(wave * 32 + qi) * 64 + 8 * q + 4 * hh;
        float4 v0 = *(const float4*)sp, v1 = *(const float4*)(sp + 32);
        n0[4 * q] = v0.x; n0[4 * q + 1] = v0.y; n0[4 * q + 2] = v0.z; n0[4 * q + 3] = v0.w;
        n1[4 * q] = v1.x; n1[4 * q + 1] = v1.y; n1[4 * q + 2] = v1.z; n1[4 * q + 3] = v1.w;
      }
#pragma unroll
      for (int s2 = 0; s2 < 4; s2++) {
        const u16* r0 = P + (size_t)qi * 64 + 16 * s2 + 4 * hh;
        const u16* r1 = P + (size_t)(32 + qi) * 64 + 16 * s2 + 4 * hh;
        uint2 a = *(const uint2*)r0, c = *(const uint2*)(r0 + 8), d = *(const uint2*)r1, f = *(const uint2*)(r1 + 8);
        u32x4 fa = {a.x, a.y, c.x, c.y}, fb = {d.x, d.y, f.x, f.y};
        n0 = MFMA32(*(b16x8*)&fa, zb[s2], n0);
        n1 = MFMA32(*(b16x8*)&fb, zb[s2], n1);
      }
      z0 = n0; z1 = n1;
    }
  }
  const int nch = J.nch;
  b16x8 xf[4];
  u32x4 kq, rq, vq;
  int tokC;
  {
    const int qi = tid & 31, hh = (tid >> 5) & 1, ci_ = tid >> 3, chg = hd * 64 + (tid & 7) * 8;
    const int tok0 = tb + (e ? L - step0 - 32 : step0);
    const int tokA = tok0 + (e ? 31 - qi : qi);
#pragma unroll
    for (int ks = 0; ks < 4; ks++) xf[ks] = ld16(Xb + (size_t)tokA * 128 + hh * 8 + ks * 16);
    tokC = tok0 + (e ? 31 - ci_ : ci_);
    kq = *(const u32x4*)(Kb + (size_t)tokC * 1024 + chg);
    rq = *(const u32x4*)(Rb + (size_t)tokC * 1024 + chg);
    vq = *(const u32x4*)(Vb + (size_t)tokC * 1024 + chg);
  }
#pragma unroll 1
  for (int ci = 0; ci < nch; ci++) {
    const int tok0 = tb + (e ? L - step0 - 32 * (ci + 1) : step0 + 32 * ci);
    const int tokn0 = tb + (e ? L - step0 - 32 * (ci + 2) : step0 + 32 * (ci + 1));
    const bool more = ci + 1 < nch;
    int tl = tid;
    asm volatile("" : "+v"(tl));
    const int lane = tl & 63, qi = lane & 31, hh = lane >> 5, ci_ = tl >> 3, cb = (tl & 7) * 8, chg = hd * 64 + cb;
    {
      f32x16 acc;
#pragma unroll
      for (int r = 0; r < 16; r++) acc[r] = 0.f;
#pragma unroll
      for (int ks = 0; ks < 4; ks++) acc = MFMA32(xf[ks], wf[ks], acc);
      if (more) {
        const int tokA = tokn0 + (e ? 31 - qi : qi);
#pragma unroll
        for (int ks = 0; ks < 4; ks++) xf[ks] = ld16(Xb + (size_t)tokA * 128 + hh * 8 + ks * 16);
      }
      const int ch = ct * 32 + qi;
      if (arr == 0) {
        float lw[16], gs[4], og[4];
#pragma unroll
        for (int r = 0; r < 16; r++) lw[r] = -0.606531f * sigm(acc[r] + bias0);
#pragma unroll
        for (int q = 0; q < 4; q++) { gs[q] = (lw[4 * q] + lw[4 * q + 1]) + (lw[4 * q + 2] + lw[4 * q + 3]); og[q] = __shfl_xor(gs[q], 32); }
        float pre = 0.f;
#pragma unroll
        for (int q = 0; q < 4; q++) {
          float run = pre + (hh ? og[q] : 0.f);
#pragma unroll
          for (int i = 0; i < 4; i++) { run += lw[4 * q + i]; sCum[(8 * q + 4 * hh + i) * 65 + ch] = run; }
          pre += gs[q] + og[q];
        }
      } else {
#pragma unroll
        for (int r = 0; r < 16; r++) {
          int row = (r & 3) + 8 * (r >> 2) + 4 * hh;
          sAa[row * 65 + ch] = sigm(acc[r] + bias0);
        }
      }
    }
    lds_barrier();
    {
      const int i = ci_;
      const unsigned ku[4] = {kq.x, kq.y, kq.z, kq.w}, ru[4] = {rq.x, rq.y, rq.z, rq.w}, vu[4] = {vq.x, vq.y, vq.z, vq.w};
      float k[8], r[8], kkr[8];
#pragma unroll
      for (int q = 0; q < 4; q++) {
        k[2 * q] = bflo(ku[q]); k[2 * q + 1] = bfhi(ku[q]);
        r[2 * q] = bflo(ru[q]); r[2 * q + 1] = bfhi(ru[q]);
      }
      float kkc[8], kac[8], rkc[8];
#pragma unroll
      for (int j = 0; j < 8; j++) { kkc[j] = sKc[cb + j]; kac[j] = sKc[64 + cb + j]; rkc[j] = sKc[128 + cb + j]; }
      float ss = 0;
#pragma unroll
      for (int j = 0; j < 8; j++) { kkr[j] = k[j] * kkc[j]; ss += kkr[j] * kkr[j]; }
      ss = allsum8(ss);
      const float inv = rsqrtf(ss + 1e-12f);
      float bon = 0;
      float oa[8], orr[8], ob[8], ok[8];
#pragma unroll
      for (int j = 0; j < 8; j++) {
        const float a = sAa[i * 65 + cb + j];
        const float cm = sCum[i * 65 + cb + j];
        const float cp = i > 0 ? sCum[(i - 1) * 65 + cb + j] : 0.f;
        const float cl = sCum[31 * 65 + cb + j];
        const float kd = k[j] * (1.f + (a - 1.f) * kac[j]);
        const float kk = kkr[j] * inv;
        const float bb = kk * a;
        bon += r[j] * kd * rkc[j];
        const float em = __expf(-cm), eC = __expf(cl - cm);
        oa[j] = -kk * __expf(cp);
        orr[j] = pq ? 0.f : r[j] * __expf(cm);
        ob[j] = bb * em;
        ok[j] = kd * em;
        BH[swz_idx(cb + j, i)] = f2bf(bb * eC);
        KH[swz_idx(cb + j, i)] = f2bf(kd * eC);
        if (i == 31) gC[cb + j] = __expf(cl);
      }
#pragma unroll
      for (int q = 0; q < 4; q++) {
        VT[swz_idx(cb + 2 * q, i)] = (u16)(vu[q] & 0xffffu);
        VT[swz_idx(cb + 2 * q + 1, i)] = (u16)(vu[q] >> 16);
      }
      *(u32x4*)(AT + i * 72 + cb) = u32x4{pack2(oa[0], oa[1]), pack2(oa[2], oa[3]), pack2(oa[4], oa[5]), pack2(oa[6], oa[7])};
      if (!pq) *(u32x4*)(RT + i * 72 + cb) = u32x4{pack2(orr[0], orr[1]), pack2(orr[2], orr[3]), pack2(orr[4], orr[5]), pack2(orr[6], orr[7])};
      *(u32x4*)(BTl + i * 72 + cb) = u32x4{pack2(ob[0], ob[1]), pack2(ob[2], ob[3]), pack2(ob[4], ob[5]), pack2(ob[6], ob[7])};
      *(u32x4*)(KTl + i * 72 + cb) = u32x4{pack2(ok[0], ok[1]), pack2(ok[2], ok[3]), pack2(ok[4], ok[5]), pack2(ok[6], ok[7])};
      bon = allsum8(bon);
      if (!pq && (tl & 7) == 0) atomicAdd(Bsum + (size_t)tokC * 16 + hd, 0.5f * bon);
      if (more) {
        tokC = tokn0 + (e ? 31 - ci_ : ci_);
        kq = *(const u32x4*)(Kb + (size_t)tokC * 1024 + chg);
        rq = *(const u32x4*)(Rb + (size_t)tokC * 1024 + chg);
        vq = *(const u32x4*)(Vb + (size_t)tokC * 1024 + chg);
      }
    }
    lds_barrier();
    if (!(pq && wave >= 2)) {
      const u16* Am = (wave < 2) ? AT : RT;
      const u16* Bm = (wave & 1) ? KTl : BTl;
      f32x16 acc;
#pragma unroll
      for (int r = 0; r < 16; r++) acc[r] = 0.f;
#pragma unroll
      for (int s = 0; s < 4; s++) acc = MFMA32(lds_norm(Am, 72, qi, s, hh), lds_norm(Bm, 72, qi, s, hh), acc);
      u16* dst = wave == 1 ? MkaT : (wave == 2 ? MbrT : MkrT);
#pragma unroll
      for (int r = 0; r < 16; r++) {
        const int tt = (r & 3) + 8 * (r >> 2) + 4 * hh, j = qi;
        const bool keep = (wave < 2) ? (j < tt) : (j <= tt);
        const float val = keep ? acc[r] : 0.f;
        if (wave == 0) sNN[j * 33 + tt] = val;
        else dst[tt * 40 + j] = f2bf(val);
      }
    }
    if (tl < 32) {
      const int i = tl & 15, base = (tl >> 4) * 16;
      float Tr[16];
#pragma unroll
      for (int q = 0; q < 16; q++) Tr[q] = (q == i) ? 1.f : 0.f;
#pragma unroll
      for (int q = 1; q < 16; q++) {
        float s0 = 0.f, s1 = 0.f, s2 = 0.f, s3 = 0.f;
#pragma unroll
        for (int j = 0; j < q; j++) {
          const float pr = Tr[j] * sNN[(base + j) * 33 + base + q];
          if ((j & 3) == 0) s0 += pr; else if ((j & 3) == 1) s1 += pr; else if ((j & 3) == 2) s2 += pr; else s3 += pr;
        }
        if (q > i) Tr[q] = (s0 + s1) + (s2 + s3);
      }
      float* sT = (tl >> 4) ? sT22 : sT11;
#pragma unroll
      for (int q = 0; q < 16; q++) { sT[i * 17 + q] = Tr[q]; TT[(base + q) * 40 + base + i] = f2bf(Tr[q]); }
    }
    lds_barrier();
    {
      const int i = tl >> 4, q = tl & 15;
      float s = 0.f;
#pragma unroll
      for (int j = 0; j < 16; j++) s += sT11[i * 17 + j] * sNN[j * 33 + 16 + q];
      sWm[i * 17 + q] = s;
      TT[i * 40 + 16 + q] = 0;
    }
    lds_barrier();
    {
      const int i = tl >> 4, q = tl & 15;
      float s = 0.f;
#pragma unroll
      for (int j = 0; j < 16; j++) s += sWm[i * 17 + j] * sT22[j * 17 + q];
      TT[(16 + q) * 40 + i] = f2bf(s);
    }
    lds_barrier();
    if (chainw) {
      const int vrow = rb * 32 + qi;
      b16x8 zb0 = pack8<0>(z0), zb1 = pack8<8>(z0), zb2 = pack8<0>(z1), zb3 = pack8<8>(z1);
      b16x8 vt0 = swz_norm(VT, vrow, 0, hh), vt1 = swz_norm(VT, vrow, 1, hh);
      f32x16 x;
#pragma unroll
      for (int r = 0; r < 16; r++) x[r] = 0.f;
      x = MFMA32(lds_perm(AT, 72, qi, 0, hh), zb0, x);
      x = MFMA32(lds_perm(AT, 72, qi, 1, hh), zb1, x);
      x = MFMA32(lds_perm(AT, 72, qi, 2, hh), zb2, x);
      x = MFMA32(lds_perm(AT, 72, qi, 3, hh), zb3, x);
      if (useV) {
        x = MFMA32(lds_norm(MkaT, 40, qi, 0, hh), vt0, x);
        x = MFMA32(lds_norm(MkaT, 40, qi, 1, hh), vt1, x);
      }
      f32x16 y;
#pragma unroll
      for (int r = 0; r < 16; r++) y[r] = 0.f;
      if (!pq) {
        y = MFMA32(lds_perm(RT, 72, qi, 0, hh), zb0, y);
        y = MFMA32(lds_perm(RT, 72, qi, 1, hh), zb1, y);
        y = MFMA32(lds_perm(RT, 72, qi, 2, hh), zb2, y);
        y = MFMA32(lds_perm(RT, 72, qi, 3, hh), zb3, y);
        y = MFMA32(lds_norm(MkrT, 40, qi, 0, hh), vt0, y);
        y = MFMA32(lds_norm(MkrT, 40, qi, 1, hh), vt1, y);
      }
#pragma unroll
      for (int q = 0; q < 4; q++) {
        float4 g0 = *(const float4*)(gC + 8 * q + 4 * hh), g1 = *(const float4*)(gC + 32 + 8 * q + 4 * hh);
        z0[4 * q] *= g0.x; z0[4 * q + 1] *= g0.y; z0[4 * q + 2] *= g0.z; z0[4 * q + 3] *= g0.w;
        z1[4 * q] *= g1.x; z1[4 * q + 1] *= g1.y; z1[4 * q + 2] *= g1.z; z1[4 * q + 3] *= g1.w;
      }
      if (useV) {
        z0 = MFMA32(swz_norm(KH, qi, 0, hh), vt0, z0);
        z0 = MFMA32(swz_norm(KH, qi, 1, hh), vt1, z0);
        z1 = MFMA32(swz_norm(KH, 32 + qi, 0, hh), vt0, z1);
        z1 = MFMA32(swz_norm(KH, 32 + qi, 1, hh), vt1, z1);
      }
      b16x8 xb0 = pack8<0>(x), xb1 = pack8<8>(x);
      f32x16 u;
#pragma unroll
      for (int r = 0; r < 16; r++) u[r] = 0.f;
      u = MFMA32(lds_perm(TT, 40, qi, 0, hh), xb0, u);
      u = MFMA32(lds_perm(TT, 40, qi, 1, hh), xb1, u);
      b16x8 ub0 = pack8<0>(u), ub1 = pack8<8>(u);
      z0 = MFMA32(swz_perm(BH, qi, 0, hh), ub0, z0);
      z0 = MFMA32(swz_perm(BH, qi, 1, hh), ub1, z0);
      z1 = MFMA32(swz_perm(BH, 32 + qi, 0, hh), ub0, z1);
      z1 = MFMA32(swz_perm(BH, 32 + qi, 1, hh), ub1, z1);
      if (!pq) {
        y = MFMA32(lds_perm(MbrT, 40, qi, 0, hh), ub0, y);
        y = MFMA32(lds_perm(MbrT, 40, qi, 1, hh), ub1, y);
#pragma unroll
        for (int r = 0; r < 16; r++) {
          const int st = (r & 3) + 8 * (r >> 2) + 4 * hh;
          const int tok = tok0 + (e ? 31 - st : st);
          atomicAdd(Ysum + (size_t)tok * 1024 + hd * 64 + vrow, y[r]);
        }
      }
    }
  }
  {
    const int qi = tid & 31, hh = (tid >> 5) & 1;
    if (pq) {
      if (wave < 2) {
#pragma unroll
        for (int r = 0; r < 16; r++) {
          const int k = (r & 3) + 8 * (r >> 2) + 4 * hh;
          J.pout[k * 64 + rb * 32 + qi] = f2bf(z0[r]);
          J.pout[(k + 32) * 64 + rb * 32 + qi] = f2bf(z1[r]);
        }
      } else {
#pragma unroll
        for (int q = 0; q < 4; q++) {
          float* sp = J.qout + (size_t)(rb * 32 + qi) * 64 + 8 * q + 4 * hh;
          *(float4*)sp = make_float4(z0[4 * q], z0[4 * q + 1], z0[4 * q + 2], z0[4 * q + 3]);
          *(float4*)(sp + 32) = make_float4(z1[4 * q], z1[4 * q + 1], z1[4 * q + 2], z1[4 * q + 3]);
        }
      }
    } else if (J.zout && wave < 2) {
#pragma unroll
      for (int q = 0; q < 4; q++) {
        float* sp = J.zout + (size_t)(wave * 32 + qi) * 64 + 8 * q + 4 * hh;
        *(float4*)sp = make_float4(z0[4 * q], z0[4 * q + 1], z0[4 * q + 2], z0[4 * q + 3]);
        *(float4*)(sp + 32) = make_float4(z1[4 * q], z1[4 * q + 1], z1[4 * q + 2], z1[4 * q + 3]);
      }
    }
  }
  __syncthreads();
}

DEV void scan_combine(const Params& p, int seq) {
  const int tid = threadIdx.x, wave = tid >> 6, qi = tid & 31, hh = (tid >> 5) & 1;
  if (wave >= 2) return;
  const int e = seq >> 5, b = (seq >> 4) & 1, hd = seq & 15;
  const float* zin = p.state_rwkv + ((size_t)(b * 2 + e) * 16 + hd) * 4096;
  f32x16 z0, z1;
#pragma unroll
  for (int q = 0; q < 4; q++) {
    const float* sp = zin + (size_t)(wave * 32 + qi) * 64 + 8 * q + 4 * hh;
    float4 v0 = *(const float4*)sp, v1 = *(const float4*)(sp + 32);
    z0[4 * q] = v0.x; z0[4 * q + 1] = v0.y; z0[4 * q + 2] = v0.z; z0[4 * q + 3] = v0.w;
    z1[4 * q] = v1.x; z1[4 * q + 1] = v1.y; z1[4 * q + 2] = v1.z; z1[4 * q + 3] = v1.w;
  }
#pragma unroll 1
  for (int g = 0; g < 7; g++) {
    const u16* P = (const u16*)(p.ws + OFF_SEGP) + (size_t)(seq * 7 + g) * 4096;
    const float* Q = (const float*)(p.ws + OFF_SEGQ) + (size_t)(seq * 7 + g) * 4096;
    b16x8 zb[4] = {pack8<0>(z0), pack8<8>(z0), pack8<0>(z1), pack8<8>(z1)};
    f32x16 n0, n1;
#pragma unroll
    for (int q = 0; q < 4; q++) {
      const float* sp = Q + (size_t)(wave * 32 + qi) * 64 + 8 * q + 4 * hh;
      float4 v0 = *(const float4*)sp, v1 = *(const float4*)(sp + 32);
      n0[4 * q] = v0.x; n0[4 * q + 1] = v0.y; n0[4 * q + 2] = v0.z; n0[4 * q + 3] = v0.w;
      n1[4 * q] = v1.x; n1[4 * q + 1] = v1.y; n1[4 * q + 2] = v1.z; n1[4 * q + 3] = v1.w;
    }
#pragma unroll
    for (int s = 0; s < 4; s++) {
      const u16* r0 = P + (size_t)qi * 64 + 16 * s + 4 * hh;
      const u16* r1 = P + (size_t)(32 + qi) * 64 + 16 * s + 4 * hh;
      uint2 a = *(const uint2*)r0, c = *(const uint2*)(r0 + 8), d = *(const uint2*)r1, f = *(const uint2*)(r1 + 8);
      u32x4 fa = {a.x, a.y, c.x, c.y}, fb = {d.x, d.y, f.x, f.y};
      n0 = MFMA32(*(b16x8*)&fa, zb[s], n0);
      n1 = MFMA32(*(b16x8*)&fb, zb[s], n1);
    }
    z0 = n0; z1 = n1;
    float* zs = (float*)(p.ws + OFF_SEGZ) + (size_t)(seq * 7 + g) * 4096;
#pragma unroll
    for (int q = 0; q < 4; q++) {
      float* sp = zs + (size_t)(wave * 32 + qi) * 64 + 8 * q + 4 * hh;
      *(float4*)sp = make_float4(z0[4 * q], z0[4 * q + 1], z0[4 * q + 2], z0[4 * q + 3]);
      *(float4*)(sp + 32) = make_float4(z1[4 * q], z1[4 * q + 1], z1[4 * q + 2], z1[4 * q + 3]);
    }
  }
}

DEV ScanJob ctx_job(const Params& p, int v) {
  ScanJob J;
  J.e = v >> 9; J.b = (v >> 4) & 31; J.hd = v & 15; J.tb = J.b * 256; J.L = 256; J.step0 = 0; J.nch = 8; J.pq = 0;
  J.zin = nullptr; J.zout = p.out + OUT_ST + ((size_t)(J.b * 2 + J.e) * 16 + J.hd) * 4096; J.pout = nullptr; J.qout = nullptr;
  J.ncomb = 0; J.seq = 0;
  return J;
}
DEV ScanJob smp_job(const Params& p, int seq, int g, int pq) {
  ScanJob J;
  J.e = seq >> 5; J.b = (seq >> 4) & 1; J.hd = seq & 15; J.tb = T_CTX + J.b * 4096; J.L = 4096; J.step0 = g * 512; J.nch = 16; J.pq = pq;
  J.zin = p.state_rwkv + ((size_t)(J.b * 2 + J.e) * 16 + J.hd) * 4096;
  J.ncomb = pq ? 0 : g; J.seq = seq;
  J.zout = nullptr;
  J.pout = (u16*)(p.ws + OFF_SEGP) + (size_t)(seq * 7 + g) * 4096;
  J.qout = (float*)(p.ws + OFF_SEGQ) + (size_t)(seq * 7 + g) * 4096;
  return J;
}

DEV void p8a_scan(const Params& p, char* smem) {
  if (blockIdx.x < 448) {
    for (int j = blockIdx.x; j < 448; j += 448) scan_job(p, smp_job(p, j / 7, j % 7, 1), smem);
  } else {
    {
      float4* ys = (float4*)(p.ws + OFF_YSUM);
      float4* bs = (float4*)(p.ws + OFF_BSUM);
      const size_t gt = (size_t)(blockIdx.x - 448) * 256 + threadIdx.x, gs = (size_t)(gridDim.x - 448) * 256;
      for (size_t i = gt; i < 4194304; i += gs) ys[i] = make_float4(0, 0, 0, 0);
      for (size_t i = gt; i < 65536; i += gs) bs[i] = make_float4(0, 0, 0, 0);
    }
    for (int q = blockIdx.x - 448; q < 1024; q += gridDim.x - 448) {
      int mt = q >> 3, nt = q & 7, m0 = mt * 128, n0 = nt * 128;
      u16* sz = (u16*)(p.ws + OFF_SZ) + (size_t)m0 * 1024 + n0;
      gemm_tile<false>((const u16*)(p.ws + OFF_HG) + (size_t)m0 * 128, 128, nullptr, m0, (const u16*)(p.ws + OFF_G2T) + (size_t)n0 * 128, 128, 128,
                       EpGate{sz, sz, 1024}, smem);
    }
  }
}
DEV void p8b_scan(const Params& p, char* smem) {
  if (blockIdx.x < 64) scan_combine(p, blockIdx.x);
}
DEV void p8c_scan(const Params& p, char* smem) {
  for (int j = blockIdx.x; j < 512 + 1024; j += gridDim.x) {
    if (j < 512) scan_job(p, smp_job(p, j >> 3, j & 7, 0), smem);
    else scan_job(p, ctx_job(p, j - 512), smem);
  }
}

DEV void p9_post(const Params& p) {
  const int lane = threadIdx.x & 63;
  const int gw = blockIdx.x * 4 + (threadIdx.x >> 6), nw = gridDim.x * 4;
  const float* Ysum = (const float*)(p.ws + OFF_YSUM);
  const float* Bsum = (const float*)(p.ws + OFF_BSUM);
  for (int row = gw; row < 16384; row += nw) {
    const size_t o = (size_t)row * 1024 + lane * 16;
    float y[16];
#pragma unroll
    for (int i = 0; i < 4; i++) { float4 v = *(const float4*)(Ysum + o + 4 * i); y[4 * i] = v.x; y[4 * i + 1] = v.y; y[4 * i + 2] = v.z; y[4 * i + 3] = v.w; }
    float s = 0;
#pragma unroll
    for (int i = 0; i < 16; i++) s += y[i];
    s += __shfl_xor(s, 1); s += __shfl_xor(s, 2);
    float mean = s * (1.f / 64.f), q = 0;
#pragma unroll
    for (int i = 0; i < 16; i++) { float d = y[i] - mean; q += d * d; }
    q += __shfl_xor(q, 1); q += __shfl_xor(q, 2);
    float rstd = rsqrtf(q * (1.f / 64.f) + 64e-5f);
    float bon = Bsum[(size_t)row * 16 + (lane >> 2)];
    u16* O = (u16*)(p.ws + OFF_U1) + o;
    const u16* V = (const u16*)(p.ws + OFF_V2) + o;
    const u16* Z = (const u16*)(p.ws + OFF_SZ) + o;
#pragma unroll
    for (int hlf = 0; hlf < 2; hlf++) {
      uint4 vq = *(const uint4*)(V + 8 * hlf), zq = *(const uint4*)(Z + 8 * hlf);
      const unsigned vu[4] = {vq.x, vq.y, vq.z, vq.w}, zu[4] = {zq.x, zq.y, zq.z, zq.w};
      unsigned ow[4];
#pragma unroll
      for (int w = 0; w < 4; w++) {
        int c = lane * 16 + hlf * 8 + 2 * w;
        float y0 = (y[hlf * 8 + 2 * w] - mean) * rstd * p.lnx_g[c] + p.lnx_b[c] + bon * bflo(vu[w]);
        float y1 = (y[hlf * 8 + 2 * w + 1] - mean) * rstd * p.lnx_g[c + 1] + p.lnx_b[c + 1] + bon * bfhi(vu[w]);
        ow[w] = pack2(y0 * bflo(zu[w]), y1 * bfhi(zu[w]));
      }
      *(uint4*)(O + 8 * hlf) = make_uint4(ow[0], ow[1], ow[2], ow[3]);
    }
  }
}


#define XB_TMO 128
#define XB_XCNT(j) (256 + 64 * (j))
#define XB_XSUB(j) (1280 + 64 * (j))
#define XB_XGEN(j) (2304 + 64 * (j))
#define XB_TOP 3328
#define XB_TOPGEN 3392
#define XCD_BAR_WORDS 3456
#define XB_SPIN_CAP (1u << 22)
#define LAS __attribute__((address_space(3)))
DEV unsigned xb_ld(unsigned* p) { return __hip_atomic_load(p, __ATOMIC_RELAXED, __HIP_MEMORY_SCOPE_AGENT); }
DEV unsigned xb_add(unsigned* p, unsigned v) { return __hip_atomic_fetch_add(p, v, __ATOMIC_RELAXED, __HIP_MEMORY_SCOPE_AGENT); }
DEV unsigned xb_xcc_id() { return (unsigned)__builtin_amdgcn_s_getreg((3 << 11) | 20) & 0xFu; }
#define XB_SPIN(cond, bar) do { unsigned _sp = 0; while (cond) { __builtin_amdgcn_s_sleep(4); \
    if ((++_sp & 255u) == 0u) { if (xb_ld(&(bar)[XB_TMO])) break; if (_sp > XB_SPIN_CAP) { atomicAdd(&(bar)[XB_TMO], 1u); break; } } } } while (0)
struct XcdBarrier { unsigned* bar; unsigned x; volatile LAS unsigned* st; };
DEV XcdBarrier xcd_barrier_post(unsigned* bar, volatile LAS unsigned* st) {
  XcdBarrier b; b.bar = bar; b.x = xb_xcc_id(); b.st = st;
  if (threadIdx.x == 0) (void)xb_add(&bar[XB_XCNT(b.x)], 1u);
  return b;
}
DEV void xcd_barrier_complete(unsigned* bar, unsigned x, unsigned& nloc, unsigned& nx) {
  const unsigned G = gridDim.x * gridDim.y * gridDim.z;
  unsigned sum, cnt, mine, sp = 0u;
  for (;;) {
    sum = 0u; cnt = 0u; mine = 0u;
#pragma unroll
    for (unsigned j = 0; j < 16; ++j) { const unsigned c = xb_ld(&bar[XB_XCNT(j)]); sum += c; cnt += (c > 0u) ? 1u : 0u; mine = (j == x) ? c : mine; }
    if (sum == G) break;
    __builtin_amdgcn_s_sleep(1);
    if ((++sp & 255u) == 0u) { if (xb_ld(&bar[XB_TMO])) break; if (sp > XB_SPIN_CAP) { atomicAdd(&bar[XB_TMO], 1u); break; } }
  }
  nloc = mine > 0u ? mine : 1u; nx = cnt > 0u ? cnt : 1u;
}
DEV void xcd_barrier(const XcdBarrier& b) {
  asm volatile("s_waitcnt vmcnt(0)" ::: "memory");
  __syncthreads();
  if (threadIdx.x == 0) {
    unsigned* bar = b.bar;
    __builtin_amdgcn_s_waitcnt(0);
    unsigned nloc = b.st[0], nx = b.st[1];
    if (nloc == 0u) { xcd_barrier_complete(bar, b.x, nloc, nx); b.st[0] = nloc; b.st[1] = nx; }
    const unsigned old = xb_add(&bar[XB_XSUB(b.x)], 1u);
    const unsigned gen = old / nloc;
    if (old + 1u == (gen + 1u) * nloc) {
      __builtin_amdgcn_fence(__ATOMIC_RELEASE, "agent");
      asm volatile("s_waitcnt vmcnt(0)" ::: "memory");
      const unsigned og = xb_add(&bar[XB_TOP], 1u);
      const unsigned tg = og / nx;
      if (og + 1u == (tg + 1u) * nx) xb_add(&bar[XB_TOPGEN], 1u);
      else XB_SPIN(xb_ld(&bar[XB_TOPGEN]) == tg, bar);
      __builtin_amdgcn_fence(__ATOMIC_ACQUIRE, "agent");
      xb_add(&bar[XB_XGEN(b.x)], 1u);
      asm volatile("s_waitcnt vmcnt(0)" ::: "memory");
    } else {
      XB_SPIN(xb_ld(&bar[XB_XGEN(b.x)]) == gen, bar);
      __builtin_amdgcn_fence(__ATOMIC_ACQUIRE, "agent");
      asm volatile("s_waitcnt vmcnt(0)" ::: "memory");
    }
  }
  __syncthreads();
}

__global__ void __launch_bounds__(256, 2) fwd_kernel(Params p) {
  __shared__ __attribute__((aligned(16))) char smem[73728];
#if FUSED
  __shared__ unsigned xb_st[4];
  if (threadIdx.x < 4) xb_st[threadIdx.x] = 0u;
  __syncthreads();
  const XcdBarrier xb = xcd_barrier_post((unsigned*)(p.ws + OFF_BAR), (volatile LAS unsigned*)xb_st);
  if (p.phase_hi > 1000) cg::this_grid().sync();
#define SYNC() xcd_barrier(xb)
#else
#define SYNC()
#endif
#define PH(n, call) if (p.phase_lo <= n && n <= p.phase_hi) { call; if (n < p.phase_hi) { SYNC(); } }
  PH(0, p0_prep(p, smem))
  PH(1, ln_phase<0>(p))
  PH(2, p2_gemm1(p, smem))
  PH(3, p3_mix(p, smem))
  PH(4, p3b_fold(p))
  PH(5, p4_fnet(p, smem))
  PH(6, p_outproj<0>(p, smem))
  PH(7, ln_phase<1>(p))
  PH(8, p6b_dx(p))
  PH(9, p7_rwkv_proj(p, smem))
  PH(10, p8a_scan(p, smem))
  PH(11, p8c_scan(p, smem))
  PH(12, p9_post(p))
  PH(13, p_outproj<1>(p, smem))
  PH(14, ln_phase<2>(p))
}

extern "C" void kernel_launch(void* const* d_in, const int* in_sizes, int n_in, void* d_out, int out_size, void* d_ws,
                              size_t ws_size, hipStream_t stream) {
  Params p;
  memset(&p, 0, sizeof(p));
  const float* const* in = (const float* const*)d_in;
  p.x_prompt = in[0]; p.x_sample = in[1]; p.cache_k = in[2]; p.cache_v = in[3]; p.state_rwkv = in[4]; p.c = in[5]; p.c_ctx = in[6];
  p.ada_w = in[7]; p.ada_b = in[8]; p.post_g = in[9]; p.post_b = in[10]; p.w_in = in[11]; p.w_fnet = in[12]; p.rpb = in[13]; p.w_out = in[14];
  p.mu = in[15]; p.rkvz = in[16]; p.w0 = in[17]; p.w1 = in[18]; p.w2 = in[19]; p.a0 = in[20]; p.a1 = in[21]; p.a2 = in[22];
  p.g1 = in[23]; p.g2 = in[24]; p.k_k = in[25]; p.k_a = in[26]; p.r_k = in[27]; p.lnx_g = in[28]; p.lnx_b = in[29]; p.rw_out = in[30];
  p.out = (float*)d_out; p.ws = (char*)d_ws;
  char* ws = (char*)d_ws;
  int n = 0, start = 0;
  auto add = [&](const float* src, size_t dstoff, int lds, int ldd, int tk, int tn) {
    p.tj[n].src = src; p.tj[n].dst = (u16*)(ws + dstoff); p.tj[n].lds = lds; p.tj[n].ldd = ldd; p.tj[n].tk = tk; p.tj[n].tn = tn;
    p.tj[n].start = start; p.tj[n].pad = 0; start += tk * tn; n++;
  };
  add(p.w_in, OFF_WINT, 3072, 1024, 16, 48);
  add(p.w_out, OFF_WOUTT, 1024, 1024, 16, 16);
  for (int i = 0; i < 4; i++) add(p.rkvz + (size_t)i * 1048576, OFF_RKVZT + (size_t)i * 2097152, 1024, 1024, 16, 16);
  add(p.rw_out, OFF_RWOUTT, 1024, 1024, 16, 16);
  for (int e = 0; e < 2; e++) add(p.w1 + e * 65536, OFF_W1T + (size_t)e * 64 * 1024 * 2, 64, 1024, 16, 1);
  for (int e = 0; e < 2; e++) add(p.a1 + e * 65536, OFF_A1T + (size_t)e * 64 * 1024 * 2, 64, 1024, 16, 1);
  add(p.g1, OFF_G1T, 128, 1024, 16, 2);
  for (int e = 0; e < 2; e++) add(p.w2 + e * 65536, OFF_W2T + (size_t)e * 65536 * 2, 1024, 64, 1, 16);
  for (int e = 0; e < 2; e++) add(p.a2 + e * 65536, OFF_A2T + (size_t)e * 65536 * 2, 1024, 64, 1, 16);
  add(p.g2, OFF_G2T, 1024, 128, 2, 16);
  for (int b = 0; b < 2; b++)
    for (int h = 0; h < 8; h++) add(p.cache_v + (size_t)b * 262144 + h * 64, OFF_CVT + (size_t)(b * 8 + h) * 64 * 512 * 2, 512, 512, 8, 1);
  p.ntr = start;

  static int grid_blocks = 0;
  if (!grid_blocks) {
    int dev = 0, cus = 0, per_cu = 0;
    (void)hipGetDevice(&dev);
    (void)hipDeviceGetAttribute(&cus, hipDeviceAttributeMultiprocessorCount, dev);
    (void)hipOccupancyMaxActiveBlocksPerMultiprocessor(&per_cu, fwd_kernel, 256, 0);
    if (per_cu > 2) per_cu = 2;
    if (per_cu < 1) per_cu = 1;
    grid_blocks = cus * per_cu;
  }
#if FUSED
  p.phase_lo = 0; p.phase_hi = 14;
  void* args[] = {&p};
  (void)hipMemsetAsync((char*)d_ws + OFF_BAR, 0, 16384, stream);
  hipError_t e = hipLaunchCooperativeKernel((void*)fwd_kernel, dim3(grid_blocks), dim3(256), args, 0, stream);
  if (e != hipSuccess) fprintf(stderr, "cooperative launch failed: %s (grid %d)\n", hipGetErrorString(e), grid_blocks);
#else
#ifndef PROBE_SEQ
#define PROBE_SEQ 0,1,2,3,4,5,6,7,8,9,10,11,12,13,14
#endif
  const int seq[] = {PROBE_SEQ};
  for (int i = 0; i < (int)(sizeof(seq) / sizeof(int)); i++) {
    p.phase_lo = seq[i]; p.phase_hi = seq[i];
    fwd_kernel<<<grid_blocks, 256, 0, stream>>>(p);
  }
#endif
}
```

```cpp
#include <hip/hip_runtime.h>
#include <hip/hip_cooperative_groups.h>
#include <stdint.h>
#include <cstdio>
#include <cstring>
namespace cg = cooperative_groups;

#ifndef FUSED
#define FUSED 1
#endif

typedef unsigned short u16;
typedef __attribute__((ext_vector_type(8))) __bf16 b16x8;
typedef __attribute__((ext_vector_type(16))) float f32x16;
typedef __attribute__((ext_vector_type(4))) unsigned u32x4;
typedef __attribute__((ext_vector_type(2))) unsigned u32x2;
#define DEV __device__ __forceinline__

constexpr int T_CTX = 8192;
constexpr float ALPHA_DN = 1.41421356237f;
constexpr float LOG2E = 1.44269504089f;
constexpr size_t MiB = 1u << 20;
constexpr size_t OFF_MODS = 0, OFF_BAR = 512 * 1024, OFF_BSUM = 1 * MiB;
constexpr size_t OFF_FSMP = 2 * MiB, OFF_U = 66 * MiB, OFF_ABUF = 98 * MiB, OFF_Q = 114 * MiB, OFF_K = 130 * MiB;
constexpr size_t OFF_VTC = 146 * MiB, OFF_VTS = 154 * MiB, OFF_GBUF = 162 * MiB, OFF_BTC = 194 * MiB, OFF_BTS = 210 * MiB;
constexpr size_t OFF_WINT = 226 * MiB, OFF_WOUTT = 232 * MiB, OFF_MCAT = 234 * MiB, OFF_FCTX = 234 * MiB + 256 * 1024;
constexpr size_t OFF_CK = 234 * MiB + 512 * 1024, OFF_CVT = 235 * MiB + 512 * 1024;
constexpr size_t OFF_RKVZT = 237 * MiB, OFF_RWOUTT = 245 * MiB, OFF_W1T = 247 * MiB, OFF_A1T = OFF_W1T + 256 * 1024,
                 OFF_G1T = OFF_W1T + 512 * 1024, OFF_W2T = OFF_W1T + 768 * 1024, OFF_A2T = 248 * MiB,
                 OFF_G2T = 248 * MiB + 256 * 1024, OFF_HW = 248 * MiB + 512 * 1024;
constexpr size_t OFF_U1 = 2 * MiB, OFF_R = 34 * MiB, OFF_K2 = 66 * MiB, OFF_V2 = 98 * MiB, OFF_SZ = 130 * MiB,
                 OFF_YSUM = 162 * MiB, OFF_HA = 226 * MiB, OFF_HG = 230 * MiB;
constexpr size_t OFF_BFOLD = 98 * MiB;
constexpr size_t OFF_Y0B = 98 * MiB, OFF_Y1B = 34 * MiB;
constexpr size_t OFF_DX = 162 * MiB;
constexpr size_t OFF_SEGP = 2 * MiB, OFF_SEGQ = 6 * MiB, OFF_SEGZ = 14 * MiB;
constexpr size_t OUT_NK = 16777216, OUT_NV = 20971520, OUT_ST = 25165824;

constexpr int NTJ = 33;
struct TJob { const float* src; u16* dst; int lds, ldd, tk, tn, start, pad; };

struct Params {
  const float *x_prompt, *x_sample, *cache_k, *cache_v, *state_rwkv, *c, *c_ctx;
  const float *ada_w, *ada_b, *post_g, *post_b, *w_in, *w_fnet, *rpb, *w_out;
  const float *mu, *rkvz, *w0, *w1, *w2, *a0, *a1, *a2, *g1, *g2, *k_k, *k_a, *r_k, *lnx_g, *lnx_b, *rw_out;
  float* out; char* ws;
  int phase_lo, phase_hi, ntr, pad;
  TJob tj[NTJ];
};

typedef __attribute__((ext_vector_type(2))) __bf16 bf16x2_t;
typedef __attribute__((ext_vector_type(2))) float f32x2_t;
DEV unsigned pack2(float a, float b) {
  f32x2_t f = {a, b};
  bf16x2_t r = __builtin_convertvector(f, bf16x2_t);
  return *(unsigned*)&r;
}
DEV u16 f2bf(float f) { return (u16)(pack2(f, 0.f) & 0xffffu); }
DEV float bflo(unsigned w) { return __uint_as_float(w << 16); }
DEV float bfhi(unsigned w) { return __uint_as_float(w & 0xffff0000u); }
DEV float rcp_f(float x) { return __builtin_amdgcn_rcpf(x); }
DEV float sigm(float x) { return rcp_f(1.f + __expf(-x)); }
DEV float silu(float x) { return x * rcp_f(1.f + __expf(-x)); }
DEV float tanh_f(float x) { return 1.f - 2.f * rcp_f(__expf(2.f * x) + 1.f); }
DEV b16x8 ld16(const u16* p) { uint4 v = *(const uint4*)p; return *(b16x8*)&v; }
DEV b16x8 asb(uint4 v) { return *(b16x8*)&v; }
template <int CTRL> DEV float dpp_add(float x) {
  return x + __int_as_float(__builtin_amdgcn_update_dpp(0, __float_as_int(x), CTRL, 0xf, 0xf, true));
}
DEV float allsum8(float x) {
  x = dpp_add<0xB1>(x); x = dpp_add<0x4E>(x); x = dpp_add<0x141>(x);
  return x;
}
DEV float wave_sum(float x) {
  x = dpp_add<0xB1>(x); x = dpp_add<0x4E>(x); x = dpp_add<0x141>(x); x = dpp_add<0x140>(x);
  x += __shfl_xor(x, 16); x += __shfl_xor(x, 32);
  return x;
}
DEV float allsum16(float x) {
  x = dpp_add<0xB1>(x); x = dpp_add<0x4E>(x); x = dpp_add<0x124>(x); x = dpp_add<0x128>(x);
  return x;
}
DEV void lds_barrier() { asm volatile("s_waitcnt lgkmcnt(0)\n\ts_barrier" ::: "memory"); }
DEV int mv_of(int token) { return token < T_CTX ? 0 : 1 + ((token - T_CTX) >> 12); }

template <bool LERP, class EP>
DEV void gemm_tile(const u16* __restrict__ A, int lda, const float* __restrict__ mu, int m0,
                   const u16* __restrict__ B, int ldb, int K, EP ep, char* smem) {
  u16(*sA0)[72] = (u16(*)[72])smem;
  u16(*sB0)[72] = (u16(*)[72])(smem + 18432);
  u16(*sA1)[72] = (u16(*)[72])(smem + 36864);
  u16(*sB1)[72] = (u16(*)[72])(smem + 36864 + 18432);
  int tid = threadIdx.x;
  asm volatile("" : "+v"(tid));
  const int lane = tid & 63, wave = tid >> 6, wm = wave >> 1, wn = wave & 1;
  const int lr = tid >> 3, lk = (tid & 7) * 8;
  f32x16 acc[2][2];
#pragma unroll
  for (int i = 0; i < 2; i++)
#pragma unroll
    for (int j = 0; j < 2; j++)
#pragma unroll
      for (int r = 0; r < 16; r++) acc[i][j][r] = 0.f;
  u32x4 ra0[4], rb0[4], rp0[4], ra1[4], rb1[4], rp1[4];
  float4 mu00, mu01, mu10, mu11;
  const u16* DXp = nullptr;
  if constexpr (LERP) DXp = (const u16*)(A) + (OFF_DX - OFF_U1) / 2;
#define GLOAD(K0, RA, RB, RP, M0, M1)                                                     \
  {                                                                                       \
    _Pragma("unroll") for (int i = 0; i < 4; i++) {                                       \
      int r = lr + 32 * i;                                                                \
      if constexpr (LERP) {                                                               \
        RA[i] = *(const u32x4*)(A + (size_t)(m0 + r) * lda + (K0) + lk);                  \
        RP[i] = *(const u32x4*)(DXp + (size_t)(m0 + r) * lda + (K0) + lk);                \
      } else {                                                                            \
        RA[i] = *(const u32x4*)(A + (size_t)r * lda + (K0) + lk);                         \
      }                                                                                   \
      RB[i] = *(const u32x4*)(B + (size_t)r * ldb + (K0) + lk);                           \
    }                                                                                     \
    if constexpr (LERP) {                                                                 \
      M0 = *(const float4*)(mu + (K0) + lk);                                              \
      M1 = *(const float4*)(mu + (K0) + lk + 4);                                          \
    }                                                                                     \
  }
#define GSTORE(RA, RB, RP, M0, M1, sA, sB)                                                     \
  {                                                                                       \
    _Pragma("unroll") for (int i = 0; i < 4; i++) {                                       \
      int r = lr + 32 * i;                                                                \
      u32x4 av = RA[i];                                                                   \
      if constexpr (LERP) {                                                               \
        unsigned cu[4] = {RA[i].x, RA[i].y, RA[i].z, RA[i].w};                            \
        unsigned du[4] = {RP[i].x, RP[i].y, RP[i].z, RP[i].w};                            \
        float m[8] = {M0.x, M0.y, M0.z, M0.w, M1.x, M1.y, M1.z, M1.w};                    \
        unsigned o[4];                                                                    \
        _Pragma("unroll") for (int q = 0; q < 4; q++)                                     \
          o[q] = pack2(bflo(cu[q]) + bflo(du[q]) * m[2 * q], bfhi(cu[q]) + bfhi(du[q]) * m[2 * q + 1]); \
        av = u32x4{o[0], o[1], o[2], o[3]};                                               \
      }                                                                                   \
      *(u32x4*)&sA[r][lk] = av;                                                           \
      *(u32x4*)&sB[r][lk] = RB[i];                                                        \
    }                                                                                     \
  }
#define GCOMPUTE(sA, sB)                                                                  \
  {                                                                                       \
    _Pragma("unroll") for (int ks = 0; ks < 4; ks++) {                                    \
      b16x8 af[2], bf[2];                                                                 \
      _Pragma("unroll") for (int i = 0; i < 2; i++) {                                     \
        af[i] = *(const b16x8*)&sA[wm * 64 + i * 32 + (lane & 31)][ks * 16 + (lane >> 5) * 8]; \
        bf[i] = *(const b16x8*)&sB[wn * 64 + i * 32 + (lane & 31)][ks * 16 + (lane >> 5) * 8]; \
      }                                                                                   \
      _Pragma("unroll") for (int i = 0; i < 2; i++)                                       \
        _Pragma("unroll") for (int j = 0; j < 2; j++)                                     \
          acc[i][j] = __builtin_amdgcn_mfma_f32_32x32x16_bf16(af[i], bf[j], acc[i][j], 0, 0, 0); \
    }                                                                                     \
  }
#define GPIPE()                                                                           \
  {                                                                                       \
    __builtin_amdgcn_sched_group_barrier(0x100, 4, 0);                                    \
    _Pragma("unroll") for (int pi = 0; pi < 16; pi++) {                                   \
      __builtin_amdgcn_sched_group_barrier(0x008, 1, 0);                                  \
      __builtin_amdgcn_sched_group_barrier(0x100, 1, 0);                                  \
      __builtin_amdgcn_sched_group_barrier(0x002, 7, 0);                                  \
      __builtin_amdgcn_sched_group_barrier(0x200, 1, 0);                                  \
    }                                                                                     \
  }
  GLOAD(0, ra0, rb0, rp0, mu00, mu01);
  GLOAD(64, ra1, rb1, rp1, mu10, mu11);
  __syncthreads();
  GSTORE(ra0, rb0, rp0, mu00, mu01, sA0, sB0);
  if (128 < K) GLOAD(128, ra0, rb0, rp0, mu00, mu01);
  __syncthreads();
#pragma unroll 1
  for (int k0 = 0; k0 < K; k0 += 128) {
    __builtin_amdgcn_s_setprio(1);
    GCOMPUTE(sA0, sB0);
    GSTORE(ra1, rb1, rp1, mu10, mu11, sA1, sB1);
    {
      const int kn = k0 + 192 < K ? k0 + 192 : K - 64;
      GLOAD(kn, ra1, rb1, rp1, mu10, mu11);
    }
    GPIPE();
    __builtin_amdgcn_s_setprio(0);
    __syncthreads();
    __builtin_amdgcn_s_setprio(1);
    GCOMPUTE(sA1, sB1);
    __builtin_amdgcn_s_setprio(0);
    if (k0 + 128 < K) {
      GSTORE(ra0, rb0, rp0, mu00, mu01, sA0, sB0);
      {
        const int kn = k0 + 256 < K ? k0 + 256 : K - 64;
        GLOAD(kn, ra0, rb0, rp0, mu00, mu01);
      }
    }
    __syncthreads();
  }
#undef GLOAD
#undef GSTORE
#undef GCOMPUTE
#undef GPIPE
  __syncthreads();
  int tide = tid;
  asm volatile("" : "+v"(tide));
  const int lane_e = tide & 63, wv_e = tide >> 6, wm_e = wv_e >> 1, wn_e = wv_e & 1;
  u16* stg = (u16*)smem + wv_e * (64 * 72);
#pragma unroll
  for (int i = 0; i < 2; i++)
#pragma unroll
    for (int j = 0; j < 2; j++)
#pragma unroll
      for (int q = 0; q < 4; q++) {
        const int r = i * 32 + q * 8 + (lane_e >> 5) * 4, c = j * 32 + (lane_e & 31);
        const float v0 = acc[i][j][q * 4 + 0], v1 = acc[i][j][q * 4 + 1], v2 = acc[i][j][q * 4 + 2], v3 = acc[i][j][q * 4 + 3];
        ep.direct(wm_e * 64 + r, wn_e * 64 + c, v0, v1, v2, v3);
        if constexpr (EP::TRANS) {
          *(uint2*)(stg + c * 72 + r) = make_uint2(pack2(ep.act(v0), ep.act(v1)), pack2(ep.act(v2), ep.act(v3)));
        } else {
          const unsigned p01 = pack2(ep.act(v0), ep.act(v1)), p23 = pack2(ep.act(v2), ep.act(v3));
          stg[(r + 0) * 72 + c] = (u16)(p01 & 0xffffu); stg[(r + 1) * 72 + c] = (u16)(p01 >> 16);
          stg[(r + 2) * 72 + c] = (u16)(p23 & 0xffffu); stg[(r + 3) * 72 + c] = (u16)(p23 >> 16);
        }
      }
#pragma unroll
  for (int n = 0; n < 8; n++) {
    const int id = lane_e + 64 * n, rr = id >> 3, cc = (id & 7) * 8;
    const u32x4 v = *(const u32x4*)(stg + rr * 72 + cc);
    if constexpr (EP::TRANS) ep.store(wn_e * 64 + rr, wm_e * 64 + cc, v);
    else ep.store(wm_e * 64 + rr, wn_e * 64 + cc, v);
  }
}

template <int ACT> struct EpStore {
  static constexpr bool TRANS = false;
  u16* dst; int ld; float scale;
  DEV float act(float x) const {
    if (ACT == 1) return silu(x);
    if (ACT == 2) return tanh_f(x);
    if (ACT == 3) return sigm(x);
    if (ACT == 4) return x * scale;
    return x;
  }
  DEV void direct(int, int, float, float, float, float) const {}
  DEV void store(int R, int C, u32x4 v) const { *(u32x4*)(dst + (size_t)R * ld + C) = v; }
};
struct EpNull {
  static constexpr bool TRANS = false;
  DEV float act(float x) const { return x; }
  DEV void direct(int, int, float, float, float, float) const {}
  DEV void store(int, int, u32x4) const {}
};
struct EpKeep {
  static constexpr bool TRANS = false;
  u16* dst; int ld; float* f32dst; int ldf;
  DEV float act(float x) const { return x; }
  DEV void direct(int r, int c, float v0, float v1, float v2, float v3) const {
    if (f32dst) {
      f32dst[(size_t)(r + 0) * ldf + c] = v0; f32dst[(size_t)(r + 1) * ldf + c] = v1;
      f32dst[(size_t)(r + 2) * ldf + c] = v2; f32dst[(size_t)(r + 3) * ldf + c] = v3;
    }
  }
  DEV void store(int R, int C, u32x4 v) const { *(u32x4*)(dst + (size_t)R * ld + C) = v; }
};
struct EpTrans {
  static constexpr bool TRANS = true;
  u16* dst; size_t ldt; float* f32dst; int ldf;
  DEV float act(float x) const { return x; }
  DEV void direct(int r, int c, float v0, float v1, float v2, float v3) const {
    if (f32dst) {
      f32dst[(size_t)(r + 0) * ldf + c] = v0; f32dst[(size_t)(r + 1) * ldf + c] = v1;
      f32dst[(size_t)(r + 2) * ldf + c] = v2; f32dst[(size_t)(r + 3) * ldf + c] = v3;
    }
  }
  DEV void store(int Rc, int Cr, u32x4 v) const { *(u32x4*)(dst + (size_t)Rc * ldt + Cr) = v; }
};
struct EpGate {
  static constexpr bool TRANS = false;
  u16* dst; const u16* gate; int ld;
  DEV float act(float x) const { return x; }
  DEV void direct(int, int, float, float, float, float) const {}
  DEV void store(int R, int C, u32x4 v) const {
    const size_t o = (size_t)R * ld + C;
    const u32x4 g = *(const u32x4*)(gate + o);
    u32x4 r;
    r.x = pack2(bflo(v.x) * bflo(g.x), bfhi(v.x) * bfhi(g.x)); r.y = pack2(bflo(v.y) * bflo(g.y), bfhi(v.y) * bfhi(g.y));
    r.z = pack2(bflo(v.z) * bflo(g.z), bfhi(v.z) * bfhi(g.z)); r.w = pack2(bflo(v.w) * bflo(g.w), bfhi(v.w) * bfhi(g.w));
    *(u32x4*)(dst + o) = r;
  }
};
struct EpRes {
  static constexpr bool TRANS = false;
  u16* dst; const float* xsrc; const float* gate;
  DEV float act(float x) const { return x; }
  DEV void direct(int, int, float, float, float, float) const {}
  DEV void store(int R, int C, u32x4 v) const {
    const size_t o = (size_t)R * 1024 + C;
    const float4 x0 = *(const float4*)(xsrc + o), x1 = *(const float4*)(xsrc + o + 4);
    const float4 g0 = *(const float4*)(gate + C), g1 = *(const float4*)(gate + C + 4);
    u32x4 r;
    r.x = pack2(ALPHA_DN * x0.x + (1.f + g0.x) * bflo(v.x), ALPHA_DN * x0.y + (1.f + g0.y) * bfhi(v.x));
    r.y = pack2(ALPHA_DN * x0.z + (1.f + g0.z) * bflo(v.y), ALPHA_DN * x0.w + (1.f + g0.w) * bfhi(v.y));
    r.z = pack2(ALPHA_DN * x1.x + (1.f + g1.x) * bflo(v.z), ALPHA_DN * x1.y + (1.f + g1.y) * bfhi(v.z));
    r.w = pack2(ALPHA_DN * x1.z + (1.f + g1.z) * bflo(v.w), ALPHA_DN * x1.w + (1.f + g1.w) * bfhi(v.w));
    *(u32x4*)(dst + o) = r;
  }
};

DEV void p0_prep(const Params& p, char* smem) {
  const int tid = threadIdx.x;
  const int njobs = 192 + p.ntr;
  for (int job = blockIdx.x; job < njobs; job += gridDim.x) {
    __syncthreads();
    if (job < 192) {
      float* sc = (float*)smem;
      float* red = sc + 3072;
      for (int i = tid; i < 3072; i += 256) {
        int m = i >> 10, k = i & 1023;
        float cv = m == 0 ? p.c_ctx[k] : p.c[(m - 1) * 1024 + k];
        sc[i] = silu(cv);
      }
      __syncthreads();
      int l = job / 96, col = (job % 96) * 32 + (tid & 31), ks = tid >> 5;
      const float* w = p.ada_w + (size_t)l * 1024 * 3072 + col;
      float a0 = 0, a1 = 0, a2 = 0;
#pragma unroll 8
      for (int k = ks * 128; k < ks * 128 + 128; k++) {
        float wv = w[(size_t)k * 3072];
        a0 += sc[k] * wv; a1 += sc[1024 + k] * wv; a2 += sc[2048 + k] * wv;
      }
      red[(ks * 32 + (tid & 31)) * 3 + 0] = a0; red[(ks * 32 + (tid & 31)) * 3 + 1] = a1; red[(ks * 32 + (tid & 31)) * 3 + 2] = a2;
      __syncthreads();
      if (tid < 96) {
        int cl = tid & 31, m = tid >> 5;
        float s = 0;
        for (int q = 0; q < 8; q++) s += red[(q * 32 + cl) * 3 + m];
        int cc = (job % 96) * 32 + cl;
        ((float*)(p.ws + OFF_MODS))[(l * 3 + m) * 3072 + cc] = s + p.ada_b[l * 3072 + cc];
      }
    } else {
      int tj = job - 192, e = 0;
      while (e + 1 < NTJ && p.tj[e + 1].start <= tj) e++;
      const TJob J = p.tj[e];
      int lt = tj - J.start, tkk = lt / J.tn, tnn = lt % J.tn;
      float(*tile)[65] = (float(*)[65])smem;
      const float* src = J.src + (size_t)(tkk * 64) * J.lds + tnn * 64;
#pragma unroll
      for (int i = 0; i < 4; i++) {
        int kk = (tid >> 4) + 16 * i, nn = (tid & 15) * 4;
        float4 v = *(const float4*)(src + (size_t)kk * J.lds + nn);
        tile[kk][nn] = v.x; tile[kk][nn + 1] = v.y; tile[kk][nn + 2] = v.z; tile[kk][nn + 3] = v.w;
      }
      __syncthreads();
      u16* dst = J.dst + (size_t)(tnn * 64) * J.ldd + tkk * 64;
#pragma unroll
      for (int i = 0; i < 2; i++) {
        int nn = (tid >> 3) + 32 * i, kk = (tid & 7) * 8;
        uint4 o;
        o.x = pack2(tile[kk][nn], tile[kk + 1][nn]); o.y = pack2(tile[kk + 2][nn], tile[kk + 3][nn]);
        o.z = pack2(tile[kk + 4][nn], tile[kk + 5][nn]); o.w = pack2(tile[kk + 6][nn], tile[kk + 7][nn]);
        *(uint4*)(dst + (size_t)nn * J.ldd + kk) = o;
      }
    }
  }
  const size_t gt = (size_t)blockIdx.x * 256 + tid, gs = (size_t)gridDim.x * 256;
  {
    u16* ck = (u16*)(p.ws + OFF_CK);
    for (size_t i = gt; i < 65536; i += gs) {
      float4 a = *(const float4*)(p.cache_k + i * 8), b = *(const float4*)(p.cache_k + i * 8 + 4);
      *(uint4*)(ck + i * 8) = make_uint4(pack2(a.x, a.y), pack2(a.z, a.w), pack2(b.x, b.y), pack2(b.z, b.w));
    }
  }
  {
    u16* fs = (u16*)(p.ws + OFF_FSMP);
    const float sc = 0.001381067932f;
    for (size_t i = gt; i < 2097152; i += gs) {
      int lp = (int)(i >> 9), j0 = (int)(i & 511) * 8;
      unsigned o[4];
#pragma unroll
      for (int q = 0; q < 4; q++) {
        float v[2];
#pragma unroll
        for (int z = 0; z < 2; z++) {
          int j = j0 + 2 * q + z;
          bool cs = j <= 2048;
          int ph = (lp * (cs ? j : j - 2048)) & 4095;
          float ang = (float)ph * (6.283185307179586f / 4096.f);
          v[z] = (cs ? __cosf(ang) : -__sinf(ang)) * sc;
        }
        o[q] = pack2(v[0], v[1]);
      }
      *(uint4*)(fs + i * 8) = make_uint4(o[0], o[1], o[2], o[3]);
    }
    u16* fc = (u16*)(p.ws + OFF_FCTX);
    const float sc2 = 0.005524271728f;
    for (size_t i = gt; i < 16384; i += gs) {
      int lp = (int)(i >> 6), j0 = (int)(i & 63) * 8;
      unsigned o[4];
#pragma unroll
      for (int q = 0; q < 4; q++) {
        float v[2];
#pragma unroll
        for (int z = 0; z < 2; z++) {
          int j = j0 + 2 * q + z;
          int ph = (lp * (j & 255)) & 255;
          float ang = (float)ph * (6.283185307179586f / 256.f);
          v[z] = (j < 256 ? __cosf(ang) : -__sinf(ang)) * sc2;
        }
        o[q] = pack2(v[0], v[1]);
      }
      *(uint4*)(fc + i * 8) = make_uint4(o[0], o[1], o[2], o[3]);
    }
  }
  {
    u16* mc = (u16*)(p.ws + OFF_MCAT);
    for (size_t i = gt; i < 131072; i += gs) {
      int c = (int)(i & 127), ep = (int)((i >> 7) & 255), g = (int)(i >> 15);
      const float* wf = p.w_fnet + (size_t)g * 16384 + (ep & 127);
      float s = 0;
      for (int cp = 0; cp < 128; cp++) {
        float ang = (float)((c * cp) & 127) * (6.283185307179586f / 128.f);
        float tw = ep < 128 ? __cosf(ang) : __sinf(ang);
        s += tw * wf[cp * 128];
      }
      mc[i] = f2bf(s);
    }
  }
}

DEV void ln_stats(const float4 (&x)[4], float& mean, float& rstd) {
  float s = 0;
#pragma unroll
  for (int i = 0; i < 4; i++) s += x[i].x + x[i].y + x[i].z + x[i].w;
  mean = wave_sum(s) * (1.f / 1024.f);
  float q = 0;
#pragma unroll
  for (int i = 0; i < 4; i++) {
    float a = x[i].x - mean, b = x[i].y - mean, c = x[i].z - mean, d = x[i].w - mean;
    q += a * a + b * b + c * c + d * d;
  }
  rstd = rsqrtf(wave_sum(q) * (1.f / 1024.f) + 1e-6f);
}

template <int MODE> DEV void ln_phase(const Params& p) {
  const int lane = threadIdx.x & 63;
  const int gw = blockIdx.x * 4 + (threadIdx.x >> 6), nw = gridDim.x * 4;
  const float* mods = (const float*)(p.ws + OFF_MODS);
  typedef __attribute__((ext_vector_type(4))) float f32x4v;
  f32x4v xn[4];
  u32x2 wn[4];
  auto fetch = [&](int row) {
    if (MODE == 0) {
      const float* src = row < T_CTX ? p.x_prompt + (size_t)row * 1024 : p.x_sample + (size_t)(row - T_CTX) * 1024;
#pragma unroll
      for (int i = 0; i < 4; i++) xn[i] = *(const f32x4v*)(src + lane * 4 + 256 * i);
    } else {
      const u16* sb = (const u16*)(p.ws + (MODE == 1 ? OFF_Y0B : OFF_Y1B)) + (size_t)row * 1024;
#pragma unroll
      for (int i = 0; i < 4; i++) wn[i] = *(const u32x2*)(sb + lane * 4 + 256 * i);
    }
  };
  if (gw < 16384) fetch(gw);
  for (int row = gw; row < 16384; row += nw) {
    float4 x[4];
#pragma unroll
    for (int i = 0; i < 4; i++) {
      if (MODE == 0) x[i] = make_float4(xn[i].x, xn[i].y, xn[i].z, xn[i].w);
      else x[i] = make_float4(bflo(wn[i].x), bfhi(wn[i].x), bflo(wn[i].y), bfhi(wn[i].y));
    }
    if (row + nw < 16384) fetch(row + nw);
    float mean, rstd;
    ln_stats(x, mean, rstd);
    if (MODE >= 1) {
      const float* g = p.post_g + (MODE == 1 ? 0 : 1024);
      const float* b = p.post_b + (MODE == 1 ? 0 : 1024);
      float* dst = p.out + (size_t)row * 1024;
#pragma unroll
      for (int i = 0; i < 4; i++) {
        float4 gv = *(const float4*)(g + lane * 4 + 256 * i), bv = *(const float4*)(b + lane * 4 + 256 * i);
        x[i].x = (x[i].x - mean) * rstd * gv.x + bv.x; x[i].y = (x[i].y - mean) * rstd * gv.y + bv.y;
        x[i].z = (x[i].z - mean) * rstd * gv.z + bv.z; x[i].w = (x[i].w - mean) * rstd * gv.w + bv.w;
        *(float4*)(dst + lane * 4 + 256 * i) = x[i];
      }
      if (MODE == 2) continue;
      ln_stats(x, mean, rstd);
    }
    const float* md = mods + ((MODE == 0 ? 0 : 3) + mv_of(row)) * 3072;
    u16* ud = (u16*)(p.ws + (MODE == 0 ? OFF_U : OFF_U1)) + (size_t)row * 1024;
#pragma unroll
    for (int i = 0; i < 4; i++) {
      int k = lane * 4 + 256 * i;
      float4 sh = *(const float4*)(md + k), sc = *(const float4*)(md + 1024 + k);
      float a = (x[i].x - mean) * rstd * (1.f + sc.x) + sh.x, b = (x[i].y - mean) * rstd * (1.f + sc.y) + sh.y;
      float c = (x[i].z - mean) * rstd * (1.f + sc.z) + sh.z, d = (x[i].w - mean) * rstd * (1.f + sc.w) + sh.w;
      *(uint2*)(ud + k) = make_uint2(pack2(a, b), pack2(c, d));
    }
  }
}

DEV void p2_gemm1(const Params& p, char* smem) {
  const u16* U = (const u16*)(p.ws + OFF_U);
  const u16* W = (const u16*)(p.ws + OFF_WINT);
  const int xcd = blockIdx.x & 7, jx = blockIdx.x >> 3, nbx = gridDim.x >> 3;
  for (int q = jx; q < 16 * 24; q += nbx) {
    int st = q >> 6, w = q & 63, sm = st / 3, sn = st % 3;
    int mt = xcd * 16 + sm * 8 + (w >> 3), nt = sn * 8 + (w & 7);
    int m0 = mt * 128, n0 = nt * 128, sec = nt >> 2, nc = (nt & 3) * 128;
    const u16* A = U + (size_t)m0 * 1024;
    const u16* B = W + (size_t)n0 * 1024;
    if (sec == 0) {
      gemm_tile<false>(A, 1024, nullptr, m0, B, 1024, 1024, EpStore<0>{(u16*)(p.ws + OFF_ABUF) + (size_t)m0 * 512 + nc, 512, 1.f}, smem);
    } else if (sec == 1 || sec == 5) {
      gemm_tile<false>(A, 1024, nullptr, m0, B, 1024, 1024,
                       EpStore<1>{(u16*)(p.ws + OFF_GBUF) + (size_t)m0 * 1024 + (sec == 5 ? 512 : 0) + nc, 1024, 1.f}, smem);
    } else if (sec == 2) {
      gemm_tile<false>(A, 1024, nullptr, m0, B, 1024, 1024, EpStore<4>{(u16*)(p.ws + OFF_Q) + (size_t)m0 * 512 + nc, 512, 0.125f * LOG2E}, smem);
    } else if (sec == 3) {
      float* f = m0 < T_CTX ? p.out + OUT_NK + (size_t)m0 * 512 + nc : nullptr;
      gemm_tile<false>(A, 1024, nullptr, m0, B, 1024, 1024, EpKeep{(u16*)(p.ws + OFF_K) + (size_t)m0 * 512 + nc, 512, f, 512}, smem);
    } else {
      float* f = m0 < T_CTX ? p.out + OUT_NV + (size_t)m0 * 512 + nc : nullptr;
      u16* d; size_t ldt;
      if (m0 < T_CTX) { int b = m0 >> 8, l = m0 & 255; ldt = 256; d = (u16*)(p.ws + OFF_VTC) + ((size_t)b * 512 + nc) * 256 + l; }
      else { int tt = m0 - T_CTX, b = tt >> 12, l = tt & 4095; ldt = 4096; d = (u16*)(p.ws + OFF_VTS) + ((size_t)b * 512 + nc) * 4096 + l; }
      gemm_tile<false>(A, 1024, nullptr, m0, B, 1024, 1024, EpTrans{d, ldt, f, 512}, smem);
    }
  }
}

struct AttnState { f32x16 o0, o1; float m, l; };

DEV void attn_tile(AttnState& st, const b16x8 (&qf)[4], const u16* kS, const u16* vS, int mode, int dr, int kc0, int c,
                   const float* rpbh, int qi, int hh) {
  f32x16 s;
#pragma unroll
  for (int r = 0; r < 16; r++) s[r] = 0.f;
#pragma unroll
  for (int ks = 0; ks < 4; ks++) s = __builtin_amdgcn_mfma_f32_32x32x16_bf16(*(const b16x8*)(kS + qi * 72 + ks * 16 + hh * 8), qf[ks], s, 0, 0, 0);
  if (mode) {
    int cs = min(max(c - 8, 0), 48);
#pragma unroll
    for (int r = 0; r < 16; r++) {
      int kc = kc0 + (r & 3) + 8 * (r >> 2) + 4 * hh;
      bool valid = (kc >= cs) && (kc < cs + 16);
      int dc = min(max(kc - c + 15, 0), 30);
      float bias = rpbh[dr * 31 + dc] * LOG2E;
      s[r] = valid ? s[r] + bias : -1e30f;
    }
  }
  float tm = s[0];
#pragma unroll
  for (int r = 1; r < 16; r++) tm = fmaxf(tm, s[r]);
  tm = fmaxf(tm, __shfl_xor(tm, 32));
  float mn = fmaxf(st.m, tm);
  float alpha = __builtin_amdgcn_exp2f(st.m - mn);
  st.m = mn;
  float ps = 0;
#pragma unroll
  for (int r = 0; r < 16; r++) { float e = __builtin_amdgcn_exp2f(s[r] - mn); ps += e; s[r] = e; }
  st.l = st.l * alpha + ps;
#pragma unroll
  for (int r = 0; r < 16; r++) { st.o0[r] *= alpha; st.o1[r] *= alpha; }
#pragma unroll
  for (int s2 = 0; s2 < 2; s2++) {
    u32x4 pw = {pack2(s[8 * s2 + 0], s[8 * s2 + 1]), pack2(s[8 * s2 + 2], s[8 * s2 + 3]),
                pack2(s[8 * s2 + 4], s[8 * s2 + 5]), pack2(s[8 * s2 + 6], s[8 * s2 + 7])};
    b16x8 pfr = *(b16x8*)&pw;
#pragma unroll
    for (int dt = 0; dt < 2; dt++) {
      const u16* vr = vS + (dt * 32 + qi) * 40 + 16 * s2 + 4 * hh;
      const uint2 lo = *(const uint2*)vr, hi = *(const uint2*)(vr + 8);
      u32x4 vw = {lo.x, lo.y, hi.x, hi.y};
      b16x8 vf = *(b16x8*)&vw;
      if (dt == 0) st.o0 = __builtin_amdgcn_mfma_f32_32x32x16_bf16(vf, pfr, st.o0, 0, 0, 0);
      else st.o1 = __builtin_amdgcn_mfma_f32_32x32x16_bf16(vf, pfr, st.o1, 0, 0, 0);
    }
  }
}

DEV void attn_unit(const Params& p, int u, int lane, char* smem) {
  const u16* Qb = (const u16*)(p.ws + OFF_Q);
  const u16* Kb = (const u16*)(p.ws + OFF_K);
  const int qi = lane & 31, hh = lane >> 5;
  u16* kS = (u16*)smem + (threadIdx.x >> 6) * 4864;
  u16* vS = kS + 32 * 72;
  bool smp = u < 2048;
  int b, h, qg, tq0, r = 0, c0 = 0;
  if (smp) { b = u >> 10; h = (u >> 7) & 7; qg = u & 127; tq0 = T_CTX + b * 4096 + qg * 32; r = qg >> 1; c0 = (qg & 1) * 32; }
  else { int v = u - 2048; b = v >> 6; h = (v >> 3) & 7; qg = v & 7; tq0 = b * 256 + qg * 32; }
  b16x8 qf[4];
#pragma unroll
  for (int s = 0; s < 4; s++) qf[s] = ld16(Qb + (size_t)(tq0 + qi) * 512 + h * 64 + s * 16 + hh * 8);
  AttnState st;
#pragma unroll
  for (int i = 0; i < 16; i++) { st.o0[i] = 0.f; st.o1[i] = 0.f; }
  st.m = -INFINITY; st.l = 0.f;
  const float* rpbh = p.rpb + h * 465;
  const int rs = min(max(r - 4, 0), 56);
  const u16* ck = (const u16*)(p.ws + OFF_CK) + (size_t)b * 512 * 512 + h * 64;
  const u16* cvt = (const u16*)(p.ws + OFF_CVT) + (size_t)(b * 8 + h) * 64 * 512;
  const u16* kls = Kb + (size_t)(T_CTX + b * 4096) * 512 + h * 64;
  const u16* vls = (const u16*)(p.ws + OFF_VTS) + (size_t)(b * 8 + h) * 64 * 4096;
  const u16* klc = Kb + (size_t)(b * 256) * 512 + h * 64;
  const u16* vlc = (const u16*)(p.ws + OFF_VTC) + (size_t)(b * 8 + h) * 64 * 256;
  const int ntile = smp ? 32 : 8;
  u32x4 kr[4], vr[4];
  auto issue = [&](int tt) {
    int ll = lane;
    asm volatile("" : "+v"(ll));
    const u16 *kp, *vp; int ldv;
    if (!smp) { kp = klc + (size_t)tt * 32 * 512; vp = vlc + tt * 32; ldv = 256; }
    else if (tt < 16) { kp = ck + (size_t)tt * 32 * 512; vp = cvt + tt * 32; ldv = 512; }
    else { int kt = tt - 16, krow = rs + (kt >> 1), kc0 = (kt & 1) * 32; kp = kls + (size_t)(krow * 64 + kc0) * 512; vp = vls + krow * 64 + kc0; ldv = 4096; }
#pragma unroll
    for (int n = 0; n < 4; n++) {
      const int id = ll + 64 * n;
      kr[n] = *(const u32x4*)(kp + (size_t)(id >> 3) * 512 + (id & 7) * 8);
      vr[n] = *(const u32x4*)(vp + (size_t)(id >> 2) * ldv + (id & 3) * 8);
    }
  };
  issue(0);
#pragma unroll 1
  for (int tt = 0; tt < ntile; tt++) {
    {
      int ll = lane;
      asm volatile("" : "+v"(ll));
#pragma unroll
      for (int n = 0; n < 4; n++) {
        const int id = ll + 64 * n;
        *(u32x4*)(kS + (id >> 3) * 72 + (id & 7) * 8) = kr[n];
        *(u32x4*)(vS + (id >> 2) * 40 + (id & 3) * 8) = vr[n];
      }
    }
    if (tt + 1 < ntile) issue(tt + 1);
    const bool loc = smp && tt >= 16;
    const int kt = tt - 16;
    attn_tile(st, qf, kS, vS, loc ? 1 : 0, loc ? rs + (kt >> 1) - r + 7 : 0, loc ? (kt & 1) * 32 : 0, c0 + qi, rpbh, qi, hh);
  }
  float lt = st.l + __shfl_xor(st.l, 32);
  float inv = 1.f / lt;
  const size_t rowo = (size_t)(tq0 + qi) * 1024 + 512 + h * 64;
  const u16* gb = (const u16*)(p.ws + OFF_GBUF) + rowo;
  u16* cat = (u16*)(p.ws + OFF_U) + rowo;
#pragma unroll
  for (int dt = 0; dt < 2; dt++)
#pragma unroll
    for (int q = 0; q < 4; q++) {
      int d = dt * 32 + q * 8 + hh * 4;
      uint2 g = *(const uint2*)(gb + d);
      float v0 = (dt ? st.o1[q * 4 + 0] : st.o0[q * 4 + 0]) * inv * bflo(g.x);
      float v1 = (dt ? st.o1[q * 4 + 1] : st.o0[q * 4 + 1]) * inv * bfhi(g.x);
      float v2 = (dt ? st.o1[q * 4 + 2] : st.o0[q * 4 + 2]) * inv * bflo(g.y);
      float v3 = (dt ? st.o1[q * 4 + 3] : st.o0[q * 4 + 3]) * inv * bfhi(g.y);
      *(uint2*)(cat + d) = make_uint2(pack2(v0, v1), pack2(v2, v3));
    }
}

DEV void p3_mix(const Params& p, char* smem) {
  for (int t = blockIdx.x; t < 2048; t += gridDim.x) {
    if (t < 1024) {
      __syncthreads();
      attn_unit(p, t * 4 + (threadIdx.x >> 6), threadIdx.x & 63, smem);
    } else {
      int q = t - 1024, mt = q >> 3, g = (q >> 1) & 3, nh = q & 1, m0 = mt * 128;
      const u16* A = (const u16*)(p.ws + OFF_ABUF) + (size_t)m0 * 512 + g * 128;
      const u16* B = (const u16*)(p.ws + OFF_MCAT) + (size_t)(g * 256 + nh * 128) * 128;
      u16* d; size_t ldt;
      if (m0 < T_CTX) { int b = m0 >> 8, l = m0 & 255; ldt = 512; d = (u16*)(p.ws + OFF_BTC) + ((size_t)b * 512 + g * 128) * 512 + nh * 256 + l; }
      else { int tt = m0 - T_CTX, b = tt >> 12, l = tt & 4095; ldt = 8192; d = (u16*)(p.ws + OFF_BTS) + ((size_t)b * 512 + g * 128) * 8192 + nh * 4096 + l; }
      gemm_tile<false>(A, 512, nullptr, m0, B, 128, 128, EpTrans{d, ldt, nullptr, 0}, smem);
    }
  }
}

DEV void p3b_fold(const Params& p) {
  const u16* bt = (const u16*)(p.ws + OFF_BTS);
  u16* bf = (u16*)(p.ws + OFF_BFOLD);
  const size_t gt = (size_t)blockIdx.x * 256 + threadIdx.x, gs = (size_t)gridDim.x * 256;
  for (size_t i = gt; i < 4194304; i += gs) {
    const int jj = (int)(i & 4095);
    const u16* row = bt + (i >> 12) * 8192;
    float v;
    if (jj <= 2048) {
      v = __uint_as_float((unsigned)row[jj] << 16);
      if (jj >= 1 && jj <= 2047) v += __uint_as_float((unsigned)row[4096 - jj] << 16);
    } else {
      const int j = jj - 2048;
      v = __uint_as_float((unsigned)row[4096 + j] << 16) - __uint_as_float((unsigned)row[8192 - j] << 16);
    }
    bf[i] = f2bf(v);
  }
}

DEV void p4_fnet(const Params& p, char* smem) {
  for (int t = blockIdx.x; t < 512; t += gridDim.x) {
    if (t < 256) {
      int b = t >> 7, mt = (t >> 2) & 31, nt = t & 3;
      int tok0 = T_CTX + b * 4096 + mt * 128;
      const u16* A = (const u16*)(p.ws + OFF_FSMP) + (size_t)(mt * 128) * 4096;
      const u16* B = (const u16*)(p.ws + OFF_BFOLD) + ((size_t)b * 512 + nt * 128) * 4096;
      size_t o = (size_t)tok0 * 1024 + nt * 128;
      gemm_tile<false>(A, 4096, nullptr, 0, B, 4096, 4096, EpGate{(u16*)(p.ws + OFF_U) + o, (const u16*)(p.ws + OFF_GBUF) + o, 1024}, smem);
    } else {
      int q = t - 256, b = q >> 3, mt = (q >> 2) & 1, nt = q & 3;
      int tok0 = b * 256 + mt * 128;
      const u16* A = (const u16*)(p.ws + OFF_FCTX) + (size_t)(mt * 128) * 512;
      const u16* B = (const u16*)(p.ws + OFF_BTC) + ((size_t)b * 512 + nt * 128) * 512;
      size_t o = (size_t)tok0 * 1024 + nt * 128;
      gemm_tile<false>(A, 512, nullptr, 0, B, 512, 512, EpGate{(u16*)(p.ws + OFF_U) + o, (const u16*)(p.ws + OFF_GBUF) + o, 1024}, smem);
    }
  }
}

template <int LAYER> DEV void p_outproj(const Params& p, char* smem) {
  const u16* Aall = (const u16*)(p.ws + (LAYER == 0 ? OFF_U : OFF_U1));
  const u16* W = (const u16*)(p.ws + (LAYER == 0 ? OFF_WOUTT : OFF_RWOUTT));
  const float* mods = (const float*)(p.ws + OFF_MODS);
  for (int t = blockIdx.x; t < 1024; t += gridDim.x) {
    int mt = t >> 3, nt = t & 7, m0 = mt * 128, n0 = nt * 128;
    const float* xs;
    if (LAYER == 0) xs = (m0 < T_CTX ? p.x_prompt + (size_t)m0 * 1024 : p.x_sample + (size_t)(m0 - T_CTX) * 1024) + n0;
    else xs = p.out + (size_t)m0 * 1024 + n0;
    const float* gate = mods + (LAYER * 3 + mv_of(m0)) * 3072 + 2048 + n0;
    gemm_tile<false>(Aall + (size_t)m0 * 1024, 1024, nullptr, m0, W + (size_t)n0 * 1024, 1024, 1024,
                     EpRes{(u16*)(p.ws + (LAYER == 0 ? OFF_Y0B : OFF_Y1B)) + (size_t)m0 * 1024 + n0, xs, gate}, smem);
  }
}

DEV void p6b_dx(const Params& p) {
  const int lane = threadIdx.x & 63;
  const int gw = blockIdx.x * 4 + (threadIdx.x >> 6), nw = gridDim.x * 4;
  const u16* U = (const u16*)(p.ws + OFF_U1);
  u16* DX = (u16*)(p.ws + OFF_DX);
  for (int row = gw; row < 16384; row += nw) {
    const int l = row < T_CTX ? (row & 255) : ((row - T_CTX) & 4095);
    const int len = row < T_CTX ? 256 : 4096;
    const float pf = l > 0 ? 1.f : 0.f, nf = l + 1 < len ? 1.f : 0.f;
    const u16* uc = U + (size_t)row * 1024 + lane * 16;
    const u16* up = l > 0 ? uc - 1024 : uc;
    const u16* un = l + 1 < len ? uc + 1024 : uc;
#pragma unroll
    for (int hlf = 0; hlf < 2; hlf++) {
      uint4 c = *(const uint4*)(uc + 8 * hlf), a = *(const uint4*)(up + 8 * hlf), n = *(const uint4*)(un + 8 * hlf);
      const unsigned cu[4] = {c.x, c.y, c.z, c.w}, au[4] = {a.x, a.y, a.z, a.w}, nu[4] = {n.x, n.y, n.z, n.w};
      unsigned o[4];
#pragma unroll
      for (int q = 0; q < 4; q++)
        o[q] = pack2(0.5f * (bflo(au[q]) * pf + bflo(nu[q]) * nf) - bflo(cu[q]), 0.5f * (bfhi(au[q]) * pf + bfhi(nu[q]) * nf) - bfhi(cu[q]));
      *(uint4*)(DX + (size_t)row * 1024 + lane * 16 + 8 * hlf) = make_uint4(o[0], o[1], o[2], o[3]);
    }
  }
}

DEV void p7_rwkv_proj(const Params& p, char* smem) {
  const u16* U1 = (const u16*)(p.ws + OFF_U1);
  const int xcd = blockIdx.x & 7, jx = blockIdx.x >> 3, nbx = gridDim.x >> 3;
  for (int q = jx; q < 16 * 35; q += nbx) {
    int mt, nt;
    if (q < 512) { int st = q >> 6, w = q & 63; mt = xcd * 16 + (st >> 2) * 8 + (w >> 3); nt = (st & 3) * 8 + (w & 7); }
    else { int w = q - 512; mt = xcd * 16 + w / 3; nt = 32 + w % 3; }
    const int m0 = mt * 128;
    if (nt < 32) {
      int which = nt >> 3, n0 = (nt & 7) * 128;
      const u16* B = (const u16*)(p.ws + OFF_RKVZT) + (size_t)which * 1048576 + (size_t)n0 * 1024;
      if (which == 3) {
        gemm_tile<false>(U1 + (size_t)m0 * 1024, 1024, nullptr, m0, B, 1024, 1024,
                         EpStore<1>{(u16*)(p.ws + OFF_SZ) + (size_t)m0 * 1024 + n0, 1024, 1.f}, smem);
      } else {
        size_t off = which == 0 ? OFF_R : (which == 1 ? OFF_K2 : OFF_V2);
        const float* mu = p.mu + (which == 0 ? 0 : (which == 1 ? 2 : 3)) * 1024;
        gemm_tile<true>(U1, 1024, mu, m0, B, 1024, 1024, EpStore<0>{(u16*)(p.ws + off) + (size_t)m0 * 1024 + n0, 1024, 1.f}, smem);
      }
    } else {
      int w = nt - 32;
      if (w == 0)
        gemm_tile<true>(U1, 1024, p.mu + 1 * 1024, m0, (const u16*)(p.ws + OFF_W1T), 1024, 1024, EpStore<2>{(u16*)(p.ws + OFF_HW) + (size_t)m0 * 128, 128, 1.f}, smem);
      else if (w == 1)
        gemm_tile<true>(U1, 1024, p.mu + 4 * 1024, m0, (const u16*)(p.ws + OFF_A1T), 1024, 1024, EpStore<0>{(u16*)(p.ws + OFF_HA) + (size_t)m0 * 128, 128, 1.f}, smem);
      else
        gemm_tile<true>(U1, 1024, p.mu + 5 * 1024, m0, (const u16*)(p.ws + OFF_G1T), 1024, 1024, EpStore<3>{(u16*)(p.ws + OFF_HG) + (size_t)m0 * 128, 128, 1.f}, smem);
    }
  }
}

DEV b16x8 lds_perm(const u16* M, int ld, int row, int s, int hh) {
  const u16* q = M + row * ld + 16 * s + 4 * hh;
  uint2 lo = *(const uint2*)q, hi = *(const uint2*)(q + 8);
  u32x4 v = {lo.x, lo.y, hi.x, hi.y};
  return *(b16x8*)&v;
}
DEV b16x8 lds_norm(const u16* M, int ld, int row, int s, int hh) { return *(const b16x8*)(M + row * ld + 16 * s + 8 * hh); }
template <int OFF> DEV b16x8 pack8(const f32x16& a) {
  u32x4 v = {pack2(a[OFF], a[OFF + 1]), pack2(a[OFF + 2], a[OFF + 3]), pack2(a[OFF + 4], a[OFF + 5]), pack2(a[OFF + 6], a[OFF + 7])};
  return *(b16x8*)&v;
}
#define MFMA32(a, b, c) __builtin_amdgcn_mfma_f32_32x32x16_bf16(a, b, c, 0, 0, 0)

DEV int swz_idx(int row, int col) { return row * 40 + ((row >> 5) & 1) * 32 + ((((col >> 3) ^ (row >> 3)) & 3) << 3) + (col & 7); }
DEV b16x8 swz_norm(const u16* M, int row, int s, int hh) { return *(const b16x8*)(M + swz_idx(row, 16 * s + 8 * hh)); }
DEV b16x8 swz_perm(const u16* M, int row, int s, int hh) {
  uint2 lo = *(const uint2*)(M + swz_idx(row, 16 * s) + 4 * hh), hi = *(const uint2*)(M + swz_idx(row, 16 * s + 8) + 4 * hh);
  u32x4 v = {lo.x, lo.y, hi.x, hi.y};
  return *(b16x8*)&v;
}
struct ScanJob {
  int e, b, hd, tb, L, step0, nch, pq;
  int ncomb, seq;
  const float* zin;
  float* zout;
  u16* pout;
  float* qout;
};
DEV void scan_job(const Params& p, const ScanJob& J, char* smem) {
  float* sCum = (float*)smem;
  float* sAa = (float*)(smem + 8320);
  float* sNN = (float*)(smem + 8320);
  float* sT11 = (float*)(smem + 12544);
  float* sT22 = (float*)(smem + 13632);
  float* sWm = (float*)(smem + 14720);
  u16* AT = (u16*)(smem + 16640);
  u16* RT = (u16*)(smem + 21248);
  u16* BTl = (u16*)(smem + 25856);
  u16* KTl = (u16*)(smem + 30464);
  u16* BH = (u16*)(smem + 35072);
  u16* KH = (u16*)(smem + 40256);
  u16* VT = (u16*)(smem + 45440);
  u16* MkaT = (u16*)(smem + 50624);
  u16* MbrT = (u16*)(smem + 53184);
  u16* MkrT = (u16*)(smem + 55744);
  u16* TT = (u16*)(smem + 58304);
  float* gC = (float*)(smem + 60864);
  const int tid = threadIdx.x, wave = __builtin_amdgcn_readfirstlane(threadIdx.x >> 6);
  float* sKc = (float*)(smem + 61120);
  const int e = J.e, hd = J.hd, tb = J.tb, L = J.L, step0 = J.step0;
  const bool pq = J.pq != 0;
  const bool chainw = pq || wave < 2;
  const bool useV = pq ? (wave >= 2) : true;
  const int rb = wave & 1;
  const u16* HW = (const u16*)(p.ws + OFF_HW);
  const u16* HA = (const u16*)(p.ws + OFF_HA);
  const u16* Rb = (const u16*)(p.ws + OFF_R);
  const u16* Kb = (const u16*)(p.ws + OFF_K2);
  const u16* Vb = (const u16*)(p.ws + OFF_V2);
  float* Ysum = (float*)(p.ws + OFF_YSUM);
  float* Bsum = (float*)(p.ws + OFF_BSUM);
  const int arr = wave >> 1, ct = wave & 1;
  const u16* Xb = (arr ? HA : HW) + e * 64;
  b16x8 wf[4];
  {
    const int qi = tid & 31, hh = (tid >> 5) & 1;
    const u16* Wt = (const u16*)(p.ws + (arr ? OFF_A2T : OFF_W2T)) + (size_t)e * 65536 + (size_t)(hd * 64 + ct * 32 + qi) * 64 + hh * 8;
#pragma unroll
    for (int ks = 0; ks < 4; ks++) wf[ks] = ld16(Wt + ks * 16);
  }
  const float bias0 = (arr ? p.a0 : p.w0)[e * 1024 + hd * 64 + ct * 32 + (tid & 31)];
  if (tid < 64) { sKc[tid] = p.k_k[hd * 64 + tid]; sKc[64 + tid] = p.k_a[hd * 64 + tid]; sKc[128 + tid] = p.r_k[hd * 64 + tid]; }
  f32x16 z0, z1;
#pragma unroll
  for (int q = 0; q < 4; q++) {
    const int qi = tid & 31, hh = (tid >> 5) & 1;
    float4 v0 = make_float4(0, 0, 0, 0), v1 = v0;
    if (pq) {
      if (wave < 2) {
#pragma unroll
        for (int i = 0; i < 4; i++) {
          const int k = 8 * q + 4 * hh + i, col = rb * 32 + qi;
          ((float*)&v0)[i] = (k == col) ? 1.f : 0.f;
          ((float*)&v1)[i] = (k + 32 == col) ? 1.f : 0.f;
        }
      }
    } else if (J.zin && wave < 2) {
      const float* sp = J.zin + (size_t)(wave * 32 + qi) * 64 + 8 * q + 4 * hh;
      v0 = *(const float4*)sp; v1 = *(const float4*)(sp + 32);
    }
    z0[4 * q] = v0.x; z0[4 * q + 1] = v0.y; z0[4 * q + 2] = v0.z; z0[4 * q + 3] = v0.w;
    z1[4 * q] = v1.x; z1[4 * q + 1] = v1.y; z1[4 * q + 2] = v1.z; z1[4 * q + 3] = v1.w;
  }
  if (!pq && wave < 2) {
    const int qi = tid & 31, hh = (tid >> 5) & 1;
#pragma unroll 1
    for (int g = 0; g < J.ncomb; g++) {
      const u16* P = (const u16*)(p.ws + OFF_SEGP) + (size_t)(J.seq * 7 + g) * 4096;
      const float* Q = (const float*)(p.ws + OFF_SEGQ) + (size_t)(J.seq * 7 + g) * 4096;
      b16x8 zb[4] = {pack8<0>(z0), pack8<8>(z0), pack8<0>(z1), pack8<8>(z1)};
      f32x16 n0, n1;
#pragma unroll
      for (int q = 0; q < 4; q++) {
        const float* sp = Q + (size_t)(wave * 32 + qi) * 64 + 8 * q + 4 * hh;
        float4 v0 = *(const float4*)sp, v1 = *(const float4*)(sp + 32);
        n0[4 * q] = v0.x; n0[4 * q + 1] = v0.y; n0[4 * q + 2] = v0.z; n0[4 * q + 3] = v0.w;
        n1[4 * q] = v1.x; n1[4 * q + 1] = v1.y; n1[4 * q + 2] = v1.z; n1[4 * q + 3] = v1.w;
      }
#pragma unroll
      for (int s2 = 0; s2 < 4; s2++) {
        const u16* r0 = P + (size_t)qi * 64 + 16 * s2 + 4 * hh;
        const u16* r1 = P + (size_t)(32 + qi) * 64 + 16 * s2 + 4 * hh;
        uint2 a = *(const uint2*)r0, c = *(const uint2*)(r0 + 8), d = *(const uint2*)r1, f = *(const uint2*)(r1 + 8);
        u32x4 fa = {a.x, a.y, c.x, c.y}, fb = {d.x, d.y, f.x, f.y};
        n0 = MFMA32(*(b16x8*)&fa, zb[s2], n0);
        n1 = MFMA32(*(b16x8*)&fb, zb[s2], n1);
      }
      z0 = n0; z1 = n1;
    }
  }
  const int nch = J.nch;
  b16x8 xf[4];
  u32x4 kq, rq, vq;
  int tokC;
  {
    const int qi = tid & 31, hh = (tid >> 5) & 1, ci_ = tid >> 3, chg = hd * 64 + (tid & 7) * 8;
    const int tok0 = tb + (e ? L - step0 - 32 : step0);
    const int tokA = tok0 + (e ? 31 - qi : qi);
#pragma unroll
    for (int ks = 0; ks < 4; ks++) xf[ks] = ld16(Xb + (size_t)tokA * 128 + hh * 8 + ks * 16);
    tokC = tok0 + (e ? 31 - ci_ : ci_);
    kq = *(const u32x4*)(Kb + (size_t)tokC * 1024 + chg);
    rq = *(const u32x4*)(Rb + (size_t)tokC * 1024 + chg);
    vq = *(const u32x4*)(Vb + (size_t)tokC * 1024 + chg);
  }
#pragma unroll 1
  for (int ci = 0; ci < nch; ci++) {
    const int tok0 = tb + (e ? L - step0 - 32 * (ci + 1) : step0 + 32 * ci);
    const int tokn0 = tb + (e ? L - step0 - 32 * (ci + 2) : step0 + 32 * (ci + 1));
    const bool more = ci + 1 < nch;
    int tl = tid;
    asm volatile("" : "+v"(tl));
    const int lane = tl & 63, qi = lane & 31, hh = lane >> 5, ci_ = tl >> 3, cb = (tl & 7) * 8, chg = hd * 64 + cb;
    {
      f32x16 acc;
#pragma unroll
      for (int r = 0; r < 16; r++) acc[r] = 0.f;
#pragma unroll
      for (int ks = 0; ks < 4; ks++) acc = MFMA32(xf[ks], wf[ks], acc);
      if (more) {
        const int tokA = tokn0 + (e ? 31 - qi : qi);
#pragma unroll
        for (int ks = 0; ks < 4; ks++) xf[ks] = ld16(Xb + (size_t)tokA * 128 + hh * 8 + ks * 16);
      }
      const int ch = ct * 32 + qi;
      if (arr == 0) {
        float lw[16], gs[4], og[4];
#pragma unroll
        for (int r = 0; r < 16; r++) lw[r] = -0.606531f * sigm(acc[r] + bias0);
#pragma unroll
        for (int q = 0; q < 4; q++) { gs[q] = (lw[4 * q] + lw[4 * q + 1]) + (lw[4 * q + 2] + lw[4 * q + 3]); og[q] = __shfl_xor(gs[q], 32); }
        float pre = 0.f;
#pragma unroll
        for (int q = 0; q < 4; q++) {
          float run = pre + (hh ? og[q] : 0.f);
#pragma unroll
          for (int i = 0; i < 4; i++) { run += lw[4 * q + i]; sCum[(8 * q + 4 * hh + i) * 65 + ch] = run; }
          pre += gs[q] + og[q];
        }
      } else {
#pragma unroll
        for (int r = 0; r < 16; r++) {
          int row = (r & 3) + 8 * (r >> 2) + 4 * hh;
          sAa[row * 65 + ch] = sigm(acc[r] + bias0);
        }
      }
    }
    lds_barrier();
    {
      const int i = ci_;
      const unsigned ku[4] = {kq.x, kq.y, kq.z, kq.w}, ru[4] = {rq.x, rq.y, rq.z, rq.w}, vu[4] = {vq.x, vq.y, vq.z, vq.w};
      float k[8], r[8], kkr[8];
#pragma unroll
      for (int q = 0; q < 4; q++) {
        k[2 * q] = bflo(ku[q]); k[2 * q + 1] = bfhi(ku[q]);
        r[2 * q] = bflo(ru[q]); r[2 * q + 1] = bfhi(ru[q]);
      }
      float kkc[8], kac[8], rkc[8];
#pragma unroll
      for (int j = 0; j < 8; j++) { kkc[j] = sKc[cb + j]; kac[j] = sKc[64 + cb + j]; rkc[j] = sKc[128 + cb + j]; }
      float ss = 0;
#pragma unroll
      for (int j = 0; j < 8; j++) { kkr[j] = k[j] * kkc[j]; ss += kkr[j] * kkr[j]; }
      ss = allsum8(ss);
      const float inv = rsqrtf(ss + 1e-12f);
      float bon = 0;
      float oa[8], orr[8], ob[8], ok[8];
#pragma unroll
      for (int j = 0; j < 8; j++) {
        const float a = sAa[i * 65 + cb + j];
        const float cm = sCum[i * 65 + cb + j];
        const float cp = i > 0 ? sCum[(i - 1) * 65 + cb + j] : 0.f;
        const float cl = sCum[31 * 65 + cb + j];
        const float kd = k[j] * (1.f + (a - 1.f) * kac[j]);
        const float kk = kkr[j] * inv;
        const float bb = kk * a;
        bon += r[j] * kd * rkc[j];
        const float em = __expf(-cm), eC = __expf(cl - cm);
        oa[j] = -kk * __expf(cp);
        orr[j] = pq ? 0.f : r[j] * __expf(cm);
        ob[j] = bb * em;
        ok[j] = kd * em;
        BH[swz_idx(cb + j, i)] = f2bf(bb * eC);
        KH[swz_idx(cb + j, i)] = f2bf(kd * eC);
        if (i == 31) gC[cb + j] = __expf(cl);
      }
#pragma unroll
      for (int q = 0; q < 4; q++) {
        VT[swz_idx(cb + 2 * q, i)] = (u16)(vu[q] & 0xffffu);
        VT[swz_idx(cb + 2 * q + 1, i)] = (u16)(vu[q] >> 16);
      }
      *(u32x4*)(AT + i * 72 + cb) = u32x4{pack2(oa[0], oa[1]), pack2(oa[2], oa[3]), pack2(oa[4], oa[5]), pack2(oa[6], oa[7])};
      if (!pq) *(u32x4*)(RT + i * 72 + cb) = u32x4{pack2(orr[0], orr[1]), pack2(orr[2], orr[3]), pack2(orr[4], orr[5]), pack2(orr[6], orr[7])};
      *(u32x4*)(BTl + i * 72 + cb) = u32x4{pack2(ob[0], ob[1]), pack2(ob[2], ob[3]), pack2(ob[4], ob[5]), pack2(ob[6], ob[7])};
      *(u32x4*)(KTl + i * 72 + cb) = u32x4{pack2(ok[0], ok[1]), pack2(ok[2], ok[3]), pack2(ok[4], ok[5]), pack2(ok[6], ok[7])};
      bon = allsum8(bon);
      if (!pq && (tl & 7) == 0) atomicAdd(Bsum + (size_t)tokC * 16 + hd, 0.5f * bon);
      if (more) {
        tokC = tokn0 + (e ? 31 - ci_ : ci_);
        kq = *(const u32x4*)(Kb + (size_t)tokC * 1024 + chg);
        rq = *(const u32x4*)(Rb + (size_t)tokC * 1024 + chg);
        vq = *(const u32x4*)(Vb + (size_t)tokC * 1024 + chg);
      }
    }
    lds_barrier();
    if (!(pq && wave >= 2)) {
      const u16* Am = (wave < 2) ? AT : RT;
      const u16* Bm = (wave & 1) ? KTl : BTl;
      f32x16 acc;
#pragma unroll
      for (int r = 0; r < 16; r++) acc[r] = 0.f;
#pragma unroll
      for (int s = 0; s < 4; s++) acc = MFMA32(lds_norm(Am, 72, qi, s, hh), lds_norm(Bm, 72, qi, s, hh), acc);
      u16* dst = wave == 1 ? MkaT : (wave == 2 ? MbrT : MkrT);
#pragma unroll
      for (int r = 0; r < 16; r++) {
        const int tt = (r & 3) + 8 * (r >> 2) + 4 * hh, j = qi;
        const bool keep = (wave < 2) ? (j < tt) : (j <= tt);
        const float val = keep ? acc[r] : 0.f;
        if (wave == 0) sNN[j * 33 + tt] = val;
        else dst[tt * 40 + j] = f2bf(val);
      }
    }
    if (tl < 32) {
      const int i = tl & 15, base = (tl >> 4) * 16;
      float Tr[16];
#pragma unroll
      for (int q = 0; q < 16; q++) Tr[q] = (q == i) ? 1.f : 0.f;
#pragma unroll
      for (int q = 1; q < 16; q++) {
        float s0 = 0.f, s1 = 0.f, s2 = 0.f, s3 = 0.f;
#pragma unroll
        for (int j = 0; j < q; j++) {
          const float pr = Tr[j] * sNN[(base + j) * 33 + base + q];
          if ((j & 3) == 0) s0 += pr; else if ((j & 3) == 1) s1 += pr; else if ((j & 3) == 2) s2 += pr; else s3 += pr;
        }
        if (q > i) Tr[q] = (s0 + s1) + (s2 + s3);
      }
      float* sT = (tl >> 4) ? sT22 : sT11;
#pragma unroll
      for (int q = 0; q < 16; q++) { sT[i * 17 + q] = Tr[q]; TT[(base + q) * 40 + base + i] = f2bf(Tr[q]); }
    }
    lds_barrier();
    {
      const int i = tl >> 4, q = tl & 15;
      float s = 0.f;
#pragma unroll
      for (int j = 0; j < 16; j++) s += sT11[i * 17 + j] * sNN[j * 33 + 16 + q];
      sWm[i * 17 + q] = s;
      TT[i * 40 + 16 + q] = 0;
    }
    lds_barrier();
    {
      const int i = tl >> 4, q = tl & 15;
      float s = 0.f;
#pragma unroll
      for (int j = 0; j < 16; j++) s += sWm[i * 17 + j] * sT22[j * 17 + q];
      TT[(16 + q) * 40 + i] = f2bf(s);
    }
    lds_barrier();
    if (chainw) {
      const int vrow = rb * 32 + qi;
      b16x8 zb0 = pack8<0>(z0), zb1 = pack8<8>(z0), zb2 = pack8<0>(z1), zb3 = pack8<8>(z1);
      b16x8 vt0 = swz_norm(VT, vrow, 0, hh), vt1 = swz_norm(VT, vrow, 1, hh);
      f32x16 x;
#pragma unroll
      for (int r = 0; r < 16; r++) x[r] = 0.f;
      x = MFMA32(lds_perm(AT, 72, qi, 0, hh), zb0, x);
      x = MFMA32(lds_perm(AT, 72, qi, 1, hh), zb1, x);
      x = MFMA32(lds_perm(AT, 72, qi, 2, hh), zb2, x);
      x = MFMA32(lds_perm(AT, 72, qi, 3, hh), zb3, x);
      if (useV) {
        x = MFMA32(lds_norm(MkaT, 40, qi, 0, hh), vt0, x);
        x = MFMA32(lds_norm(MkaT, 40, qi, 1, hh), vt1, x);
      }
      f32x16 y;
#pragma unroll
      for (int r = 0; r < 16; r++) y[r] = 0.f;
      if (!pq) {
        y = MFMA32(lds_perm(RT, 72, qi, 0, hh), zb0, y);
        y = MFMA32(lds_perm(RT, 72, qi, 1, hh), zb1, y);
        y = MFMA32(lds_perm(RT, 72, qi, 2, hh), zb2, y);
        y = MFMA32(lds_perm(RT, 72, qi, 3, hh), zb3, y);
        y = MFMA32(lds_norm(MkrT, 40, qi, 0, hh), vt0, y);
        y = MFMA32(lds_norm(MkrT, 40, qi, 1, hh), vt1, y);
      }
#pragma unroll
      for (int q = 0; q < 4; q++) {
        float4 g0 = *(const float4*)(gC + 8 * q + 4 * hh), g1 = *(const float4*)(gC + 32 + 8 * q + 4 * hh);
        z0[4 * q] *= g0.x; z0[4 * q + 1] *= g0.y; z0[4 * q + 2] *= g0.z; z0[4 * q + 3] *= g0.w;
        z1[4 * q] *= g1.x; z1[4 * q + 1] *= g1.y; z1[4 * q + 2] *= g1.z; z1[4 * q + 3] *= g1.w;
      }
      if (useV) {
        z0 = MFMA32(swz_norm(KH, qi, 0, hh), vt0, z0);
        z0 = MFMA32(swz_norm(KH, qi, 1, hh), vt1, z0);
        z1 = MFMA32(swz_norm(KH, 32 + qi, 0, hh), vt0, z1);
        z1 = MFMA32(swz_norm(KH, 32 + qi, 1, hh), vt1, z1);
      }
      b16x8 xb0 = pack8<0>(x), xb1 = pack8<8>(x);
      f32x16 u;
#pragma unroll
      for (int r = 0; r < 16; r++) u[r] = 0.f;
      u = MFMA32(lds_perm(TT, 40, qi, 0, hh), xb0, u);
      u = MFMA32(lds_perm(TT, 40, qi, 1, hh), xb1, u);
      b16x8 ub0 = pack8<0>(u), ub1 = pack8<8>(u);
      z0 = MFMA32(swz_perm(BH, qi, 0, hh), ub0, z0);
      z0 = MFMA32(swz_perm(BH, qi, 1, hh), ub1, z0);
      z1 = MFMA32(swz_perm(BH, 32 + qi, 0, hh), ub0, z1);
      z1 = MFMA32(swz_perm(BH, 32 + qi, 1, hh), ub1, z1);
      if (!pq) {
        y = MFMA32(lds_perm(MbrT, 40, qi, 0, hh), ub0, y);
        y = MFMA32(lds_perm(MbrT, 40, qi, 1, hh), ub1, y);
#pragma unroll
        for (int r = 0; r < 16; r++) {
          const int st = (r & 3) + 8 * (r >> 2) + 4 * hh;
          const int tok = tok0 + (e ? 31 - st : st);
          atomicAdd(Ysum + (size_t)tok * 1024 + hd * 64 + vrow, y[r]);
        }
      }
    }
  }
  {
    const int qi = tid & 31, hh = (tid >> 5) & 1;
    if (pq) {
      if (wave < 2) {
#pragma unroll
        for (int r = 0; r < 16; r++) {
          const int k = (r & 3) + 8 * (r >> 2) + 4 * hh;
          J.pout[k * 64 + rb * 32 + qi] = f2bf(z0[r]);
          J.pout[(k + 32) * 64 + rb * 32 + qi] = f2bf(z1[r]);
        }
      } else {
#pragma unroll
        for (int q = 0; q < 4; q++) {
          float* sp = J.qout + (size_t)(rb * 32 + qi) * 64 + 8 * q + 4 * hh;
          *(float4*)sp = make_float4(z0[4 * q], z0[4 * q + 1], z0[4 * q + 2], z0[4 * q + 3]);
          *(float4*)(sp + 32) = make_float4(z1[4 * q], z1[4 * q + 1], z1[4 * q + 2], z1[4 * q + 3]);
        }
      }
    } else if (J.zout && wave < 2) {
#pragma unroll
      for (int q = 0; q < 4; q++) {
        float* sp = J.zout + (size_t)(wave * 32 + qi) * 64 + 8 * q + 4 * hh;
        *(float4*)sp = make_float4(z0[4 * q], z0[4 * q + 1], z0[4 * q + 2], z0[4 * q + 3]);
        *(float4*)(sp + 32) = make_float4(z1[4 * q], z1[4 * q + 1], z1[4 * q + 2], z1[4 * q + 3]);
      }
    }
  }
  __syncthreads();
}

DEV void scan_combine(const Params& p, int seq) {
  const int tid = threadIdx.x, wave = tid >> 6, qi = tid & 31, hh = (tid >> 5) & 1;
  if (wave >= 2) return;
  const int e = seq >> 5, b = (seq >> 4) & 1, hd = seq & 15;
  const float* zin = p.state_rwkv + ((size_t)(b * 2 + e) * 16 + hd) * 4096;
  f32x16 z0, z1;
#pragma unroll
  for (int q = 0; q < 4; q++) {
    const float* sp = zin + (size_t)(wave * 32 + qi) * 64 + 8 * q + 4 * hh;
    float4 v0 = *(const float4*)sp, v1 = *(const float4*)(sp + 32);
    z0[4 * q] = v0.x; z0[4 * q + 1] = v0.y; z0[4 * q + 2] = v0.z; z0[4 * q + 3] = v0.w;
    z1[4 * q] = v1.x; z1[4 * q + 1] = v1.y; z1[4 * q + 2] = v1.z; z1[4 * q + 3] = v1.w;
  }
#pragma unroll 1
  for (int g = 0; g < 7; g++) {
    const u16* P = (const u16*)(p.ws + OFF_SEGP) + (size_t)(seq * 7 + g) * 4096;
    const float* Q = (const float*)(p.ws + OFF_SEGQ) + (size_t)(seq * 7 + g) * 4096;
    b16x8 zb[4] = {pack8<0>(z0), pack8<8>(z0), pack8<0>(z1), pack8<8>(z1)};
    f32x16 n0, n1;
#pragma unroll
    for (int q = 0; q < 4; q++) {
      const float* sp = Q + (size_t)(wave * 32 + qi) * 64 + 8 * q + 4 * hh;
      float4 v0 = *(const float4*)sp, v1 = *(const float4*)(sp + 32);
      n0[4 * q] = v0.x; n0[4 * q + 1] = v0.y; n0[4 * q + 2] = v0.z; n0[4 * q + 3] = v0.w;
      n1[4 * q] = v1.x; n1[4 * q + 1] = v1.y; n1[4 * q + 2] = v1.z; n1[4 * q + 3] = v1.w;
    }
#pragma unroll
    for (int s = 0; s < 4; s++) {
      const u16* r0 = P + (size_t)qi * 64 + 16 * s + 4 * hh;
      const u16* r1 = P + (size_t)(32 + qi) * 64 + 16 * s + 4 * hh;
      uint2 a = *(const uint2*)r0, c = *(const uint2*)(r0 + 8), d = *(const uint2*)r1, f = *(const uint2*)(r1 + 8);
      u32x4 fa = {a.x, a.y, c.x, c.y}, fb = {d.x, d.y, f.x, f.y};
      n0 = MFMA32(*(b16x8*)&fa, zb[s], n0);
      n1 = MFMA32(*(b16x8*)&fb, zb[s], n1);
    }
    z0 = n0; z1 = n1;
    float* zs = (float*)(p.ws + OFF_SEGZ) + (size_t)(seq * 7 + g) * 4096;
#pragma unroll
    for (int q = 0; q < 4; q++) {
      float* sp = zs + (size_t)(wave * 32 + qi) * 64 + 8 * q + 4 * hh;
      *(float4*)sp = make_float4(z0[4 * q], z0[4 * q + 1], z0[4 * q + 2], z0[4 * q + 3]);
      *(float4*)(sp + 32) = make_float4(z1[4 * q], z1[4 * q + 1], z1[4 * q + 2], z1[4 * q + 3]);
    }
  }
}

DEV ScanJob ctx_job(const Params& p, int v) {
  ScanJob J;
  J.e = v >> 9; J.b = (v >> 4) & 31; J.hd = v & 15; J.tb = J.b * 256; J.L = 256; J.step0 = 0; J.nch = 8; J.pq = 0;
  J.zin = nullptr; J.zout = p.out + OUT_ST + ((size_t)(J.b * 2 + J.e) * 16 + J.hd) * 4096; J.pout = nullptr; J.qout = nullptr;
  J.ncomb = 0; J.seq = 0;
  return J;
}
DEV ScanJob smp_job(const Params& p, int seq, int g, int pq) {
  ScanJob J;
  J.e = seq >> 5; J.b = (seq >> 4) & 1; J.hd = seq & 15; J.tb = T_CTX + J.b * 4096; J.L = 4096; J.step0 = g * 512; J.nch = 16; J.pq = pq;
  J.zin = p.state_rwkv + ((size_t)(J.b * 2 + J.e) * 16 + J.hd) * 4096;
  J.ncomb = pq ? 0 : g; J.seq = seq;
  J.zout = nullptr;
  J.pout = (u16*)(p.ws + OFF_SEGP) + (size_t)(seq * 7 + g) * 4096;
  J.qout = (float*)(p.ws + OFF_SEGQ) + (size_t)(seq * 7 + g) * 4096;
  return J;
}

DEV void p8a_scan(const Params& p, char* smem) {
  if (blockIdx.x < 448) {
    for (int j = blockIdx.x; j < 448; j += 448) scan_job(p, smp_job(p, j / 7, j % 7, 1), smem);
  } else {
    {
      float4* ys = (float4*)(p.ws + OFF_YSUM);
      float4* bs = (float4*)(p.ws + OFF_BSUM);
      const size_t gt = (size_t)(blockIdx.x - 448) * 256 + threadIdx.x, gs = (size_t)(gridDim.x - 448) * 256;
      for (size_t i = gt; i < 4194304; i += gs) ys[i] = make_float4(0, 0, 0, 0);
      for (size_t i = gt; i < 65536; i += gs) bs[i] = make_float4(0, 0, 0, 0);
    }
    for (int q = blockIdx.x - 448; q < 1024; q += gridDim.x - 448) {
      int mt = q >> 3, nt = q & 7, m0 = mt * 128, n0 = nt * 128;
      u16* sz = (u16*)(p.ws + OFF_SZ) + (size_t)m0 * 1024 + n0;
      gemm_tile<false>((const u16*)(p.ws + OFF_HG) + (size_t)m0 * 128, 128, nullptr, m0, (const u16*)(p.ws + OFF_G2T) + (size_t)n0 * 128, 128, 128,
                       EpGate{sz, sz, 1024}, smem);
    }
  }
}
DEV void p8b_scan(const Params& p, char* smem) {
  if (blockIdx.x < 64) scan_combine(p, blockIdx.x);
}
DEV void p8c_scan(const Params& p, char* smem) {
  for (int j = blockIdx.x; j < 512 + 1024; j += gridDim.x) {
    if (j < 512) scan_job(p, smp_job(p, j >> 3, j & 7, 0), smem);
    else scan_job(p, ctx_job(p, j - 512), smem);
  }
}

DEV void p9_post(const Params& p) {
  const int lane = threadIdx.x & 63;
  const int gw = blockIdx.x * 4 + (threadIdx.x >> 6), nw = gridDim.x * 4;
  const float* Ysum = (const float*)(p.ws + OFF_YSUM);
  const float* Bsum = (const float*)(p.ws + OFF_BSUM);
  for (int row = gw; row < 16384; row += nw) {
    const size_t o = (size_t)row * 1024 + lane * 16;
    float y[16];
#pragma unroll
    for (int i = 0; i < 4; i++) { float4 v = *(const float4*)(Ysum + o + 4 * i); y[4 * i] = v.x; y[4 * i + 1] = v.y; y[4 * i + 2] = v.z; y[4 * i + 3] = v.w; }
    float s = 0;
#pragma unroll
    for (int i = 0; i < 16; i++) s += y[i];
    s += __shfl_xor(s, 1); s += __shfl_xor(s, 2);
    float mean = s * (1.f / 64.f), q = 0;
#pragma unroll
    for (int i = 0; i < 16; i++) { float d = y[i] - mean; q += d * d; }
    q += __shfl_xor(q, 1); q += __shfl_xor(q, 2);
    float rstd = rsqrtf(q * (1.f / 64.f) + 64e-5f);
    float bon = Bsum[(size_t)row * 16 + (lane >> 2)];
    u16* O = (u16*)(p.ws + OFF_U1) + o;
    const u16* V = (const u16*)(p.ws + OFF_V2) + o;
    const u16* Z = (const u16*)(p.ws + OFF_SZ) + o;
#pragma unroll
    for (int hlf = 0; hlf < 2; hlf++) {
      uint4 vq = *(const uint4*)(V + 8 * hlf), zq = *(const uint4*)(Z + 8 * hlf);
      const unsigned vu[4] = {vq.x, vq.y, vq.z, vq.w}, zu[4] = {zq.x, zq.y, zq.z, zq.w};
      unsigned ow[4];
#pragma unroll
      for (int w = 0; w < 4; w++) {
        int c = lane * 16 + hlf * 8 + 2 * w;
        float y0 = (y[hlf * 8 + 2 * w] - mean) * rstd * p.lnx_g[c] + p.lnx_b[c] + bon * bflo(vu[w]);
        float y1 = (y[hlf * 8 + 2 * w + 1] - mean) * rstd * p.lnx_g[c + 1] + p.lnx_b[c + 1] + bon * bfhi(vu[w]);
        ow[w] = pack2(y0 * bflo(zu[w]), y1 * bfhi(zu[w]));
      }
      *(uint4*)(O + 8 * hlf) = make_uint4(ow[0], ow[1], ow[2], ow[3]);
    }
  }
}


#define XB_TMO 128
#define XB_XCNT(j) (256 + 64 * (j))
#define XB_XSUB(j) (1280 + 64 * (j))
#define XB_XGEN(j) (2304 + 64 * (j))
#define XB_TOP 3328
#define XB_TOPGEN 3392
#define XCD_BAR_WORDS 3456
#define XB_SPIN_CAP (1u << 22)
#define LAS __attribute__((address_space(3)))
DEV unsigned xb_ld(unsigned* p) { return __hip_atomic_load(p, __ATOMIC_RELAXED, __HIP_MEMORY_SCOPE_AGENT); }
DEV unsigned xb_add(unsigned* p, unsigned v) { return __hip_atomic_fetch_add(p, v, __ATOMIC_RELAXED, __HIP_MEMORY_SCOPE_AGENT); }
DEV unsigned xb_xcc_id() { return (unsigned)__builtin_amdgcn_s_getreg((3 << 11) | 20) & 0xFu; }
#define XB_SPIN(cond, bar) do { unsigned _sp = 0; while (cond) { __builtin_amdgcn_s_sleep(4); \
    if ((++_sp & 255u) == 0u) { if (xb_ld(&(bar)[XB_TMO])) break; if (_sp > XB_SPIN_CAP) { atomicAdd(&(bar)[XB_TMO], 1u); break; } } } } while (0)
struct XcdBarrier { unsigned* bar; unsigned x; volatile LAS unsigned* st; };
DEV XcdBarrier xcd_barrier_post(unsigned* bar, volatile LAS unsigned* st) {
  XcdBarrier b; b.bar = bar; b.x = xb_xcc_id(); b.st = st;
  if (threadIdx.x == 0) (void)xb_add(&bar[XB_XCNT(b.x)], 1u);
  return b;
}
DEV void xcd_barrier_complete(unsigned* bar, unsigned x, unsigned& nloc, unsigned& nx) {
  const unsigned G = gridDim.x * gridDim.y * gridDim.z;
  unsigned sum, cnt, mine, sp = 0u;
  for (;;) {
    sum = 0u; cnt = 0u; mine = 0u;
#pragma unroll
    for (unsigned j = 0; j < 16; ++j) { const unsigned c = xb_ld(&bar[XB_XCNT(j)]); sum += c; cnt += (c > 0u) ? 1u : 0u; mine = (j == x) ? c : mine; }
    if (sum == G) break;
    __builtin_amdgcn_s_sleep(1);
    if ((++sp & 255u) == 0u) { if (xb_ld(&bar[XB_TMO])) break; if (sp > XB_SPIN_CAP) { atomicAdd(&bar[XB_TMO], 1u); break; } }
  }
  nloc = mine > 0u ? mine : 1u; nx = cnt > 0u ? cnt : 1u;
}
DEV void xcd_barrier(const XcdBarrier& b) {
  asm volatile("s_waitcnt vmcnt(0)" ::: "memory");
  __syncthreads();
  if (threadIdx.x == 0) {
    unsigned* bar = b.bar;
    __builtin_amdgcn_s_waitcnt(0);
    unsigned nloc = b.st[0], nx = b.st[1];
    if (nloc == 0u) { xcd_barrier_complete(bar, b.x, nloc, nx); b.st[0] = nloc; b.st[1] = nx; }
    const unsigned old = xb_add(&bar[XB_XSUB(b.x)], 1u);
    const unsigned gen = old / nloc;
    if (old + 1u == (gen + 1u) * nloc) {
      __builtin_amdgcn_fence(__ATOMIC_RELEASE, "agent");
      asm volatile("s_waitcnt vmcnt(0)" ::: "memory");
      const unsigned og = xb_add(&bar[XB_TOP], 1u);
      const unsigned tg = og / nx;
      if (og + 1u == (tg + 1u) * nx) xb_add(&bar[XB_TOPGEN], 1u);
      else XB_SPIN(xb_ld(&bar[XB_TOPGEN]) == tg, bar);
      __builtin_amdgcn_fence(__ATOMIC_ACQUIRE, "agent");
      xb_add(&bar[XB_XGEN(b.x)], 1u);
      asm volatile("s_waitcnt vmcnt(0)" ::: "memory");
    } else {
      XB_SPIN(xb_ld(&bar[XB_XGEN(b.x)]) == gen, bar);
      __builtin_amdgcn_fence(__ATOMIC_ACQUIRE, "agent");
      asm volatile("s_waitcnt vmcnt(0)" ::: "memory");
    }
  }
  __syncthreads();
}

__global__ void __launch_bounds__(256, 2) fwd_kernel(Params p) {
  __shared__ __attribute__((aligned(16))) char smem[73728];
#if FUSED
  __shared__ unsigned xb_st[4];
  if (threadIdx.x < 4) xb_st[threadIdx.x] = 0u;
  __syncthreads();
  const XcdBarrier xb = xcd_barrier_post((unsigned*)(p.ws + OFF_BAR), (volatile LAS unsigned*)xb_st);
  if (p.phase_hi > 1000) cg::this_grid().sync();
#define SYNC() xcd_barrier(xb)
#else
#define SYNC()
#endif
#define PH(n, call) if (p.phase_lo <= n && n <= p.phase_hi) { call; if (n < p.phase_hi) { SYNC(); } }
  PH(0, p0_prep(p, smem))
  PH(1, ln_phase<0>(p))
  PH(2, p2_gemm1(p, smem))
  PH(3, p3_mix(p, smem))
  PH(4, p3b_fold(p))
  PH(5, p4_fnet(p, smem))
  PH(6, p_outproj<0>(p, smem))
  PH(7, ln_phase<1>(p))
  PH(8, p6b_dx(p))
  PH(9, p7_rwkv_proj(p, smem))
  PH(10, p8a_scan(p, smem))
  PH(11, p8c_scan(p, smem))
  PH(12, p9_post(p))
  PH(13, p_outproj<1>(p, smem))
  PH(14, ln_phase<2>(p))
}

extern "C" void kernel_launch(void* const* d_in, const int* in_sizes, int n_in, void* d_out, int out_size, void* d_ws,
                              size_t ws_size, hipStream_t stream) {
  Params p;
  memset(&p, 0, sizeof(p));
  const float* const* in = (const float* const*)d_in;
  p.x_prompt = in[0]; p.x_sample = in[1]; p.cache_k = in[2]; p.cache_v = in[3]; p.state_rwkv = in[4]; p.c = in[5]; p.c_ctx = in[6];
  p.ada_w = in[7]; p.ada_b = in[8]; p.post_g = in[9]; p.post_b = in[10]; p.w_in = in[11]; p.w_fnet = in[12]; p.rpb = in[13]; p.w_out = in[14];
  p.mu = in[15]; p.rkvz = in[16]; p.w0 = in[17]; p.w1 = in[18]; p.w2 = in[19]; p.a0 = in[20]; p.a1 = in[21]; p.a2 = in[22];
  p.g1 = in[23]; p.g2 = in[24]; p.k_k = in[25]; p.k_a = in[26]; p.r_k = in[27]; p.lnx_g = in[28]; p.lnx_b = in[29]; p.rw_out = in[30];
  p.out = (float*)d_out; p.ws = (char*)d_ws;
  char* ws = (char*)d_ws;
  int n = 0, start = 0;
  auto add = [&](const float* src, size_t dstoff, int lds, int ldd, int tk, int tn) {
    p.tj[n].src = src; p.tj[n].dst = (u16*)(ws + dstoff); p.tj[n].lds = lds; p.tj[n].ldd = ldd; p.tj[n].tk = tk; p.tj[n].tn = tn;
    p.tj[n].start = start; p.tj[n].pad = 0; start += tk * tn; n++;
  };
  add(p.w_in, OFF_WINT, 3072, 1024, 16, 48);
  add(p.w_out, OFF_WOUTT, 1024, 1024, 16, 16);
  for (int i = 0; i < 4; i++) add(p.rkvz + (size_t)i * 1048576, OFF_RKVZT + (size_t)i * 2097152, 1024, 1024, 16, 16);
  add(p.rw_out, OFF_RWOUTT, 1024, 1024, 16, 16);
  for (int e = 0; e < 2; e++) add(p.w1 + e * 65536, OFF_W1T + (size_t)e * 64 * 1024 * 2, 64, 1024, 16, 1);
  for (int e = 0; e < 2; e++) add(p.a1 + e * 65536, OFF_A1T + (size_t)e * 64 * 1024 * 2, 64, 1024, 16, 1);
  add(p.g1, OFF_G1T, 128, 1024, 16, 2);
  for (int e = 0; e < 2; e++) add(p.w2 + e * 65536, OFF_W2T + (size_t)e * 65536 * 2, 1024, 64, 1, 16);
  for (int e = 0; e < 2; e++) add(p.a2 + e * 65536, OFF_A2T + (size_t)e * 65536 * 2, 1024, 64, 1, 16);
  add(p.g2, OFF_G2T, 1024, 128, 2, 16);
  for (int b = 0; b < 2; b++)
    for (int h = 0; h < 8; h++) add(p.cache_v + (size_t)b * 262144 + h * 64, OFF_CVT + (size_t)(b * 8 + h) * 64 * 512 * 2, 512, 512, 8, 1);
  p.ntr = start;

  static int grid_blocks = 0;
  if (!grid_blocks) {
    int dev = 0, cus = 0, per_cu = 0;
    (void)hipGetDevice(&dev);
    (void)hipDeviceGetAttribute(&cus, hipDeviceAttributeMultiprocessorCount, dev);
    (void)hipOccupancyMaxActiveBlocksPerMultiprocessor(&per_cu, fwd_kernel, 256, 0);
    if (per_cu > 2) per_cu = 2;
    if (per_cu < 1) per_cu = 1;
    grid_blocks = cus * per_cu;
  }
#if FUSED
  p.phase_lo = 0; p.phase_hi = 14;
  void* args[] = {&p};
  (void)hipMemsetAsync((char*)d_ws + OFF_BAR, 0, 16384, stream);
  hipError_t e = hipLaunchCooperativeKernel((void*)fwd_kernel, dim3(grid_blocks), dim3(256), args, 0, stream);
  if (e != hipSuccess) fprintf(stderr, "cooperative launch failed: %s (grid %d)\n", hipGetErrorString(e), grid_blocks);
#else
#ifndef PROBE_SEQ
#define PROBE_SEQ 0,1,2,3,4,5,6,7,8,9,10,11,12,13,14
#endif
  const int seq[] = {PROBE_SEQ};
  for (int i = 0; i < (int)(sizeof(seq) / sizeof(int)); i++) {
    p.phase_lo = seq[i]; p.phase_hi = seq[i];
    fwd_kernel<<<grid_blocks, 256, 0, stream>>>(p);
  }
#endif
}
```

```cpp
#include <hip/hip_runtime.h>
#include <hip/hip_cooperative_groups.h>
#include <stdint.h>
#include <cstdio>
#include <cstring>
namespace cg = cooperative_groups;

#ifndef FUSED
#define FUSED 1
#endif

typedef unsigned short u16;
typedef __attribute__((ext_vector_type(8))) __bf16 b16x8;
typedef __attribute__((ext_vector_type(16))) float f32x16;
typedef __attribute__((ext_vector_type(4))) unsigned u32x4;
typedef __attribute__((ext_vector_type(2))) unsigned u32x2;
#define DEV __device__ __forceinline__

constexpr int T_CTX = 8192;
constexpr float ALPHA_DN = 1.41421356237f;
constexpr float LOG2E = 1.44269504089f;
constexpr size_t MiB = 1u << 20;
constexpr size_t OFF_MODS = 0, OFF_BAR = 512 * 1024, OFF_BSUM = 1 * MiB;
constexpr size_t OFF_FSMP = 2 * MiB, OFF_U = 66 * MiB, OFF_ABUF = 98 * MiB, OFF_Q = 114 * MiB, OFF_K = 130 * MiB;
constexpr size_t OFF_VTC = 146 * MiB, OFF_VTS = 154 * MiB, OFF_GBUF = 162 * MiB, OFF_BTC = 194 * MiB, OFF_BTS = 210 * MiB;
constexpr size_t OFF_WINT = 226 * MiB, OFF_WOUTT = 232 * MiB, OFF_MCAT = 234 * MiB, OFF_FCTX = 234 * MiB + 256 * 1024;
constexpr size_t OFF_CK = 234 * MiB + 512 * 1024, OFF_CVT = 235 * MiB + 512 * 1024;
constexpr size_t OFF_RKVZT = 237 * MiB, OFF_RWOUTT = 245 * MiB, OFF_W1T = 247 * MiB, OFF_A1T = OFF_W1T + 256 * 1024,
                 OFF_G1T = OFF_W1T + 512 * 1024, OFF_W2T = OFF_W1T + 768 * 1024, OFF_A2T = 248 * MiB,
                 OFF_G2T = 248 * MiB + 256 * 1024, OFF_HW = 248 * MiB + 512 * 1024;
constexpr size_t OFF_U1 = 2 * MiB, OFF_R = 34 * MiB, OFF_K2 = 66 * MiB, OFF_V2 = 98 * MiB, OFF_SZ = 130 * MiB,
                 OFF_YSUM = 162 * MiB, OFF_HA = 226 * MiB, OFF_HG = 230 * MiB;
constexpr size_t OFF_BFOLD = 98 * MiB;
constexpr size_t OFF_Y0B = 98 * MiB, OFF_Y1B = 34 * MiB;
constexpr size_t OFF_DX = 162 * MiB;
constexpr size_t OFF_SEGP = 2 * MiB, OFF_SEGQ = 6 * MiB, OFF_SEGZ = 14 * MiB;
constexpr size_t OUT_NK = 16777216, OUT_NV = 20971520, OUT_ST = 25165824;

constexpr int NTJ = 33;
struct TJob { const float* src; u16* dst; int lds, ldd, tk, tn, start, pad; };

struct Params {
  const float *x_prompt, *x_sample, *cache_k, *cache_v, *state_rwkv, *c, *c_ctx;
  const float *ada_w, *ada_b, *post_g, *post_b, *w_in, *w_fnet, *rpb, *w_out;
  const float *mu, *rkvz, *w0, *w1, *w2, *a0, *a1, *a2, *g1, *g2, *k_k, *k_a, *r_k, *lnx_g, *lnx_b, *rw_out;
  float* out; char* ws;
  int phase_lo, phase_hi, ntr, pad;
  TJob tj[NTJ];
};

typedef __attribute__((ext_vector_type(2))) __bf16 bf16x2_t;
typedef __attribute__((ext_vector_type(2))) float f32x2_t;
DEV unsigned pack2(float a, float b) {
  f32x2_t f = {a, b};
  bf16x2_t r = __builtin_convertvector(f, bf16x2_t);
  return *(unsigned*)&r;
}
DEV u16 f2bf(float f) { return (u16)(pack2(f, 0.f) & 0xffffu); }
DEV float bflo(unsigned w) { return __uint_as_float(w << 16); }
DEV float bfhi(unsigned w) { return __uint_as_float(w & 0xffff0000u); }
DEV float rcp_f(float x) { return __builtin_amdgcn_rcpf(x); }
DEV float sigm(float x) { return rcp_f(1.f + __expf(-x)); }
DEV float silu(float x) { return x * rcp_f(1.f + __expf(-x)); }
DEV float tanh_f(float x) { return 1.f - 2.f * rcp_f(__expf(2.f * x) + 1.f); }
DEV b16x8 ld16(const u16* p) { uint4 v = *(const uint4*)p; return *(b16x8*)&v; }
DEV b16x8 asb(uint4 v) { return *(b16x8*)&v; }
template <int CTRL> DEV float dpp_add(float x) {
  return x + __int_as_float(__builtin_amdgcn_update_dpp(0, __float_as_int(x), CTRL, 0xf, 0xf, true));
}
DEV float allsum8(float x) {
  x = dpp_add<0xB1>(x); x = dpp_add<0x4E>(x); x = dpp_add<0x141>(x);
  return x;
}
DEV float wave_sum(float x) {
  x = dpp_add<0xB1>(x); x = dpp_add<0x4E>(x); x = dpp_add<0x141>(x); x = dpp_add<0x140>(x);
  x += __shfl_xor(x, 16); x += __shfl_xor(x, 32);
  return x;
}
DEV float allsum16(float x) {
  x = dpp_add<0xB1>(x); x = dpp_add<0x4E>(x); x = dpp_add<0x124>(x); x = dpp_add<0x128>(x);
  return x;
}
DEV void lds_barrier() { asm volatile("s_waitcnt lgkmcnt(0)\n\ts_barrier" ::: "memory"); }
DEV int mv_of(int token) { return token < T_CTX ? 0 : 1 + ((token - T_CTX) >> 12); }

template <bool LERP, class EP>
DEV void gemm_tile(const u16* __restrict__ A, int lda, const float* __restrict__ mu, int m0,
                   const u16* __restrict__ B, int ldb, int K, EP ep, char* smem) {
  u16(*sA0)[72] = (u16(*)[72])smem;
  u16(*sB0)[72] = (u16(*)[72])(smem + 18432);
  u16(*sA1)[72] = (u16(*)[72])(smem + 36864);
  u16(*sB1)[72] = (u16(*)[72])(smem + 36864 + 18432);
  int tid = threadIdx.x;
  asm volatile("" : "+v"(tid));
  const int lane = tid & 63, wave = tid >> 6, wm = wave >> 1, wn = wave & 1;
  const int lr = tid >> 3, lk = (tid & 7) * 8;
  f32x16 acc[2][2];
#pragma unroll
  for (int i = 0; i < 2; i++)
#pragma unroll
    for (int j = 0; j < 2; j++)
#pragma unroll
      for (int r = 0; r < 16; r++) acc[i][j][r] = 0.f;
  u32x4 ra0[4], rb0[4], rp0[4], ra1[4], rb1[4], rp1[4];
  float4 mu00, mu01, mu10, mu11;
  const u16* DXp = nullptr;
  if constexpr (LERP) DXp = (const u16*)(A) + (OFF_DX - OFF_U1) / 2;
#define GLOAD(K0, RA, RB, RP, M0, M1)                                                     \
  {                                                                                       \
    _Pragma("unroll") for (int i = 0; i < 4; i++) {                                       \
      int r = lr + 32 * i;                                                                \
      if constexpr (LERP) {                                                               \
        RA[i] = *(const u32x4*)(A + (size_t)(m0 + r) * lda + (K0) + lk);                  \
        RP[i] = *(const u32x4*)(DXp + (size_t)(m0 + r) * lda + (K0) + lk);                \
      } else {                                                                            \
        RA[i] = *(const u32x4*)(A + (size_t)r * lda + (K0) + lk);                         \
      }                                                                                   \
      RB[i] = *(const u32x4*)(B + (size_t)r * ldb + (K0) + lk);                           \
    }                                                                                     \
    if constexpr (LERP) {                                                                 \
      M0 = *(const float4*)(mu + (K0) + lk);                                              \
      M1 = *(const float4*)(mu + (K0) + lk + 4);                                          \
    }                                                                                     \
  }
#define GSTORE(RA, RB, RP, M0, M1, sA, sB)                                                     \
  {                                                                                       \
    _Pragma("unroll") for (int i = 0; i < 4; i++) {                                       \
      int r = lr + 32 * i;                                                                \
      u32x4 av = RA[i];                                                                   \
      if constexpr (LERP) {                                                               \
        unsigned cu[4] = {RA[i].x, RA[i].y, RA[i].z, RA[i].w};                            \
        unsigned du[4] = {RP[i].x, RP[i].y, RP[i].z, RP[i].w};                            \
        float m[8] = {M0.x, M0.y, M0.z, M0.w, M1.x, M1.y, M1.z, M1.w};                    \
        unsigned o[4];                                                                    \
        _Pragma("unroll") for (int q = 0; q < 4; q++)                                     \
          o[q] = pack2(bflo(cu[q]) + bflo(du[q]) * m[2 * q], bfhi(cu[q]) + bfhi(du[q]) * m[2 * q + 1]); \
        av = u32x4{o[0], o[1], o[2], o[3]};                                               \
      }                                                                                   \
      *(u32x4*)&sA[r][lk] = av;                                                           \
      *(u32x4*)&sB[r][lk] = RB[i];                                                        \
    }                                                                                     \
  }
#define GCOMPUTE(sA, sB)                                                                  \
  {                                                                                       \
    _Pragma("unroll") for (int ks = 0; ks < 4; ks++) {                                    \
      b16x8 af[2], bf[2];                                                                 \
      _Pragma("unroll") for (int i = 0; i < 2; i++) {                                     \
        af[i] = *(const b16x8*)&sA[wm * 64 + i * 32 + (lane & 31)][ks * 16 + (lane >> 5) * 8]; \
        bf[i] = *(const b16x8*)&sB[wn * 64 + i * 32 + (lane & 31)][ks * 16 + (lane >> 5) * 8]; \
      }                                                                                   \
      _Pragma("unroll") for (int i = 0; i < 2; i++)                                       \
        _Pragma("unroll") for (int j = 0; j < 2; j++)                                     \
          acc[i][j] = __builtin_amdgcn_mfma_f32_32x32x16_bf16(af[i], bf[j], acc[i][j], 0, 0, 0); \
    }                                                                                     \
  }
#define GPIPE()                                                                           \
  {                                                                                       \
    __builtin_amdgcn_sched_group_barrier(0x100, 4, 0);                                    \
    _Pragma("unroll") for (int pi = 0; pi < 16; pi++) {                                   \
      __builtin_amdgcn_sched_group_barrier(0x008, 1, 0);                                  \
      __builtin_amdgcn_sched_group_barrier(0x100, 1, 0);                                  \
      __builtin_amdgcn_sched_group_barrier(0x002, 7, 0);                                  \
      __builtin_amdgcn_sched_group_barrier(0x200, 1, 0);                                  \
    }                                                                                     \
  }
  GLOAD(0, ra0, rb0, rp0, mu00, mu01);
  GLOAD(64, ra1, rb1, rp1, mu10, mu11);
  __syncthreads();
  GSTORE(ra0, rb0, rp0, mu00, mu01, sA0, sB0);
  if (128 < K) GLOAD(128, ra0, rb0, rp0, mu00, mu01);
  __syncthreads();
#pragma unroll 1
  for (int k0 = 0; k0 < K; k0 += 128) {
    __builtin_amdgcn_s_setprio(1);
    GCOMPUTE(sA0, sB0);
    GSTORE(ra1, rb1, rp1, mu10, mu11, sA1, sB1);
    {
      const int kn = k0 + 192 < K ? k0 + 192 : K - 64;
      GLOAD(kn, ra1, rb1, rp1, mu10, mu11);
    }
    GPIPE();
    __builtin_amdgcn_s_setprio(0);
    __syncthreads();
    __builtin_amdgcn_s_setprio(1);
    GCOMPUTE(sA1, sB1);
    GSTORE(ra0, rb0, rp0, mu00, mu01, sA0, sB0);
    {
      const int kn = k0 + 256 < K ? k0 + 256 : K - 64;
      GLOAD(kn, ra0, rb0, rp0, mu00, mu01);
    }
    GPIPE();
    __builtin_amdgcn_s_setprio(0);
    __syncthreads();
  }
#undef GLOAD
#undef GSTORE
#undef GCOMPUTE
#undef GPIPE
  __syncthreads();
  int tide = tid;
  asm volatile("" : "+v"(tide));
  const int lane_e = tide & 63, wv_e = tide >> 6, wm_e = wv_e >> 1, wn_e = wv_e & 1;
  u16* stg = (u16*)smem + wv_e * (64 * 72);
#pragma unroll
  for (int i = 0; i < 2; i++)
#pragma unroll
    for (int j = 0; j < 2; j++)
#pragma unroll
      for (int q = 0; q < 4; q++) {
        const int r = i * 32 + q * 8 + (lane_e >> 5) * 4, c = j * 32 + (lane_e & 31);
        const float v0 = acc[i][j][q * 4 + 0], v1 = acc[i][j][q * 4 + 1], v2 = acc[i][j][q * 4 + 2], v3 = acc[i][j][q * 4 + 3];
        ep.direct(wm_e * 64 + r, wn_e * 64 + c, v0, v1, v2, v3);
        if constexpr (EP::TRANS) {
          *(uint2*)(stg + c * 72 + r) = make_uint2(pack2(ep.act(v0), ep.act(v1)), pack2(ep.act(v2), ep.act(v3)));
        } else {
          const unsigned p01 = pack2(ep.act(v0), ep.act(v1)), p23 = pack2(ep.act(v2), ep.act(v3));
          stg[(r + 0) * 72 + c] = (u16)(p01 & 0xffffu); stg[(r + 1) * 72 + c] = (u16)(p01 >> 16);
          stg[(r + 2) * 72 + c] = (u16)(p23 & 0xffffu); stg[(r + 3) * 72 + c] = (u16)(p23 >> 16);
        }
      }
#pragma unroll
  for (int n = 0; n < 8; n++) {
    const int id = lane_e + 64 * n, rr = id >> 3, cc = (id & 7) * 8;
    const u32x4 v = *(const u32x4*)(stg + rr * 72 + cc);
    if constexpr (EP::TRANS) ep.store(wn_e * 64 + rr, wm_e * 64 + cc, v);
    else ep.store(wm_e * 64 + rr, wn_e * 64 + cc, v);
  }
}

template <int ACT> struct EpStore {
  static constexpr bool TRANS = false;
  u16* dst; int ld; float scale;
  DEV float act(float x) const {
    if (ACT == 1) return silu(x);
    if (ACT == 2) return tanh_f(x);
    if (ACT == 3) return sigm(x);
    if (ACT == 4) return x * scale;
    return x;
  }
  DEV void direct(int, int, float, float, float, float) const {}
  DEV void store(int R, int C, u32x4 v) const { *(u32x4*)(dst + (size_t)R * ld + C) = v; }
};
struct EpNull {
  static constexpr bool TRANS = false;
  DEV float act(float x) const { return x; }
  DEV void direct(int, int, float, float, float, float) const {}
  DEV void store(int, int, u32x4) const {}
};
struct EpKeep {
  static constexpr bool TRANS = false;
  u16* dst; int ld; float* f32dst; int ldf;
  DEV float act(float x) const { return x; }
  DEV void direct(int r, int c, float v0, float v1, float v2, float v3) const {
    if (f32dst) {
      f32dst[(size_t)(r + 0) * ldf + c] = v0; f32dst[(size_t)(r + 1) * ldf + c] = v1;
      f32dst[(size_t)(r + 2) * ldf + c] = v2; f32dst[(size_t)(r + 3) * ldf + c] = v3;
    }
  }
  DEV void store(int R, int C, u32x4 v) const { *(u32x4*)(dst + (size_t)R * ld + C) = v; }
};
struct EpTrans {
  static constexpr bool TRANS = true;
  u16* dst; size_t ldt; float* f32dst; int ldf;
  DEV float act(float x) const { return x; }
  DEV void direct(int r, int c, float v0, float v1, float v2, float v3) const {
    if (f32dst) {
      f32dst[(size_t)(r + 0) * ldf + c] = v0; f32dst[(size_t)(r + 1) * ldf + c] = v1;
      f32dst[(size_t)(r + 2) * ldf + c] = v2; f32dst[(size_t)(r + 3) * ldf + c] = v3;
    }
  }
  DEV void store(int Rc, int Cr, u32x4 v) const { *(u32x4*)(dst + (size_t)Rc * ldt + Cr) = v; }
};
struct EpGate {
  static constexpr bool TRANS = false;
  u16* dst; const u16* gate; int ld;
  DEV float act(float x) const { return x; }
  DEV void direct(int, int, float, float, float, float) const {}
  DEV void store(int R, int C, u32x4 v) const {
    const size_t o = (size_t)R * ld + C;
    const u32x4 g = *(const u32x4*)(gate + o);
    u32x4 r;
    r.x = pack2(bflo(v.x) * bflo(g.x), bfhi(v.x) * bfhi(g.x)); r.y = pack2(bflo(v.y) * bflo(g.y), bfhi(v.y) * bfhi(g.y));
    r.z = pack2(bflo(v.z) * bflo(g.z), bfhi(v.z) * bfhi(g.z)); r.w = pack2(bflo(v.w) * bflo(g.w), bfhi(v.w) * bfhi(g.w));
    *(u32x4*)(dst + o) = r;
  }
};
struct EpRes {
  static constexpr bool TRANS = false;
  u16* dst; const float* xsrc; const float* gate;
  DEV float act(float x) const { return x; }
  DEV void direct(int, int, float, float, float, float) const {}
  DEV void store(int R, int C, u32x4 v) const {
    const size_t o = (size_t)R * 1024 + C;
    const float4 x0 = *(const float4*)(xsrc + o), x1 = *(const float4*)(xsrc + o + 4);
    const float4 g0 = *(const float4*)(gate + C), g1 = *(const float4*)(gate + C + 4);
    u32x4 r;
    r.x = pack2(ALPHA_DN * x0.x + (1.f + g0.x) * bflo(v.x), ALPHA_DN * x0.y + (1.f + g0.y) * bfhi(v.x));
    r.y = pack2(ALPHA_DN * x0.z + (1.f + g0.z) * bflo(v.y), ALPHA_DN * x0.w + (1.f + g0.w) * bfhi(v.y));
    r.z = pack2(ALPHA_DN * x1.x + (1.f + g1.x) * bflo(v.z), ALPHA_DN * x1.y + (1.f + g1.y) * bfhi(v.z));
    r.w = pack2(ALPHA_DN * x1.z + (1.f + g1.z) * bflo(v.w), ALPHA_DN * x1.w + (1.f + g1.w) * bfhi(v.w));
    *(u32x4*)(dst + o) = r;
  }
};

DEV void p0_prep(const Params& p, char* smem) {
  const int tid = threadIdx.x;
  const int njobs = 192 + p.ntr;
  for (int job = blockIdx.x; job < njobs; job += gridDim.x) {
    __syncthreads();
    if (job < 192) {
      float* sc = (float*)smem;
      float* red = sc + 3072;
      for (int i = tid; i < 3072; i += 256) {
        int m = i >> 10, k = i & 1023;
        float cv = m == 0 ? p.c_ctx[k] : p.c[(m - 1) * 1024 + k];
        sc[i] = silu(cv);
      }
      __syncthreads();
      int l = job / 96, col = (job % 96) * 32 + (tid & 31), ks = tid >> 5;
      const float* w = p.ada_w + (size_t)l * 1024 * 3072 + col;
      float a0 = 0, a1 = 0, a2 = 0;
#pragma unroll 8
      for (int k = ks * 128; k < ks * 128 + 128; k++) {
        float wv = w[(size_t)k * 3072];
        a0 += sc[k] * wv; a1 += sc[1024 + k] * wv; a2 += sc[2048 + k] * wv;
      }
      red[(ks * 32 + (tid & 31)) * 3 + 0] = a0; red[(ks * 32 + (tid & 31)) * 3 + 1] = a1; red[(ks * 32 + (tid & 31)) * 3 + 2] = a2;
      __syncthreads();
      if (tid < 96) {
        int cl = tid & 31, m = tid >> 5;
        float s = 0;
        for (int q = 0; q < 8; q++) s += red[(q * 32 + cl) * 3 + m];
        int cc = (job % 96) * 32 + cl;
        ((float*)(p.ws + OFF_MODS))[(l * 3 + m) * 3072 + cc] = s + p.ada_b[l * 3072 + cc];
      }
    } else {
      int tj = job - 192, e = 0;
      while (e + 1 < NTJ && p.tj[e + 1].start <= tj) e++;
      const TJob J = p.tj[e];
      int lt = tj - J.start, tkk = lt / J.tn, tnn = lt % J.tn;
      float(*tile)[65] = (float(*)[65])smem;
      const float* src = J.src + (size_t)(tkk * 64) * J.lds + tnn * 64;
#pragma unroll
      for (int i = 0; i < 4; i++) {
        int kk = (tid >> 4) + 16 * i, nn = (tid & 15) * 4;
        float4 v = *(const float4*)(src + (size_t)kk * J.lds + nn);
        tile[kk][nn] = v.x; tile[kk][nn + 1] = v.y; tile[kk][nn + 2] = v.z; tile[kk][nn + 3] = v.w;
      }
      __syncthreads();
      u16* dst = J.dst + (size_t)(tnn * 64) * J.ldd + tkk * 64;
#pragma unroll
      for (int i = 0; i < 2; i++) {
        int nn = (tid >> 3) + 32 * i, kk = (tid & 7) * 8;
        uint4 o;
        o.x = pack2(tile[kk][nn], tile[kk + 1][nn]); o.y = pack2(tile[kk + 2][nn], tile[kk + 3][nn]);
        o.z = pack2(tile[kk + 4][nn], tile[kk + 5][nn]); o.w = pack2(tile[kk + 6][nn], tile[kk + 7][nn]);
        *(uint4*)(dst + (size_t)nn * J.ldd + kk) = o;
      }
    }
  }
  const size_t gt = (size_t)blockIdx.x * 256 + tid, gs = (size_t)gridDim.x * 256;
  {
    u16* ck = (u16*)(p.ws + OFF_CK);
    for (size_t i = gt; i < 65536; i += gs) {
      float4 a = *(const float4*)(p.cache_k + i * 8), b = *(const float4*)(p.cache_k + i * 8 + 4);
      *(uint4*)(ck + i * 8) = make_uint4(pack2(a.x, a.y), pack2(a.z, a.w), pack2(b.x, b.y), pack2(b.z, b.w));
    }
  }
  {
    u16* fs = (u16*)(p.ws + OFF_FSMP);
    const float sc = 0.001381067932f;
    for (size_t i = gt; i < 2097152; i += gs) {
      int lp = (int)(i >> 9), j0 = (int)(i & 511) * 8;
      unsigned o[4];
#pragma unroll
      for (int q = 0; q < 4; q++) {
        float v[2];
#pragma unroll
        for (int z = 0; z < 2; z++) {
          int j = j0 + 2 * q + z;
          bool cs = j <= 2048;
          int ph = (lp * (cs ? j : j - 2048)) & 4095;
          float ang = (float)ph * (6.283185307179586f / 4096.f);
          v[z] = (cs ? __cosf(ang) : -__sinf(ang)) * sc;
        }
        o[q] = pack2(v[0], v[1]);
      }
      *(uint4*)(fs + i * 8) = make_uint4(o[0], o[1], o[2], o[3]);
    }
    u16* fc = (u16*)(p.ws + OFF_FCTX);
    const float sc2 = 0.005524271728f;
    for (size_t i = gt; i < 16384; i += gs) {
      int lp = (int)(i >> 6), j0 = (int)(i & 63) * 8;
      unsigned o[4];
#pragma unroll
      for (int q = 0; q < 4; q++) {
        float v[2];
#pragma unroll
        for (int z = 0; z < 2; z++) {
          int j = j0 + 2 * q + z;
          int ph = (lp * (j & 255)) & 255;
          float ang = (float)ph * (6.283185307179586f / 256.f);
          v[z] = (j < 256 ? __cosf(ang) : -__sinf(ang)) * sc2;
        }
        o[q] = pack2(v[0], v[1]);
      }
      *(uint4*)(fc + i * 8) = make_uint4(o[0], o[1], o[2], o[3]);
    }
  }
  {
    u16* mc = (u16*)(p.ws + OFF_MCAT);
    for (size_t i = gt; i < 131072; i += gs) {
      int c = (int)(i & 127), ep = (int)((i >> 7) & 255), g = (int)(i >> 15);
      const float* wf = p.w_fnet + (size_t)g * 16384 + (ep & 127);
      float s = 0;
      for (int cp = 0; cp < 128; cp++) {
        float ang = (float)((c * cp) & 127) * (6.283185307179586f / 128.f);
        float tw = ep < 128 ? __cosf(ang) : __sinf(ang);
        s += tw * wf[cp * 128];
      }
      mc[i] = f2bf(s);
    }
  }
}

DEV void ln_stats(const float4 (&x)[4], float& mean, float& rstd) {
  float s = 0;
#pragma unroll
  for (int i = 0; i < 4; i++) s += x[i].x + x[i].y + x[i].z + x[i].w;
  mean = wave_sum(s) * (1.f / 1024.f);
  float q = 0;
#pragma unroll
  for (int i = 0; i < 4; i++) {
    float a = x[i].x - mean, b = x[i].y - mean, c = x[i].z - mean, d = x[i].w - mean;
    q += a * a + b * b + c * c + d * d;
  }
  rstd = rsqrtf(wave_sum(q) * (1.f / 1024.f) + 1e-6f);
}

template <int MODE> DEV void ln_phase(const Params& p) {
  const int lane = threadIdx.x & 63;
  const int gw = blockIdx.x * 4 + (threadIdx.x >> 6), nw = gridDim.x * 4;
  const float* mods = (const float*)(p.ws + OFF_MODS);
  typedef __attribute__((ext_vector_type(4))) float f32x4v;
  f32x4v xn[4];
  u32x2 wn[4];
  auto fetch = [&](int row) {
    if (MODE == 0) {
      const float* src = row < T_CTX ? p.x_prompt + (size_t)row * 1024 : p.x_sample + (size_t)(row - T_CTX) * 1024;
#pragma unroll
      for (int i = 0; i < 4; i++) xn[i] = *(const f32x4v*)(src + lane * 4 + 256 * i);
    } else {
      const u16* sb = (const u16*)(p.ws + (MODE == 1 ? OFF_Y0B : OFF_Y1B)) + (size_t)row * 1024;
#pragma unroll
      for (int i = 0; i < 4; i++) wn[i] = *(const u32x2*)(sb + lane * 4 + 256 * i);
    }
  };
  if (gw < 16384) fetch(gw);
  for (int row = gw; row < 16384; row += nw) {
    float4 x[4];
#pragma unroll
    for (int i = 0; i < 4; i++) {
      if (MODE == 0) x[i] = make_float4(xn[i].x, xn[i].y, xn[i].z, xn[i].w);
      else x[i] = make_float4(bflo(wn[i].x), bfhi(wn[i].x), bflo(wn[i].y), bfhi(wn[i].y));
    }
    if (row + nw < 16384) fetch(row + nw);
    float mean, rstd;
    ln_stats(x, mean, rstd);
    if (MODE >= 1) {
      const float* g = p.post_g + (MODE == 1 ? 0 : 1024);
      const float* b = p.post_b + (MODE == 1 ? 0 : 1024);
      float* dst = p.out + (size_t)row * 1024;
#pragma unroll
      for (int i = 0; i < 4; i++) {
        float4 gv = *(const float4*)(g + lane * 4 + 256 * i), bv = *(const float4*)(b + lane * 4 + 256 * i);
        x[i].x = (x[i].x - mean) * rstd * gv.x + bv.x; x[i].y = (x[i].y - mean) * rstd * gv.y + bv.y;
        x[i].z = (x[i].z - mean) * rstd * gv.z + bv.z; x[i].w = (x[i].w - mean) * rstd * gv.w + bv.w;
        *(float4*)(dst + lane * 4 + 256 * i) = x[i];
      }
      if (MODE == 2) continue;
      ln_stats(x, mean, rstd);
    }
    const float* md = mods + ((MODE == 0 ? 0 : 3) + mv_of(row)) * 3072;
    u16* ud = (u16*)(p.ws + (MODE == 0 ? OFF_U : OFF_U1)) + (size_t)row * 1024;
#pragma unroll
    for (int i = 0; i < 4; i++) {
      int k = lane * 4 + 256 * i;
      float4 sh = *(const float4*)(md + k), sc = *(const float4*)(md + 1024 + k);
      float a = (x[i].x - mean) * rstd * (1.f + sc.x) + sh.x, b = (x[i].y - mean) * rstd * (1.f + sc.y) + sh.y;
      float c = (x[i].z - mean) * rstd * (1.f + sc.z) + sh.z, d = (x[i].w - mean) * rstd * (1.f + sc.w) + sh.w;
      *(uint2*)(ud + k) = make_uint2(pack2(a, b), pack2(c, d));
    }
  }
}

DEV void p2_gemm1(const Params& p, char* smem) {
  const u16* U = (const u16*)(p.ws + OFF_U);
  const u16* W = (const u16*)(p.ws + OFF_WINT);
  const int xcd = blockIdx.x & 7, jx = blockIdx.x >> 3, nbx = gridDim.x >> 3;
  for (int q = jx; q < 16 * 24; q += nbx) {
    int st = q >> 6, w = q & 63, sm = st / 3, sn = st % 3;
    int mt = xcd * 16 + sm * 8 + (w >> 3), nt = sn * 8 + (w & 7);
    int m0 = mt * 128, n0 = nt * 128, sec = nt >> 2, nc = (nt & 3) * 128;
    const u16* A = U + (size_t)m0 * 1024;
    const u16* B = W + (size_t)n0 * 1024;
    if (sec == 0) {
      gemm_tile<false>(A, 1024, nullptr, m0, B, 1024, 1024, EpStore<0>{(u16*)(p.ws + OFF_ABUF) + (size_t)m0 * 512 + nc, 512, 1.f}, smem);
    } else if (sec == 1 || sec == 5) {
      gemm_tile<false>(A, 1024, nullptr, m0, B, 1024, 1024,
                       EpStore<1>{(u16*)(p.ws + OFF_GBUF) + (size_t)m0 * 1024 + (sec == 5 ? 512 : 0) + nc, 1024, 1.f}, smem);
    } else if (sec == 2) {
      gemm_tile<false>(A, 1024, nullptr, m0, B, 1024, 1024, EpStore<4>{(u16*)(p.ws + OFF_Q) + (size_t)m0 * 512 + nc, 512, 0.125f * LOG2E}, smem);
    } else if (sec == 3) {
      float* f = m0 < T_CTX ? p.out + OUT_NK + (size_t)m0 * 512 + nc : nullptr;
      gemm_tile<false>(A, 1024, nullptr, m0, B, 1024, 1024, EpKeep{(u16*)(p.ws + OFF_K) + (size_t)m0 * 512 + nc, 512, f, 512}, smem);
    } else {
      float* f = m0 < T_CTX ? p.out + OUT_NV + (size_t)m0 * 512 + nc : nullptr;
      u16* d; size_t ldt;
      if (m0 < T_CTX) { int b = m0 >> 8, l = m0 & 255; ldt = 256; d = (u16*)(p.ws + OFF_VTC) + ((size_t)b * 512 + nc) * 256 + l; }
      else { int tt = m0 - T_CTX, b = tt >> 12, l = tt & 4095; ldt = 4096; d = (u16*)(p.ws + OFF_VTS) + ((size_t)b * 512 + nc) * 4096 + l; }
      gemm_tile<false>(A, 1024, nullptr, m0, B, 1024, 1024, EpTrans{d, ldt, f, 512}, smem);
    }
  }
}

struct AttnState { f32x16 o0, o1; float m, l; };

DEV void attn_tile(AttnState& st, const b16x8 (&qf)[4], const u16* kS, const u16* vS, int mode, int dr, int kc0, int c,
                   const float* rpbh, int qi, int hh) {
  f32x16 s;
#pragma unroll
  for (int r = 0; r < 16; r++) s[r] = 0.f;
#pragma unroll
  for (int ks = 0; ks < 4; ks++) s = __builtin_amdgcn_mfma_f32_32x32x16_bf16(*(const b16x8*)(kS + qi * 72 + ks * 16 + hh * 8), qf[ks], s, 0, 0, 0);
  if (mode) {
    int cs = min(max(c - 8, 0), 48);
#pragma unroll
    for (int r = 0; r < 16; r++) {
      int kc = kc0 + (r & 3) + 8 * (r >> 2) + 4 * hh;
      bool valid = (kc >= cs) && (kc < cs + 16);
      int dc = min(max(kc - c + 15, 0), 30);
      float bias = rpbh[dr * 31 + dc] * LOG2E;
      s[r] = valid ? s[r] + bias : -1e30f;
    }
  }
  float tm = s[0];
#pragma unroll
  for (int r = 1; r < 16; r++) tm = fmaxf(tm, s[r]);
  tm = fmaxf(tm, __shfl_xor(tm, 32));
  float mn = fmaxf(st.m, tm);
  float alpha = __builtin_amdgcn_exp2f(st.m - mn);
  st.m = mn;
  float ps = 0;
#pragma unroll
  for (int r = 0; r < 16; r++) { float e = __builtin_amdgcn_exp2f(s[r] - mn); ps += e; s[r] = e; }
  st.l = st.l * alpha + ps;
#pragma unroll
  for (int r = 0; r < 16; r++) { st.o0[r] *= alpha; st.o1[r] *= alpha; }
#pragma unroll
  for (int s2 = 0; s2 < 2; s2++) {
    u32x4 pw = {pack2(s[8 * s2 + 0], s[8 * s2 + 1]), pack2(s[8 * s2 + 2], s[8 * s2 + 3]),
                pack2(s[8 * s2 + 4], s[8 * s2 + 5]), pack2(s[8 * s2 + 6], s[8 * s2 + 7])};
    b16x8 pfr = *(b16x8*)&pw;
#pragma unroll
    for (int dt = 0; dt < 2; dt++) {
      const u16* vr = vS + (dt * 32 + qi) * 40 + 16 * s2 + 4 * hh;
      const uint2 lo = *(const uint2*)vr, hi = *(const uint2*)(vr + 8);
      u32x4 vw = {lo.x, lo.y, hi.x, hi.y};
      b16x8 vf = *(b16x8*)&vw;
      if (dt == 0) st.o0 = __builtin_amdgcn_mfma_f32_32x32x16_bf16(vf, pfr, st.o0, 0, 0, 0);
      else st.o1 = __builtin_amdgcn_mfma_f32_32x32x16_bf16(vf, pfr, st.o1, 0, 0, 0);
    }
  }
}

DEV void attn_unit(const Params& p, int u, int lane, char* smem) {
  const u16* Qb = (const u16*)(p.ws + OFF_Q);
  const u16* Kb = (const u16*)(p.ws + OFF_K);
  const int qi = lane & 31, hh = lane >> 5;
  u16* kS = (u16*)smem + (threadIdx.x >> 6) * 4864;
  u16* vS = kS + 32 * 72;
  bool smp = u < 2048;
  int b, h, qg, tq0, r = 0, c0 = 0;
  if (smp) { b = u >> 10; h = (u >> 7) & 7; qg = u & 127; tq0 = T_CTX + b * 4096 + qg * 32; r = qg >> 1; c0 = (qg & 1) * 32; }
  else { int v = u - 2048; b = v >> 6; h = (v >> 3) & 7; qg = v & 7; tq0 = b * 256 + qg * 32; }
  b16x8 qf[4];
#pragma unroll
  for (int s = 0; s < 4; s++) qf[s] = ld16(Qb + (size_t)(tq0 + qi) * 512 + h * 64 + s * 16 + hh * 8);
  AttnState st;
#pragma unroll
  for (int i = 0; i < 16; i++) { st.o0[i] = 0.f; st.o1[i] = 0.f; }
  st.m = -INFINITY; st.l = 0.f;
  const float* rpbh = p.rpb + h * 465;
  const int rs = min(max(r - 4, 0), 56);
  const u16* ck = (const u16*)(p.ws + OFF_CK) + (size_t)b * 512 * 512 + h * 64;
  const u16* cvt = (const u16*)(p.ws + OFF_CVT) + (size_t)(b * 8 + h) * 64 * 512;
  const u16* kls = Kb + (size_t)(T_CTX + b * 4096) * 512 + h * 64;
  const u16* vls = (const u16*)(p.ws + OFF_VTS) + (size_t)(b * 8 + h) * 64 * 4096;
  const u16* klc = Kb + (size_t)(b * 256) * 512 + h * 64;
  const u16* vlc = (const u16*)(p.ws + OFF_VTC) + (size_t)(b * 8 + h) * 64 * 256;
  const int ntile = smp ? 32 : 8;
  u32x4 kr[4], vr[4];
  auto issue = [&](int tt) {
    int ll = lane;
    asm volatile("" : "+v"(ll));
    const u16 *kp, *vp; int ldv;
    if (!smp) { kp = klc + (size_t)tt * 32 * 512; vp = vlc + tt * 32; ldv = 256; }
    else if (tt < 16) { kp = ck + (size_t)tt * 32 * 512; vp = cvt + tt * 32; ldv = 512; }
    else { int kt = tt - 16, krow = rs + (kt >> 1), kc0 = (kt & 1) * 32; kp = kls + (size_t)(krow * 64 + kc0) * 512; vp = vls + krow * 64 + kc0; ldv = 4096; }
#pragma unroll
    for (int n = 0; n < 4; n++) {
      const int id = ll + 64 * n;
      kr[n] = *(const u32x4*)(kp + (size_t)(id >> 3) * 512 + (id & 7) * 8);
      vr[n] = *(const u32x4*)(vp + (size_t)(id >> 2) * ldv + (id & 3) * 8);
    }
  };
  issue(0);
#pragma unroll 1
  for (int tt = 0; tt < ntile; tt++) {
    {
      int ll = lane;
      asm volatile("" : "+v"(ll));
#pragma unroll
      for (int n = 0; n < 4; n++) {
        const int id = ll + 64 * n;
        *(u32x4*)(kS + (id >> 3) * 72 + (id & 7) * 8) = kr[n];
        *(u32x4*)(vS + (id >> 2) * 40 + (id & 3) * 8) = vr[n];
      }
    }
    if (tt + 1 < ntile) issue(tt + 1);
    const bool loc = smp && tt >= 16;
    const int kt = tt - 16;
    attn_tile(st, qf, kS, vS, loc ? 1 : 0, loc ? rs + (kt >> 1) - r + 7 : 0, loc ? (kt & 1) * 32 : 0, c0 + qi, rpbh, qi, hh);
  }
  float lt = st.l + __shfl_xor(st.l, 32);
  float inv = 1.f / lt;
  const size_t rowo = (size_t)(tq0 + qi) * 1024 + 512 + h * 64;
  const u16* gb = (const u16*)(p.ws + OFF_GBUF) + rowo;
  u16* cat = (u16*)(p.ws + OFF_U) + rowo;
#pragma unroll
  for (int dt = 0; dt < 2; dt++)
#pragma unroll
    for (int q = 0; q < 4; q++) {
      int d = dt * 32 + q * 8 + hh * 4;
      uint2 g = *(const uint2*)(gb + d);
      float v0 = (dt ? st.o1[q * 4 + 0] : st.o0[q * 4 + 0]) * inv * bflo(g.x);
      float v1 = (dt ? st.o1[q * 4 + 1] : st.o0[q * 4 + 1]) * inv * bfhi(g.x);
      float v2 = (dt ? st.o1[q * 4 + 2] : st.o0[q * 4 + 2]) * inv * bflo(g.y);
      float v3 = (dt ? st.o1[q * 4 + 3] : st.o0[q * 4 + 3]) * inv * bfhi(g.y);
      *(uint2*)(cat + d) = make_uint2(pack2(v0, v1), pack2(v2, v3));
    }
}

DEV void p3_mix(const Params& p, char* smem) {
  for (int t = blockIdx.x; t < 2048; t += gridDim.x) {
    if (t < 1024) {
      __syncthreads();
      attn_unit(p, t * 4 + (threadIdx.x >> 6), threadIdx.x & 63, smem);
    } else {
      int q = t - 1024, mt = q >> 3, g = (q >> 1) & 3, nh = q & 1, m0 = mt * 128;
      const u16* A = (const u16*)(p.ws + OFF_ABUF) + (size_t)m0 * 512 + g * 128;
      const u16* B = (const u16*)(p.ws + OFF_MCAT) + (size_t)(g * 256 + nh * 128) * 128;
      u16* d; size_t ldt;
      if (m0 < T_CTX) { int b = m0 >> 8, l = m0 & 255; ldt = 512; d = (u16*)(p.ws + OFF_BTC) + ((size_t)b * 512 + g * 128) * 512 + nh * 256 + l; }
      else { int tt = m0 - T_CTX, b = tt >> 12, l = tt & 4095; ldt = 8192; d = (u16*)(p.ws + OFF_BTS) + ((size_t)b * 512 + g * 128) * 8192 + nh * 4096 + l; }
      gemm_tile<false>(A, 512, nullptr, m0, B, 128, 128, EpTrans{d, ldt, nullptr, 0}, smem);
    }
  }
}

DEV void p3b_fold(const Params& p) {
  const u16* bt = (const u16*)(p.ws + OFF_BTS);
  u16* bf = (u16*)(p.ws + OFF_BFOLD);
  const size_t gt = (size_t)blockIdx.x * 256 + threadIdx.x, gs = (size_t)gridDim.x * 256;
  for (size_t i = gt; i < 4194304; i += gs) {
    const int jj = (int)(i & 4095);
    const u16* row = bt + (i >> 12) * 8192;
    float v;
    if (jj <= 2048) {
      v = __uint_as_float((unsigned)row[jj] << 16);
      if (jj >= 1 && jj <= 2047) v += __uint_as_float((unsigned)row[4096 - jj] << 16);
    } else {
      const int j = jj - 2048;
      v = __uint_as_float((unsigned)row[4096 + j] << 16) - __uint_as_float((unsigned)row[8192 - j] << 16);
    }
    bf[i] = f2bf(v);
  }
}

DEV void p4_fnet(const Params& p, char* smem) {
  for (int t = blockIdx.x; t < 512; t += gridDim.x) {
    if (t < 256) {
      int b = t >> 7, mt = (t >> 2) & 31, nt = t & 3;
      int tok0 = T_CTX + b * 4096 + mt * 128;
      const u16* A = (const u16*)(p.ws + OFF_FSMP) + (size_t)(mt * 128) * 4096;
      const u16* B = (const u16*)(p.ws + OFF_BFOLD) + ((size_t)b * 512 + nt * 128) * 4096;
      size_t o = (size_t)tok0 * 1024 + nt * 128;
      gemm_tile<false>(A, 4096, nullptr, 0, B, 4096, 4096, EpGate{(u16*)(p.ws + OFF_U) + o, (const u16*)(p.ws + OFF_GBUF) + o, 1024}, smem);
    } else {
      int q = t - 256, b = q >> 3, mt = (q >> 2) & 1, nt = q & 3;
      int tok0 = b * 256 + mt * 128;
      const u16* A = (const u16*)(p.ws + OFF_FCTX) + (size_t)(mt * 128) * 512;
      const u16* B = (const u16*)(p.ws + OFF_BTC) + ((size_t)b * 512 + nt * 128) * 512;
      size_t o = (size_t)tok0 * 1024 + nt * 128;
      gemm_tile<false>(A, 512, nullptr, 0, B, 512, 512, EpGate{(u16*)(p.ws + OFF_U) + o, (const u16*)(p.ws + OFF_GBUF) + o, 1024}, smem);
    }
  }
}

template <int LAYER> DEV void p_outproj(const Params& p, char* smem) {
  const u16* Aall = (const u16*)(p.ws + (LAYER == 0 ? OFF_U : OFF_U1));
  const u16* W = (const u16*)(p.ws + (LAYER == 0 ? OFF_WOUTT : OFF_RWOUTT));
  const float* mods = (const float*)(p.ws + OFF_MODS);
  for (int t = blockIdx.x; t < 1024; t += gridDim.x) {
    int mt = t >> 3, nt = t & 7, m0 = mt * 128, n0 = nt * 128;
    const float* xs;
    if (LAYER == 0) xs = (m0 < T_CTX ? p.x_prompt + (size_t)m0 * 1024 : p.x_sample + (size_t)(m0 - T_CTX) * 1024) + n0;
    else xs = p.out + (size_t)m0 * 1024 + n0;
    const float* gate = mods + (LAYER * 3 + mv_of(m0)) * 3072 + 2048 + n0;
    gemm_tile<false>(Aall + (size_t)m0 * 1024, 1024, nullptr, m0, W + (size_t)n0 * 1024, 1024, 1024,
                     EpRes{(u16*)(p.ws + (LAYER == 0 ? OFF_Y0B : OFF_Y1B)) + (size_t)m0 * 1024 + n0, xs, gate}, smem);
  }
}

DEV void p6b_dx(const Params& p) {
  const int lane = threadIdx.x & 63;
  const int gw = blockIdx.x * 4 + (threadIdx.x >> 6), nw = gridDim.x * 4;
  const u16* U = (const u16*)(p.ws + OFF_U1);
  u16* DX = (u16*)(p.ws + OFF_DX);
  for (int row = gw; row < 16384; row += nw) {
    const int l = row < T_CTX ? (row & 255) : ((row - T_CTX) & 4095);
    const int len = row < T_CTX ? 256 : 4096;
    const float pf = l > 0 ? 1.f : 0.f, nf = l + 1 < len ? 1.f : 0.f;
    const u16* uc = U + (size_t)row * 1024 + lane * 16;
    const u16* up = l > 0 ? uc - 1024 : uc;
    const u16* un = l + 1 < len ? uc + 1024 : uc;
#pragma unroll
    for (int hlf = 0; hlf < 2; hlf++) {
      uint4 c = *(const uint4*)(uc + 8 * hlf), a = *(const uint4*)(up + 8 * hlf), n = *(const uint4*)(un + 8 * hlf);
      const unsigned cu[4] = {c.x, c.y, c.z, c.w}, au[4] = {a.x, a.y, a.z, a.w}, nu[4] = {n.x, n.y, n.z, n.w};
      unsigned o[4];
#pragma unroll
      for (int q = 0; q < 4; q++)
        o[q] = pack2(0.5f * (bflo(au[q]) * pf + bflo(nu[q]) * nf) - bflo(cu[q]), 0.5f * (bfhi(au[q]) * pf + bfhi(nu[q]) * nf) - bfhi(cu[q]));
      *(uint4*)(DX + (size_t)row * 1024 + lane * 16 + 8 * hlf) = make_uint4(o[0], o[1], o[2], o[3]);
    }
  }
}

DEV void p7_rwkv_proj(const Params& p, char* smem) {
  const u16* U1 = (const u16*)(p.ws + OFF_U1);
  const int xcd = blockIdx.x & 7, jx = blockIdx.x >> 3, nbx = gridDim.x >> 3;
  for (int q = jx; q < 16 * 35; q += nbx) {
    int mt, nt;
    if (q < 512) { int st = q >> 6, w = q & 63; mt = xcd * 16 + (st >> 2) * 8 + (w >> 3); nt = (st & 3) * 8 + (w & 7); }
    else { int w = q - 512; mt = xcd * 16 + w / 3; nt = 32 + w % 3; }
    const int m0 = mt * 128;
    if (nt < 32) {
      int which = nt >> 3, n0 = (nt & 7) * 128;
      const u16* B = (const u16*)(p.ws + OFF_RKVZT) + (size_t)which * 1048576 + (size_t)n0 * 1024;
      if (which == 3) {
        gemm_tile<false>(U1 + (size_t)m0 * 1024, 1024, nullptr, m0, B, 1024, 1024,
                         EpStore<1>{(u16*)(p.ws + OFF_SZ) + (size_t)m0 * 1024 + n0, 1024, 1.f}, smem);
      } else {
        size_t off = which == 0 ? OFF_R : (which == 1 ? OFF_K2 : OFF_V2);
        const float* mu = p.mu + (which == 0 ? 0 : (which == 1 ? 2 : 3)) * 1024;
        gemm_tile<true>(U1, 1024, mu, m0, B, 1024, 1024, EpStore<0>{(u16*)(p.ws + off) + (size_t)m0 * 1024 + n0, 1024, 1.f}, smem);
      }
    } else {
      int w = nt - 32;
      if (w == 0)
        gemm_tile<true>(U1, 1024, p.mu + 1 * 1024, m0, (const u16*)(p.ws + OFF_W1T), 1024, 1024, EpStore<2>{(u16*)(p.ws + OFF_HW) + (size_t)m0 * 128, 128, 1.f}, smem);
      else if (w == 1)
        gemm_tile<true>(U1, 1024, p.mu + 4 * 1024, m0, (const u16*)(p.ws + OFF_A1T), 1024, 1024, EpStore<0>{(u16*)(p.ws + OFF_HA) + (size_t)m0 * 128, 128, 1.f}, smem);
      else
        gemm_tile<true>(U1, 1024, p.mu + 5 * 1024, m0, (const u16*)(p.ws + OFF_G1T), 1024, 1024, EpStore<3>{(u16*)(p.ws + OFF_HG) + (size_t)m0 * 128, 128, 1.f}, smem);
    }
  }
}

DEV b16x8 lds_perm(const u16* M, int ld, int row, int s, int hh) {
  const u16* q = M + row * ld + 16 * s + 4 * hh;
  uint2 lo = *(const uint2*)q, hi = *(const uint2*)(q + 8);
  u32x4 v = {lo.x, lo.y, hi.x, hi.y};
  return *(b16x8*)&v;
}
DEV b16x8 lds_norm(const u16* M, int ld, int row, int s, int hh) { return *(const b16x8*)(M + row * ld + 16 * s + 8 * hh); }
template <int OFF> DEV b16x8 pack8(const f32x16& a) {
  u32x4 v = {pack2(a[OFF], a[OFF + 1]), pack2(a[OFF + 2], a[OFF + 3]), pack2(a[OFF + 4], a[OFF + 5]), pack2(a[OFF + 6], a[OFF + 7])};
  return *(b16x8*)&v;
}
#define MFMA32(a, b, c) __builtin_amdgcn_mfma_f32_32x32x16_bf16(a, b, c, 0, 0, 0)

DEV int swz_idx(int row, int col) { return row * 40 + ((row >> 5) & 1) * 32 + ((((col >> 3) ^ (row >> 3)) & 3) << 3) + (col & 7); }
DEV b16x8 swz_norm(const u16* M, int row, int s, int hh) { return *(const b16x8*)(M + swz_idx(row, 16 * s + 8 * hh)); }
DEV b16x8 swz_perm(const u16* M, int row, int s, int hh) {
  uint2 lo = *(const uint2*)(M + swz_idx(row, 16 * s) + 4 * hh), hi = *(const uint2*)(M + swz_idx(row, 16 * s + 8) + 4 * hh);
  u32x4 v = {lo.x, lo.y, hi.x, hi.y};
  return *(b16x8*)&v;
}
struct ScanJob {
  int e, b, hd, tb, L, step0, nch, pq;
  int ncomb, seq;
  const float* zin;
  float* zout;
  u16* pout;
  float* qout;
};
DEV void scan_job(const Params& p, const ScanJob& J, char* smem) {
  float* sCum = (float*)smem;
  float* sAa = (float*)(smem + 8320);
  float* sNN = (float*)(smem + 8320);
  float* sT11 = (float*)(smem + 12544);
  float* sT22 = (float*)(smem + 13632);
  float* sWm = (float*)(smem + 14720);
  u16* AT = (u16*)(smem + 16640);
  u16* RT = (u16*)(smem + 21248);
  u16* BTl = (u16*)(smem + 25856);
  u16* KTl = (u16*)(smem + 30464);
  u16* BH = (u16*)(smem + 35072);
  u16* KH = (u16*)(smem + 40256);
  u16* VT = (u16*)(smem + 45440);
  u16* MkaT = (u16*)(smem + 50624);
  u16* MbrT = (u16*)(smem + 53184);
  u16* MkrT = (u16*)(smem + 55744);
  u16* TT = (u16*)(smem + 58304);
  float* gC = (float*)(smem + 60864);
  const int tid = threadIdx.x, wave = __builtin_amdgcn_readfirstlane(threadIdx.x >> 6);
  float* sKc = (float*)(smem + 61120);
  const int e = J.e, hd = J.hd, tb = J.tb, L = J.L, step0 = J.step0;
  const bool pq = J.pq != 0;
  const bool chainw = pq || wave < 2;
  const bool useV = pq ? (wave >= 2) : true;
  const int rb = wave & 1;
  const u16* HW = (const u16*)(p.ws + OFF_HW);
  const u16* HA = (const u16*)(p.ws + OFF_HA);
  const u16* Rb = (const u16*)(p.ws + OFF_R);
  const u16* Kb = (const u16*)(p.ws + OFF_K2);
  const u16* Vb = (const u16*)(p.ws + OFF_V2);
  float* Ysum = (float*)(p.ws + OFF_YSUM);
  float* Bsum = (float*)(p.ws + OFF_BSUM);
  const int arr = wave >> 1, ct = wave & 1;
  const u16* Xb = (arr ? HA : HW) + e * 64;
  b16x8 wf[4];
  {
    const int qi = tid & 31, hh = (tid >> 5) & 1;
    const u16* Wt = (const u16*)(p.ws + (arr ? OFF_A2T : OFF_W2T)) + (size_t)e * 65536 + (size_t)(hd * 64 + ct * 32 + qi) * 64 + hh * 8;
#pragma unroll
    for (int ks = 0; ks < 4; ks++) wf[ks] = ld16(Wt + ks * 16);
  }
  const float bias0 = (arr ? p.a0 : p.w0)[e * 1024 + hd * 64 + ct * 32 + (tid & 31)];
  if (tid < 64) { sKc[tid] = p.k_k[hd * 64 + tid]; sKc[64 + tid] = p.k_a[hd * 64 + tid]; sKc[128 + tid] = p.r_k[hd * 64 + tid]; }
  f32x16 z0, z1;
#pragma unroll
  for (int q = 0; q < 4; q++) {
    const int qi = tid & 31, hh = (tid >> 5) & 1;
    float4 v0 = make_float4(0, 0, 0, 0), v1 = v0;
    if (pq) {
      if (wave < 2) {
#pragma unroll
        for (int i = 0; i < 4; i++) {
          const int k = 8 * q + 4 * hh + i, col = rb * 32 + qi;
          ((float*)&v0)[i] = (k == col) ? 1.f : 0.f;
          ((float*)&v1)[i] = (k + 32 == col) ? 1.f : 0.f;
        }
      }
    } else if (J.zin && wave < 2) {
      const float* sp = J.zin + (size_t)(wave * 32 + qi) * 64 + 8 * q + 4 * hh;
      v0 = *(const float4*)sp; v1 = *(const float4*)(sp + 32);
    }
    z0[4 * q] = v0.x; z0[4 * q + 1] = v0.y; z0[4 * q + 2] = v0.z; z0[4 * q + 3] = v0.w;
    z1[4 * q] = v1.x; z1[4 * q + 1] = v1.y; z1[4 * q + 2] = v1.z; z1[4 * q + 3] = v1.w;
  }
  if (!pq && wave < 2) {
    const int qi = tid & 31, hh = (tid >> 5) & 1;
#pragma unroll 1
    for (int g = 0; g < J.ncomb; g++) {
      const u16* P = (const u16*)(p.ws + OFF_SEGP) + (size_t)(J.seq * 7 + g) * 4096;
      const float* Q = (const float*)(p.ws + OFF_SEGQ) + (size_t)(J.seq * 7 + g) * 4096;
      b16x8 zb[4] = {pack8<0>(z0), pack8<8>(z0), pack8<0>(z1), pack8<8>(z1)};
      f32x16 n0, n1;
#pragma unroll
      for (int q = 0; q < 4; q++) {
        const float* sp = Q + (size_t)(wave * 32 + qi) * 64 + 8 * q + 4 * hh;
        float4 v0 = *(const float4*)sp, v1 = *(const float4*)(sp + 32);
        n0[4 * q] = v0.x; n0[4 * q + 1] = v0.y; n0[4 * q + 2] = v0.z; n0[4 * q + 3] = v0.w;
        n1[4 * q] = v1.x; n1[4 * q + 1] = v1.y; n1[4 * q + 2] = v1.z; n1[4 * q + 3] = v1.w;
      }
#pragma unroll
      for (int s2 = 0; s2 < 4; s2++) {
        const u16* r0 = P + (size_t)qi * 64 + 16 * s2 + 4 * hh;
        const u16* r1 = P + (size_t)(32 + qi) * 64 + 16 * s2 + 4 * hh;
        uint2 a = *(const uint2*)r0, c = *(const uint2*)(r0 + 8), d = *(const uint2*)r1, f = *(const uint2*)(r1 + 8);
        u32x4 fa = {a.x, a.y, c.x, c.y}, fb = {d.x, d.y, f.x, f.y};
        n0 = MFMA32(*(b16x8*)&fa, zb[s2], n0);
        n1 = MFMA32(*(b16x8*)&fb, zb[s2], n1);
      }
      z0 = n0; z1 = n1;
    }
  }
  const int nch = J.nch;
  b16x8 xf[4];
  u32x4 kq, rq, vq;
  int tokC;
  {
    const int qi = tid & 31, hh = (tid >> 5) & 1, ci_ = tid >> 3, chg = hd * 64 + (tid & 7) * 8;
    const int tok0 = tb + (e ? L - step0 - 32 : step0);
    const int tokA = tok0 + (e ? 31 - qi : qi);
#pragma unroll
    for (int ks = 0; ks < 4; ks++) xf[ks] = ld16(Xb + (size_t)tokA * 128 + hh * 8 + ks * 16);
    tokC = tok0 + (e ? 31 - ci_ : ci_);
    kq = *(const u32x4*)(Kb + (size_t)tokC * 1024 + chg);
    rq = *(const u32x4*)(Rb + (size_t)tokC * 1024 + chg);
    vq = *(const u32x4*)(Vb + (size_t)tokC * 1024 + chg);
  }
#pragma unroll 1
  for (int ci = 0; ci < nch; ci++) {
    const int tok0 = tb + (e ? L - step0 - 32 * (ci + 1) : step0 + 32 * ci);
    const int tokn0 = tb + (e ? L - step0 - 32 * (ci + 2) : step0 + 32 * (ci + 1));
    const bool more = ci + 1 < nch;
    int tl = tid;
    asm volatile("" : "+v"(tl));
    const int lane = tl & 63, qi = lane & 31, hh = lane >> 5, ci_ = tl >> 3, cb = (tl & 7) * 8, chg = hd * 64 + cb;
    {
      f32x16 acc;
#pragma unroll
      for (int r = 0; r < 16; r++) acc[r] = 0.f;
#pragma unroll
      for (int ks = 0; ks < 4; ks++) acc = MFMA32(xf[ks], wf[ks], acc);
      if (more) {
        const int tokA = tokn0 + (e ? 31 - qi : qi);
#pragma unroll
        for (int ks = 0; ks < 4; ks++) xf[ks] = ld16(Xb + (size_t)tokA * 128 + hh * 8 + ks * 16);
      }
      const int ch = ct * 32 + qi;
      if (arr == 0) {
        float lw[16], gs[4], og[4];
#pragma unroll
        for (int r = 0; r < 16; r++) lw[r] = -0.606531f * sigm(acc[r] + bias0);
#pragma unroll
        for (int q = 0; q < 4; q++) { gs[q] = (lw[4 * q] + lw[4 * q + 1]) + (lw[4 * q + 2] + lw[4 * q + 3]); og[q] = __shfl_xor(gs[q], 32); }
        float pre = 0.f;
#pragma unroll
        for (int q = 0; q < 4; q++) {
          float run = pre + (hh ? og[q] : 0.f);
#pragma unroll
          for (int i = 0; i < 4; i++) { run += lw[4 * q + i]; sCum[(8 * q + 4 * hh + i) * 65 + ch] = run; }
          pre += gs[q] + og[q];
        }
      } else {
#pragma unroll
        for (int r = 0; r < 16; r++) {
          int row = (r & 3) + 8 * (r >> 2) + 4 * hh;
          sAa[row * 65 + ch] = sigm(acc[r] + bias0);
        }
      }
    }
    lds_barrier();
    {
      const int i = ci_;
      const unsigned ku[4] = {kq.x, kq.y, kq.z, kq.w}, ru[4] = {rq.x, rq.y, rq.z, rq.w}, vu[4] = {vq.x, vq.y, vq.z, vq.w};
      float k[8], r[8], kkr[8];
#pragma unroll
      for (int q = 0; q < 4; q++) {
        k[2 * q] = bflo(ku[q]); k[2 * q + 1] = bfhi(ku[q]);
        r[2 * q] = bflo(ru[q]); r[2 * q + 1] = bfhi(ru[q]);
      }
      float kkc[8], kac[8], rkc[8];
#pragma unroll
      for (int j = 0; j < 8; j++) { kkc[j] = sKc[cb + j]; kac[j] = sKc[64 + cb + j]; rkc[j] = sKc[128 + cb + j]; }
      float ss = 0;
#pragma unroll
      for (int j = 0; j < 8; j++) { kkr[j] = k[j] * kkc[j]; ss += kkr[j] * kkr[j]; }
      ss = allsum8(ss);
      const float inv = rsqrtf(ss + 1e-12f);
      float bon = 0;
      float oa[8], orr[8], ob[8], ok[8];
#pragma unroll
      for (int j = 0; j < 8; j++) {
        const float a = sAa[i * 65 + cb + j];
        const float cm = sCum[i * 65 + cb + j];
        const float cp = i > 0 ? sCum[(i - 1) * 65 + cb + j] : 0.f;
        const float cl = sCum[31 * 65 + cb + j];
        const float kd = k[j] * (1.f + (a - 1.f) * kac[j]);
        const float kk = kkr[j] * inv;
        const float bb = kk * a;
        bon += r[j] * kd * rkc[j];
        const float em = __expf(-cm), eC = __expf(cl - cm);
        oa[j] = -kk * __expf(cp);
        orr[j] = pq ? 0.f : r[j] * __expf(cm);
        ob[j] = bb * em;
        ok[j] = kd * em;
        BH[swz_idx(cb + j, i)] = f2bf(bb * eC);
        KH[swz_idx(cb + j, i)] = f2bf(kd * eC);
        if (i == 31) gC[cb + j] = __expf(cl);
      }
#pragma unroll
      for (int q = 0; q < 4; q++) {
        VT[swz_idx(cb + 2 * q, i)] = (u16)(vu[q] & 0xffffu);
        VT[swz_idx(cb + 2 * q + 1, i)] = (u16)(vu[q] >> 16);
      }
      *(u32x4*)(AT + i * 72 + cb) = u32x4{pack2(oa[0], oa[1]), pack2(oa[2], oa[3]), pack2(oa[4], oa[5]), pack2(oa[6], oa[7])};
      if (!pq) *(u32x4*)(RT + i * 72 + cb) = u32x4{pack2(orr[0], orr[1]), pack2(orr[2], orr[3]), pack2(orr[4], orr[5]), pack2(orr[6], orr[7])};
      *(u32x4*)(BTl + i * 72 + cb) = u32x4{pack2(ob[0], ob[1]), pack2(ob[2], ob[3]), pack2(ob[4], ob[5]), pack2(ob[6], ob[7])};
      *(u32x4*)(KTl + i * 72 + cb) = u32x4{pack2(ok[0], ok[1]), pack2(ok[2], ok[3]), pack2(ok[4], ok[5]), pack2(ok[6], ok[7])};
      bon = allsum8(bon);
      if (!pq && (tl & 7) == 0) atomicAdd(Bsum + (size_t)tokC * 16 + hd, 0.5f * bon);
      if (more) {
        tokC = tokn0 + (e ? 31 - ci_ : ci_);
        kq = *(const u32x4*)(Kb + (size_t)tokC * 1024 + chg);
        rq = *(const u32x4*)(Rb + (size_t)tokC * 1024 + chg);
        vq = *(const u32x4*)(Vb + (size_t)tokC * 1024 + chg);
      }
    }
    lds_barrier();
    if (!(pq && wave >= 2)) {
      const u16* Am = (wave < 2) ? AT : RT;
      const u16* Bm = (wave & 1) ? KTl : BTl;
      f32x16 acc;
#pragma unroll
      for (int r = 0; r < 16; r++) acc[r] = 0.f;
#pragma unroll
      for (int s = 0; s < 4; s++) acc = MFMA32(lds_norm(Am, 72, qi, s, hh), lds_norm(Bm, 72, qi, s, hh), acc);
      u16* dst = wave == 1 ? MkaT : (wave == 2 ? MbrT : MkrT);
#pragma unroll
      for (int r = 0; r < 16; r++) {
        const int tt = (r & 3) + 8 * (r >> 2) + 4 * hh, j = qi;
        const bool keep = (wave < 2) ? (j < tt) : (j <= tt);
        const float val = keep ? acc[r] : 0.f;
        if (wave == 0) sNN[j * 33 + tt] = val;
        else dst[tt * 40 + j] = f2bf(val);
      }
    }
    if (tl < 32) {
      const int i = tl & 15, base = (tl >> 4) * 16;
      float Tr[16];
#pragma unroll
      for (int q = 0; q < 16; q++) Tr[q] = (q == i) ? 1.f : 0.f;
#pragma unroll
      for (int q = 1; q < 16; q++) {
        float s0 = 0.f, s1 = 0.f, s2 = 0.f, s3 = 0.f;
#pragma unroll
        for (int j = 0; j < q; j++) {
          const float pr = Tr[j] * sNN[(base + j) * 33 + base + q];
          if ((j & 3) == 0) s0 += pr; else if ((j & 3) == 1) s1 += pr; else if ((j & 3) == 2) s2 += pr; else s3 += pr;
        }
        if (q > i) Tr[q] = (s0 + s1) + (s2 + s3);
      }
      float* sT = (tl >> 4) ? sT22 : sT11;
#pragma unroll
      for (int q = 0; q < 16; q++) { sT[i * 17 + q] = Tr[q]; TT[(base + q) * 40 + base + i] = f2bf(Tr[q]); }
    }
    lds_barrier();
    {
      const int i = tl >> 4, q = tl & 15;
      float s = 0.f;
#pragma unroll
      for (int j = 0; j < 16; j++) s += sT11[i * 17 + j] * sNN[j * 33 + 16 + q];
      sWm[i * 17 + q] = s;
      TT[i * 40 + 16 + q] = 0;
    }
    lds_barrier();
    {
      const int i = tl >> 4, q = tl & 15;
      float s = 0.f;
#pragma unroll
      for (int j = 0; j < 16; j++) s += sWm[i * 17 + j] * sT22[j * 17 + q];
      TT[(16 + q) * 40 + i] = f2bf(s);
    }
    lds_barrier();
    if (chainw) {
      const int vrow = rb * 32 + qi;
      b16x8 zb0 = pack8<0>(z0), zb1 = pack8<8>(z0), zb2 = pack8<0>(z1), zb3 = pack8<8>(z1);
      b16x8 vt0 = swz_norm(VT, vrow, 0, hh), vt1 = swz_norm(VT, vrow, 1, hh);
      f32x16 x;
#pragma unroll
      for (int r = 0; r < 16; r++) x[r] = 0.f;
      x = MFMA32(lds_perm(AT, 72, qi, 0, hh), zb0, x);
      x = MFMA32(lds_perm(AT, 72, qi, 1, hh), zb1, x);
      x = MFMA32(lds_perm(AT, 72, qi, 2, hh), zb2, x);
      x = MFMA32(lds_perm(AT, 72, qi, 3, hh), zb3, x);
      if (useV) {
        x = MFMA32(lds_norm(MkaT, 40, qi, 0, hh), vt0, x);
        x = MFMA32(lds_norm(MkaT, 40, qi, 1, hh), vt1, x);
      }
      f32x16 y;
#pragma unroll
      for (int r = 0; r < 16; r++) y[r] = 0.f;
      if (!pq) {
        y = MFMA32(lds_perm(RT, 72, qi, 0, hh), zb0, y);
        y = MFMA32(lds_perm(RT, 72, qi, 1, hh), zb1, y);
        y = MFMA32(lds_perm(RT, 72, qi, 2, hh), zb2, y);
        y = MFMA32(lds_perm(RT, 72, qi, 3, hh), zb3, y);
        y = MFMA32(lds_norm(MkrT, 40, qi, 0, hh), vt0, y);
        y = MFMA32(lds_norm(MkrT, 40, qi, 1, hh), vt1, y);
      }
#pragma unroll
      for (int q = 0; q < 4; q++) {
        float4 g0 = *(const float4*)(gC + 8 * q + 4 * hh), g1 = *(const float4*)(gC + 32 + 8 * q + 4 * hh);
        z0[4 * q] *= g0.x; z0[4 * q + 1] *= g0.y; z0[4 * q + 2] *= g0.z; z0[4 * q + 3] *= g0.w;
        z1[4 * q] *= g1.x; z1[4 * q + 1] *= g1.y; z1[4 * q + 2] *= g1.z; z1[4 * q + 3] *= g1.w;
      }
      if (useV) {
        z0 = MFMA32(swz_norm(KH, qi, 0, hh), vt0, z0);
        z0 = MFMA32(swz_norm(KH, qi, 1, hh), vt1, z0);
        z1 = MFMA32(swz_norm(KH, 32 + qi, 0, hh), vt0, z1);
        z1 = MFMA32(swz_norm(KH, 32 + qi, 1, hh), vt1, z1);
      }
      b16x8 xb0 = pack8<0>(x), xb1 = pack8<8>(x);
      f32x16 u;
#pragma unroll
      for (int r = 0; r < 16; r++) u[r] = 0.f;
      u = MFMA32(lds_perm(TT, 40, qi, 0, hh), xb0, u);
      u = MFMA32(lds_perm(TT, 40, qi, 1, hh), xb1, u);
      b16x8 ub0 = pack8<0>(u), ub1 = pack8<8>(u);
      z0 = MFMA32(swz_perm(BH, qi, 0, hh), ub0, z0);
      z0 = MFMA32(swz_perm(BH, qi, 1, hh), ub1, z0);
      z1 = MFMA32(swz_perm(BH, 32 + qi, 0, hh), ub0, z1);
      z1 = MFMA32(swz_perm(BH, 32 + qi, 1, hh), ub1, z1);
      if (!pq) {
        y = MFMA32(lds_perm(MbrT, 40, qi, 0, hh), ub0, y);
        y = MFMA32(lds_perm(MbrT, 40, qi, 1, hh), ub1, y);
#pragma unroll
        for (int r = 0; r < 16; r++) {
          const int st = (r & 3) + 8 * (r >> 2) + 4 * hh;
          const int tok = tok0 + (e ? 31 - st : st);
          atomicAdd(Ysum + (size_t)tok * 1024 + hd * 64 + vrow, y[r]);
        }
      }
    }
  }
  {
    const int qi = tid & 31, hh = (tid >> 5) & 1;
    if (pq) {
      if (wave < 2) {
#pragma unroll
        for (int r = 0; r < 16; r++) {
          const int k = (r & 3) + 8 * (r >> 2) + 4 * hh;
          J.pout[k * 64 + rb * 32 + qi] = f2bf(z0[r]);
          J.pout[(k + 32) * 64 + rb * 32 + qi] = f2bf(z1[r]);
        }
      } else {
#pragma unroll
        for (int q = 0; q < 4; q++) {
          float* sp = J.qout + (size_t)(rb * 32 + qi) * 64 + 8 * q + 4 * hh;
          *(float4*)sp = make_float4(z0[4 * q], z0[4 * q + 1], z0[4 * q + 2], z0[4 * q + 3]);
          *(float4*)(sp + 32) = make_float4(z1[4 * q], z1[4 * q + 1], z1[4 * q + 2], z1[4 * q + 3]);
        }
      }
    } else if (J.zout && wave < 2) {
#pragma unroll
      for (int q = 0; q < 4; q++) {
        float* sp = J.zout + (size_t)(wave * 32 + qi) * 64 + 8 * q + 4 * hh;
        *(float4*)sp = make_float4(z0[4 * q], z0[4 * q + 1], z0[4 * q + 2], z0[4 * q + 3]);
        *(float4*)(sp + 32) = make_float4(z1[4 * q], z1[4 * q + 1], z1[4 * q + 2], z1[4 * q + 3]);
      }
    }
  }
  __syncthreads();
}

DEV void scan_combine(const Params& p, int seq) {
  const int tid = threadIdx.x, wave = tid >> 6, qi = tid & 31, hh = (tid >> 5) & 1;
  if (wave >= 2) return;
  const int e = seq >> 5, b = (seq >> 4) & 1, hd = seq & 15;
  const float* zin = p.state_rwkv + ((size_t)(b * 2 + e) * 16 + hd) * 4096;
  f32x16 z0, z1;
#pragma unroll
  for (int q = 0; q < 4; q++) {
    const float* sp = zin + (size_t)(wave * 32 + qi) * 64 + 8 * q + 4 * hh;
    float4 v0 = *(const float4*)sp, v1 = *(const float4*)(sp + 32);
    z0[4 * q] = v0.x; z0[4 * q + 1] = v0.y; z0[4 * q + 2] = v0.z; z0[4 * q + 3] = v0.w;
    z1[4 * q] = v1.x; z1[4 * q + 1] = v1.y; z1[4 * q + 2] = v1.z; z1[4 * q + 3] = v1.w;
  }
#pragma unroll 1
  for (int g = 0; g < 7; g++) {
    const u16* P = (const u16*)(p.ws + OFF_SEGP) + (size_t)(seq * 7 + g) * 4096;
    const float* Q = (const float*)(p.ws + OFF_SEGQ) + (size_t)(seq * 7 + g) * 4096;
    b16x8 zb[4] = {pack8<0>(z0), pack8<8>(z0), pack8<0>(z1), pack8<8>(z1)};
    f32x16 n0, n1;
#pragma unroll
    for (int q = 0; q < 4; q++) {
      const float* sp = Q + (size_t)(wave * 32 + qi) * 64 + 8 * q + 4 * hh;
      float4 v0 = *(const float4*)sp, v1 = *(const float4*)(sp + 32);
      n0[4 * q] = v0.x; n0[4 * q + 1] = v0.y; n0[4 * q + 2] = v0.z; n0[4 * q + 3] = v0.w;
      n1[4 * q] = v1.x; n1[4 * q + 1] = v1.y; n1[4 * q + 2] = v1.z; n1[4 * q + 3] = v1.w;
    }
#pragma unroll
    for (int s = 0; s < 4; s++) {
      const u16* r0 = P + (size_t)qi * 64 + 16 * s + 4 * hh;
      const u16* r1 = P + (size_t)(32 + qi) * 64 + 16 * s + 4 * hh;
      uint2 a = *(const uint2*)r0, c = *(const uint2*)(r0 + 8), d = *(const uint2*)r1, f = *(const uint2*)(r1 + 8);
      u32x4 fa = {a.x, a.y, c.x, c.y}, fb = {d.x, d.y, f.x, f.y};
      n0 = MFMA32(*(b16x8*)&fa, zb[s], n0);
      n1 = MFMA32(*(b16x8*)&fb, zb[s], n1);
    }
    z0 = n0; z1 = n1;
    float* zs = (float*)(p.ws + OFF_SEGZ) + (size_t)(seq * 7 + g) * 4096;
#pragma unroll
    for (int q = 0; q < 4; q++) {
      float* sp = zs + (size_t)(wave * 32 + qi) * 64 + 8 * q + 4 * hh;
      *(float4*)sp = make_float4(z0[4 * q], z0[4 * q + 1], z0[4 * q + 2], z0[4 * q + 3]);
      *(float4*)(sp + 32) = make_float4(z1[4 * q], z1[4 * q + 1], z1[4 * q + 2], z1[4 * q + 3]);
    }
  }
}

DEV ScanJob ctx_job(const Params& p, int v) {
  ScanJob J;
  J.e = v >> 9; J.b = (v >> 4) & 31; J.hd = v & 15; J.tb = J.b * 256; J.L = 256; J.step0 = 0; J.nch = 8; J.pq = 0;
  J.zin = nullptr; J.zout = p.out + OUT_ST + ((size_t)(J.b * 2 + J.e) * 16 + J.hd) * 4096; J.pout = nullptr; J.qout = nullptr;
  J.ncomb = 0; J.seq = 0;
  return J;
}
DEV ScanJob smp_job(const Params& p, int seq, int g, int pq) {
  ScanJob J;
  J.e = seq >> 5; J.b = (seq >> 4) & 1; J.hd = seq & 15; J.tb = T_CTX + J.b * 4096; J.L = 4096; J.step0 = g * 512; J.nch = 16; J.pq = pq;
  J.zin = p.state_rwkv + ((size_t)(J.b * 2 + J.e) * 16 + J.hd) * 4096;
  J.ncomb = pq ? 0 : g; J.seq = seq;
  J.zout = nullptr;
  J.pout = (u16*)(p.ws + OFF_SEGP) + (size_t)(seq * 7 + g) * 4096;
  J.qout = (float*)(p.ws + OFF_SEGQ) + (size_t)(seq * 7 + g) * 4096;
  return J;
}

DEV void p8a_scan(const Params& p, char* smem) {
  if (blockIdx.x < 448) {
    for (int j = blockIdx.x; j < 448; j += 448) scan_job(p, smp_job(p, j / 7, j % 7, 1), smem);
  } else {
    {
      float4* ys = (float4*)(p.ws + OFF_YSUM);
      float4* bs = (float4*)(p.ws + OFF_BSUM);
      const size_t gt = (size_t)(blockIdx.x - 448) * 256 + threadIdx.x, gs = (size_t)(gridDim.x - 448) * 256;
      for (size_t i = gt; i < 4194304; i += gs) ys[i] = make_float4(0, 0, 0, 0);
      for (size_t i = gt; i < 65536; i += gs) bs[i] = make_float4(0, 0, 0, 0);
    }
    for (int q = blockIdx.x - 448; q < 1024; q += gridDim.x - 448) {
      int mt = q >> 3, nt = q & 7, m0 = mt * 128, n0 = nt * 128;
      u16* sz = (u16*)(p.ws + OFF_SZ) + (size_t)m0 * 1024 + n0;
      gemm_tile<false>((const u16*)(p.ws + OFF_HG) + (size_t)m0 * 128, 128, nullptr, m0, (const u16*)(p.ws + OFF_G2T) + (size_t)n0 * 128, 128, 128,
                       EpGate{sz, sz, 1024}, smem);
    }
  }
}
DEV void p8b_scan(const Params& p, char* smem) {
  if (blockIdx.x < 64) scan_combine(p, blockIdx.x);
}
DEV void p8c_scan(const Params& p, char* smem) {
  for (int j = blockIdx.x; j < 512 + 1024; j += gridDim.x) {
    if (j < 512) scan_job(p, smp_job(p, j >> 3, j & 7, 0), smem);
    else scan_job(p, ctx_job(p, j - 512), smem);
  }
}

DEV void p9_post(const Params& p) {
  const int lane = threadIdx.x & 63;
  const int gw = blockIdx.x * 4 + (threadIdx.x >> 6), nw = gridDim.x * 4;
  const float* Ysum = (const float*)(p.ws + OFF_YSUM);
  const float* Bsum = (const float*)(p.ws + OFF_BSUM);
  for (int row = gw; row < 16384; row += nw) {
    const size_t o = (size_t)row * 1024 + lane * 16;
    float y[16];
#pragma unroll
    for (int i = 0; i < 4; i++) { float4 v = *(const float4*)(Ysum + o + 4 * i); y[4 * i] = v.x; y[4 * i + 1] = v.y; y[4 * i + 2] = v.z; y[4 * i + 3] = v.w; }
    float s = 0;
#pragma unroll
    for (int i = 0; i < 16; i++) s += y[i];
    s += __shfl_xor(s, 1); s += __shfl_xor(s, 2);
    float mean = s * (1.f / 64.f), q = 0;
#pragma unroll
    for (int i = 0; i < 16; i++) { float d = y[i] - mean; q += d * d; }
    q += __shfl_xor(q, 1); q += __shfl_xor(q, 2);
    float rstd = rsqrtf(q * (1.f / 64.f) + 64e-5f);
    float bon = Bsum[(size_t)row * 16 + (lane >> 2)];
    u16* O = (u16*)(p.ws + OFF_U1) + o;
    const u16* V = (const u16*)(p.ws + OFF_V2) + o;
    const u16* Z = (const u16*)(p.ws + OFF_SZ) + o;
#pragma unroll
    for (int hlf = 0; hlf < 2; hlf++) {
      uint4 vq = *(const uint4*)(V + 8 * hlf), zq = *(const uint4*)(Z + 8 * hlf);
      const unsigned vu[4] = {vq.x, vq.y, vq.z, vq.w}, zu[4] = {zq.x, zq.y, zq.z, zq.w};
      unsigned ow[4];
#pragma unroll
      for (int w = 0; w < 4; w++) {
        int c = lane * 16 + hlf * 8 + 2 * w;
        float y0 = (y[hlf * 8 + 2 * w] - mean) * rstd * p.lnx_g[c] + p.lnx_b[c] + bon * bflo(vu[w]);
        float y1 = (y[hlf * 8 + 2 * w + 1] - mean) * rstd * p.lnx_g[c + 1] + p.lnx_b[c + 1] + bon * bfhi(vu[w]);
        ow[w] = pack2(y0 * bflo(zu[w]), y1 * bfhi(zu[w]));
      }
      *(uint4*)(O + 8 * hlf) = make_uint4(ow[0], ow[1], ow[2], ow[3]);
    }
  }
}


#define XB_TMO 128
#define XB_XCNT(j) (256 + 64 * (j))
#define XB_XSUB(j) (1280 + 64 * (j))
#define XB_XGEN(j) (2304 + 64 * (j))
#define XB_TOP 3328
#define XB_TOPGEN 3392
#define XCD_BAR_WORDS 3456
#define XB_SPIN_CAP (1u << 22)
#define LAS __attribute__((address_space(3)))
DEV unsigned xb_ld(unsigned* p) { return __hip_atomic_load(p, __ATOMIC_RELAXED, __HIP_MEMORY_SCOPE_AGENT); }
DEV unsigned xb_add(unsigned* p, unsigned v) { return __hip_atomic_fetch_add(p, v, __ATOMIC_RELAXED, __HIP_MEMORY_SCOPE_AGENT); }
DEV unsigned xb_xcc_id() { return (unsigned)__builtin_amdgcn_s_getreg((3 << 11) | 20) & 0xFu; }
#define XB_SPIN(cond, bar) do { unsigned _sp = 0; while (cond) { __builtin_amdgcn_s_sleep(4); \
    if ((++_sp & 255u) == 0u) { if (xb_ld(&(bar)[XB_TMO])) break; if (_sp > XB_SPIN_CAP) { atomicAdd(&(bar)[XB_TMO], 1u); break; } } } } while (0)
struct XcdBarrier { unsigned* bar; unsigned x; volatile LAS unsigned* st; };
DEV XcdBarrier xcd_barrier_post(unsigned* bar, volatile LAS unsigned* st) {
  XcdBarrier b; b.bar = bar; b.x = xb_xcc_id(); b.st = st;
  if (threadIdx.x == 0) (void)xb_add(&bar[XB_XCNT(b.x)], 1u);
  return b;
}
DEV void xcd_barrier_complete(unsigned* bar, unsigned x, unsigned& nloc, unsigned& nx) {
  const unsigned G = gridDim.x * gridDim.y * gridDim.z;
  unsigned sum, cnt, mine, sp = 0u;
  for (;;) {
    sum = 0u; cnt = 0u; mine = 0u;
#pragma unroll
    for (unsigned j = 0; j < 16; ++j) { const unsigned c = xb_ld(&bar[XB_XCNT(j)]); sum += c; cnt += (c > 0u) ? 1u : 0u; mine = (j == x) ? c : mine; }
    if (sum == G) break;
    __builtin_amdgcn_s_sleep(1);
    if ((++sp & 255u) == 0u) { if (xb_ld(&bar[XB_TMO])) break; if (sp > XB_SPIN_CAP) { atomicAdd(&bar[XB_TMO], 1u); break; } }
  }
  nloc = mine > 0u ? mine : 1u; nx = cnt > 0u ? cnt : 1u;
}
DEV void xcd_barrier(const XcdBarrier& b) {
  asm volatile("s_waitcnt vmcnt(0)" ::: "memory");
  __syncthreads();
  if (threadIdx.x == 0) {
    unsigned* bar = b.bar;
    __builtin_amdgcn_s_waitcnt(0);
    unsigned nloc = b.st[0], nx = b.st[1];
    if (nloc == 0u) { xcd_barrier_complete(bar, b.x, nloc, nx); b.st[0] = nloc; b.st[1] = nx; }
    const unsigned old = xb_add(&bar[XB_XSUB(b.x)], 1u);
    const unsigned gen = old / nloc;
    if (old + 1u == (gen + 1u) * nloc) {
      __builtin_amdgcn_fence(__ATOMIC_RELEASE, "agent");
      asm volatile("s_waitcnt vmcnt(0)" ::: "memory");
      const unsigned og = xb_add(&bar[XB_TOP], 1u);
      const unsigned tg = og / nx;
      if (og + 1u == (tg + 1u) * nx) xb_add(&bar[XB_TOPGEN], 1u);
      else XB_SPIN(xb_ld(&bar[XB_TOPGEN]) == tg, bar);
      __builtin_amdgcn_fence(__ATOMIC_ACQUIRE, "agent");
      xb_add(&bar[XB_XGEN(b.x)], 1u);
      asm volatile("s_waitcnt vmcnt(0)" ::: "memory");
    } else {
      XB_SPIN(xb_ld(&bar[XB_XGEN(b.x)]) == gen, bar);
      __builtin_amdgcn_fence(__ATOMIC_ACQUIRE, "agent");
      asm volatile("s_waitcnt vmcnt(0)" ::: "memory");
    }
  }
  __syncthreads();
}

__global__ void __launch_bounds__(256, 2) fwd_kernel(Params p) {
  __shared__ __attribute__((aligned(16))) char smem[73728];
#if FUSED
  __shared__ unsigned xb_st[4];
  if (threadIdx.x < 4) xb_st[threadIdx.x] = 0u;
  __syncthreads();
  const XcdBarrier xb = xcd_barrier_post((unsigned*)(p.ws + OFF_BAR), (volatile LAS unsigned*)xb_st);
  if (p.phase_hi > 1000) cg::this_grid().sync();
#define SYNC() xcd_barrier(xb)
#else
#define SYNC()
#endif
#define PH(n, call) if (p.phase_lo <= n && n <= p.phase_hi) { call; if (n < p.phase_hi) { SYNC(); } }
  PH(0, p0_prep(p, smem))
  PH(1, ln_phase<0>(p))
  PH(2, p2_gemm1(p, smem))
  PH(3, p3_mix(p, smem))
  PH(4, p3b_fold(p))
  PH(5, p4_fnet(p, smem))
  PH(6, p_outproj<0>(p, smem))
  PH(7, ln_phase<1>(p))
  PH(8, p6b_dx(p))
  PH(9, p7_rwkv_proj(p, smem))
  PH(10, p8a_scan(p, smem))
  PH(11, p8c_scan(p, smem))
  PH(12, p9_post(p))
  PH(13, p_outproj<1>(p, smem))
  PH(14, ln_phase<2>(p))
}

extern "C" void kernel_launch(void* const* d_in, const int* in_sizes, int n_in, void* d_out, int out_size, void* d_ws,
                              size_t ws_size, hipStream_t stream) {
  Params p;
  memset(&p, 0, sizeof(p));
  const float* const* in = (const float* const*)d_in;
  p.x_prompt = in[0]; p.x_sample = in[1]; p.cache_k = in[2]; p.cache_v = in[3]; p.state_rwkv = in[4]; p.c = in[5]; p.c_ctx = in[6];
  p.ada_w = in[7]; p.ada_b = in[8]; p.post_g = in[9]; p.post_b = in[10]; p.w_in = in[11]; p.w_fnet = in[12]; p.rpb = in[13]; p.w_out = in[14];
  p.mu = in[15]; p.rkvz = in[16]; p.w0 = in[17]; p.w1 = in[18]; p.w2 = in[19]; p.a0 = in[20]; p.a1 = in[21]; p.a2 = in[22];
  p.g1 = in[23]; p.g2 = in[24]; p.k_k = in[25]; p.k_a = in[26]; p.r_k = in[27]; p.lnx_g = in[28]; p.lnx_b = in[29]; p.rw_out = in[30];
  p.out = (float*)d_out; p.ws = (char*)d_ws;
  char* ws = (char*)d_ws;
  int n = 0, start = 0;
  auto add = [&](const float* src, size_t dstoff, int lds, int ldd, int tk, int tn) {
    p.tj[n].src = src; p.tj[n].dst = (u16*)(ws + dstoff); p.tj[n].lds = lds; p.tj[n].ldd = ldd; p.tj[n].tk = tk; p.tj[n].tn = tn;
    p.tj[n].start = start; p.tj[n].pad = 0; start += tk * tn; n++;
  };
  add(p.w_in, OFF_WINT, 3072, 1024, 16, 48);
  add(p.w_out, OFF_WOUTT, 1024, 1024, 16, 16);
  for (int i = 0; i < 4; i++) add(p.rkvz + (size_t)i * 1048576, OFF_RKVZT + (size_t)i * 2097152, 1024, 1024, 16, 16);
  add(p.rw_out, OFF_RWOUTT, 1024, 1024, 16, 16);
  for (int e = 0; e < 2; e++) add(p.w1 + e * 65536, OFF_W1T + (size_t)e * 64 * 1024 * 2, 64, 1024, 16, 1);
  for (int e = 0; e < 2; e++) add(p.a1 + e * 65536, OFF_A1T + (size_t)e * 64 * 1024 * 2, 64, 1024, 16, 1);
  add(p.g1, OFF_G1T, 128, 1024, 16, 2);
  for (int e = 0; e < 2; e++) add(p.w2 + e * 65536, OFF_W2T + (size_t)e * 65536 * 2, 1024, 64, 1, 16);
  for (int e = 0; e < 2; e++) add(p.a2 + e * 65536, OFF_A2T + (size_t)e * 65536 * 2, 1024, 64, 1, 16);
  add(p.g2, OFF_G2T, 1024, 128, 2, 16);
  for (int b = 0; b < 2; b++)
    for (int h = 0; h < 8; h++) add(p.cache_v + (size_t)b * 262144 + h * 64, OFF_CVT + (size_t)(b * 8 + h) * 64 * 512 * 2, 512, 512, 8, 1);
  p.ntr = start;

  static int grid_blocks = 0;
  if (!grid_blocks) {
    int dev = 0, cus = 0, per_cu = 0;
    (void)hipGetDevice(&dev);
    (void)hipDeviceGetAttribute(&cus, hipDeviceAttributeMultiprocessorCount, dev);
    (void)hipOccupancyMaxActiveBlocksPerMultiprocessor(&per_cu, fwd_kernel, 256, 0);
    if (per_cu > 2) per_cu = 2;
    if (per_cu < 1) per_cu = 1;
    grid_blocks = cus * per_cu;
  }
#if FUSED
  p.phase_lo = 0; p.phase_hi = 14;
  void* args[] = {&p};
  (void)hipMemsetAsync((char*)d_ws + OFF_BAR, 0, 16384, stream);
  hipError_t e = hipLaunchCooperativeKernel((void*)fwd_kernel, dim3(grid_blocks), dim3(256), args, 0, stream);
  if (e != hipSuccess) fprintf(stderr, "cooperative launch failed: %s (grid %d)\n", hipGetErrorString(e), grid_blocks);
#else
#ifndef PROBE_SEQ
#define PROBE_SEQ 0,1,2,3,4,5,6,7,8,9,10,11,12,13,14
#endif
  const int seq[] = {PROBE_SEQ};
  for (int i = 0; i < (int)(sizeof(seq) / sizeof(int)); i++) {
    p.phase_lo = seq[i]; p.phase_hi = seq[i];
    fwd_kernel<<<grid_blocks, 256, 0, stream>>>(p);
  }
#endif
}
```
